# Optimizing an MI355X kernel written in HIP

```python
import math
import jax, jax.numpy as jnp
from jax import lax
import numpy as np

D_MODEL = 1024
BATCH = 8
SEQ = 2048
DEPTH = 4
DEC_BATCH = 128
DEC_SEQ = 4
PAST_LEN = 8192
PAGE_SIZE = 128

N_MIXERS = 2
N_DELTA_LAYERS = (DEPTH + 1) // 2
N_SWA_LAYERS = DEPTH // 2

DN_QK_HEADS = 8
DN_V_HEADS = 16
DN_V_PER_QK = DN_V_HEADS // DN_QK_HEADS
DN_HEAD_K = 128
DN_HEAD_V = 128
DN_KEY_DIM = DN_QK_HEADS * DN_HEAD_K
DN_VAL_DIM = DN_V_HEADS * DN_HEAD_V
DN_CONV_DIM = 2 * DN_KEY_DIM + DN_VAL_DIM
DN_CONV = 4
DN_CHUNK = 64
DN_IN_DIM = DN_CONV_DIM + DN_VAL_DIM + 2 * DN_V_HEADS

SWA_HEADS = 16
SWA_KV_HEADS = 4
SWA_GROUPS = SWA_HEADS // SWA_KV_HEADS
SWA_HEAD_DIM = 64
SWA_QKV_DIM = (SWA_HEADS + 2 * SWA_KV_HEADS) * SWA_HEAD_DIM
SWA_SCALE = SWA_HEAD_DIM ** -0.5
WINDOW = 128

D_FF = -(-8 * D_MODEL // (3 * 256)) * 256

RMS_EPS = 1e-6
L2_EPS = 1e-6

kernel_name = "hybrid_gdn_swa_sink_alibi_step"


def rmsnorm(x, w):
    xf = x.astype(jnp.float32)
    y = xf * lax.rsqrt(jnp.mean(xf * xf, -1, keepdims=True) + RMS_EPS)
    return (y * w.astype(jnp.float32)).astype(x.dtype)


def l2norm(x):
    return x * lax.rsqrt(jnp.sum(x * x, -1, keepdims=True) + L2_EPS)


def swiglu(h, w_gu, w_down):
    gu = h @ w_gu
    return (jax.nn.silu(gu[..., :D_FF]) * gu[..., D_FF:]) @ w_down


def short_conv(u, buf, w):
    L = u.shape[1]
    full = jnp.concatenate([buf.astype(u.dtype), u], 1)
    y = sum(full[:, k:k + L] * w[k] for k in range(DN_CONV))
    return jax.nn.silu(y), full[:, L:]


def gated_delta_chunked(q, k, v, g, beta, s0):
    B, L, H, DK = q.shape
    C = min(DN_CHUNK, L)
    pad = (-L) % C
    if pad:
        pw = ((0, 0), (0, pad), (0, 0), (0, 0))
        q, k, v = jnp.pad(q, pw), jnp.pad(k, pw), jnp.pad(v, pw)
        g, beta = jnp.pad(g, pw[:3]), jnp.pad(beta, pw[:3])
    N = (L + pad) // C

    def blk(t):
        return jnp.moveaxis(t.reshape((B, N, C) + t.shape[2:]), 3, 1)

    q, k, v, g, beta = blk(q), blk(k), blk(v), blk(g), blk(beta)
    G = jnp.cumsum(g, -1)
    idx = jnp.arange(C)
    causal = idx[:, None] >= idx[None, :]
    strict = idx[:, None] > idx[None, :]
    diff = G[..., :, None] - G[..., None, :]
    decay = jnp.where(causal, jnp.exp(jnp.where(causal, diff, 0.0)), 0.0)
    kb = k * beta[..., None]
    Bm = jnp.where(strict, jnp.einsum('bhncd,bhnsd->bhncs', kb, k) * decay, 0.0)
    M = -Bm
    T = jnp.eye(C, dtype=jnp.float32) + M
    Mp = M
    for _ in range(1, max(1, (C - 1).bit_length())):
        Mp = Mp @ Mp
        T = T + T @ Mp
    u = jnp.einsum('bhncs,bhnse->bhnce', T, v * beta[..., None])
    w = jnp.einsum('bhncs,bhnsd->bhncd', T, kb * jnp.exp(G)[..., None])
    aqk = jnp.einsum('bhncd,bhnsd->bhncs', q, k) * decay

    def step(S, xs):
        qc, kc, uc, wc, Gc, ac = xs
        unew = uc - jnp.einsum('bhcd,bhde->bhce', wc, S)
        o = (jnp.einsum('bhcd,bhde->bhce', qc * jnp.exp(Gc)[..., None], S)
             + jnp.einsum('bhcs,bhse->bhce', ac, unew))
        Gl = Gc[..., -1:]
        S = S * jnp.exp(Gl)[..., None] + jnp.einsum('bhcd,bhce->bhde', kc * jnp.exp(Gl - Gc)[..., None], unew)
        return S, o

    xs = tuple(jnp.moveaxis(t, 2, 0) for t in (q, k, u, w, G, aqk))
    s_new, o = lax.scan(step, s0, xs)
    o = jnp.transpose(o, (1, 0, 3, 2, 4)).reshape(B, N * C, H, -1)[:, :L]
    return o, s_new


def deltanet_mixer(h, conv_buf, s0, w_in, conv_w, a_log, dt_bias, norm_w, w_out):
    B, L, _ = h.shape
    f32 = jnp.float32
    proj = h @ w_in
    o1 = DN_CONV_DIM
    o2 = o1 + DN_VAL_DIM
    o3 = o2 + DN_V_HEADS
    qkv, new_buf = short_conv(proj[..., :o1], conv_buf, conv_w)
    z, b, a = proj[..., o1:o2], proj[..., o2:o3], proj[..., o3:]
    qkv = qkv.astype(f32)
    q = qkv[..., :DN_KEY_DIM].reshape(B, L, DN_QK_HEADS, DN_HEAD_K)
    k = qkv[..., DN_KEY_DIM:2 * DN_KEY_DIM].reshape(B, L, DN_QK_HEADS, DN_HEAD_K)
    v = qkv[..., 2 * DN_KEY_DIM:].reshape(B, L, DN_V_HEADS, DN_HEAD_V)
    q = jnp.repeat(l2norm(q) * DN_HEAD_K ** -0.5, DN_V_PER_QK, axis=2)
    k = jnp.repeat(l2norm(k), DN_V_PER_QK, axis=2)
    beta = jax.nn.sigmoid(b.astype(f32))
    g = -jnp.exp(a_log.astype(f32)) * jax.nn.softplus(a.astype(f32) + dt_bias.astype(f32))
    o, s_new = gated_delta_chunked(q, k, v, g, beta, s0.astype(f32))
    o = o * lax.rsqrt(jnp.mean(o * o, -1, keepdims=True) + RMS_EPS) * norm_w.astype(f32)
    o = o * jax.nn.silu(z.astype(f32).reshape(B, L, DN_V_HEADS, DN_HEAD_V))
    out = o.reshape(B, L, DN_VAL_DIM).astype(h.dtype) @ w_out
    return out, new_buf, s_new


def alibi_slopes():
    s = 2.0 ** (-8.0 * np.arange(1, SWA_HEADS + 1) / SWA_HEADS)
    return jnp.asarray(s, dtype=jnp.float32).reshape(SWA_KV_HEADS, SWA_GROUPS, 1, 1)


def swa_project(h, w_qkv, b_qkv):
    B, L, _ = h.shape
    qkv = h @ w_qkv + b_qkv
    nq = SWA_HEADS * SWA_HEAD_DIM
    nk = SWA_KV_HEADS * SWA_HEAD_DIM
    q = qkv[..., :nq].reshape(B, L, SWA_KV_HEADS, SWA_GROUPS, SWA_HEAD_DIM)
    k = qkv[..., nq:nq + nk].reshape(B, L, SWA_KV_HEADS, SWA_HEAD_DIM)
    v = qkv[..., nq + nk:].reshape(B, L, SWA_KV_HEADS, SWA_HEAD_DIM)
    return q, k, v


def sink_probs(s, rel, mask, sinks):
    s = s.astype(jnp.float32) * SWA_SCALE - alibi_slopes() * rel.astype(jnp.float32)
    s = jnp.where(mask, s, -jnp.inf)
    sk = sinks.astype(jnp.float32).reshape(SWA_KV_HEADS, SWA_GROUPS, 1, 1)
    m = jnp.maximum(jnp.max(s, -1, keepdims=True), sk)
    p = jnp.exp(s - m)
    return p / (jnp.sum(p, -1, keepdims=True) + jnp.exp(sk - m))


def swa_prompt(h, w_qkv, b_qkv, sinks, w_o, b_o):
    B, L, _ = h.shape
    q, k, v = swa_project(h, w_qkv, b_qkv)
    W = WINDOW
    pad = (-L) % W
    qp, kp, vp = q, k, v
    if pad:
        qp = jnp.pad(q, ((0, 0), (0, pad), (0, 0), (0, 0), (0, 0)))
        kp = jnp.pad(k, ((0, 0), (0, pad), (0, 0), (0, 0)))
        vp = jnp.pad(v, ((0, 0), (0, pad), (0, 0), (0, 0)))
    nb = (L + pad) // W
    qb = qp.reshape(B, nb, W, SWA_KV_HEADS, SWA_GROUPS, SWA_HEAD_DIM)
    kb = kp.reshape(B, nb, W, SWA_KV_HEADS, SWA_HEAD_DIM)
    vb = vp.reshape(B, nb, W, SWA_KV_HEADS, SWA_HEAD_DIM)
    prev = lambda t: jnp.concatenate([jnp.zeros_like(t[:, :1]), t[:, :-1]], 1)
    kk = jnp.concatenate([prev(kb), kb], 2)
    vv = jnp.concatenate([prev(vb), vb], 2)
    s = jnp.einsum('bnqkgd,bnskd->bnkgqs', qb, kk)
    i = jnp.arange(W)[:, None]
    j = jnp.arange(2 * W)[None, :]
    rel = W + i - j
    band = (rel >= 0) & (rel <= WINDOW)
    blkid = jnp.arange(nb)[:, None, None]
    mask = band[None] & ((blkid > 0) | (j[None] >= W))
    p = sink_probs(s, rel, mask[None, :, None, None], sinks).astype(vv.dtype)
    o = jnp.einsum('bnkgqs,bnskd->bnqkgd', p, vv).reshape(B, nb * W, SWA_HEADS * SWA_HEAD_DIM)[:, :L]
    R = min(WINDOW, L)
    return o @ w_o + b_o, k[:, L - R:], v[:, L - R:]


def swa_sample(h, cache_k, cache_v, w_qkv, b_qkv, sinks, w_o, b_o):
    B, L, _ = h.shape
    q, k, v = swa_project(h, w_qkv, b_qkv)
    R = cache_k.shape[1]
    kk = jnp.concatenate([cache_k.astype(k.dtype), k], 1)
    vv = jnp.concatenate([cache_v.astype(v.dtype), v], 1)
    s = jnp.einsum('bqkgd,bskd->bkgqs', q, kk)
    rel = (R + jnp.arange(L))[:, None] - jnp.arange(R + L)[None, :]
    mask = (rel >= 0) & (rel <= WINDOW)
    p = sink_probs(s, rel, mask, sinks).astype(vv.dtype)
    o = jnp.einsum('bkgqs,bskd->bqkgd', p, vv).reshape(B, L, SWA_HEADS * SWA_HEAD_DIM)
    return o @ w_o + b_o, k, v


def setup_inputs(seed: int = 0) -> dict:
    key = jax.random.key(seed)
    ks = jax.random.split(key, 26)
    f32 = jnp.float32
    nrm = lambda k, shape, scale: jax.random.normal(k, shape, f32) * scale
    NA, NB = N_DELTA_LAYERS, N_SWA_LAYERS
    cache_rows = min(WINDOW, PAST_LEN)
    dt = jnp.exp(jax.random.uniform(ks[13], (NA, DN_V_HEADS), f32, math.log(1e-3), math.log(1e-1)))
    return {
        "x_prompt": nrm(ks[0], (BATCH, SEQ, D_MODEL), 1.0),
        "x_sample": nrm(ks[1], (DEC_BATCH, DEC_SEQ, D_MODEL), 1.0),
        "state_conv": nrm(ks[2], (NA, DEC_BATCH, DN_CONV - 1, DN_CONV_DIM), 1.0),
        "state_delta": nrm(ks[3], (NA, DEC_BATCH, DN_V_HEADS, DN_HEAD_K, DN_HEAD_V), 0.5),
        "cache_k": nrm(ks[4], (NB, DEC_BATCH, cache_rows, SWA_KV_HEADS, SWA_HEAD_DIM), 1.0),
        "cache_v": nrm(ks[5], (NB, DEC_BATCH, cache_rows, SWA_KV_HEADS, SWA_HEAD_DIM), 1.0),
        "norm_mix": 1.0 + nrm(ks[6], (DEPTH, D_MODEL), 0.05),
        "norm_ffn": 1.0 + nrm(ks[7], (DEPTH, D_MODEL), 0.05),
        "norm_final": 1.0 + nrm(ks[8], (D_MODEL,), 0.05),
        "dn_w_in": nrm(ks[9], (NA, D_MODEL, DN_IN_DIM), D_MODEL ** -0.5),
        "dn_conv_w": nrm(ks[10], (NA, DN_CONV, DN_CONV_DIM), DN_CONV ** -0.5),
        "dn_a_log": jnp.log(jax.random.uniform(ks[11], (NA, DN_V_HEADS), f32, 1.0, 16.0)),
        "dn_dt_bias": dt + jnp.log(-jnp.expm1(-dt)),
        "dn_norm_w": 1.0 + nrm(ks[12], (NA, DN_HEAD_V), 0.05),
        "dn_w_out": nrm(ks[14], (NA, DN_VAL_DIM, D_MODEL), DN_VAL_DIM ** -0.5),
        "swa_w_qkv": nrm(ks[15], (NB, D_MODEL, SWA_QKV_DIM), D_MODEL ** -0.5),
        "swa_b_qkv": nrm(ks[16], (NB, SWA_QKV_DIM), 0.02),
        "swa_sinks": nrm(ks[17], (NB, SWA_HEADS), 1.0),
        "swa_w_o": nrm(ks[18], (NB, SWA_HEADS * SWA_HEAD_DIM, D_MODEL), (SWA_HEADS * SWA_HEAD_DIM) ** -0.5),
        "swa_b_o": nrm(ks[19], (NB, D_MODEL), 0.02),
        "ffn_w_gu": nrm(ks[20], (DEPTH, D_MODEL, 2 * D_FF), D_MODEL ** -0.5),
        "ffn_w_down": nrm(ks[21], (DEPTH, D_FF, D_MODEL), D_FF ** -0.5),
    }


def reference(x_prompt, x_sample, state_conv, state_delta, cache_k, cache_v,
              norm_mix, norm_ffn, norm_final,
              dn_w_in, dn_conv_w, dn_a_log, dn_dt_bias, dn_norm_w, dn_w_out,
              swa_w_qkv, swa_b_qkv, swa_sinks, swa_w_o, swa_b_o,
              ffn_w_gu, ffn_w_down):
    yp, ys = x_prompt, x_sample
    conv_p, delta_p, kp_list, vp_list = [], [], [], []
    conv_s, delta_s, ks_list, vs_list = [], [], [], []
    Bp = x_prompt.shape[0]
    for i in range(DEPTH):
        j = i // N_MIXERS
        hp = rmsnorm(yp, norm_mix[i])
        hs = rmsnorm(ys, norm_mix[i])
        if i % N_MIXERS == 0:
            wts = (dn_w_in[j], dn_conv_w[j], dn_a_log[j], dn_dt_bias[j], dn_norm_w[j], dn_w_out[j])
            buf0 = jnp.zeros((Bp, DN_CONV - 1, DN_CONV_DIM), hp.dtype)
            s00 = jnp.zeros((Bp, DN_V_HEADS, DN_HEAD_K, DN_HEAD_V), jnp.float32)
            op, cbp, sp = deltanet_mixer(hp, buf0, s00, *wts)
            os_, cbs, ss = deltanet_mixer(hs, state_conv[j], state_delta[j], *wts)
            conv_p.append(cbp.astype(state_conv.dtype))
            delta_p.append(sp.astype(state_delta.dtype))
            conv_s.append(cbs.astype(state_conv.dtype))
            delta_s.append(ss.astype(state_delta.dtype))
        else:
            wts = (swa_w_qkv[j], swa_b_qkv[j], swa_sinks[j], swa_w_o[j], swa_b_o[j])
            op, kpn, vpn = swa_prompt(hp, *wts)
            os_, ksn, vsn = swa_sample(hs, cache_k[j], cache_v[j], *wts)
            kp_list.append(kpn.astype(cache_k.dtype))
            vp_list.append(vpn.astype(cache_v.dtype))
            ks_list.append(ksn.astype(cache_k.dtype))
            vs_list.append(vsn.astype(cache_v.dtype))
        yp = yp + op
        ys = ys + os_
        yp = yp + swiglu(rmsnorm(yp, norm_ffn[i]), ffn_w_gu[i], ffn_w_down[i])
        ys = ys + swiglu(rmsnorm(ys, norm_ffn[i]), ffn_w_gu[i], ffn_w_down[i])
    y_prompt = rmsnorm(yp, norm_final)
    y_sample = rmsnorm(ys, norm_final)
    return (y_prompt, y_sample,
            jnp.stack(conv_p), jnp.stack(delta_p), jnp.stack(kp_list), jnp.stack(vp_list),
            jnp.stack(conv_s), jnp.stack(delta_s), jnp.stack(ks_list), jnp.stack(vs_list))
```

```cpp
#include <hip/hip_runtime.h>
#include <cstdio>
#include <cstdint>
namespace pg8 {
#define PG8_LAS __attribute__((address_space(3)))
typedef unsigned short bf16_t;
typedef short bf16x8 __attribute__((ext_vector_type(8)));
typedef float f32x4 __attribute__((ext_vector_type(4)));
typedef unsigned u32x4 __attribute__((ext_vector_type(4)));
constexpr int BM = 256, BK = 64, HALF = 128, HTB = HALF * BK * 2  , STAGE_BYTES = 8 * HTB, NXCD = 8, WGM = 8;

__host__ __device__ __forceinline__ int lds_byte(int r, int c) { const int st = (r >> 4) * 2 + (c >> 5), rr = r & 15, cc = c & 31, ob = rr * 64 + cc * 2; return st * 1024 + (ob ^ (((ob >> 9) & 1) << 5)); }
__host__ __device__ __forceinline__ void stage_rc(int b, int& R, int& C) { const int st = b / 1024, sb = b % 1024, swz = sb ^ (((sb >> 9) & 1) << 5); R = (st >> 1) * 16 + swz / 64; C = (st & 1) * 32 + (swz % 64) / 2; }
__host__ __device__ __forceinline__ int perm32(int rho) { const int n = rho >> 4, i = rho & 15; return 8 * (i >> 2) + 4 * n + (i & 3); }

struct Unit { int pm, pn; };
struct Gemm { const bf16_t* A; const bf16_t* Bt; int M, N, K; };

struct StaticOrder {
    int nM, nN, nwg, G, c;
    __host__ __device__ void init(int M, int N, int G_, int c_) { nM = M / BM; nN = N / BM; nwg = nM * nN; G = G_; c = c_; }
    __host__ __device__ bool next(int i, Unit& u) const {
        const long L = (long)i * G + c; if (L >= nwg) return false;
        int wgid = (int)L; { const int q = nwg / NXCD, r = nwg % NXCD, xcd = wgid % NXCD, off = wgid / NXCD; wgid = (xcd < r ? xcd * (q + 1) : r * (q + 1) + (xcd - r) * q) + off; }
        const int nig = WGM * nN, gid = wgid / nig, fm = gid * WGM, gsz = (nM - fm) < WGM ? (nM - fm) : WGM;
        u.pm = fm + ((wgid % nig) % gsz); u.pn = (wgid % nig) / gsz; return true;
    }
    __device__ __forceinline__ void a_ready(const Unit&) const {}
    __device__ __forceinline__ void done(const Unit&) const {}
};
__device__ __forceinline__ unsigned cvt_pk_bf16(float lo, float hi) { unsigned r; asm volatile("v_cvt_pk_bf16_f32 %0, %1, %2" : "=v"(r) : "v"(lo), "v"(hi)); return r; }
typedef float f32x2 __attribute__((ext_vector_type(2)));
template <class Epi, class Sched, bool ALIGN_EPI = false, bool SP2 = false>
__device__ __forceinline__ void gemm_phase(PG8_LAS unsigned char* lds, const Gemm g, const Sched& S, const Epi& E) {
    const int tid = threadIdx.x, wid = __builtin_amdgcn_readfirstlane(tid >> 6), lane = tid & 63, wr = wid >> 2, wc = wid & 3, fr = lane & 15, fq = lane >> 4;
    const int K = g.K, nt = K / BK;
    unsigned voffA[2], voffB[2];
#pragma unroll
    for (int i = 0; i < 2; ++i) { int R, C; stage_rc(tid * 16 + i * 8192, R, C); const int Rb = Epi::PERM ? ((R & ~31) + perm32(R & 31)) : R;
        voffA[i] = (unsigned)(R * K + C) * 2u; voffB[i] = (unsigned)(Rb * K + C) * 2u; }
    const size_t kstep = (size_t)(BK * 2);
    const size_t hstep = (size_t)HALF * K * 2;
    const size_t tstep = 2 * hstep;
    const unsigned ldsw = (unsigned)wid * 1024u;
    const int aoff = lds_byte(wr * 64 + fr, fq * 8), boff = lds_byte(wc * 32 + fr, fq * 8);
#define PG8_SA(b, h) (((b) * 2 + (h)) * HTB)
#define PG8_SB(b, h) ((4 + (b) * 2 + (h)) * HTB)
#define PG8_STAGE(bufoff, gbase, voff) do { _Pragma("unroll") for (int _i = 0; _i < 2; ++_i) \
        __builtin_amdgcn_global_load_lds((const unsigned*)((const char*)(gbase) + (voff)[_i]), (PG8_LAS unsigned*)(lds + (bufoff) + ldsw + _i * 8192), 16, 0, 0); } while (0)
#define PG8_LDA(dst, b, h) do { _Pragma("unroll") for (int m = 0; m < 4; ++m) _Pragma("unroll") for (int k = 0; k < 2; ++k) dst[m][k] = *(const PG8_LAS bf16x8*)(lds + PG8_SA(b, h) + aoff + m * 2048 + k * 1024); } while (0)
#define PG8_LDB(dst, b, h) do { _Pragma("unroll") for (int n = 0; n < 2; ++n) _Pragma("unroll") for (int k = 0; k < 2; ++k) dst[n][k] = *(const PG8_LAS bf16x8*)(lds + PG8_SB(b, h) + boff + n * 2048 + k * 1024); } while (0)
#define PG8_MMA(ai, bj, At, Bt) do { __builtin_amdgcn_s_setprio(1); _Pragma("unroll") for (int m = 0; m < 4; ++m) _Pragma("unroll") for (int n = 0; n < 2; ++n) _Pragma("unroll") for (int k = 0; k < 2; ++k) \
        acc[ai][bj][m][n] = __builtin_amdgcn_mfma_f32_16x16x32_bf16(Bt[n][k], At[m][k], acc[ai][bj][m][n], 0, 0, 0); __builtin_amdgcn_s_setprio(0); } while (0)
#define PG8_WAIT_V(n) asm volatile("s_waitcnt vmcnt(" #n ")" ::: "memory")
#define PG8_WAIT_L(n) asm volatile("s_waitcnt lgkmcnt(" #n ")" ::: "memory")
#define PG8_BAR __builtin_amdgcn_s_barrier()
#define PG8_SCHED __builtin_amdgcn_sched_barrier(0)
    Unit cur, nxt; int ui = 0;
    if (!S.next(0, cur)) return;
    f32x4 acc[2][2][4][2];
#pragma unroll
    for (int a = 0; a < 2; ++a)
#pragma unroll
        for (int b = 0; b < 2; ++b)
#pragma unroll
            for (int m = 0; m < 4; ++m)
#pragma unroll
                for (int n = 0; n < 2; ++n) acc[a][b][m][n] = (f32x4){0.f, 0.f, 0.f, 0.f};
    bf16x8 At[4][2], B0[2][2], B1[2][2];
    const char* cA = (const char*)g.A + (size_t)cur.pm * tstep; const char* cB = (const char*)g.Bt + (size_t)cur.pn * tstep;
    S.a_ready(cur);
    if constexpr (SP2) {
        PG8_STAGE(PG8_SB(0, 0), cB, voffB); PG8_STAGE(PG8_SB(0, 1), cB + hstep, voffB); PG8_STAGE(PG8_SA(0, 0), cA, voffA); PG8_STAGE(PG8_SA(0, 1), cA + hstep, voffA);
        if (wr == 1) PG8_BAR;
        PG8_WAIT_V(2); PG8_BAR;
        PG8_STAGE(PG8_SB(1, 0), cB + kstep, voffB); PG8_STAGE(PG8_SA(1, 0), cA + kstep, voffA); PG8_STAGE(PG8_SB(1, 1), cB + hstep + kstep, voffB);
        PG8_WAIT_V(6); PG8_BAR;
    } else {
        PG8_STAGE(PG8_SB(0, 0), cB, voffB); PG8_STAGE(PG8_SA(0, 0), cA, voffA); PG8_STAGE(PG8_SB(0, 1), cB + hstep, voffB); PG8_STAGE(PG8_SA(0, 1), cA + hstep, voffA);
        if (wr == 1) PG8_BAR;
        PG8_WAIT_V(4); PG8_BAR;
        PG8_STAGE(PG8_SB(1, 0), cB + kstep, voffB); PG8_STAGE(PG8_SA(1, 0), cA + kstep, voffA); PG8_STAGE(PG8_SB(1, 1), cB + hstep + kstep, voffB);
        PG8_WAIT_V(6); PG8_BAR;
    }
    for (;;) {
        const bool has_next = S.next(ui + 1, nxt);
        const char* nA = has_next ? (const char*)g.A + (size_t)nxt.pm * tstep : cA; const char* nB = has_next ? (const char*)g.Bt + (size_t)nxt.pn * tstep : cB;
        for (int t = 0; t < nt; t += 2) {
            const bool last = (t == nt - 2);
            const char* a1 = cA + (size_t)(t + 1) * kstep;
            const char* a2 = last ? nA : cA + (size_t)(t + 2) * kstep; const char* b2 = last ? nB : cB + (size_t)(t + 2) * kstep;
            const char* a3 = a2 + kstep; const char* b3 = b2 + kstep;
            if (last && has_next) S.a_ready(nxt);
            if constexpr (SP2) {
            PG8_LDB(B0, 0, 0); PG8_LDB(B1, 0, 1); PG8_SCHED; PG8_LDA(At, 0, 0); PG8_STAGE(PG8_SA(1, 1), a1 + hstep, voffA);
            PG8_WAIT_V(8); PG8_WAIT_L(0); PG8_BAR; PG8_MMA(0, 0, At, B0); PG8_MMA(0, 1, At, B1); PG8_BAR; PG8_SCHED;
            PG8_LDA(At, 0, 1); PG8_STAGE(PG8_SB(0, 0), b2, voffB); PG8_STAGE(PG8_SB(0, 1), b2 + hstep, voffB); PG8_STAGE(PG8_SA(0, 0), a2, voffA);
            PG8_WAIT_V(8); PG8_WAIT_L(0); PG8_BAR; PG8_MMA(1, 0, At, B0); PG8_MMA(1, 1, At, B1); PG8_BAR; PG8_SCHED;
            PG8_LDB(B0, 1, 0); PG8_LDB(B1, 1, 1); PG8_SCHED; PG8_LDA(At, 1, 0); PG8_STAGE(PG8_SA(0, 1), a2 + hstep, voffA);
            PG8_WAIT_V(8); PG8_WAIT_L(0); PG8_BAR; PG8_MMA(0, 0, At, B0); PG8_MMA(0, 1, At, B1); PG8_BAR; PG8_SCHED;
            PG8_LDA(At, 1, 1); PG8_STAGE(PG8_SB(1, 0), b3, voffB); PG8_STAGE(PG8_SB(1, 1), b3 + hstep, voffB); PG8_STAGE(PG8_SA(1, 0), a3, voffA);
            PG8_WAIT_V(8); PG8_WAIT_L(0); PG8_BAR; PG8_MMA(1, 0, At, B0); PG8_MMA(1, 1, At, B1); PG8_BAR; PG8_SCHED;
            } else {
            PG8_LDB(B0, 0, 0); PG8_SCHED; PG8_LDA(At, 0, 0); PG8_STAGE(PG8_SA(1, 1), a1 + hstep, voffA);
            PG8_WAIT_L(8); PG8_BAR; PG8_WAIT_L(0); PG8_MMA(0, 0, At, B0); PG8_BAR; PG8_SCHED;
            PG8_LDB(B1, 0, 1); PG8_STAGE(PG8_SB(0, 0), b2, voffB);
            PG8_BAR; PG8_WAIT_L(0); PG8_MMA(0, 1, At, B1); PG8_BAR;
            PG8_LDA(At, 0, 1); PG8_STAGE(PG8_SA(0, 0), a2, voffA);
            PG8_BAR; PG8_WAIT_L(0); PG8_MMA(1, 0, At, B0); PG8_BAR; PG8_SCHED;
            PG8_STAGE(PG8_SB(0, 1), b2 + hstep, voffB);
            PG8_WAIT_V(6); PG8_BAR; PG8_MMA(1, 1, At, B1); PG8_BAR;
            PG8_LDB(B0, 1, 0); PG8_SCHED; PG8_LDA(At, 1, 0); PG8_STAGE(PG8_SA(0, 1), a2 + hstep, voffA);
            PG8_WAIT_L(8); PG8_BAR; PG8_WAIT_L(0); PG8_MMA(0, 0, At, B0); PG8_BAR; PG8_SCHED;
            PG8_LDB(B1, 1, 1); PG8_STAGE(PG8_SB(1, 0), b3, voffB);
            PG8_BAR; PG8_WAIT_L(0); PG8_MMA(0, 1, At, B1); PG8_BAR;
            PG8_LDA(At, 1, 1); PG8_STAGE(PG8_SA(1, 0), a3, voffA);
            PG8_BAR; PG8_WAIT_L(0); PG8_MMA(1, 0, At, B0); PG8_BAR; PG8_SCHED;
            PG8_STAGE(PG8_SB(1, 1), b3 + hstep, voffB);
            PG8_WAIT_V(6); PG8_BAR; PG8_MMA(1, 1, At, B1); PG8_BAR;
            }
        }
        if constexpr (ALIGN_EPI) { if (wr == 0) PG8_BAR; }
        if constexpr (!Epi::AFTER_DRAIN) { E(acc, cur, wr, wc, fr, fq); S.done(cur); }
        if (!has_next) break;
#pragma unroll
        for (int a = 0; a < 2; ++a)
#pragma unroll
            for (int b = 0; b < 2; ++b)
#pragma unroll
                for (int m = 0; m < 4; ++m)
#pragma unroll
                    for (int n = 0; n < 2; ++n) acc[a][b][m][n] = (f32x4){0.f, 0.f, 0.f, 0.f};
        cur = nxt; cA = nA; cB = nB; ++ui;
        if constexpr (ALIGN_EPI) { if (wr == 1) PG8_BAR; }
    }
    PG8_WAIT_V(0);
    if constexpr (!ALIGN_EPI) { if (wr == 0) PG8_BAR; }
    PG8_BAR;
    if constexpr (Epi::AFTER_DRAIN) { E.fused(acc, cur, wr, wc, fr, fq, lds, wid, lane); S.done(cur); }
#undef PG8_SA
#undef PG8_SB
#undef PG8_STAGE
#undef PG8_LDA
#undef PG8_LDB
#undef PG8_MMA
#undef PG8_WAIT_V
#undef PG8_WAIT_L
#undef PG8_BAR
#undef PG8_SCHED
}
}

#define GAS __attribute__((address_space(1)))
#define LAS __attribute__((address_space(3)))
typedef unsigned short bf16;
typedef unsigned v4u __attribute__((ext_vector_type(4)));
typedef unsigned v2u __attribute__((ext_vector_type(2)));
typedef float f32x4 __attribute__((ext_vector_type(4)));
typedef float f32x2v __attribute__((ext_vector_type(2)));

constexpr int DM = 1024, NB_P = 8, SEQ = 2048, NB_S = 128, DSEQ = 4;
constexpr int TP = NB_P * SEQ, TS = NB_S * DSEQ, T = TP + TS;
constexpr int DN_IN = 6176, DN_INP = 6400, PROJ_LD = 6144, CONV_DIM = 4096, VAL_DIM = 2048;
constexpr int QKV_N = 1536, DFF = 2816, GU_N = 5632;
constexpr float RMS_EPS = 1e-6f, L2_EPS = 1e-6f;

constexpr size_t O_YP = 0, O_YS = 16777216, O_CONVP = 17301504, O_DELTAP = 17498112, O_KP = 21692416, O_VP = 22216704,
                 O_CONVS = 22740992, O_DELTAS = 25886720, O_KS = 92995584, O_VS = 93257728, O_END = 93519872;

constexpr size_t MiB = 1u << 20;
constexpr size_t WS_CTL = 0, CTL_ZERO_BYTES = 1 * MiB;
constexpr size_t WS_WIN = 2 * MiB;
constexpr size_t WS_WOUT = 27 * MiB;
constexpr size_t WS_WQKV = 35 * MiB;
constexpr size_t WS_WO = 41 * MiB;
constexpr size_t WS_WGU = 45 * MiB;
constexpr size_t WS_WDOWN = 89 * MiB;
constexpr size_t WS_X = 112 * MiB;
constexpr size_t WS_XB = 178 * MiB;
constexpr size_t WS_SSQ = 211 * MiB;
constexpr size_t WS_BA = 213 * MiB;
constexpr size_t WS_BG = 216 * MiB;
constexpr size_t WS_PROJ = 220 * MiB;
constexpr size_t WS_Q = 220 * MiB;
constexpr size_t WS_KB = 253 * MiB;
constexpr size_t WS_VB = 262 * MiB;
constexpr size_t WS_ATT = 271 * MiB;
constexpr size_t WS_QKV = 418 * MiB;
constexpr size_t WS_OG = 682 * MiB;
constexpr size_t WS_ACT = 748 * MiB;
constexpr size_t WS_END = 840 * MiB;
constexpr size_t KV_DELTA = (WS_VB - WS_KB) / 2;

constexpr int NWAVES = 8, NTHREADS = 512;
constexpr int LDS_BYTES = 147456;

#define LDS_WAIT() asm volatile("s_waitcnt lgkmcnt(0)" ::: "memory")
__device__ __forceinline__ unsigned f2bf(float f) { unsigned u = __builtin_bit_cast(unsigned, f); return (u + 0x7fffu + ((u >> 16) & 1u)) >> 16; }
__device__ __forceinline__ unsigned pk2(float lo, float hi) { return f2bf(lo) | (f2bf(hi) << 16); }
__device__ __forceinline__ float bf2f(unsigned short b) { return __builtin_bit_cast(float, (unsigned)b << 16); }
__device__ __forceinline__ float bflo(unsigned w) { return __builtin_bit_cast(float, w << 16); }
__device__ __forceinline__ float bfhi(unsigned w) { return __builtin_bit_cast(float, w & 0xffff0000u); }
__device__ __forceinline__ float wave_sum(float v) {
#pragma unroll
    for (int o = 1; o < 64; o <<= 1) v += __shfl_xor(v, o);
    return v;
}
__device__ __forceinline__ float wave_max(float v) {
#pragma unroll
    for (int o = 1; o < 64; o <<= 1) v = fmaxf(v, __shfl_xor(v, o));
    return v;
}
__device__ __forceinline__ float silu_f(float x) { return x / (1.f + __expf(-x)); }
__device__ __forceinline__ float row_rstd(const float* ssq, int row) {
    const f32x4* p = (const f32x4*)(ssq + (size_t)row * 16);
    const f32x4 a = p[0], b = p[1], c = p[2], d = p[3];
    const float s = ((a[0] + a[1]) + (a[2] + a[3])) + ((b[0] + b[1]) + (b[2] + b[3])) + ((c[0] + c[1]) + (c[2] + c[3])) + ((d[0] + d[1]) + (d[2] + d[3]));
    return rsqrtf(s * (1.f / 1024.f) + RMS_EPS);
}

using pg8::Unit; using pg8::cvt_pk_bf16;
struct EpiDnIn {
    static constexpr bool PERM = true, AFTER_DRAIN = false;
    bf16* proj; float* ba; const float* ssq;
    __device__ __forceinline__ void operator()(const f32x4 (&acc)[2][2][4][2], const Unit& u, int wr, int wc, int fr, int fq) const {
        const int row0 = u.pm * 256 + wr * 64 + fr;
        if (u.pn < 24) {
            const int col0 = u.pn * 256 + wc * 32 + 8 * fq;
#pragma unroll
            for (int ai = 0; ai < 2; ++ai)
#pragma unroll
                for (int m = 0; m < 4; ++m) { const int row = row0 + ai * 128 + m * 16; const float rs = row_rstd(ssq, row);
                    bf16* rowp = proj + (size_t)row * PROJ_LD + col0;
#pragma unroll
                    for (int bj = 0; bj < 2; ++bj) { const f32x4 v0 = acc[ai][bj][m][0] * rs, v1 = acc[ai][bj][m][1] * rs;
                        v4u w; w.x = cvt_pk_bf16(v0[0], v0[1]); w.y = cvt_pk_bf16(v0[2], v0[3]); w.z = cvt_pk_bf16(v1[0], v1[1]); w.w = cvt_pk_bf16(v1[2], v1[3]);
                        *(v4u*)(rowp + bj * 128) = w; } }
        } else if (wc == 0) {
#pragma unroll
            for (int ai = 0; ai < 2; ++ai)
#pragma unroll
                for (int m = 0; m < 4; ++m) { const int row = row0 + ai * 128 + m * 16; const float rs = row_rstd(ssq, row);
                    float* o = ba + (size_t)row * 32 + 8 * fq;
                    *(f32x4*)o = acc[ai][0][m][0] * rs; *(f32x4*)(o + 4) = acc[ai][0][m][1] * rs; }
        }
    }
};
struct EpiRes {
    static constexpr bool PERM = false, AFTER_DRAIN = false;
    float* X; bf16* XB; float* ssq; const float* bias;
    __device__ __forceinline__ void operator()(const f32x4 (&acc)[2][2][4][2], const Unit& u, int wr, int wc, int fr, int fq) const {
        const int row0 = u.pm * 256 + wr * 64 + fr, col0 = u.pn * 256 + wc * 32 + 4 * fq;
#pragma unroll
        for (int ai = 0; ai < 2; ++ai)
#pragma unroll
            for (int m = 0; m < 4; ++m) { const int row = row0 + ai * 128 + m * 16; float s = 0.f;
#pragma unroll
                for (int bj = 0; bj < 2; ++bj)
#pragma unroll
                    for (int n = 0; n < 2; ++n) { const int c = col0 + bj * 128 + n * 16; float* xp = X + (size_t)row * DM + c;
                        f32x4 x = *(const f32x4*)xp + acc[ai][bj][m][n];
                        if (bias) x = x + *(const f32x4*)(bias + c);
                        *(f32x4*)xp = x; v2u w; w.x = cvt_pk_bf16(x[0], x[1]); w.y = cvt_pk_bf16(x[2], x[3]);
                        *(v2u*)(XB + (size_t)row * DM + c) = w;
                        s += (x[0] * x[0] + x[1] * x[1]) + (x[2] * x[2] + x[3] * x[3]); }
                s += __shfl_xor(s, 16); s += __shfl_xor(s, 32);
                if (fq == 0) ssq[(size_t)row * 16 + u.pn * 4 + wc] = s; }
    }
};
struct EpiQkv {
    static constexpr bool PERM = true, AFTER_DRAIN = false;
    bf16 *Q, *KB; const float* ssq; const float* bias; float *okp, *oks;
    __device__ __forceinline__ void operator()(const f32x4 (&acc)[2][2][4][2], const Unit& u, int wr, int wc, int fr, int fq) const {
        const int row0 = u.pm * 256 + wr * 64 + fr, cw = wc * 32 + 8 * fq;
        const bool isq = u.pn < 4; const size_t kvsel = (u.pn == 5) ? 1 : 0;
        const float qs = isq ? 0.125f : 1.f;
#pragma unroll
        for (int ai = 0; ai < 2; ++ai)
#pragma unroll
            for (int m = 0; m < 4; ++m) { const int row = row0 + ai * 128 + m * 16; const float rs = row_rstd(ssq, row);
#pragma unroll
                for (int bj = 0; bj < 2; ++bj) { const int colk = bj * 128 + cw, gcol = u.pn * 256 + colk;
                    const f32x4 v0 = (acc[ai][bj][m][0] * rs + *(const f32x4*)(bias + gcol)) * qs, v1 = (acc[ai][bj][m][1] * rs + *(const f32x4*)(bias + gcol + 4)) * qs;
                    v4u w; w.x = cvt_pk_bf16(v0[0], v0[1]); w.y = cvt_pk_bf16(v0[2], v0[3]); w.z = cvt_pk_bf16(v1[0], v1[1]); w.w = cvt_pk_bf16(v1[2], v1[3]);
                    if (isq) *(v4u*)(Q + (size_t)row * DM + gcol) = w;
                    else {
                        *(v4u*)(KB + kvsel * KV_DELTA + (size_t)row * 256 + colk) = w;
                        if (row < TP) { const int b = row >> 11, pos = row & 2047;
                            if (pos >= 1920) { float* o = okp + kvsel * (O_VP - O_KP) + (size_t)(b * 128 + pos - 1920) * 256 + colk; *(f32x4*)o = v0; *(f32x4*)(o + 4) = v1; } }
                        else { float* o = oks + kvsel * (O_VS - O_KS) + (size_t)(row - TP) * 256 + colk; *(f32x4*)o = v0; *(f32x4*)(o + 4) = v1; } } } }
    }
};
struct EpiGu {
    static constexpr bool PERM = true, AFTER_DRAIN = false;
    bf16* act; const float* ssq;
    __device__ __forceinline__ void operator()(const f32x4 (&acc)[2][2][4][2], const Unit& u, int wr, int wc, int fr, int fq) const {
        const int row0 = u.pm * 256 + wr * 64 + fr, col0 = u.pn * 128 + wc * 32 + 8 * fq;
#pragma unroll
        for (int ai = 0; ai < 2; ++ai)
#pragma unroll
            for (int m = 0; m < 4; ++m) { const int row = row0 + ai * 128 + m * 16; const float rs = row_rstd(ssq, row);
                float r[8];
#pragma unroll
                for (int n = 0; n < 2; ++n)
#pragma unroll
                    for (int e = 0; e < 4; ++e) { const float g = acc[ai][0][m][n][e] * rs, uu = acc[ai][1][m][n][e] * rs; r[n * 4 + e] = silu_f(g) * uu; }
                v4u w; w.x = cvt_pk_bf16(r[0], r[1]); w.y = cvt_pk_bf16(r[2], r[3]); w.z = cvt_pk_bf16(r[4], r[5]); w.w = cvt_pk_bf16(r[6], r[7]);
                *(v4u*)(act + (size_t)row * DFF + col0) = w; }
    }
};

struct Args { const float* in[22]; float* out; unsigned char* ws; int ph_lo, ph_hi; };

__device__ __forceinline__ void tr_item(const float* W, int K, int N, const float* nw, bf16* WT, int dst_row0, LAS float* scr, int k0, int n0, int lane) {
#pragma unroll 8
    for (int i = 0; i < 32; ++i) { const int kk = 2 * i + (lane >> 5); const float s = nw ? nw[k0 + kk] : 1.f;
        scr[kk * 33 + (lane & 31)] = W[(size_t)(k0 + kk) * N + n0 + (lane & 31)] * s; }
    LDS_WAIT(); asm volatile("" ::: "memory");
    const int c = lane & 7;
#pragma unroll
    for (int j = 0; j < 4; ++j) { const int n = (lane >> 3) + 8 * j; const LAS float* s = scr + (8 * c) * 33 + n;
        v4u o; o.x = pk2(s[0 * 33], s[1 * 33]); o.y = pk2(s[2 * 33], s[3 * 33]); o.z = pk2(s[4 * 33], s[5 * 33]); o.w = pk2(s[6 * 33], s[7 * 33]);
        *(v4u*)(WT + (size_t)(dst_row0 + n) * K + k0 + 8 * c) = o; }
    LDS_WAIT(); asm volatile("" ::: "memory");
}
__device__ __forceinline__ void tr_matrix_item(const float* W, int K, int N, const float* nw, bf16* WT, int gu, LAS float* scr, int r, int lane) {
    const int nblk = N / 32, kb = r / nblk, nb = r % nblk, k0 = 64 * kb, n0 = 32 * nb;
    int dr = n0;
    if (gu) dr = (n0 < DFF) ? (n0 / 128) * 256 + (n0 % 128) : ((n0 - DFF) / 128) * 256 + 128 + ((n0 - DFF) % 128);
    tr_item(W, K, N, nw, WT, dr, scr, k0, n0, lane);
}
__device__ __forceinline__ void phase_prologue(const Args& a, LAS unsigned char* lds) {
    const int tid = threadIdx.x, lane = tid & 63, wave = __builtin_amdgcn_readfirstlane(tid >> 6);
    LAS float* scr = (LAS float*)(lds + wave * 16384);
    const int gw = blockIdx.x * NWAVES + wave, NGW = gridDim.x * NWAVES;
    unsigned char* ws = a.ws;
    constexpr int I_IN = 16 * 193, I_OUT = 32 * 32, I_QKV = 16 * 48, I_O = 16 * 32, I_GU = 16 * 176, I_DN = 44 * 32;
    constexpr int NITEMS = 2 * I_IN + 2 * I_OUT + 2 * I_QKV + 2 * I_O + 4 * I_GU + 4 * I_DN;
    for (int it = gw; it < NITEMS; it += NGW) {
        int r = it;
        if (r < 2 * I_IN) { const int j = r / I_IN; r -= j * I_IN;
            tr_matrix_item(a.in[9] + (size_t)j * DM * DN_IN, DM, DN_IN, a.in[6] + (2 * j) * DM, (bf16*)(ws + WS_WIN) + (size_t)j * DN_INP * DM, 0, scr, r, lane); continue; }
        r -= 2 * I_IN;
        if (r < 2 * I_OUT) { const int j = r / I_OUT; r -= j * I_OUT;
            tr_matrix_item(a.in[14] + (size_t)j * VAL_DIM * DM, VAL_DIM, DM, nullptr, (bf16*)(ws + WS_WOUT) + (size_t)j * DM * VAL_DIM, 0, scr, r, lane); continue; }
        r -= 2 * I_OUT;
        if (r < 2 * I_QKV) { const int j = r / I_QKV; r -= j * I_QKV;
            tr_matrix_item(a.in[15] + (size_t)j * DM * QKV_N, DM, QKV_N, a.in[6] + (2 * j + 1) * DM, (bf16*)(ws + WS_WQKV) + (size_t)j * QKV_N * DM, 0, scr, r, lane); continue; }
        r -= 2 * I_QKV;
        if (r < 2 * I_O) { const int j = r / I_O; r -= j * I_O;
            tr_matrix_item(a.in[18] + (size_t)j * DM * DM, DM, DM, nullptr, (bf16*)(ws + WS_WO) + (size_t)j * DM * DM, 0, scr, r, lane); continue; }
        r -= 2 * I_O;
        if (r < 4 * I_GU) { const int i = r / I_GU; r -= i * I_GU;
            tr_matrix_item(a.in[20] + (size_t)i * DM * GU_N, DM, GU_N, a.in[7] + i * DM, (bf16*)(ws + WS_WGU) + (size_t)i * GU_N * DM, 1, scr, r, lane); continue; }
        r -= 4 * I_GU;
        { const int i = r / I_DN; r -= i * I_DN;
            tr_matrix_item(a.in[21] + (size_t)i * DFF * DM, DFF, DM, nullptr, (bf16*)(ws + WS_WDOWN) + (size_t)i * DM * DFF, 0, scr, r, lane); }
    }
    for (int i = blockIdx.x * NTHREADS + tid; i < 2 * 28672; i += gridDim.x * NTHREADS) { const int j = i / 28672, o = i % 28672;
        *(v4u*)((bf16*)(ws + WS_WIN) + (size_t)j * DN_INP * DM + (size_t)DN_IN * DM + (size_t)o * 8) = (v4u){0u, 0u, 0u, 0u}; }
    float* X = (float*)(ws + WS_X); bf16* XB = (bf16*)(ws + WS_XB); float* SSQ = (float*)(ws + WS_SSQ);
    for (int m = gw; m < T; m += NGW) {
        const float* src = (m < TP) ? a.in[0] + (size_t)m * DM : a.in[1] + (size_t)(m - TP) * DM;
        float s = 0.f;
#pragma unroll
        for (int j = 0; j < 4; ++j) { const f32x4 v = *((const f32x4*)src + lane + 64 * j);
            *((f32x4*)(X + (size_t)m * DM) + lane + 64 * j) = v;
            v2u w; w.x = pk2(v[0], v[1]); w.y = pk2(v[2], v[3]); *((v2u*)(XB + (size_t)m * DM) + lane + 64 * j) = w;
            s += (v[0] * v[0] + v[1] * v[1]) + (v[2] * v[2] + v[3] * v[3]); }
        s = wave_sum(s);
        if (lane < 16) SSQ[(size_t)m * 16 + lane] = (lane == 0) ? s : 0.f;
    }
}

__device__ __forceinline__ void phase_dn_post(const Args& a, int j) {
    const int tid = threadIdx.x, lane = tid & 63, wave = __builtin_amdgcn_readfirstlane(tid >> 6);
    const int gw = blockIdx.x * NWAVES + wave, NGW = gridDim.x * NWAVES;
    unsigned char* ws = a.ws;
    const bf16* PROJ = (const bf16*)(ws + WS_PROJ); const float* BA = (const float*)(ws + WS_BA);
    float* QKV = (float*)(ws + WS_QKV); float* BG = (float*)(ws + WS_BG);
    const float* cw = a.in[10] + (size_t)j * 4 * CONV_DIM;
    const float* sconv = a.in[2] + (size_t)j * NB_S * 3 * CONV_DIM;
    float* oconvp = a.out + O_CONVP + (size_t)j * NB_P * 3 * CONV_DIM;
    float* oconvs = a.out + O_CONVS + (size_t)j * NB_S * 3 * CONV_DIM;
    for (int task = gw; task < T * 32; task += NGW) {
        const int t = task >> 5, hc = task & 31, col0 = hc * 128 + 2 * lane;
        const bool prompt = t < TP; const int pos = prompt ? (t & 2047) : ((t - TP) & 3); const int b = prompt ? (t >> 11) : ((t - TP) >> 2);
        float y0 = 0.f, y1 = 0.f, u00 = 0.f, u01 = 0.f;
#pragma unroll
        for (int k = 0; k < 4; ++k) {
            float u0 = 0.f, u1 = 0.f;
            if (pos - k >= 0) { const unsigned w = *(const unsigned*)(PROJ + (size_t)(t - k) * PROJ_LD + col0); u0 = bflo(w); u1 = bfhi(w); }
            else if (!prompt) { const f32x2v v = *(const f32x2v*)(sconv + (size_t)(b * 3 + (3 + pos - k)) * CONV_DIM + col0); u0 = v[0]; u1 = v[1]; }
            const f32x2v wv = *(const f32x2v*)(cw + (size_t)(3 - k) * CONV_DIM + col0);
            y0 += u0 * wv[0]; y1 += u1 * wv[1];
            if (k == 0) { u00 = u0; u01 = u1; }
        }
        y0 = silu_f(y0); y1 = silu_f(y1);
        if (hc < 16) {
            const float ss = wave_sum(y0 * y0 + y1 * y1);
            float inv = rsqrtf(ss + L2_EPS); if (hc < 8) inv *= 0.08838834764831845f;
            y0 *= inv; y1 *= inv;
        }
        *(f32x2v*)(QKV + (size_t)t * CONV_DIM + col0) = (f32x2v){y0, y1};
        if (prompt) { if (pos >= SEQ - 3) *(f32x2v*)(oconvp + (size_t)(b * 3 + pos - (SEQ - 3)) * CONV_DIM + col0) = (f32x2v){u00, u01}; }
        else if (pos >= 1) *(f32x2v*)(oconvs + (size_t)(b * 3 + pos - 1) * CONV_DIM + col0) = (f32x2v){u00, u01};
        if (hc == 0 && lane < 32) {
            const int h = lane & 15; const float v = BA[(size_t)t * 32 + lane];
            float r;
            if (lane < 16) r = 1.f / (1.f + __expf(-v));
            else { const float x = v + a.in[12][j * 16 + h]; const float sp = (x > 20.f) ? x : log1pf(__expf(x)); r = -__expf(a.in[11][j * 16 + h]) * sp; }
            BG[(size_t)t * 32 + lane] = r;
        }
    }
}

__device__ __forceinline__ void phase_delta_rec(const Args& a, int j, LAS unsigned char* lds) {
    const int tid = threadIdx.x, lane = tid & 63, wave = __builtin_amdgcn_readfirstlane(tid >> 6);
    const int e = tid & 127, dq = tid >> 7;
    unsigned char* ws = a.ws;
    const float* QKV = (const float*)(ws + WS_QKV); const float* BG = (const float*)(ws + WS_BG); const bf16* PROJ = (const bf16*)(ws + WS_PROJ);
    bf16* OG = (bf16*)(ws + WS_OG);
    const float* nw = a.in[13] + j * 128;
    constexpr int NTB = 16;
    LAS float* qs = (LAS float*)lds;
    LAS float* ks = qs + NTB * 128;
    LAS float* vs = ks + NTB * 128;
    LAS float* ob = vs + NTB * 128;
    LAS float* red = ob + NTB * 128;
    LAS float* red2 = red + 512;
    LAS float* ab = red2 + 512;
    for (int unit = blockIdx.x; unit < 128 + 2048; unit += gridDim.x) {
        int b, h, L, t0; const float* s0 = nullptr; float* sout;
        if (unit < 128) { b = unit >> 4; h = unit & 15; L = SEQ; t0 = b * SEQ; sout = a.out + O_DELTAP + ((size_t)(j * NB_P + b) * 16 + h) * 16384; }
        else { const int su = unit - 128; b = su >> 4; h = su & 15; L = DSEQ; t0 = TP + b * DSEQ;
            s0 = a.in[3] + ((size_t)(j * NB_S + b) * 16 + h) * 16384; sout = a.out + O_DELTAS + ((size_t)(j * NB_S + b) * 16 + h) * 16384; }
        const int hq = h >> 1;
        float S[32];
#pragma unroll
        for (int i = 0; i < 32; ++i) S[i] = s0 ? s0[(size_t)(32 * dq + i) * 128 + e] : 0.f;
        for (int tb = 0; tb < L; tb += NTB) {
            const int nb = (L - tb) < NTB ? (L - tb) : NTB;
            __syncthreads();
            for (int i = tid; i < nb * 384; i += NTHREADS) { const int tt = i / 384, rem = i % 384, which = rem >> 7, ee = rem & 127;
                const int col = (which == 0) ? hq * 128 + ee : (which == 1) ? 1024 + hq * 128 + ee : 2048 + h * 128 + ee;
                qs[which * (NTB * 128) + tt * 128 + ee] = QKV[(size_t)(t0 + tb + tt) * CONV_DIM + col]; }
            if (tid < nb) { ab[tid * 2] = __expf(BG[(size_t)(t0 + tb + tid) * 32 + 16 + h]); ab[tid * 2 + 1] = BG[(size_t)(t0 + tb + tid) * 32 + h]; }
            __syncthreads();
            for (int tt = 0; tt < nb; ++tt) {
                const float av = ab[tt * 2], bt = ab[tt * 2 + 1];
                float part = 0.f;
#pragma unroll
                for (int i = 0; i < 32; ++i) part += ks[tt * 128 + 32 * dq + i] * S[i];
                red[dq * 128 + e] = part;
                __syncthreads();
                const float kS = (red[e] + red[128 + e]) + (red[256 + e] + red[384 + e]);
                const float vv = bt * (vs[tt * 128 + e] - av * kS);
                float po = 0.f;
#pragma unroll
                for (int i = 0; i < 32; ++i) { S[i] = av * S[i] + ks[tt * 128 + 32 * dq + i] * vv; po += S[i] * qs[tt * 128 + 32 * dq + i]; }
                red2[dq * 128 + e] = po;
                __syncthreads();
                if (dq == 0) ob[tt * 128 + e] = (red2[e] + red2[128 + e]) + (red2[256 + e] + red2[384 + e]);
            }
            __syncthreads();
            for (int tt = wave; tt < nb; tt += NWAVES) {
                const float o0 = ob[tt * 128 + lane], o1 = ob[tt * 128 + 64 + lane];
                const float ss = wave_sum(o0 * o0 + o1 * o1);
                const float rs = rsqrtf(ss * (1.f / 128.f) + RMS_EPS);
                const size_t tok = (size_t)(t0 + tb + tt);
                const float z0 = bf2f(PROJ[tok * PROJ_LD + 4096 + h * 128 + lane]), z1 = bf2f(PROJ[tok * PROJ_LD + 4096 + h * 128 + 64 + lane]);
                OG[tok * VAL_DIM + h * 128 + lane] = (bf16)f2bf(o0 * rs * nw[lane] * silu_f(z0));
                OG[tok * VAL_DIM + h * 128 + 64 + lane] = (bf16)f2bf(o1 * rs * nw[64 + lane] * silu_f(z1));
            }
        }
#pragma unroll
        for (int i = 0; i < 32; ++i) sout[(size_t)(32 * dq + i) * 128 + e] = S[i];
        __syncthreads();
    }
}

__device__ __forceinline__ void phase_swa_attn(const Args& a, int j, LAS unsigned char* lds) {
    const int tid = threadIdx.x, lane = tid & 63, wave = __builtin_amdgcn_readfirstlane(tid >> 6);
    const int gw = blockIdx.x * NWAVES + wave, NGW = gridDim.x * NWAVES;
    unsigned char* ws = a.ws;
    const bf16* Q = (const bf16*)(ws + WS_Q); const bf16* KB = (const bf16*)(ws + WS_KB); const bf16* VB = (const bf16*)(ws + WS_VB);
    bf16* ATT = (bf16*)(ws + WS_ATT);
    const float* ck = a.in[4] + (size_t)j * NB_S * 128 * 256; const float* cv = a.in[5] + (size_t)j * NB_S * 128 * 256;
    const float* sinks = a.in[17] + j * 16;
    LAS float* qs = (LAS float*)(lds + wave * 4096);
    LAS float* ps = qs + 256;
    for (int task = gw; task < T * 4; task += NGW) {
        const int t = task >> 2, kh = task & 3;
#pragma unroll
        for (int g = 0; g < 4; ++g) qs[g * 64 + lane] = bf2f(Q[(size_t)t * DM + (kh * 4 + g) * 64 + lane]);
        LDS_WAIT(); asm volatile("" ::: "memory");
        const bool prompt = t < TP; int nk, b = 0, l = 0;
        if (prompt) { const int pos = t & 2047; nk = (pos < 128 ? pos : 128) + 1; } else { const int r = t - TP; b = r >> 2; l = r & 3; nk = 129; }
        const float sl0 = exp2f(-0.5f * (float)(kh * 4 + 1)), sl1 = exp2f(-0.5f * (float)(kh * 4 + 2)), sl2 = exp2f(-0.5f * (float)(kh * 4 + 3)), sl3 = exp2f(-0.5f * (float)(kh * 4 + 4));
#pragma unroll 1
        for (int kb = 0; kb < 3; ++kb) {
            const int jj = kb * 64 + lane; const bool valid = jj < nk;
            float d0 = 0.f, d1 = 0.f, d2 = 0.f, d3 = 0.f;
            if (valid) {
                const int cj = l + jj;
                if (prompt || cj >= 128) {
                    const bf16* kp = prompt ? KB + (size_t)(t - (nk - 1) + jj) * 256 + kh * 64 : KB + (size_t)(TP + b * 4 + (cj - 128)) * 256 + kh * 64;
#pragma unroll 1
                    for (int d = 0; d < 64; d += 8) {
                        const v4u w = *(const v4u*)(kp + d);
                        const float kv[8] = {bflo(w.x), bfhi(w.x), bflo(w.y), bfhi(w.y), bflo(w.z), bfhi(w.z), bflo(w.w), bfhi(w.w)};
#pragma unroll
                        for (int i = 0; i < 8; ++i) { d0 += kv[i] * qs[d + i]; d1 += kv[i] * qs[64 + d + i]; d2 += kv[i] * qs[128 + d + i]; d3 += kv[i] * qs[192 + d + i]; }
                    }
                } else {
                    const float* kf = ck + (size_t)(b * 128 + cj) * 256 + kh * 64;
#pragma unroll 1
                    for (int d = 0; d < 64; d += 4) {
                        const f32x4 x = *(const f32x4*)(kf + d);
#pragma unroll
                        for (int i = 0; i < 4; ++i) { d0 += x[i] * qs[d + i]; d1 += x[i] * qs[64 + d + i]; d2 += x[i] * qs[128 + d + i]; d3 += x[i] * qs[192 + d + i]; }
                    }
                }
            }
            const float rel = (float)((nk - 1) - jj);
            const float NEG = -INFINITY;
            ps[jj] = valid ? d0 - sl0 * rel : NEG; ps[192 + jj] = valid ? d1 - sl1 * rel : NEG; ps[384 + jj] = valid ? d2 - sl2 * rel : NEG; ps[576 + jj] = valid ? d3 - sl3 * rel : NEG;
        }
        LDS_WAIT(); asm volatile("" ::: "memory");
#pragma unroll 1
        for (int g = 0; g < 4; ++g) {
            const float sk = sinks[kh * 4 + g];
            const float s0 = ps[g * 192 + lane], s1 = ps[g * 192 + 64 + lane], s2 = ps[g * 192 + 128 + lane];
            float m = wave_max(fmaxf(fmaxf(s0, s1), s2)); m = fmaxf(m, sk);
            const float p0 = __expf(s0 - m), p1 = __expf(s1 - m), p2 = __expf(s2 - m);
            const float den = wave_sum(p0 + p1 + p2) + __expf(sk - m); const float inv = 1.f / den;
            ps[g * 192 + lane] = p0 * inv; ps[g * 192 + 64 + lane] = p1 * inv; ps[g * 192 + 128 + lane] = p2 * inv;
        }
        LDS_WAIT(); asm volatile("" ::: "memory");
        float o0 = 0.f, o1 = 0.f, o2 = 0.f, o3 = 0.f;
        if (prompt) {
            const bf16* vp = VB + (size_t)(t - (nk - 1)) * 256 + kh * 64 + lane;
#pragma unroll 4
            for (int jj = 0; jj < nk; ++jj) { const float vv = bf2f(vp[(size_t)jj * 256]);
                o0 += ps[jj] * vv; o1 += ps[192 + jj] * vv; o2 += ps[384 + jj] * vv; o3 += ps[576 + jj] * vv; }
        } else {
#pragma unroll 4
            for (int jj = 0; jj < 129; ++jj) { const int cj = l + jj;
                const float vv = (cj < 128) ? cv[(size_t)(b * 128 + cj) * 256 + kh * 64 + lane] : bf2f(VB[(size_t)(TP + b * 4 + (cj - 128)) * 256 + kh * 64 + lane]);
                o0 += ps[jj] * vv; o1 += ps[192 + jj] * vv; o2 += ps[384 + jj] * vv; o3 += ps[576 + jj] * vv; }
        }
        bf16* op = ATT + (size_t)t * DM + kh * 256 + lane;
        op[0] = (bf16)f2bf(o0); op[64] = (bf16)f2bf(o1); op[128] = (bf16)f2bf(o2); op[192] = (bf16)f2bf(o3);
        LDS_WAIT(); asm volatile("" ::: "memory");
    }
}

__device__ __forceinline__ void phase_final(const Args& a) {
    const int tid = threadIdx.x, lane = tid & 63, wave = __builtin_amdgcn_readfirstlane(tid >> 6);
    const int gw = blockIdx.x * NWAVES + wave, NGW = gridDim.x * NWAVES;
    const float* X = (const float*)(a.ws + WS_X); const float* nw = a.in[8];
    for (int m = gw; m < T; m += NGW) {
        f32x4 v[4]; float s = 0.f;
#pragma unroll
        for (int j = 0; j < 4; ++j) { v[j] = *((const f32x4*)(X + (size_t)m * DM) + lane + 64 * j); s += (v[j][0] * v[j][0] + v[j][1] * v[j][1]) + (v[j][2] * v[j][2] + v[j][3] * v[j][3]); }
        const float rs = rsqrtf(wave_sum(s) * (1.f / 1024.f) + RMS_EPS);
        float* o = a.out + (size_t)m * DM;
#pragma unroll
        for (int j = 0; j < 4; ++j) { const f32x4 w = *((const f32x4*)nw + lane + 64 * j); *((f32x4*)o + lane + 64 * j) = v[j] * rs * w; }
    }
}

constexpr int N_PHASES = 26;
__device__ __forceinline__ void run_phase(const Args& a, int p, LAS unsigned char* lds) {
    unsigned char* ws = a.ws;
    float* X = (float*)(ws + WS_X); bf16* XB = (bf16*)(ws + WS_XB); float* SSQ = (float*)(ws + WS_SSQ);
    if (p == 0) { phase_prologue(a, lds); return; }
    if (p == 25) { phase_final(a); return; }
    const int li = (p - 1) / 6, st = (p - 1) % 6, j = li >> 1; const bool delta = (li & 1) == 0;
    const int G = gridDim.x, c = blockIdx.x;
    pg8::StaticOrder S;
    if (st == 0) {
        if (delta) { pg8::Gemm g{XB, (const bf16*)(ws + WS_WIN) + (size_t)j * DN_INP * DM, T, DN_INP, DM}; S.init(T, DN_INP, G, c);
            EpiDnIn E{(bf16*)(ws + WS_PROJ), (float*)(ws + WS_BA), SSQ};
            pg8::gemm_phase<EpiDnIn, pg8::StaticOrder, true, true>(lds, g, S, E);
        } else { pg8::Gemm g{XB, (const bf16*)(ws + WS_WQKV) + (size_t)j * QKV_N * DM, T, QKV_N, DM}; S.init(T, QKV_N, G, c);
            EpiQkv E{(bf16*)(ws + WS_Q), (bf16*)(ws + WS_KB), SSQ, a.in[16] + j * QKV_N,
                     a.out + O_KP + (size_t)j * NB_P * 128 * 256, a.out + O_KS + (size_t)j * NB_S * 4 * 256};
            pg8::gemm_phase<EpiQkv, pg8::StaticOrder, true, true>(lds, g, S, E);
        }
    } else if (st == 1) {
        if (delta) phase_dn_post(a, j); else phase_swa_attn(a, j, lds);
    } else if (st == 2) {
        if (delta) phase_delta_rec(a, j, lds);
    } else if (st == 3) {
        if (delta) { pg8::Gemm g{(const bf16*)(ws + WS_OG), (const bf16*)(ws + WS_WOUT) + (size_t)j * DM * VAL_DIM, T, DM, VAL_DIM}; S.init(T, DM, G, c);
            EpiRes E{X, XB, SSQ, nullptr};
            pg8::gemm_phase<EpiRes, pg8::StaticOrder, true, true>(lds, g, S, E);
        } else { pg8::Gemm g{(const bf16*)(ws + WS_ATT), (const bf16*)(ws + WS_WO) + (size_t)j * DM * DM, T, DM, DM}; S.init(T, DM, G, c);
            EpiRes E{X, XB, SSQ, a.in[19] + j * DM};
            pg8::gemm_phase<EpiRes, pg8::StaticOrder, true, true>(lds, g, S, E);
        }
    } else if (st == 4) {
        pg8::Gemm g{XB, (const bf16*)(ws + WS_WGU) + (size_t)li * GU_N * DM, T, GU_N, DM}; S.init(T, GU_N, G, c);
        EpiGu E{(bf16*)(ws + WS_ACT), SSQ};
        pg8::gemm_phase<EpiGu, pg8::StaticOrder, true, true>(lds, g, S, E);
    } else {
        pg8::Gemm g{(const bf16*)(ws + WS_ACT), (const bf16*)(ws + WS_WDOWN) + (size_t)li * DM * DFF, T, DM, DFF}; S.init(T, DM, G, c);
        EpiRes E{X, XB, SSQ, nullptr};
        pg8::gemm_phase<EpiRes, pg8::StaticOrder, true, true>(lds, g, S, E);
    }
}

__global__ void __launch_bounds__(NTHREADS, 2) mk_fwd(Args a) {
    extern __shared__ __attribute__((aligned(16))) unsigned char lds_raw[];
    LAS unsigned char* lds = (LAS unsigned char*)lds_raw;
    run_phase(a, a.ph_lo, lds);
}

extern "C" void kernel_launch(void* const* d_in, const int* in_sizes, int n_in, void* d_out, int out_size, void* d_ws, size_t ws_size, hipStream_t stream) {
    static int grid = 0;
    if (grid == 0) {
        if (n_in != 22 || (size_t)out_size != O_END || ws_size < WS_END) { fprintf(stderr, "kernel_launch: unexpected shapes: n_in %d out %d ws %zu\n", n_in, out_size, ws_size); grid = -1; return; }
        int dev = 0, cus = 0;
        if (hipGetDevice(&dev) != hipSuccess || hipDeviceGetAttribute(&cus, hipDeviceAttributeMultiprocessorCount, dev) != hipSuccess) { grid = -1; return; }
        if (hipFuncSetAttribute((const void*)mk_fwd, hipFuncAttributeMaxDynamicSharedMemorySize, LDS_BYTES) != hipSuccess) { fprintf(stderr, "kernel_launch: hipFuncSetAttribute failed\n"); grid = -1; return; }
        grid = cus;
    }
    if (grid < 0) return;
    (void)hipMemsetAsync((char*)d_ws + WS_CTL, 0, CTL_ZERO_BYTES, stream);
    Args a{};
    for (int i = 0; i < 22; ++i) a.in[i] = (const float*)d_in[i];
    a.out = (float*)d_out; a.ws = (unsigned char*)d_ws;
    for (int p = 0; p < N_PHASES; ++p) {
        if (p >= 1 && p < 25) { const int li = (p - 1) / 6, st = (p - 1) % 6; if (st == 2 && (li & 1)) continue; }
        a.ph_lo = p; a.ph_hi = p + 1;
        hipLaunchKernelGGL(mk_fwd, dim3(grid), dim3(NTHREADS), LDS_BYTES, stream, a);
    }
}
```

```cpp
#include <hip/hip_runtime.h>
#include <cstdio>
#include <cstdint>
namespace pg8 {
#define PG8_LAS __attribute__((address_space(3)))
typedef unsigned short bf16_t;
typedef short bf16x8 __attribute__((ext_vector_type(8)));
typedef float f32x4 __attribute__((ext_vector_type(4)));
typedef unsigned u32x4 __attribute__((ext_vector_type(4)));
constexpr int BM = 256, BK = 64, HALF = 128, HTB = HALF * BK * 2  , STAGE_BYTES = 8 * HTB, NXCD = 8, WGM = 8;

__host__ __device__ __forceinline__ int lds_byte(int r, int c) { const int st = (r >> 4) * 2 + (c >> 5), rr = r & 15, cc = c & 31, ob = rr * 64 + cc * 2; return st * 1024 + (ob ^ (((ob >> 9) & 1) << 5)); }
__host__ __device__ __forceinline__ void stage_rc(int b, int& R, int& C) { const int st = b / 1024, sb = b % 1024, swz = sb ^ (((sb >> 9) & 1) << 5); R = (st >> 1) * 16 + swz / 64; C = (st & 1) * 32 + (swz % 64) / 2; }
__host__ __device__ __forceinline__ int perm32(int rho) { const int n = rho >> 4, i = rho & 15; return 8 * (i >> 2) + 4 * n + (i & 3); }

struct Unit { int pm, pn; };
struct Gemm { const bf16_t* A; const bf16_t* Bt; int M, N, K; };

struct StaticOrder {
    int nM, nN, nwg, G, c;
    __host__ __device__ void init(int M, int N, int G_, int c_) { nM = M / BM; nN = N / BM; nwg = nM * nN; G = G_; c = c_; }
    __host__ __device__ bool next(int i, Unit& u) const {
        const long L = (long)i * G + c; if (L >= nwg) return false;
        int wgid = (int)L; { const int q = nwg / NXCD, r = nwg % NXCD, xcd = wgid % NXCD, off = wgid / NXCD; wgid = (xcd < r ? xcd * (q + 1) : r * (q + 1) + (xcd - r) * q) + off; }
        const int nig = WGM * nN, gid = wgid / nig, fm = gid * WGM, gsz = (nM - fm) < WGM ? (nM - fm) : WGM;
        u.pm = fm + ((wgid % nig) % gsz); u.pn = (wgid % nig) / gsz; return true;
    }
    __device__ __forceinline__ void a_ready(const Unit&) const {}
    __device__ __forceinline__ void done(const Unit&) const {}
};
__device__ __forceinline__ unsigned cvt_pk_bf16(float lo, float hi) { unsigned r; asm volatile("v_cvt_pk_bf16_f32 %0, %1, %2" : "=v"(r) : "v"(lo), "v"(hi)); return r; }
typedef float f32x2 __attribute__((ext_vector_type(2)));
template <class Epi, class Sched, bool ALIGN_EPI = false, bool SP2 = false>
__device__ __forceinline__ void gemm_phase(PG8_LAS unsigned char* lds, const Gemm g, const Sched& S, const Epi& E) {
    int tid_ = threadIdx.x; asm volatile("" : "+v"(tid_)); const int tid = tid_, wid = __builtin_amdgcn_readfirstlane(tid >> 6), lane = tid & 63, wr = wid >> 2, wc = wid & 3, fr = lane & 15, fq = lane >> 4;
    const int K = g.K, nt = K / BK;
    unsigned voffA[2], voffB[2];
#pragma unroll
    for (int i = 0; i < 2; ++i) { int R, C; stage_rc(tid * 16 + i * 8192, R, C); const int Rb = Epi::PERM ? ((R & ~31) + perm32(R & 31)) : R;
        voffA[i] = (unsigned)(R * K + C) * 2u; voffB[i] = (unsigned)(Rb * K + C) * 2u; }
    const size_t kstep = (size_t)(BK * 2);
    const size_t hstep = (size_t)HALF * K * 2;
    const size_t tstep = 2 * hstep;
    const unsigned ldsw = (unsigned)wid * 1024u;
    const int aoff = lds_byte(wr * 64 + fr, fq * 8), boff = lds_byte(wc * 32 + fr, fq * 8);
#define PG8_SA(b, h) (((b) * 2 + (h)) * HTB)
#define PG8_SB(b, h) ((4 + (b) * 2 + (h)) * HTB)
#define PG8_STAGE(bufoff, gbase, voff) do { _Pragma("unroll") for (int _i = 0; _i < 2; ++_i) \
        __builtin_amdgcn_global_load_lds((const unsigned*)((const char*)(gbase) + (voff)[_i]), (PG8_LAS unsigned*)(lds + (bufoff) + ldsw + _i * 8192), 16, 0, 0); } while (0)
#define PG8_LDA(dst, b, h) do { _Pragma("unroll") for (int m = 0; m < 4; ++m) _Pragma("unroll") for (int k = 0; k < 2; ++k) dst[m][k] = *(const PG8_LAS bf16x8*)(lds + PG8_SA(b, h) + aoff + m * 2048 + k * 1024); } while (0)
#define PG8_LDB(dst, b, h) do { _Pragma("unroll") for (int n = 0; n < 2; ++n) _Pragma("unroll") for (int k = 0; k < 2; ++k) dst[n][k] = *(const PG8_LAS bf16x8*)(lds + PG8_SB(b, h) + boff + n * 2048 + k * 1024); } while (0)
#define PG8_MMA(ai, bj, At, Bt) do { __builtin_amdgcn_s_setprio(1); _Pragma("unroll") for (int m = 0; m < 4; ++m) _Pragma("unroll") for (int n = 0; n < 2; ++n) _Pragma("unroll") for (int k = 0; k < 2; ++k) \
        acc[ai][bj][m][n] = __builtin_amdgcn_mfma_f32_16x16x32_bf16(Bt[n][k], At[m][k], acc[ai][bj][m][n], 0, 0, 0); __builtin_amdgcn_s_setprio(0); } while (0)
#define PG8_WAIT_V(n) asm volatile("s_waitcnt vmcnt(" #n ")" ::: "memory")
#define PG8_WAIT_L(n) asm volatile("s_waitcnt lgkmcnt(" #n ")" ::: "memory")
#define PG8_BAR __builtin_amdgcn_s_barrier()
#define PG8_SCHED __builtin_amdgcn_sched_barrier(0)
    Unit cur, nxt; int ui = 0;
    if (!S.next(0, cur)) return;
    f32x4 acc[2][2][4][2];
#pragma unroll
    for (int a = 0; a < 2; ++a)
#pragma unroll
        for (int b = 0; b < 2; ++b)
#pragma unroll
            for (int m = 0; m < 4; ++m)
#pragma unroll
                for (int n = 0; n < 2; ++n) acc[a][b][m][n] = (f32x4){0.f, 0.f, 0.f, 0.f};
    bf16x8 At[4][2], B0[2][2], B1[2][2];
    const char* cA = (const char*)g.A + (size_t)cur.pm * tstep; const char* cB = (const char*)g.Bt + (size_t)cur.pn * tstep;
    S.a_ready(cur);
    if constexpr (SP2) {
        PG8_STAGE(PG8_SB(0, 0), cB, voffB); PG8_STAGE(PG8_SB(0, 1), cB + hstep, voffB); PG8_STAGE(PG8_SA(0, 0), cA, voffA); PG8_STAGE(PG8_SA(0, 1), cA + hstep, voffA);
        if (wr == 1) PG8_BAR;
        PG8_WAIT_V(2); PG8_BAR;
        PG8_STAGE(PG8_SB(1, 0), cB + kstep, voffB); PG8_STAGE(PG8_SA(1, 0), cA + kstep, voffA); PG8_STAGE(PG8_SB(1, 1), cB + hstep + kstep, voffB);
        PG8_WAIT_V(6); PG8_BAR;
    } else {
        PG8_STAGE(PG8_SB(0, 0), cB, voffB); PG8_STAGE(PG8_SA(0, 0), cA, voffA); PG8_STAGE(PG8_SB(0, 1), cB + hstep, voffB); PG8_STAGE(PG8_SA(0, 1), cA + hstep, voffA);
        if (wr == 1) PG8_BAR;
        PG8_WAIT_V(4); PG8_BAR;
        PG8_STAGE(PG8_SB(1, 0), cB + kstep, voffB); PG8_STAGE(PG8_SA(1, 0), cA + kstep, voffA); PG8_STAGE(PG8_SB(1, 1), cB + hstep + kstep, voffB);
        PG8_WAIT_V(6); PG8_BAR;
    }
    for (;;) {
        const bool has_next = S.next(ui + 1, nxt);
        const char* nA = has_next ? (const char*)g.A + (size_t)nxt.pm * tstep : cA; const char* nB = has_next ? (const char*)g.Bt + (size_t)nxt.pn * tstep : cB;
        for (int t = 0; t < nt; t += 2) {
            const bool last = (t == nt - 2);
            const char* a1 = cA + (size_t)(t + 1) * kstep;
            const char* a2 = last ? nA : cA + (size_t)(t + 2) * kstep; const char* b2 = last ? nB : cB + (size_t)(t + 2) * kstep;
            const char* a3 = a2 + kstep; const char* b3 = b2 + kstep;
            if (last && has_next) S.a_ready(nxt);
            if constexpr (SP2) {
            PG8_LDB(B0, 0, 0); PG8_LDB(B1, 0, 1); PG8_SCHED; PG8_LDA(At, 0, 0); PG8_STAGE(PG8_SA(1, 1), a1 + hstep, voffA);
            PG8_WAIT_V(8); PG8_WAIT_L(0); PG8_BAR; PG8_MMA(0, 0, At, B0); PG8_MMA(0, 1, At, B1); PG8_BAR; PG8_SCHED;
            PG8_LDA(At, 0, 1); PG8_STAGE(PG8_SB(0, 0), b2, voffB); PG8_STAGE(PG8_SB(0, 1), b2 + hstep, voffB); PG8_STAGE(PG8_SA(0, 0), a2, voffA);
            PG8_WAIT_V(8); PG8_WAIT_L(0); PG8_BAR; PG8_MMA(1, 0, At, B0); PG8_MMA(1, 1, At, B1); PG8_BAR; PG8_SCHED;
            PG8_LDB(B0, 1, 0); PG8_LDB(B1, 1, 1); PG8_SCHED; PG8_LDA(At, 1, 0); PG8_STAGE(PG8_SA(0, 1), a2 + hstep, voffA);
            PG8_WAIT_V(8); PG8_WAIT_L(0); PG8_BAR; PG8_MMA(0, 0, At, B0); PG8_MMA(0, 1, At, B1); PG8_BAR; PG8_SCHED;
            PG8_LDA(At, 1, 1); PG8_STAGE(PG8_SB(1, 0), b3, voffB); PG8_STAGE(PG8_SB(1, 1), b3 + hstep, voffB); PG8_STAGE(PG8_SA(1, 0), a3, voffA);
            PG8_WAIT_V(8); PG8_WAIT_L(0); PG8_BAR; PG8_MMA(1, 0, At, B0); PG8_MMA(1, 1, At, B1); PG8_BAR; PG8_SCHED;
            } else {
            PG8_LDB(B0, 0, 0); PG8_SCHED; PG8_LDA(At, 0, 0); PG8_STAGE(PG8_SA(1, 1), a1 + hstep, voffA);
            PG8_WAIT_L(8); PG8_BAR; PG8_WAIT_L(0); PG8_MMA(0, 0, At, B0); PG8_BAR; PG8_SCHED;
            PG8_LDB(B1, 0, 1); PG8_STAGE(PG8_SB(0, 0), b2, voffB);
            PG8_BAR; PG8_WAIT_L(0); PG8_MMA(0, 1, At, B1); PG8_BAR;
            PG8_LDA(At, 0, 1); PG8_STAGE(PG8_SA(0, 0), a2, voffA);
            PG8_BAR; PG8_WAIT_L(0); PG8_MMA(1, 0, At, B0); PG8_BAR; PG8_SCHED;
            PG8_STAGE(PG8_SB(0, 1), b2 + hstep, voffB);
            PG8_WAIT_V(6); PG8_BAR; PG8_MMA(1, 1, At, B1); PG8_BAR;
            PG8_LDB(B0, 1, 0); PG8_SCHED; PG8_LDA(At, 1, 0); PG8_STAGE(PG8_SA(0, 1), a2 + hstep, voffA);
            PG8_WAIT_L(8); PG8_BAR; PG8_WAIT_L(0); PG8_MMA(0, 0, At, B0); PG8_BAR; PG8_SCHED;
            PG8_LDB(B1, 1, 1); PG8_STAGE(PG8_SB(1, 0), b3, voffB);
            PG8_BAR; PG8_WAIT_L(0); PG8_MMA(0, 1, At, B1); PG8_BAR;
            PG8_LDA(At, 1, 1); PG8_STAGE(PG8_SA(1, 0), a3, voffA);
            PG8_BAR; PG8_WAIT_L(0); PG8_MMA(1, 0, At, B0); PG8_BAR; PG8_SCHED;
            PG8_STAGE(PG8_SB(1, 1), b3 + hstep, voffB);
            PG8_WAIT_V(6); PG8_BAR; PG8_MMA(1, 1, At, B1); PG8_BAR;
            }
        }
        if constexpr (ALIGN_EPI) { if (wr == 0) PG8_BAR; }
        if constexpr (!Epi::AFTER_DRAIN) { E(acc, cur, wr, wc, fr, fq); S.done(cur); }
        if (!has_next) break;
#pragma unroll
        for (int a = 0; a < 2; ++a)
#pragma unroll
            for (int b = 0; b < 2; ++b)
#pragma unroll
                for (int m = 0; m < 4; ++m)
#pragma unroll
                    for (int n = 0; n < 2; ++n) acc[a][b][m][n] = (f32x4){0.f, 0.f, 0.f, 0.f};
        cur = nxt; cA = nA; cB = nB; ++ui;
        if constexpr (ALIGN_EPI) { if (wr == 1) PG8_BAR; }
    }
    PG8_WAIT_V(0);
    if constexpr (!ALIGN_EPI) { if (wr == 0) PG8_BAR; }
    PG8_BAR;
    if constexpr (Epi::AFTER_DRAIN) { E.fused(acc, cur, wr, wc, fr, fq, lds, wid, lane); S.done(cur); }
#undef PG8_SA
#undef PG8_SB
#undef PG8_STAGE
#undef PG8_LDA
#undef PG8_LDB
#undef PG8_MMA
#undef PG8_WAIT_V
#undef PG8_WAIT_L
#undef PG8_BAR
#undef PG8_SCHED
}
}

#define GAS __attribute__((address_space(1)))
#define LAS __attribute__((address_space(3)))
typedef unsigned short bf16;
typedef unsigned v4u __attribute__((ext_vector_type(4)));
typedef unsigned v2u __attribute__((ext_vector_type(2)));
typedef float f32x4 __attribute__((ext_vector_type(4)));
typedef float f32x2v __attribute__((ext_vector_type(2)));

constexpr int DM = 1024, NB_P = 8, SEQ = 2048, NB_S = 128, DSEQ = 4;
constexpr int TP = NB_P * SEQ, TS = NB_S * DSEQ, T = TP + TS;
constexpr int DN_IN = 6176, DN_INP = 6400, PROJ_LD = 6144, CONV_DIM = 4096, VAL_DIM = 2048;
constexpr int QKV_N = 1536, DFF = 2816, GU_N = 5632;
constexpr float RMS_EPS = 1e-6f, L2_EPS = 1e-6f;

constexpr size_t O_YP = 0, O_YS = 16777216, O_CONVP = 17301504, O_DELTAP = 17498112, O_KP = 21692416, O_VP = 22216704,
                 O_CONVS = 22740992, O_DELTAS = 25886720, O_KS = 92995584, O_VS = 93257728, O_END = 93519872;

constexpr size_t MiB = 1u << 20;
constexpr size_t WS_CTL = 0, CTL_ZERO_BYTES = 1 * MiB;
constexpr size_t WS_WIN = 2 * MiB;
constexpr size_t WS_WOUT = 27 * MiB;
constexpr size_t WS_WQKV = 35 * MiB;
constexpr size_t WS_WO = 41 * MiB;
constexpr size_t WS_WGU = 45 * MiB;
constexpr size_t WS_WDOWN = 89 * MiB;
constexpr size_t WS_X = 112 * MiB;
constexpr size_t WS_XB = 178 * MiB;
constexpr size_t WS_SSQ = 211 * MiB;
constexpr size_t WS_BA = 213 * MiB;
constexpr size_t WS_BG = 216 * MiB;
constexpr size_t WS_PROJ = 220 * MiB;
constexpr size_t WS_Q = 220 * MiB;
constexpr size_t WS_KB = 253 * MiB;
constexpr size_t WS_VB = 262 * MiB;
constexpr size_t WS_ATT = 271 * MiB;
constexpr size_t WS_QKV = 418 * MiB;
constexpr size_t WS_OG = 682 * MiB;
constexpr size_t WS_ACT = 748 * MiB;
constexpr size_t WS_END = 840 * MiB;
constexpr size_t KV_DELTA = (WS_VB - WS_KB) / 2;

constexpr int NWAVES = 8, NTHREADS = 512;
constexpr int LDS_BYTES = 147456;

#define LDS_WAIT() asm volatile("s_waitcnt lgkmcnt(0)" ::: "memory")
__device__ __forceinline__ unsigned f2bf(float f) { unsigned u = __builtin_bit_cast(unsigned, f); return (u + 0x7fffu + ((u >> 16) & 1u)) >> 16; }
__device__ __forceinline__ unsigned pk2(float lo, float hi) { return f2bf(lo) | (f2bf(hi) << 16); }
__device__ __forceinline__ float bf2f(unsigned short b) { return __builtin_bit_cast(float, (unsigned)b << 16); }
__device__ __forceinline__ float bflo(unsigned w) { return __builtin_bit_cast(float, w << 16); }
__device__ __forceinline__ float bfhi(unsigned w) { return __builtin_bit_cast(float, w & 0xffff0000u); }
__device__ __forceinline__ float wave_sum(float v) {
#pragma unroll
    for (int o = 1; o < 64; o <<= 1) v += __shfl_xor(v, o);
    return v;
}
__device__ __forceinline__ float wave_max(float v) {
#pragma unroll
    for (int o = 1; o < 64; o <<= 1) v = fmaxf(v, __shfl_xor(v, o));
    return v;
}
__device__ __forceinline__ float silu_f(float x) { return x / (1.f + __expf(-x)); }
__device__ __forceinline__ float row_rstd(const float* ssq, int row) {
    const f32x4* p = (const f32x4*)(ssq + (size_t)row * 16);
    const f32x4 a = p[0], b = p[1], c = p[2], d = p[3];
    const float s = ((a[0] + a[1]) + (a[2] + a[3])) + ((b[0] + b[1]) + (b[2] + b[3])) + ((c[0] + c[1]) + (c[2] + c[3])) + ((d[0] + d[1]) + (d[2] + d[3]));
    return rsqrtf(s * (1.f / 1024.f) + RMS_EPS);
}

using pg8::Unit; using pg8::cvt_pk_bf16;
struct EpiDnIn {
    static constexpr bool PERM = true, AFTER_DRAIN = false;
    bf16* proj; float* ba; const float* ssq;
    __device__ __forceinline__ void operator()(const f32x4 (&acc)[2][2][4][2], const Unit& u, int wr, int wc, int fr, int fq) const {
        const int row0 = u.pm * 256 + wr * 64 + fr;
        if (u.pn < 24) {
            const int col0 = u.pn * 256 + wc * 32 + 8 * fq;
#pragma unroll
            for (int ai = 0; ai < 2; ++ai)
#pragma unroll
                for (int m = 0; m < 4; ++m) { const int row = row0 + ai * 128 + m * 16; const float rs = row_rstd(ssq, row);
                    bf16* rowp = proj + (size_t)row * PROJ_LD + col0;
#pragma unroll
                    for (int bj = 0; bj < 2; ++bj) { const f32x4 v0 = acc[ai][bj][m][0] * rs, v1 = acc[ai][bj][m][1] * rs;
                        v4u w; w.x = cvt_pk_bf16(v0[0], v0[1]); w.y = cvt_pk_bf16(v0[2], v0[3]); w.z = cvt_pk_bf16(v1[0], v1[1]); w.w = cvt_pk_bf16(v1[2], v1[3]);
                        *(v4u*)(rowp + bj * 128) = w; } }
        } else if (wc == 0) {
#pragma unroll
            for (int ai = 0; ai < 2; ++ai)
#pragma unroll
                for (int m = 0; m < 4; ++m) { const int row = row0 + ai * 128 + m * 16; const float rs = row_rstd(ssq, row);
                    float* o = ba + (size_t)row * 32 + 8 * fq;
                    *(f32x4*)o = acc[ai][0][m][0] * rs; *(f32x4*)(o + 4) = acc[ai][0][m][1] * rs; }
        }
    }
};
struct EpiRes {
    static constexpr bool PERM = false, AFTER_DRAIN = false;
    float* X; bf16* XB; float* ssq; const float* bias;
    __device__ __forceinline__ void operator()(const f32x4 (&acc)[2][2][4][2], const Unit& u, int wr, int wc, int fr, int fq) const {
        const int row0 = u.pm * 256 + wr * 64 + fr, col0 = u.pn * 256 + wc * 32 + 4 * fq;
#pragma unroll
        for (int ai = 0; ai < 2; ++ai)
#pragma unroll
            for (int m = 0; m < 4; ++m) { const int row = row0 + ai * 128 + m * 16; float s = 0.f;
#pragma unroll
                for (int bj = 0; bj < 2; ++bj)
#pragma unroll
                    for (int n = 0; n < 2; ++n) { const int c = col0 + bj * 128 + n * 16; float* xp = X + (size_t)row * DM + c;
                        f32x4 x = *(const f32x4*)xp + acc[ai][bj][m][n];
                        if (bias) x = x + *(const f32x4*)(bias + c);
                        *(f32x4*)xp = x; v2u w; w.x = cvt_pk_bf16(x[0], x[1]); w.y = cvt_pk_bf16(x[2], x[3]);
                        *(v2u*)(XB + (size_t)row * DM + c) = w;
                        s += (x[0] * x[0] + x[1] * x[1]) + (x[2] * x[2] + x[3] * x[3]); }
                s += __shfl_xor(s, 16); s += __shfl_xor(s, 32);
                if (fq == 0) ssq[(size_t)row * 16 + u.pn * 4 + wc] = s; }
    }
};
struct EpiQkv {
    static constexpr bool PERM = true, AFTER_DRAIN = false;
    bf16 *Q, *KB; const float* ssq; const float* bias; float *okp, *oks;
    __device__ __forceinline__ void operator()(const f32x4 (&acc)[2][2][4][2], const Unit& u, int wr, int wc, int fr, int fq) const {
        const int row0 = u.pm * 256 + wr * 64 + fr, cw = wc * 32 + 8 * fq;
        const bool isq = u.pn < 4; const size_t kvsel = (u.pn == 5) ? 1 : 0;
        const float qs = isq ? 0.125f : 1.f;
#pragma unroll
        for (int ai = 0; ai < 2; ++ai)
#pragma unroll
            for (int m = 0; m < 4; ++m) { const int row = row0 + ai * 128 + m * 16; const float rs = row_rstd(ssq, row);
#pragma unroll
                for (int bj = 0; bj < 2; ++bj) { const int colk = bj * 128 + cw, gcol = u.pn * 256 + colk;
                    const f32x4 v0 = (acc[ai][bj][m][0] * rs + *(const f32x4*)(bias + gcol)) * qs, v1 = (acc[ai][bj][m][1] * rs + *(const f32x4*)(bias + gcol + 4)) * qs;
                    v4u w; w.x = cvt_pk_bf16(v0[0], v0[1]); w.y = cvt_pk_bf16(v0[2], v0[3]); w.z = cvt_pk_bf16(v1[0], v1[1]); w.w = cvt_pk_bf16(v1[2], v1[3]);
                    if (isq) *(v4u*)(Q + (size_t)row * DM + gcol) = w;
                    else {
                        *(v4u*)(KB + kvsel * KV_DELTA + (size_t)row * 256 + colk) = w;
                        if (row < TP) { const int b = row >> 11, pos = row & 2047;
                            if (pos >= 1920) { float* o = okp + kvsel * (O_VP - O_KP) + (size_t)(b * 128 + pos - 1920) * 256 + colk; *(f32x4*)o = v0; *(f32x4*)(o + 4) = v1; } }
                        else { float* o = oks + kvsel * (O_VS - O_KS) + (size_t)(row - TP) * 256 + colk; *(f32x4*)o = v0; *(f32x4*)(o + 4) = v1; } } } }
    }
};
struct EpiGu {
    static constexpr bool PERM = true, AFTER_DRAIN = false;
    bf16* act; const float* ssq;
    __device__ __forceinline__ void operator()(const f32x4 (&acc)[2][2][4][2], const Unit& u, int wr, int wc, int fr, int fq) const {
        const int row0 = u.pm * 256 + wr * 64 + fr, col0 = u.pn * 128 + wc * 32 + 8 * fq;
#pragma unroll
        for (int ai = 0; ai < 2; ++ai)
#pragma unroll
            for (int m = 0; m < 4; ++m) { const int row = row0 + ai * 128 + m * 16; const float rs = row_rstd(ssq, row);
                float r[8];
#pragma unroll
                for (int n = 0; n < 2; ++n)
#pragma unroll
                    for (int e = 0; e < 4; ++e) { const float g = acc[ai][0][m][n][e] * rs, uu = acc[ai][1][m][n][e] * rs; r[n * 4 + e] = silu_f(g) * uu; }
                v4u w; w.x = cvt_pk_bf16(r[0], r[1]); w.y = cvt_pk_bf16(r[2], r[3]); w.z = cvt_pk_bf16(r[4], r[5]); w.w = cvt_pk_bf16(r[6], r[7]);
                *(v4u*)(act + (size_t)row * DFF + col0) = w; }
    }
};

struct Args { const float* in[22]; float* out; unsigned char* ws; int ph_lo, ph_hi; };
typedef const __attribute__((address_space(4))) Args* CArgs;
__device__ __forceinline__ CArgs kargs() { CArgs p = (CArgs)__builtin_amdgcn_kernarg_segment_ptr(); asm volatile("" : "+s"(p)); return p; }

__device__ __forceinline__ void tr_item(const float* W, int K, int N, const float* nw, bf16* WT, int dst_row0, LAS float* scr, int k0, int n0, int lane) {
#pragma unroll 8
    for (int i = 0; i < 32; ++i) { const int kk = 2 * i + (lane >> 5); const float s = nw ? nw[k0 + kk] : 1.f;
        scr[kk * 33 + (lane & 31)] = W[(size_t)(k0 + kk) * N + n0 + (lane & 31)] * s; }
    LDS_WAIT(); asm volatile("" ::: "memory");
    const int c = lane & 7;
#pragma unroll
    for (int j = 0; j < 4; ++j) { const int n = (lane >> 3) + 8 * j; const LAS float* s = scr + (8 * c) * 33 + n;
        v4u o; o.x = pk2(s[0 * 33], s[1 * 33]); o.y = pk2(s[2 * 33], s[3 * 33]); o.z = pk2(s[4 * 33], s[5 * 33]); o.w = pk2(s[6 * 33], s[7 * 33]);
        *(v4u*)(WT + (size_t)(dst_row0 + n) * K + k0 + 8 * c) = o; }
    LDS_WAIT(); asm volatile("" ::: "memory");
}
__device__ __forceinline__ void tr_matrix_item(const float* W, int K, int N, const float* nw, bf16* WT, int gu, LAS float* scr, int r, int lane) {
    const int nblk = N / 32, kb = r / nblk, nb = r % nblk, k0 = 64 * kb, n0 = 32 * nb;
    int dr = n0;
    if (gu) dr = (n0 < DFF) ? (n0 / 128) * 256 + (n0 % 128) : ((n0 - DFF) / 128) * 256 + 128 + ((n0 - DFF) % 128);
    tr_item(W, K, N, nw, WT, dr, scr, k0, n0, lane);
}
__device__ __forceinline__ void phase_prologue(CArgs ap, LAS unsigned char* lds) {
    int tid_ = threadIdx.x; asm volatile("" : "+v"(tid_)); const int tid = tid_, lane = tid & 63, wave = __builtin_amdgcn_readfirstlane(tid >> 6);
    LAS float* scr = (LAS float*)(lds + wave * 16384);
    const int gw = blockIdx.x * NWAVES + wave, NGW = gridDim.x * NWAVES;
    unsigned char* ws = ap->ws;
    constexpr int I_IN = 16 * 193, I_OUT = 32 * 32, I_QKV = 16 * 48, I_O = 16 * 32, I_GU = 16 * 176, I_DN = 44 * 32;
    constexpr int NITEMS = 2 * I_IN + 2 * I_OUT + 2 * I_QKV + 2 * I_O + 4 * I_GU + 4 * I_DN;
    for (int it = gw; it < NITEMS; it += NGW) {
        int r = it;
        if (r < 2 * I_IN) { const int j = r / I_IN; r -= j * I_IN;
            tr_matrix_item(ap->in[9] + (size_t)j * DM * DN_IN, DM, DN_IN, ap->in[6] + (2 * j) * DM, (bf16*)(ws + WS_WIN) + (size_t)j * DN_INP * DM, 0, scr, r, lane); continue; }
        r -= 2 * I_IN;
        if (r < 2 * I_OUT) { const int j = r / I_OUT; r -= j * I_OUT;
            tr_matrix_item(ap->in[14] + (size_t)j * VAL_DIM * DM, VAL_DIM, DM, nullptr, (bf16*)(ws + WS_WOUT) + (size_t)j * DM * VAL_DIM, 0, scr, r, lane); continue; }
        r -= 2 * I_OUT;
        if (r < 2 * I_QKV) { const int j = r / I_QKV; r -= j * I_QKV;
            tr_matrix_item(ap->in[15] + (size_t)j * DM * QKV_N, DM, QKV_N, ap->in[6] + (2 * j + 1) * DM, (bf16*)(ws + WS_WQKV) + (size_t)j * QKV_N * DM, 0, scr, r, lane); continue; }
        r -= 2 * I_QKV;
        if (r < 2 * I_O) { const int j = r / I_O; r -= j * I_O;
            tr_matrix_item(ap->in[18] + (size_t)j * DM * DM, DM, DM, nullptr, (bf16*)(ws + WS_WO) + (size_t)j * DM * DM, 0, scr, r, lane); continue; }
        r -= 2 * I_O;
        if (r < 4 * I_GU) { const int i = r / I_GU; r -= i * I_GU;
            tr_matrix_item(ap->in[20] + (size_t)i * DM * GU_N, DM, GU_N, ap->in[7] + i * DM, (bf16*)(ws + WS_WGU) + (size_t)i * GU_N * DM, 1, scr, r, lane); continue; }
        r -= 4 * I_GU;
        { const int i = r / I_DN; r -= i * I_DN;
            tr_matrix_item(ap->in[21] + (size_t)i * DFF * DM, DFF, DM, nullptr, (bf16*)(ws + WS_WDOWN) + (size_t)i * DM * DFF, 0, scr, r, lane); }
    }
    for (int i = blockIdx.x * NTHREADS + tid; i < 2 * 28672; i += gridDim.x * NTHREADS) { const int j = i / 28672, o = i % 28672;
        *(v4u*)((bf16*)(ws + WS_WIN) + (size_t)j * DN_INP * DM + (size_t)DN_IN * DM + (size_t)o * 8) = (v4u){0u, 0u, 0u, 0u}; }
    float* X = (float*)(ws + WS_X); bf16* XB = (bf16*)(ws + WS_XB); float* SSQ = (float*)(ws + WS_SSQ);
    for (int m = gw; m < T; m += NGW) {
        const float* src = (m < TP) ? ap->in[0] + (size_t)m * DM : ap->in[1] + (size_t)(m - TP) * DM;
        float s = 0.f;
#pragma unroll
        for (int j = 0; j < 4; ++j) { const f32x4 v = *((const f32x4*)src + lane + 64 * j);
            *((f32x4*)(X + (size_t)m * DM) + lane + 64 * j) = v;
            v2u w; w.x = pk2(v[0], v[1]); w.y = pk2(v[2], v[3]); *((v2u*)(XB + (size_t)m * DM) + lane + 64 * j) = w;
            s += (v[0] * v[0] + v[1] * v[1]) + (v[2] * v[2] + v[3] * v[3]); }
        s = wave_sum(s);
        if (lane < 16) SSQ[(size_t)m * 16 + lane] = (lane == 0) ? s : 0.f;
    }
}

__device__ __forceinline__ void phase_dn_post(CArgs ap, int j) {
    int tid_ = threadIdx.x; asm volatile("" : "+v"(tid_)); const int tid = tid_, lane = tid & 63, wave = __builtin_amdgcn_readfirstlane(tid >> 6);
    const int gw = blockIdx.x * NWAVES + wave, NGW = gridDim.x * NWAVES;
    unsigned char* ws = ap->ws;
    const bf16* PROJ = (const bf16*)(ws + WS_PROJ); const float* BA = (const float*)(ws + WS_BA);
    float* QKV = (float*)(ws + WS_QKV); float* BG = (float*)(ws + WS_BG);
    const float* cw = ap->in[10] + (size_t)j * 4 * CONV_DIM;
    const float* sconv = ap->in[2] + (size_t)j * NB_S * 3 * CONV_DIM;
    float* oconvp = ap->out + O_CONVP + (size_t)j * NB_P * 3 * CONV_DIM;
    float* oconvs = ap->out + O_CONVS + (size_t)j * NB_S * 3 * CONV_DIM;
    for (int task = gw; task < T * 32; task += NGW) {
        const int t = task >> 5, hc = task & 31, col0 = hc * 128 + 2 * lane;
        const bool prompt = t < TP; const int pos = prompt ? (t & 2047) : ((t - TP) & 3); const int b = prompt ? (t >> 11) : ((t - TP) >> 2);
        float y0 = 0.f, y1 = 0.f, u00 = 0.f, u01 = 0.f;
#pragma unroll
        for (int k = 0; k < 4; ++k) {
            float u0 = 0.f, u1 = 0.f;
            if (pos - k >= 0) { const unsigned w = *(const unsigned*)(PROJ + (size_t)(t - k) * PROJ_LD + col0); u0 = bflo(w); u1 = bfhi(w); }
            else if (!prompt) { const f32x2v v = *(const f32x2v*)(sconv + (size_t)(b * 3 + (3 + pos - k)) * CONV_DIM + col0); u0 = v[0]; u1 = v[1]; }
            const f32x2v wv = *(const f32x2v*)(cw + (size_t)(3 - k) * CONV_DIM + col0);
            y0 += u0 * wv[0]; y1 += u1 * wv[1];
            if (k == 0) { u00 = u0; u01 = u1; }
        }
        y0 = silu_f(y0); y1 = silu_f(y1);
        if (hc < 16) {
            const float ss = wave_sum(y0 * y0 + y1 * y1);
            float inv = rsqrtf(ss + L2_EPS); if (hc < 8) inv *= 0.08838834764831845f;
            y0 *= inv; y1 *= inv;
        }
        *(f32x2v*)(QKV + (size_t)t * CONV_DIM + col0) = (f32x2v){y0, y1};
        if (prompt) { if (pos >= SEQ - 3) *(f32x2v*)(oconvp + (size_t)(b * 3 + pos - (SEQ - 3)) * CONV_DIM + col0) = (f32x2v){u00, u01}; }
        else if (pos >= 1) *(f32x2v*)(oconvs + (size_t)(b * 3 + pos - 1) * CONV_DIM + col0) = (f32x2v){u00, u01};
        if (hc == 0 && lane < 32) {
            const int h = lane & 15; const float v = BA[(size_t)t * 32 + lane];
            float r;
            if (lane < 16) r = 1.f / (1.f + __expf(-v));
            else { const float x = v + ap->in[12][j * 16 + h]; const float sp = (x > 20.f) ? x : log1pf(__expf(x)); r = -__expf(ap->in[11][j * 16 + h]) * sp; }
            BG[(size_t)t * 32 + lane] = r;
        }
    }
}

__device__ __forceinline__ void phase_delta_rec(CArgs ap, int j, LAS unsigned char* lds) {
    int tid_ = threadIdx.x; asm volatile("" : "+v"(tid_)); const int tid = tid_, lane = tid & 63, wave = __builtin_amdgcn_readfirstlane(tid >> 6);
    const int e = tid & 127, dq = tid >> 7;
    unsigned char* ws = ap->ws;
    const float* QKV = (const float*)(ws + WS_QKV); const float* BG = (const float*)(ws + WS_BG); const bf16* PROJ = (const bf16*)(ws + WS_PROJ);
    bf16* OG = (bf16*)(ws + WS_OG);
    const float* nw = ap->in[13] + j * 128;
    constexpr int NTB = 16;
    LAS float* qs = (LAS float*)lds;
    LAS float* ks = qs + NTB * 128;
    LAS float* vs = ks + NTB * 128;
    LAS float* ob = vs + NTB * 128;
    LAS float* red = ob + NTB * 128;
    LAS float* red2 = red + 512;
    LAS float* ab = red2 + 512;
    for (int unit = blockIdx.x; unit < 128 + 2048; unit += gridDim.x) {
        int b, h, L, t0; const float* s0 = nullptr; float* sout;
        if (unit < 128) { b = unit >> 4; h = unit & 15; L = SEQ; t0 = b * SEQ; sout = ap->out + O_DELTAP + ((size_t)(j * NB_P + b) * 16 + h) * 16384; }
        else { const int su = unit - 128; b = su >> 4; h = su & 15; L = DSEQ; t0 = TP + b * DSEQ;
            s0 = ap->in[3] + ((size_t)(j * NB_S + b) * 16 + h) * 16384; sout = ap->out + O_DELTAS + ((size_t)(j * NB_S + b) * 16 + h) * 16384; }
        const int hq = h >> 1;
        float S[32];
#pragma unroll
        for (int i = 0; i < 32; ++i) S[i] = s0 ? s0[(size_t)(32 * dq + i) * 128 + e] : 0.f;
        for (int tb = 0; tb < L; tb += NTB) {
            const int nb = (L - tb) < NTB ? (L - tb) : NTB;
            __syncthreads();
            for (int i = tid; i < nb * 384; i += NTHREADS) { const int tt = i / 384, rem = i % 384, which = rem >> 7, ee = rem & 127;
                const int col = (which == 0) ? hq * 128 + ee : (which == 1) ? 1024 + hq * 128 + ee : 2048 + h * 128 + ee;
                qs[which * (NTB * 128) + tt * 128 + ee] = QKV[(size_t)(t0 + tb + tt) * CONV_DIM + col]; }
            if (tid < nb) { ab[tid * 2] = __expf(BG[(size_t)(t0 + tb + tid) * 32 + 16 + h]); ab[tid * 2 + 1] = BG[(size_t)(t0 + tb + tid) * 32 + h]; }
            __syncthreads();
            for (int tt = 0; tt < nb; ++tt) {
                const float av = ab[tt * 2], bt = ab[tt * 2 + 1];
                float part = 0.f;
#pragma unroll
                for (int i = 0; i < 32; ++i) part += ks[tt * 128 + 32 * dq + i] * S[i];
                red[dq * 128 + e] = part;
                __syncthreads();
                const float kS = (red[e] + red[128 + e]) + (red[256 + e] + red[384 + e]);
                const float vv = bt * (vs[tt * 128 + e] - av * kS);
                float po = 0.f;
#pragma unroll
                for (int i = 0; i < 32; ++i) { S[i] = av * S[i] + ks[tt * 128 + 32 * dq + i] * vv; po += S[i] * qs[tt * 128 + 32 * dq + i]; }
                red2[dq * 128 + e] = po;
                __syncthreads();
                if (dq == 0) ob[tt * 128 + e] = (red2[e] + red2[128 + e]) + (red2[256 + e] + red2[384 + e]);
            }
            __syncthreads();
            for (int tt = wave; tt < nb; tt += NWAVES) {
                const float o0 = ob[tt * 128 + lane], o1 = ob[tt * 128 + 64 + lane];
                const float ss = wave_sum(o0 * o0 + o1 * o1);
                const float rs = rsqrtf(ss * (1.f / 128.f) + RMS_EPS);
                const size_t tok = (size_t)(t0 + tb + tt);
                const float z0 = bf2f(PROJ[tok * PROJ_LD + 4096 + h * 128 + lane]), z1 = bf2f(PROJ[tok * PROJ_LD + 4096 + h * 128 + 64 + lane]);
                OG[tok * VAL_DIM + h * 128 + lane] = (bf16)f2bf(o0 * rs * nw[lane] * silu_f(z0));
                OG[tok * VAL_DIM + h * 128 + 64 + lane] = (bf16)f2bf(o1 * rs * nw[64 + lane] * silu_f(z1));
            }
        }
#pragma unroll
        for (int i = 0; i < 32; ++i) sout[(size_t)(32 * dq + i) * 128 + e] = S[i];
        __syncthreads();
    }
}

__device__ __forceinline__ void phase_swa_attn(CArgs ap, int j, LAS unsigned char* lds) {
    int tid_ = threadIdx.x; asm volatile("" : "+v"(tid_)); const int tid = tid_, lane = tid & 63, wave = __builtin_amdgcn_readfirstlane(tid >> 6);
    const int gw = blockIdx.x * NWAVES + wave, NGW = gridDim.x * NWAVES;
    unsigned char* ws = ap->ws;
    const bf16* Q = (const bf16*)(ws + WS_Q); const bf16* KB = (const bf16*)(ws + WS_KB); const bf16* VB = (const bf16*)(ws + WS_VB);
    bf16* ATT = (bf16*)(ws + WS_ATT);
    const float* ck = ap->in[4] + (size_t)j * NB_S * 128 * 256; const float* cv = ap->in[5] + (size_t)j * NB_S * 128 * 256;
    const float* sinks = ap->in[17] + j * 16;
    LAS float* qs = (LAS float*)(lds + wave * 4096);
    LAS float* ps = qs + 256;
    for (int task = gw; task < T * 4; task += NGW) {
        const int t = task >> 2, kh = task & 3;
#pragma unroll
        for (int g = 0; g < 4; ++g) qs[g * 64 + lane] = bf2f(Q[(size_t)t * DM + (kh * 4 + g) * 64 + lane]);
        LDS_WAIT(); asm volatile("" ::: "memory");
        const bool prompt = t < TP; int nk, b = 0, l = 0;
        if (prompt) { const int pos = t & 2047; nk = (pos < 128 ? pos : 128) + 1; } else { const int r = t - TP; b = r >> 2; l = r & 3; nk = 129; }
        const float sl0 = exp2f(-0.5f * (float)(kh * 4 + 1)), sl1 = exp2f(-0.5f * (float)(kh * 4 + 2)), sl2 = exp2f(-0.5f * (float)(kh * 4 + 3)), sl3 = exp2f(-0.5f * (float)(kh * 4 + 4));
#pragma unroll 1
        for (int kb = 0; kb < 3; ++kb) {
            const int jj = kb * 64 + lane; const bool valid = jj < nk;
            float d0 = 0.f, d1 = 0.f, d2 = 0.f, d3 = 0.f;
            if (valid) {
                const int cj = l + jj;
                if (prompt || cj >= 128) {
                    const bf16* kp = prompt ? KB + (size_t)(t - (nk - 1) + jj) * 256 + kh * 64 : KB + (size_t)(TP + b * 4 + (cj - 128)) * 256 + kh * 64;
#pragma unroll 1
                    for (int d = 0; d < 64; d += 8) {
                        const v4u w = *(const v4u*)(kp + d);
                        const float kv[8] = {bflo(w.x), bfhi(w.x), bflo(w.y), bfhi(w.y), bflo(w.z), bfhi(w.z), bflo(w.w), bfhi(w.w)};
#pragma unroll
                        for (int i = 0; i < 8; ++i) { d0 += kv[i] * qs[d + i]; d1 += kv[i] * qs[64 + d + i]; d2 += kv[i] * qs[128 + d + i]; d3 += kv[i] * qs[192 + d + i]; }
                    }
                } else {
                    const float* kf = ck + (size_t)(b * 128 + cj) * 256 + kh * 64;
#pragma unroll 1
                    for (int d = 0; d < 64; d += 4) {
                        const f32x4 x = *(const f32x4*)(kf + d);
#pragma unroll
                        for (int i = 0; i < 4; ++i) { d0 += x[i] * qs[d + i]; d1 += x[i] * qs[64 + d + i]; d2 += x[i] * qs[128 + d + i]; d3 += x[i] * qs[192 + d + i]; }
                    }
                }
            }
            const float rel = (float)((nk - 1) - jj);
            const float NEG = -INFINITY;
            ps[jj] = valid ? d0 - sl0 * rel : NEG; ps[192 + jj] = valid ? d1 - sl1 * rel : NEG; ps[384 + jj] = valid ? d2 - sl2 * rel : NEG; ps[576 + jj] = valid ? d3 - sl3 * rel : NEG;
        }
        LDS_WAIT(); asm volatile("" ::: "memory");
#pragma unroll 1
        for (int g = 0; g < 4; ++g) {
            const float sk = sinks[kh * 4 + g];
            const float s0 = ps[g * 192 + lane], s1 = ps[g * 192 + 64 + lane], s2 = ps[g * 192 + 128 + lane];
            float m = wave_max(fmaxf(fmaxf(s0, s1), s2)); m = fmaxf(m, sk);
            const float p0 = __expf(s0 - m), p1 = __expf(s1 - m), p2 = __expf(s2 - m);
            const float den = wave_sum(p0 + p1 + p2) + __expf(sk - m); const float inv = 1.f / den;
            ps[g * 192 + lane] = p0 * inv; ps[g * 192 + 64 + lane] = p1 * inv; ps[g * 192 + 128 + lane] = p2 * inv;
        }
        LDS_WAIT(); asm volatile("" ::: "memory");
        float o0 = 0.f, o1 = 0.f, o2 = 0.f, o3 = 0.f;
        if (prompt) {
            const bf16* vp = VB + (size_t)(t - (nk - 1)) * 256 + kh * 64 + lane;
#pragma unroll 4
            for (int jj = 0; jj < nk; ++jj) { const float vv = bf2f(vp[(size_t)jj * 256]);
                o0 += ps[jj] * vv; o1 += ps[192 + jj] * vv; o2 += ps[384 + jj] * vv; o3 += ps[576 + jj] * vv; }
        } else {
#pragma unroll 4
            for (int jj = 0; jj < 129; ++jj) { const int cj = l + jj;
                const float vv = (cj < 128) ? cv[(size_t)(b * 128 + cj) * 256 + kh * 64 + lane] : bf2f(VB[(size_t)(TP + b * 4 + (cj - 128)) * 256 + kh * 64 + lane]);
                o0 += ps[jj] * vv; o1 += ps[192 + jj] * vv; o2 += ps[384 + jj] * vv; o3 += ps[576 + jj] * vv; }
        }
        bf16* op = ATT + (size_t)t * DM + kh * 256 + lane;
        op[0] = (bf16)f2bf(o0); op[64] = (bf16)f2bf(o1); op[128] = (bf16)f2bf(o2); op[192] = (bf16)f2bf(o3);
        LDS_WAIT(); asm volatile("" ::: "memory");
    }
}

__device__ __forceinline__ void phase_final(CArgs ap) {
    int tid_ = threadIdx.x; asm volatile("" : "+v"(tid_)); const int tid = tid_, lane = tid & 63, wave = __builtin_amdgcn_readfirstlane(tid >> 6);
    const int gw = blockIdx.x * NWAVES + wave, NGW = gridDim.x * NWAVES;
    const float* X = (const float*)(ap->ws + WS_X); const float* nw = ap->in[8];
    for (int m = gw; m < T; m += NGW) {
        f32x4 v[4]; float s = 0.f;
#pragma unroll
        for (int j = 0; j < 4; ++j) { v[j] = *((const f32x4*)(X + (size_t)m * DM) + lane + 64 * j); s += (v[j][0] * v[j][0] + v[j][1] * v[j][1]) + (v[j][2] * v[j][2] + v[j][3] * v[j][3]); }
        const float rs = rsqrtf(wave_sum(s) * (1.f / 1024.f) + RMS_EPS);
        float* o = ap->out + (size_t)m * DM;
#pragma unroll
        for (int j = 0; j < 4; ++j) { const f32x4 w = *((const f32x4*)nw + lane + 64 * j); *((f32x4*)o + lane + 64 * j) = v[j] * rs * w; }
    }
}

#define XB_TMO      128
#define XB_XCNT(j)  (256  + 64 * (j))
#define XB_XSUB(j)  (1280 + 64 * (j))
#define XB_XGEN(j)  (2304 + 64 * (j))
#define XB_TOP      3328
#define XB_TOPGEN   3392
#define XCD_BAR_WORDS 3456
#define XB_SPIN_CAP (1u << 18)

__device__ __forceinline__ unsigned xb_ld(unsigned* p)              { return __hip_atomic_load(p, __ATOMIC_RELAXED, __HIP_MEMORY_SCOPE_AGENT); }
__device__ __forceinline__ unsigned xb_add(unsigned* p, unsigned v) { return __hip_atomic_fetch_add(p, v, __ATOMIC_RELAXED, __HIP_MEMORY_SCOPE_AGENT); }
__device__ __forceinline__ unsigned xb_xcc_id() { return (unsigned)__builtin_amdgcn_s_getreg((3 << 11) | 20) & 0xFu; }
#define XB_SPIN(cond, bar) do { unsigned _sp = 0; while (cond) { __builtin_amdgcn_s_sleep(1); \
    if ((++_sp & 255u) == 0u) { if (xb_ld(&(bar)[XB_TMO])) break; if (_sp > XB_SPIN_CAP) { atomicAdd(&(bar)[XB_TMO], 1u); break; } } } } while (0)

struct XcdBarrier {
    unsigned* bar; unsigned x;
    volatile LAS unsigned* st;
};

__device__ __forceinline__ XcdBarrier xcd_barrier_post(unsigned* bar, volatile LAS unsigned* st) {
    XcdBarrier b; b.bar = bar; b.x = xb_xcc_id(); b.st = st;
    if (threadIdx.x == 0) (void)xb_add(&bar[XB_XCNT(b.x)], 1u);
    return b;
}
__device__ __forceinline__ void xcd_barrier_complete(unsigned* bar, unsigned x, unsigned& nloc, unsigned& nx) {
    const unsigned G = gridDim.x * gridDim.y * gridDim.z;
    unsigned sum, cnt, mine, sp = 0u;
    for (;;) {
        sum = 0u; cnt = 0u; mine = 0u;
#pragma unroll
        for (unsigned j = 0; j < 16; ++j) { const unsigned c = xb_ld(&bar[XB_XCNT(j)]); sum += c; cnt += (c > 0u) ? 1u : 0u; mine = (j == x) ? c : mine; }
        if (sum == G) break;
        __builtin_amdgcn_s_sleep(1);
        if ((++sp & 255u) == 0u) { if (xb_ld(&bar[XB_TMO])) break; if (sp > XB_SPIN_CAP) { atomicAdd(&bar[XB_TMO], 1u); break; } }
    }
    nloc = mine > 0u ? mine : 1u; nx = cnt > 0u ? cnt : 1u;
}

__device__ __forceinline__ void xcd_barrier(const XcdBarrier& b) {
    asm volatile("s_waitcnt vmcnt(0)" ::: "memory");
    __syncthreads();
    if (threadIdx.x == 0) {
        unsigned* bar = b.bar;
        __builtin_amdgcn_s_waitcnt(0);
        unsigned nloc = b.st[0], nx = b.st[1];
        if (nloc == 0u) { xcd_barrier_complete(bar, b.x, nloc, nx); b.st[0] = nloc; b.st[1] = nx; }
        const unsigned old = xb_add(&bar[XB_XSUB(b.x)], 1u);
        const unsigned gen = old / nloc;
        if (old + 1u == (gen + 1u) * nloc) {
            __builtin_amdgcn_fence(__ATOMIC_RELEASE, "agent");
            asm volatile("s_waitcnt vmcnt(0)" ::: "memory");
            const unsigned og = xb_add(&bar[XB_TOP], 1u);
            const unsigned tg = og / nx;
            if (og + 1u == (tg + 1u) * nx) xb_add(&bar[XB_TOPGEN], 1u);
            else XB_SPIN(xb_ld(&bar[XB_TOPGEN]) == tg, bar);
            __builtin_amdgcn_fence(__ATOMIC_ACQUIRE, "agent");
            xb_add(&bar[XB_XGEN(b.x)], 1u);
            asm volatile("s_waitcnt vmcnt(0)" ::: "memory");
        } else {
            XB_SPIN(xb_ld(&bar[XB_XGEN(b.x)]) == gen, bar);
            __builtin_amdgcn_fence(__ATOMIC_ACQUIRE, "agent");
            asm volatile("s_waitcnt vmcnt(0)" ::: "memory");
        }
    }
    __syncthreads();
}

constexpr int CW_BAR = 4096;
constexpr int MISC_OFF = 131072 + 320;

template <class Epi>
__device__ __forceinline__ void run_gemm(LAS unsigned char* lds, const bf16* A, const bf16* Bt, int N, int K, const Epi& E) {
    pg8::Gemm g{A, Bt, T, N, K}; pg8::StaticOrder S; S.init(T, N, (int)gridDim.x, (int)blockIdx.x);
    pg8::gemm_phase<Epi, pg8::StaticOrder, true, true>(lds, g, S, E);
}

__global__ void __launch_bounds__(NTHREADS, 2) mk_fwd(Args a) {
    extern __shared__ __attribute__((aligned(16))) unsigned char lds_raw[];
    LAS unsigned char* lds = (LAS unsigned char*)lds_raw;
    unsigned char* ws = kargs()->ws;
    for (int u = threadIdx.x; u < (LDS_BYTES - 131072) / 4; u += NTHREADS) ((LAS unsigned*)(lds + 131072))[u] = 0u;
    __syncthreads();
    (void)xcd_barrier_post((unsigned*)(ws + WS_CTL) + CW_BAR, (volatile LAS unsigned*)(lds + MISC_OFF) + 8);
#define GRID_BAR() do { XcdBarrier b_; b_.bar = (unsigned*)(kargs()->ws + WS_CTL) + CW_BAR; b_.x = xb_xcc_id(); b_.st = (volatile LAS unsigned*)(lds + MISC_OFF) + 8; xcd_barrier(b_); } while (0)
    float* X = (float*)(ws + WS_X); bf16* XB = (bf16*)(ws + WS_XB); float* SSQ = (float*)(ws + WS_SSQ);

    phase_prologue(kargs(), lds);
    GRID_BAR();
#pragma unroll 1
    for (int li = 0; li < 4; ++li) {
        const int j = li >> 1;
        if ((li & 1) == 0) {
            { EpiDnIn E{(bf16*)(ws + WS_PROJ), (float*)(ws + WS_BA), SSQ};
              run_gemm(lds, XB, (const bf16*)(ws + WS_WIN) + (size_t)j * DN_INP * DM, DN_INP, DM, E); }
            GRID_BAR();
            phase_dn_post(kargs(), j);
            GRID_BAR();
            phase_delta_rec(kargs(), j, lds);
            GRID_BAR();
            { EpiRes E{X, XB, SSQ, nullptr};
              run_gemm(lds, (const bf16*)(ws + WS_OG), (const bf16*)(ws + WS_WOUT) + (size_t)j * DM * VAL_DIM, DM, VAL_DIM, E); }
            GRID_BAR();
        } else {
            { EpiQkv E{(bf16*)(ws + WS_Q), (bf16*)(ws + WS_KB), SSQ, kargs()->in[16] + j * QKV_N,
                       kargs()->out + O_KP + (size_t)j * NB_P * 128 * 256, kargs()->out + O_KS + (size_t)j * NB_S * 4 * 256};
              run_gemm(lds, XB, (const bf16*)(ws + WS_WQKV) + (size_t)j * QKV_N * DM, QKV_N, DM, E); }
            GRID_BAR();
            phase_swa_attn(kargs(), j, lds);
            GRID_BAR();
            { EpiRes E{X, XB, SSQ, kargs()->in[19] + j * DM};
              run_gemm(lds, (const bf16*)(ws + WS_ATT), (const bf16*)(ws + WS_WO) + (size_t)j * DM * DM, DM, DM, E); }
            GRID_BAR();
        }
        { EpiGu E{(bf16*)(ws + WS_ACT), SSQ};
          run_gemm(lds, XB, (const bf16*)(ws + WS_WGU) + (size_t)li * GU_N * DM, GU_N, DM, E); }
        GRID_BAR();
        { EpiRes E{X, XB, SSQ, nullptr};
          run_gemm(lds, (const bf16*)(ws + WS_ACT), (const bf16*)(ws + WS_WDOWN) + (size_t)li * DM * DFF, DM, DFF, E); }
        GRID_BAR();
    }
    phase_final(kargs());
}

extern "C" void kernel_launch(void* const* d_in, const int* in_sizes, int n_in, void* d_out, int out_size, void* d_ws, size_t ws_size, hipStream_t stream) {
    static int grid = 0;
    if (grid == 0) {
        if (n_in != 22 || (size_t)out_size != O_END || ws_size < WS_END) { fprintf(stderr, "kernel_launch: unexpected shapes: n_in %d out %d ws %zu\n", n_in, out_size, ws_size); grid = -1; return; }
        int dev = 0, cus = 0, per_cu = 0;
        if (hipGetDevice(&dev) != hipSuccess || hipDeviceGetAttribute(&cus, hipDeviceAttributeMultiprocessorCount, dev) != hipSuccess) { grid = -1; return; }
        if (hipFuncSetAttribute((const void*)mk_fwd, hipFuncAttributeMaxDynamicSharedMemorySize, LDS_BYTES) != hipSuccess) { fprintf(stderr, "kernel_launch: hipFuncSetAttribute failed\n"); grid = -1; return; }
        if (hipOccupancyMaxActiveBlocksPerMultiprocessor(&per_cu, (const void*)mk_fwd, NTHREADS, LDS_BYTES) != hipSuccess || per_cu < 1) { fprintf(stderr, "kernel_launch: occupancy query reports %d blocks per CU\n", per_cu); (void)hipGetLastError(); }
        grid = cus;
    }
    if (grid < 0) return;
    (void)hipMemsetAsync((char*)d_ws + WS_CTL, 0, CTL_ZERO_BYTES, stream);
    Args a{};
    for (int i = 0; i < 22; ++i) a.in[i] = (const float*)d_in[i];
    a.out = (float*)d_out; a.ws = (unsigned char*)d_ws;
    hipLaunchKernelGGL(mk_fwd, dim3(grid), dim3(NTHREADS), LDS_BYTES, stream, a);
}
```

```cpp
#include <hip/hip_runtime.h>
#include <cstdio>
#include <cstdint>
namespace pg8 {
#define PG8_LAS __attribute__((address_space(3)))
typedef unsigned short bf16_t;
typedef short bf16x8 __attribute__((ext_vector_type(8)));
typedef float f32x4 __attribute__((ext_vector_type(4)));
typedef unsigned u32x4 __attribute__((ext_vector_type(4)));
constexpr int BM = 256, BK = 64, HALF = 128, HTB = HALF * BK * 2  , STAGE_BYTES = 8 * HTB, NXCD = 8, WGM = 8;

__host__ __device__ __forceinline__ int lds_byte(int r, int c) { const int st = (r >> 4) * 2 + (c >> 5), rr = r & 15, cc = c & 31, ob = rr * 64 + cc * 2; return st * 1024 + (ob ^ (((ob >> 9) & 1) << 5)); }
__host__ __device__ __forceinline__ void stage_rc(int b, int& R, int& C) { const int st = b / 1024, sb = b % 1024, swz = sb ^ (((sb >> 9) & 1) << 5); R = (st >> 1) * 16 + swz / 64; C = (st & 1) * 32 + (swz % 64) / 2; }
__host__ __device__ __forceinline__ int perm32(int rho) { const int n = rho >> 4, i = rho & 15; return 8 * (i >> 2) + 4 * n + (i & 3); }

struct Unit { int pm, pn; };
struct Gemm { const bf16_t* A; const bf16_t* Bt; int M, N, K; };

struct StaticOrder {
    int nM, nN, nwg, G, c;
    __host__ __device__ void init(int M, int N, int G_, int c_) { nM = M / BM; nN = N / BM; nwg = nM * nN; G = G_; c = c_; }
    __host__ __device__ bool next(int i, Unit& u) const {
        const long L = (long)i * G + c; if (L >= nwg) return false;
        int wgid = (int)L; { const int q = nwg / NXCD, r = nwg % NXCD, xcd = wgid % NXCD, off = wgid / NXCD; wgid = (xcd < r ? xcd * (q + 1) : r * (q + 1) + (xcd - r) * q) + off; }
        const int nig = WGM * nN, gid = wgid / nig, fm = gid * WGM, gsz = (nM - fm) < WGM ? (nM - fm) : WGM;
        u.pm = fm + ((wgid % nig) % gsz); u.pn = (wgid % nig) / gsz; return true;
    }
    __device__ __forceinline__ void a_ready(const Unit&) const {}
    __device__ __forceinline__ void done(const Unit&) const {}
};
__device__ __forceinline__ unsigned cvt_pk_bf16(float lo, float hi) { unsigned r; asm volatile("v_cvt_pk_bf16_f32 %0, %1, %2" : "=v"(r) : "v"(lo), "v"(hi)); return r; }
typedef float f32x2 __attribute__((ext_vector_type(2)));
template <class Epi, class Sched, bool ALIGN_EPI = false, bool SP2 = false>
__device__ __forceinline__ void gemm_phase(PG8_LAS unsigned char* lds, const Gemm g, const Sched& S, const Epi& E) {
    int tid_ = threadIdx.x; asm volatile("" : "+v"(tid_)); const int tid = tid_, wid = __builtin_amdgcn_readfirstlane(tid >> 6), lane = tid & 63, wr = wid >> 2, wc = wid & 3, fr = lane & 15, fq = lane >> 4;
    const int K = g.K, nt = K / BK;
    unsigned voffA[2], voffB[2];
#pragma unroll
    for (int i = 0; i < 2; ++i) { int R, C; stage_rc(tid * 16 + i * 8192, R, C); const int Rb = Epi::PERM ? ((R & ~31) + perm32(R & 31)) : R;
        voffA[i] = (unsigned)(R * K + C) * 2u; voffB[i] = (unsigned)(Rb * K + C) * 2u; }
    const size_t kstep = (size_t)(BK * 2);
    const size_t hstep = (size_t)HALF * K * 2;
    const size_t tstep = 2 * hstep;
    const unsigned ldsw = (unsigned)wid * 1024u;
    const int aoff = lds_byte(wr * 64 + fr, fq * 8), boff = lds_byte(wc * 32 + fr, fq * 8);
#define PG8_SA(b, h) (((b) * 2 + (h)) * HTB)
#define PG8_SB(b, h) ((4 + (b) * 2 + (h)) * HTB)
#define PG8_STAGE(bufoff, gbase, voff) do { _Pragma("unroll") for (int _i = 0; _i < 2; ++_i) \
        __builtin_amdgcn_global_load_lds((const unsigned*)((const char*)(gbase) + (voff)[_i]), (PG8_LAS unsigned*)(lds + (bufoff) + ldsw + _i * 8192), 16, 0, 0); } while (0)
#define PG8_LDA(dst, b, h) do { _Pragma("unroll") for (int m = 0; m < 4; ++m) _Pragma("unroll") for (int k = 0; k < 2; ++k) dst[m][k] = *(const PG8_LAS bf16x8*)(lds + PG8_SA(b, h) + aoff + m * 2048 + k * 1024); } while (0)
#define PG8_LDB(dst, b, h) do { _Pragma("unroll") for (int n = 0; n < 2; ++n) _Pragma("unroll") for (int k = 0; k < 2; ++k) dst[n][k] = *(const PG8_LAS bf16x8*)(lds + PG8_SB(b, h) + boff + n * 2048 + k * 1024); } while (0)
#define PG8_MMA(ai, bj, At, Bt) do { __builtin_amdgcn_s_setprio(1); _Pragma("unroll") for (int m = 0; m < 4; ++m) _Pragma("unroll") for (int n = 0; n < 2; ++n) _Pragma("unroll") for (int k = 0; k < 2; ++k) \
        acc[ai][bj][m][n] = __builtin_amdgcn_mfma_f32_16x16x32_bf16(Bt[n][k], At[m][k], acc[ai][bj][m][n], 0, 0, 0); __builtin_amdgcn_s_setprio(0); } while (0)
#define PG8_WAIT_V(n) asm volatile("s_waitcnt vmcnt(" #n ")" ::: "memory")
#define PG8_WAIT_L(n) asm volatile("s_waitcnt lgkmcnt(" #n ")" ::: "memory")
#define PG8_BAR __builtin_amdgcn_s_barrier()
#define PG8_SCHED __builtin_amdgcn_sched_barrier(0)
    Unit cur, nxt; int ui = 0;
    if (!S.next(0, cur)) return;
    f32x4 acc[2][2][4][2];
#pragma unroll
    for (int a = 0; a < 2; ++a)
#pragma unroll
        for (int b = 0; b < 2; ++b)
#pragma unroll
            for (int m = 0; m < 4; ++m)
#pragma unroll
                for (int n = 0; n < 2; ++n) acc[a][b][m][n] = (f32x4){0.f, 0.f, 0.f, 0.f};
    bf16x8 At[4][2], B0[2][2], B1[2][2];
    const char* cA = (const char*)g.A + (size_t)cur.pm * tstep; const char* cB = (const char*)g.Bt + (size_t)cur.pn * tstep;
    S.a_ready(cur);
    if constexpr (SP2) {
        PG8_STAGE(PG8_SB(0, 0), cB, voffB); PG8_STAGE(PG8_SB(0, 1), cB + hstep, voffB); PG8_STAGE(PG8_SA(0, 0), cA, voffA); PG8_STAGE(PG8_SA(0, 1), cA + hstep, voffA);
        if (wr == 1) PG8_BAR;
        PG8_WAIT_V(2); PG8_BAR;
        PG8_STAGE(PG8_SB(1, 0), cB + kstep, voffB); PG8_STAGE(PG8_SA(1, 0), cA + kstep, voffA); PG8_STAGE(PG8_SB(1, 1), cB + hstep + kstep, voffB);
        PG8_WAIT_V(6); PG8_BAR;
    } else {
        PG8_STAGE(PG8_SB(0, 0), cB, voffB); PG8_STAGE(PG8_SA(0, 0), cA, voffA); PG8_STAGE(PG8_SB(0, 1), cB + hstep, voffB); PG8_STAGE(PG8_SA(0, 1), cA + hstep, voffA);
        if (wr == 1) PG8_BAR;
        PG8_WAIT_V(4); PG8_BAR;
        PG8_STAGE(PG8_SB(1, 0), cB + kstep, voffB); PG8_STAGE(PG8_SA(1, 0), cA + kstep, voffA); PG8_STAGE(PG8_SB(1, 1), cB + hstep + kstep, voffB);
        PG8_WAIT_V(6); PG8_BAR;
    }
    for (;;) {
        const bool has_next = S.next(ui + 1, nxt);
        const char* nA = has_next ? (const char*)g.A + (size_t)nxt.pm * tstep : cA; const char* nB = has_next ? (const char*)g.Bt + (size_t)nxt.pn * tstep : cB;
        for (int t = 0; t < nt; t += 2) {
            const bool last = (t == nt - 2);
            const char* a1 = cA + (size_t)(t + 1) * kstep;
            const char* a2 = last ? nA : cA + (size_t)(t + 2) * kstep; const char* b2 = last ? nB : cB + (size_t)(t + 2) * kstep;
            const char* a3 = a2 + kstep; const char* b3 = b2 + kstep;
            if (last && has_next) S.a_ready(nxt);
            if constexpr (SP2) {
            PG8_LDB(B0, 0, 0); PG8_LDB(B1, 0, 1); PG8_SCHED; PG8_LDA(At, 0, 0); PG8_STAGE(PG8_SA(1, 1), a1 + hstep, voffA);
            PG8_WAIT_V(8); PG8_WAIT_L(0); PG8_BAR; PG8_MMA(0, 0, At, B0); PG8_MMA(0, 1, At, B1); PG8_BAR; PG8_SCHED;
            PG8_LDA(At, 0, 1); PG8_STAGE(PG8_SB(0, 0), b2, voffB); PG8_STAGE(PG8_SB(0, 1), b2 + hstep, voffB); PG8_STAGE(PG8_SA(0, 0), a2, voffA);
            PG8_WAIT_V(8); PG8_WAIT_L(0); PG8_BAR; PG8_MMA(1, 0, At, B0); PG8_MMA(1, 1, At, B1); PG8_BAR; PG8_SCHED;
            PG8_LDB(B0, 1, 0); PG8_LDB(B1, 1, 1); PG8_SCHED; PG8_LDA(At, 1, 0); PG8_STAGE(PG8_SA(0, 1), a2 + hstep, voffA);
            PG8_WAIT_V(8); PG8_WAIT_L(0); PG8_BAR; PG8_MMA(0, 0, At, B0); PG8_MMA(0, 1, At, B1); PG8_BAR; PG8_SCHED;
            PG8_LDA(At, 1, 1); PG8_STAGE(PG8_SB(1, 0), b3, voffB); PG8_STAGE(PG8_SB(1, 1), b3 + hstep, voffB); PG8_STAGE(PG8_SA(1, 0), a3, voffA);
            PG8_WAIT_V(8); PG8_WAIT_L(0); PG8_BAR; PG8_MMA(1, 0, At, B0); PG8_MMA(1, 1, At, B1); PG8_BAR; PG8_SCHED;
            } else {
            PG8_LDB(B0, 0, 0); PG8_SCHED; PG8_LDA(At, 0, 0); PG8_STAGE(PG8_SA(1, 1), a1 + hstep, voffA);
            PG8_WAIT_L(8); PG8_BAR; PG8_WAIT_L(0); PG8_MMA(0, 0, At, B0); PG8_BAR; PG8_SCHED;
            PG8_LDB(B1, 0, 1); PG8_STAGE(PG8_SB(0, 0), b2, voffB);
            PG8_BAR; PG8_WAIT_L(0); PG8_MMA(0, 1, At, B1); PG8_BAR;
            PG8_LDA(At, 0, 1); PG8_STAGE(PG8_SA(0, 0), a2, voffA);
            PG8_BAR; PG8_WAIT_L(0); PG8_MMA(1, 0, At, B0); PG8_BAR; PG8_SCHED;
            PG8_STAGE(PG8_SB(0, 1), b2 + hstep, voffB);
            PG8_WAIT_V(6); PG8_BAR; PG8_MMA(1, 1, At, B1); PG8_BAR;
            PG8_LDB(B0, 1, 0); PG8_SCHED; PG8_LDA(At, 1, 0); PG8_STAGE(PG8_SA(0, 1), a2 + hstep, voffA);
            PG8_WAIT_L(8); PG8_BAR; PG8_WAIT_L(0); PG8_MMA(0, 0, At, B0); PG8_BAR; PG8_SCHED;
            PG8_LDB(B1, 1, 1); PG8_STAGE(PG8_SB(1, 0), b3, voffB);
            PG8_BAR; PG8_WAIT_L(0); PG8_MMA(0, 1, At, B1); PG8_BAR;
            PG8_LDA(At, 1, 1); PG8_STAGE(PG8_SA(1, 0), a3, voffA);
            PG8_BAR; PG8_WAIT_L(0); PG8_MMA(1, 0, At, B0); PG8_BAR; PG8_SCHED;
            PG8_STAGE(PG8_SB(1, 1), b3 + hstep, voffB);
            PG8_WAIT_V(6); PG8_BAR; PG8_MMA(1, 1, At, B1); PG8_BAR;
            }
        }
        if constexpr (ALIGN_EPI) { if (wr == 0) PG8_BAR; }
        if constexpr (!Epi::AFTER_DRAIN) { E(acc, cur, wr, wc, fr, fq); S.done(cur); }
        if (!has_next) break;
#pragma unroll
        for (int a = 0; a < 2; ++a)
#pragma unroll
            for (int b = 0; b < 2; ++b)
#pragma unroll
                for (int m = 0; m < 4; ++m)
#pragma unroll
                    for (int n = 0; n < 2; ++n) acc[a][b][m][n] = (f32x4){0.f, 0.f, 0.f, 0.f};
        cur = nxt; cA = nA; cB = nB; ++ui;
        if constexpr (ALIGN_EPI) { if (wr == 1) PG8_BAR; }
    }
    PG8_WAIT_V(0);
    if constexpr (!ALIGN_EPI) { if (wr == 0) PG8_BAR; }
    PG8_BAR;
    if constexpr (Epi::AFTER_DRAIN) { E.fused(acc, cur, wr, wc, fr, fq, lds, wid, lane); S.done(cur); }
#undef PG8_SA
#undef PG8_SB
#undef PG8_STAGE
#undef PG8_LDA
#undef PG8_LDB
#undef PG8_MMA
#undef PG8_WAIT_V
#undef PG8_WAIT_L
#undef PG8_BAR
#undef PG8_SCHED
}
}

#define GAS __attribute__((address_space(1)))
#define LAS __attribute__((address_space(3)))
typedef unsigned short bf16;
typedef unsigned v4u __attribute__((ext_vector_type(4)));
typedef unsigned v2u __attribute__((ext_vector_type(2)));
typedef float f32x4 __attribute__((ext_vector_type(4)));
typedef float f32x2v __attribute__((ext_vector_type(2)));

constexpr int DM = 1024, NB_P = 8, SEQ = 2048, NB_S = 128, DSEQ = 4;
constexpr int TP = NB_P * SEQ, TS = NB_S * DSEQ, T = TP + TS;
constexpr int DN_IN = 6176, DN_INP = 6400, PROJ_LD = 6144, CONV_DIM = 4096, VAL_DIM = 2048;
constexpr int QKV_N = 1536, DFF = 2816, GU_N = 5632;
constexpr float RMS_EPS = 1e-6f, L2_EPS = 1e-6f;

constexpr size_t O_YP = 0, O_YS = 16777216, O_CONVP = 17301504, O_DELTAP = 17498112, O_KP = 21692416, O_VP = 22216704,
                 O_CONVS = 22740992, O_DELTAS = 25886720, O_KS = 92995584, O_VS = 93257728, O_END = 93519872;

constexpr size_t MiB = 1u << 20;
constexpr size_t WS_CTL = 0, CTL_ZERO_BYTES = 1 * MiB;
constexpr size_t WS_WIN = 2 * MiB;
constexpr size_t WS_WOUT = 27 * MiB;
constexpr size_t WS_WQKV = 35 * MiB;
constexpr size_t WS_WO = 41 * MiB;
constexpr size_t WS_WGU = 45 * MiB;
constexpr size_t WS_WDOWN = 89 * MiB;
constexpr size_t WS_X = 112 * MiB;
constexpr size_t WS_XB = 178 * MiB;
constexpr size_t WS_SSQ = 211 * MiB;
constexpr size_t WS_BA = 213 * MiB;
constexpr size_t WS_BG = 216 * MiB;
constexpr size_t WS_PROJ = 220 * MiB;
constexpr size_t WS_Q = 220 * MiB;
constexpr size_t WS_KB = 253 * MiB;
constexpr size_t WS_VB = 262 * MiB;
constexpr size_t WS_ATT = 271 * MiB;
constexpr size_t WS_QKV = 418 * MiB;
constexpr size_t WS_DREC = 428 * MiB;
constexpr size_t WS_OG = 716 * MiB;
constexpr size_t WS_ACT = 782 * MiB;
constexpr size_t WS_EGL = 874 * MiB;
constexpr size_t WS_END = 876 * MiB;
constexpr size_t KV_DELTA = (WS_VB - WS_KB) / 2;

constexpr int NWAVES = 8, NTHREADS = 512;
constexpr int LDS_BYTES = 155648;

#define LDS_WAIT() asm volatile("s_waitcnt lgkmcnt(0)" ::: "memory")
__device__ __forceinline__ unsigned f2bf(float f) { unsigned u = __builtin_bit_cast(unsigned, f); return (u + 0x7fffu + ((u >> 16) & 1u)) >> 16; }
__device__ __forceinline__ unsigned pk2(float lo, float hi) { return f2bf(lo) | (f2bf(hi) << 16); }
__device__ __forceinline__ float bf2f(unsigned short b) { return __builtin_bit_cast(float, (unsigned)b << 16); }
__device__ __forceinline__ float bflo(unsigned w) { return __builtin_bit_cast(float, w << 16); }
__device__ __forceinline__ float bfhi(unsigned w) { return __builtin_bit_cast(float, w & 0xffff0000u); }
__device__ __forceinline__ float wave_sum(float v) {
#pragma unroll
    for (int o = 1; o < 64; o <<= 1) v += __shfl_xor(v, o);
    return v;
}
__device__ __forceinline__ float wave_max(float v) {
#pragma unroll
    for (int o = 1; o < 64; o <<= 1) v = fmaxf(v, __shfl_xor(v, o));
    return v;
}
__device__ __forceinline__ float silu_f(float x) { return x / (1.f + __expf(-x)); }
__device__ __forceinline__ float row_rstd(const float* ssq, int row) {
    const f32x4* p = (const f32x4*)(ssq + (size_t)row * 16);
    const f32x4 a = p[0], b = p[1], c = p[2], d = p[3];
    const float s = ((a[0] + a[1]) + (a[2] + a[3])) + ((b[0] + b[1]) + (b[2] + b[3])) + ((c[0] + c[1]) + (c[2] + c[3])) + ((d[0] + d[1]) + (d[2] + d[3]));
    return rsqrtf(s * (1.f / 1024.f) + RMS_EPS);
}

using pg8::Unit; using pg8::cvt_pk_bf16;
struct EpiDnIn {
    static constexpr bool PERM = true, AFTER_DRAIN = false;
    bf16* proj; float* ba; const float* ssq;
    __device__ __forceinline__ void operator()(const f32x4 (&acc)[2][2][4][2], const Unit& u, int wr, int wc, int fr, int fq) const {
        const int row0 = u.pm * 256 + wr * 64 + fr;
        if (u.pn < 24) {
            const int col0 = u.pn * 256 + wc * 32 + 8 * fq;
#pragma unroll
            for (int ai = 0; ai < 2; ++ai)
#pragma unroll
                for (int m = 0; m < 4; ++m) { const int row = row0 + ai * 128 + m * 16; const float rs = row_rstd(ssq, row);
                    bf16* rowp = proj + (size_t)row * PROJ_LD + col0;
#pragma unroll
                    for (int bj = 0; bj < 2; ++bj) { const f32x4 v0 = acc[ai][bj][m][0] * rs, v1 = acc[ai][bj][m][1] * rs;
                        v4u w; w.x = cvt_pk_bf16(v0[0], v0[1]); w.y = cvt_pk_bf16(v0[2], v0[3]); w.z = cvt_pk_bf16(v1[0], v1[1]); w.w = cvt_pk_bf16(v1[2], v1[3]);
                        *(v4u*)(rowp + bj * 128) = w; } }
        } else if (wc == 0) {
#pragma unroll
            for (int ai = 0; ai < 2; ++ai)
#pragma unroll
                for (int m = 0; m < 4; ++m) { const int row = row0 + ai * 128 + m * 16; const float rs = row_rstd(ssq, row);
                    float* o = ba + (size_t)row * 32 + 8 * fq;
                    *(f32x4*)o = acc[ai][0][m][0] * rs; *(f32x4*)(o + 4) = acc[ai][0][m][1] * rs; }
        }
    }
};
struct EpiRes {
    static constexpr bool PERM = false, AFTER_DRAIN = false;
    float* X; bf16* XB; float* ssq; const float* bias;
    __device__ __forceinline__ void operator()(const f32x4 (&acc)[2][2][4][2], const Unit& u, int wr, int wc, int fr, int fq) const {
        const int row0 = u.pm * 256 + wr * 64 + fr, col0 = u.pn * 256 + wc * 32 + 4 * fq;
#pragma unroll
        for (int ai = 0; ai < 2; ++ai)
#pragma unroll
            for (int m = 0; m < 4; ++m) { const int row = row0 + ai * 128 + m * 16; float s = 0.f;
#pragma unroll
                for (int bj = 0; bj < 2; ++bj)
#pragma unroll
                    for (int n = 0; n < 2; ++n) { const int c = col0 + bj * 128 + n * 16; float* xp = X + (size_t)row * DM + c;
                        f32x4 x = *(const f32x4*)xp + acc[ai][bj][m][n];
                        if (bias) x = x + *(const f32x4*)(bias + c);
                        *(f32x4*)xp = x; v2u w; w.x = cvt_pk_bf16(x[0], x[1]); w.y = cvt_pk_bf16(x[2], x[3]);
                        *(v2u*)(XB + (size_t)row * DM + c) = w;
                        s += (x[0] * x[0] + x[1] * x[1]) + (x[2] * x[2] + x[3] * x[3]); }
                s += __shfl_xor(s, 16); s += __shfl_xor(s, 32);
                if (fq == 0) ssq[(size_t)row * 16 + u.pn * 4 + wc] = s; }
    }
};
struct EpiQkv {
    static constexpr bool PERM = true, AFTER_DRAIN = false;
    bf16 *Q, *KB; const float* ssq; const float* bias; float *okp, *oks;
    __device__ __forceinline__ void operator()(const f32x4 (&acc)[2][2][4][2], const Unit& u, int wr, int wc, int fr, int fq) const {
        const int row0 = u.pm * 256 + wr * 64 + fr, cw = wc * 32 + 8 * fq;
        const bool isq = u.pn < 4; const size_t kvsel = (u.pn == 5) ? 1 : 0;
        const float qs = isq ? 0.125f : 1.f;
#pragma unroll
        for (int ai = 0; ai < 2; ++ai)
#pragma unroll
            for (int m = 0; m < 4; ++m) { const int row = row0 + ai * 128 + m * 16; const float rs = row_rstd(ssq, row);
#pragma unroll
                for (int bj = 0; bj < 2; ++bj) { const int colk = bj * 128 + cw, gcol = u.pn * 256 + colk;
                    const f32x4 v0 = (acc[ai][bj][m][0] * rs + *(const f32x4*)(bias + gcol)) * qs, v1 = (acc[ai][bj][m][1] * rs + *(const f32x4*)(bias + gcol + 4)) * qs;
                    v4u w; w.x = cvt_pk_bf16(v0[0], v0[1]); w.y = cvt_pk_bf16(v0[2], v0[3]); w.z = cvt_pk_bf16(v1[0], v1[1]); w.w = cvt_pk_bf16(v1[2], v1[3]);
                    if (isq) *(v4u*)(Q + (size_t)row * DM + gcol) = w;
                    else {
                        *(v4u*)(KB + kvsel * KV_DELTA + (size_t)row * 256 + colk) = w;
                        if (row < TP) { const int b = row >> 11, pos = row & 2047;
                            if (pos >= 1920) { float* o = okp + kvsel * (O_VP - O_KP) + (size_t)(b * 128 + pos - 1920) * 256 + colk; *(f32x4*)o = v0; *(f32x4*)(o + 4) = v1; } }
                        else { float* o = oks + kvsel * (O_VS - O_KS) + (size_t)(row - TP) * 256 + colk; *(f32x4*)o = v0; *(f32x4*)(o + 4) = v1; } } } }
    }
};
struct EpiGu {
    static constexpr bool PERM = true, AFTER_DRAIN = false;
    bf16* act; const float* ssq;
    __device__ __forceinline__ void operator()(const f32x4 (&acc)[2][2][4][2], const Unit& u, int wr, int wc, int fr, int fq) const {
        const int row0 = u.pm * 256 + wr * 64 + fr, col0 = u.pn * 128 + wc * 32 + 8 * fq;
#pragma unroll
        for (int ai = 0; ai < 2; ++ai)
#pragma unroll
            for (int m = 0; m < 4; ++m) { const int row = row0 + ai * 128 + m * 16; const float rs = row_rstd(ssq, row);
                float r[8];
#pragma unroll
                for (int n = 0; n < 2; ++n)
#pragma unroll
                    for (int e = 0; e < 4; ++e) { const float g = acc[ai][0][m][n][e] * rs, uu = acc[ai][1][m][n][e] * rs; r[n * 4 + e] = silu_f(g) * uu; }
                v4u w; w.x = cvt_pk_bf16(r[0], r[1]); w.y = cvt_pk_bf16(r[2], r[3]); w.z = cvt_pk_bf16(r[4], r[5]); w.w = cvt_pk_bf16(r[6], r[7]);
                *(v4u*)(act + (size_t)row * DFF + col0) = w; }
    }
};

struct Args { const float* in[22]; float* out; unsigned char* ws; int ph_lo, ph_hi; };
typedef const __attribute__((address_space(4))) Args* CArgs;
__device__ __forceinline__ CArgs kargs() { CArgs p = (CArgs)__builtin_amdgcn_kernarg_segment_ptr(); asm volatile("" : "+s"(p)); return p; }

__device__ __forceinline__ void tr_item(const float* W, int K, int N, const float* nw, bf16* WT, int dst_row0, LAS float* scr, int k0, int n0, int lane) {
#pragma unroll 8
    for (int i = 0; i < 32; ++i) { const int kk = 2 * i + (lane >> 5); const float s = nw ? nw[k0 + kk] : 1.f;
        scr[kk * 33 + (lane & 31)] = W[(size_t)(k0 + kk) * N + n0 + (lane & 31)] * s; }
    LDS_WAIT(); asm volatile("" ::: "memory");
    const int c = lane & 7;
#pragma unroll
    for (int j = 0; j < 4; ++j) { const int n = (lane >> 3) + 8 * j; const LAS float* s = scr + (8 * c) * 33 + n;
        v4u o; o.x = pk2(s[0 * 33], s[1 * 33]); o.y = pk2(s[2 * 33], s[3 * 33]); o.z = pk2(s[4 * 33], s[5 * 33]); o.w = pk2(s[6 * 33], s[7 * 33]);
        *(v4u*)(WT + (size_t)(dst_row0 + n) * K + k0 + 8 * c) = o; }
    LDS_WAIT(); asm volatile("" ::: "memory");
}
__device__ __forceinline__ void tr_matrix_item(const float* W, int K, int N, const float* nw, bf16* WT, int gu, LAS float* scr, int r, int lane) {
    const int nblk = N / 32, kb = r / nblk, nb = r % nblk, k0 = 64 * kb, n0 = 32 * nb;
    int dr = n0;
    if (gu) dr = (n0 < DFF) ? (n0 / 128) * 256 + (n0 % 128) : ((n0 - DFF) / 128) * 256 + 128 + ((n0 - DFF) % 128);
    tr_item(W, K, N, nw, WT, dr, scr, k0, n0, lane);
}
__device__ __forceinline__ void phase_prologue(CArgs ap, LAS unsigned char* lds) {
    int tid_ = threadIdx.x; asm volatile("" : "+v"(tid_)); const int tid = tid_, lane = tid & 63, wave = __builtin_amdgcn_readfirstlane(tid >> 6);
    LAS float* scr = (LAS float*)(lds + wave * 16384);
    const int gw = blockIdx.x * NWAVES + wave, NGW = gridDim.x * NWAVES;
    unsigned char* ws = ap->ws;
    constexpr int I_IN = 16 * 193, I_OUT = 32 * 32, I_QKV = 16 * 48, I_O = 16 * 32, I_GU = 16 * 176, I_DN = 44 * 32;
    constexpr int NITEMS = 2 * I_IN + 2 * I_OUT + 2 * I_QKV + 2 * I_O + 4 * I_GU + 4 * I_DN;
    for (int it = gw; it < NITEMS; it += NGW) {
        int r = it;
        if (r < 2 * I_IN) { const int j = r / I_IN; r -= j * I_IN;
            tr_matrix_item(ap->in[9] + (size_t)j * DM * DN_IN, DM, DN_IN, ap->in[6] + (2 * j) * DM, (bf16*)(ws + WS_WIN) + (size_t)j * DN_INP * DM, 0, scr, r, lane); continue; }
        r -= 2 * I_IN;
        if (r < 2 * I_OUT) { const int j = r / I_OUT; r -= j * I_OUT;
            tr_matrix_item(ap->in[14] + (size_t)j * VAL_DIM * DM, VAL_DIM, DM, nullptr, (bf16*)(ws + WS_WOUT) + (size_t)j * DM * VAL_DIM, 0, scr, r, lane); continue; }
        r -= 2 * I_OUT;
        if (r < 2 * I_QKV) { const int j = r / I_QKV; r -= j * I_QKV;
            tr_matrix_item(ap->in[15] + (size_t)j * DM * QKV_N, DM, QKV_N, ap->in[6] + (2 * j + 1) * DM, (bf16*)(ws + WS_WQKV) + (size_t)j * QKV_N * DM, 0, scr, r, lane); continue; }
        r -= 2 * I_QKV;
        if (r < 2 * I_O) { const int j = r / I_O; r -= j * I_O;
            tr_matrix_item(ap->in[18] + (size_t)j * DM * DM, DM, DM, nullptr, (bf16*)(ws + WS_WO) + (size_t)j * DM * DM, 0, scr, r, lane); continue; }
        r -= 2 * I_O;
        if (r < 4 * I_GU) { const int i = r / I_GU; r -= i * I_GU;
            tr_matrix_item(ap->in[20] + (size_t)i * DM * GU_N, DM, GU_N, ap->in[7] + i * DM, (bf16*)(ws + WS_WGU) + (size_t)i * GU_N * DM, 1, scr, r, lane); continue; }
        r -= 4 * I_GU;
        { const int i = r / I_DN; r -= i * I_DN;
            tr_matrix_item(ap->in[21] + (size_t)i * DFF * DM, DFF, DM, nullptr, (bf16*)(ws + WS_WDOWN) + (size_t)i * DM * DFF, 0, scr, r, lane); }
    }
    for (int i = blockIdx.x * NTHREADS + tid; i < 2 * 28672; i += gridDim.x * NTHREADS) { const int j = i / 28672, o = i % 28672;
        *(v4u*)((bf16*)(ws + WS_WIN) + (size_t)j * DN_INP * DM + (size_t)DN_IN * DM + (size_t)o * 8) = (v4u){0u, 0u, 0u, 0u}; }
    float* X = (float*)(ws + WS_X); bf16* XB = (bf16*)(ws + WS_XB); float* SSQ = (float*)(ws + WS_SSQ);
    for (int m = gw; m < T; m += NGW) {
        const float* src = (m < TP) ? ap->in[0] + (size_t)m * DM : ap->in[1] + (size_t)(m - TP) * DM;
        float s = 0.f;
#pragma unroll
        for (int j = 0; j < 4; ++j) { const f32x4 v = *((const f32x4*)src + lane + 64 * j);
            *((f32x4*)(X + (size_t)m * DM) + lane + 64 * j) = v;
            v2u w; w.x = pk2(v[0], v[1]); w.y = pk2(v[2], v[3]); *((v2u*)(XB + (size_t)m * DM) + lane + 64 * j) = w;
            s += (v[0] * v[0] + v[1] * v[1]) + (v[2] * v[2] + v[3] * v[3]); }
        s = wave_sum(s);
        if (lane < 16) SSQ[(size_t)m * 16 + lane] = (lane == 0) ? s : 0.f;
    }
}

__device__ __forceinline__ void phase_dn_post(CArgs ap, int j, int tstart) {
    int tid_ = threadIdx.x; asm volatile("" : "+v"(tid_)); const int tid = tid_, lane = tid & 63, wave = __builtin_amdgcn_readfirstlane(tid >> 6);
    const int gw = blockIdx.x * NWAVES + wave, NGW = gridDim.x * NWAVES;
    unsigned char* ws = ap->ws;
    const bf16* PROJ = (const bf16*)(ws + WS_PROJ); const float* BA = (const float*)(ws + WS_BA);
    float* QKV = (float*)(ws + WS_QKV) - (size_t)TP * CONV_DIM; float* BG = (float*)(ws + WS_BG);
    const float* cw = ap->in[10] + (size_t)j * 4 * CONV_DIM;
    const float* sconv = ap->in[2] + (size_t)j * NB_S * 3 * CONV_DIM;
    float* oconvp = ap->out + O_CONVP + (size_t)j * NB_P * 3 * CONV_DIM;
    float* oconvs = ap->out + O_CONVS + (size_t)j * NB_S * 3 * CONV_DIM;
    for (int task = tstart * 32 + gw; task < T * 32; task += NGW) {
        const int t = task >> 5, hc = task & 31, col0 = hc * 128 + 2 * lane;
        const bool prompt = t < TP; const int pos = prompt ? (t & 2047) : ((t - TP) & 3); const int b = prompt ? (t >> 11) : ((t - TP) >> 2);
        float y0 = 0.f, y1 = 0.f, u00 = 0.f, u01 = 0.f;
#pragma unroll
        for (int k = 0; k < 4; ++k) {
            float u0 = 0.f, u1 = 0.f;
            if (pos - k >= 0) { const unsigned w = *(const unsigned*)(PROJ + (size_t)(t - k) * PROJ_LD + col0); u0 = bflo(w); u1 = bfhi(w); }
            else if (!prompt) { const f32x2v v = *(const f32x2v*)(sconv + (size_t)(b * 3 + (3 + pos - k)) * CONV_DIM + col0); u0 = v[0]; u1 = v[1]; }
            const f32x2v wv = *(const f32x2v*)(cw + (size_t)(3 - k) * CONV_DIM + col0);
            y0 += u0 * wv[0]; y1 += u1 * wv[1];
            if (k == 0) { u00 = u0; u01 = u1; }
        }
        y0 = silu_f(y0); y1 = silu_f(y1);
        if (hc < 16) {
            const float ss = wave_sum(y0 * y0 + y1 * y1);
            float inv = rsqrtf(ss + L2_EPS); if (hc < 8) inv *= 0.08838834764831845f;
            y0 *= inv; y1 *= inv;
        }
        *(f32x2v*)(QKV + (size_t)t * CONV_DIM + col0) = (f32x2v){y0, y1};
        if (prompt) { if (pos >= SEQ - 3) *(f32x2v*)(oconvp + (size_t)(b * 3 + pos - (SEQ - 3)) * CONV_DIM + col0) = (f32x2v){u00, u01}; }
        else if (pos >= 1) *(f32x2v*)(oconvs + (size_t)(b * 3 + pos - 1) * CONV_DIM + col0) = (f32x2v){u00, u01};
        if (hc == 0 && lane < 32) {
            const int h = lane & 15; const float v = BA[(size_t)t * 32 + lane];
            float r;
            if (lane < 16) r = 1.f / (1.f + __expf(-v));
            else { const float x = v + ap->in[12][j * 16 + h]; const float sp = (x > 20.f) ? x : log1pf(__expf(x)); r = -__expf(ap->in[11][j * 16 + h]) * sp; }
            BG[(size_t)t * 32 + lane] = r;
        }
    }
}

__device__ __forceinline__ void phase_delta_rec(CArgs ap, int j, LAS unsigned char* lds, int ufirst, int ustride) {
    int tid_ = threadIdx.x; asm volatile("" : "+v"(tid_)); const int tid = tid_, lane = tid & 63, wave = __builtin_amdgcn_readfirstlane(tid >> 6);
    const int e = tid & 127, dq = tid >> 7;
    unsigned char* ws = ap->ws;
    const float* QKV = (const float*)(ws + WS_QKV) - (size_t)TP * CONV_DIM; const float* BG = (const float*)(ws + WS_BG); const bf16* PROJ = (const bf16*)(ws + WS_PROJ);
    bf16* OG = (bf16*)(ws + WS_OG);
    const float* nw = ap->in[13] + j * 128;
    constexpr int NTB = 16;
    LAS float* qs = (LAS float*)lds;
    LAS float* ks = qs + NTB * 128;
    LAS float* vs = ks + NTB * 128;
    LAS float* ob = vs + NTB * 128;
    LAS float* red = ob + NTB * 128;
    LAS float* red2 = red + 512;
    LAS float* ab = red2 + 512;
    for (int unit = ufirst; unit < 128 + 2048; unit += ustride) {
        int b, h, L, t0; const float* s0 = nullptr; float* sout;
        if (unit < 128) { b = unit >> 4; h = unit & 15; L = SEQ; t0 = b * SEQ; sout = ap->out + O_DELTAP + ((size_t)(j * NB_P + b) * 16 + h) * 16384; }
        else { const int su = unit - 128; b = su >> 4; h = su & 15; L = DSEQ; t0 = TP + b * DSEQ;
            s0 = ap->in[3] + ((size_t)(j * NB_S + b) * 16 + h) * 16384; sout = ap->out + O_DELTAS + ((size_t)(j * NB_S + b) * 16 + h) * 16384; }
        const int hq = h >> 1;
        float S[32];
#pragma unroll
        for (int i = 0; i < 32; ++i) S[i] = s0 ? s0[(size_t)(32 * dq + i) * 128 + e] : 0.f;
        for (int tb = 0; tb < L; tb += NTB) {
            const int nb = (L - tb) < NTB ? (L - tb) : NTB;
            __syncthreads();
            for (int i = tid; i < nb * 384; i += NTHREADS) { const int tt = i / 384, rem = i % 384, which = rem >> 7, ee = rem & 127;
                const int col = (which == 0) ? hq * 128 + ee : (which == 1) ? 1024 + hq * 128 + ee : 2048 + h * 128 + ee;
                qs[which * (NTB * 128) + tt * 128 + ee] = QKV[(size_t)(t0 + tb + tt) * CONV_DIM + col]; }
            if (tid < nb) { ab[tid * 2] = __expf(BG[(size_t)(t0 + tb + tid) * 32 + 16 + h]); ab[tid * 2 + 1] = BG[(size_t)(t0 + tb + tid) * 32 + h]; }
            __syncthreads();
            for (int tt = 0; tt < nb; ++tt) {
                const float av = ab[tt * 2], bt = ab[tt * 2 + 1];
                float part = 0.f;
#pragma unroll
                for (int i = 0; i < 32; ++i) part += ks[tt * 128 + 32 * dq + i] * S[i];
                red[dq * 128 + e] = part;
                __syncthreads();
                const float kS = (red[e] + red[128 + e]) + (red[256 + e] + red[384 + e]);
                const float vv = bt * (vs[tt * 128 + e] - av * kS);
                float po = 0.f;
#pragma unroll
                for (int i = 0; i < 32; ++i) { S[i] = av * S[i] + ks[tt * 128 + 32 * dq + i] * vv; po += S[i] * qs[tt * 128 + 32 * dq + i]; }
                red2[dq * 128 + e] = po;
                __syncthreads();
                if (dq == 0) ob[tt * 128 + e] = (red2[e] + red2[128 + e]) + (red2[256 + e] + red2[384 + e]);
            }
            __syncthreads();
            for (int tt = wave; tt < nb; tt += NWAVES) {
                const float o0 = ob[tt * 128 + lane], o1 = ob[tt * 128 + 64 + lane];
                const float ss = wave_sum(o0 * o0 + o1 * o1);
                const float rs = rsqrtf(ss * (1.f / 128.f) + RMS_EPS);
                const size_t tok = (size_t)(t0 + tb + tt);
                const float z0 = bf2f(PROJ[tok * PROJ_LD + 4096 + h * 128 + lane]), z1 = bf2f(PROJ[tok * PROJ_LD + 4096 + h * 128 + 64 + lane]);
                OG[tok * VAL_DIM + h * 128 + lane] = (bf16)f2bf(o0 * rs * nw[lane] * silu_f(z0));
                OG[tok * VAL_DIM + h * 128 + 64 + lane] = (bf16)f2bf(o1 * rs * nw[64 + lane] * silu_f(z1));
            }
        }
#pragma unroll
        for (int i = 0; i < 32; ++i) sout[(size_t)(32 * dq + i) * 128 + e] = S[i];
        __syncthreads();
    }
}

__device__ __forceinline__ void phase_swa_attn(CArgs ap, int j, LAS unsigned char* lds) {
    int tid_ = threadIdx.x; asm volatile("" : "+v"(tid_)); const int tid = tid_, lane = tid & 63, wave = __builtin_amdgcn_readfirstlane(tid >> 6);
    const int gw = blockIdx.x * NWAVES + wave, NGW = gridDim.x * NWAVES;
    unsigned char* ws = ap->ws;
    const bf16* Q = (const bf16*)(ws + WS_Q); const bf16* KB = (const bf16*)(ws + WS_KB); const bf16* VB = (const bf16*)(ws + WS_VB);
    bf16* ATT = (bf16*)(ws + WS_ATT);
    const float* ck = ap->in[4] + (size_t)j * NB_S * 128 * 256; const float* cv = ap->in[5] + (size_t)j * NB_S * 128 * 256;
    const float* sinks = ap->in[17] + j * 16;
    LAS float* qs = (LAS float*)(lds + wave * 4096);
    LAS float* ps = qs + 256;
    for (int task = gw; task < T * 4; task += NGW) {
        const int t = task >> 2, kh = task & 3;
#pragma unroll
        for (int g = 0; g < 4; ++g) qs[g * 64 + lane] = bf2f(Q[(size_t)t * DM + (kh * 4 + g) * 64 + lane]);
        LDS_WAIT(); asm volatile("" ::: "memory");
        const bool prompt = t < TP; int nk, b = 0, l = 0;
        if (prompt) { const int pos = t & 2047; nk = (pos < 128 ? pos : 128) + 1; } else { const int r = t - TP; b = r >> 2; l = r & 3; nk = 129; }
        const float sl0 = exp2f(-0.5f * (float)(kh * 4 + 1)), sl1 = exp2f(-0.5f * (float)(kh * 4 + 2)), sl2 = exp2f(-0.5f * (float)(kh * 4 + 3)), sl3 = exp2f(-0.5f * (float)(kh * 4 + 4));
#pragma unroll 1
        for (int kb = 0; kb < 3; ++kb) {
            const int jj = kb * 64 + lane; const bool valid = jj < nk;
            float d0 = 0.f, d1 = 0.f, d2 = 0.f, d3 = 0.f;
            if (valid) {
                const int cj = l + jj;
                if (prompt || cj >= 128) {
                    const bf16* kp = prompt ? KB + (size_t)(t - (nk - 1) + jj) * 256 + kh * 64 : KB + (size_t)(TP + b * 4 + (cj - 128)) * 256 + kh * 64;
#pragma unroll 1
                    for (int d = 0; d < 64; d += 8) {
                        const v4u w = *(const v4u*)(kp + d);
                        const float kv[8] = {bflo(w.x), bfhi(w.x), bflo(w.y), bfhi(w.y), bflo(w.z), bfhi(w.z), bflo(w.w), bfhi(w.w)};
#pragma unroll
                        for (int i = 0; i < 8; ++i) { d0 += kv[i] * qs[d + i]; d1 += kv[i] * qs[64 + d + i]; d2 += kv[i] * qs[128 + d + i]; d3 += kv[i] * qs[192 + d + i]; }
                    }
                } else {
                    const float* kf = ck + (size_t)(b * 128 + cj) * 256 + kh * 64;
#pragma unroll 1
                    for (int d = 0; d < 64; d += 4) {
                        const f32x4 x = *(const f32x4*)(kf + d);
#pragma unroll
                        for (int i = 0; i < 4; ++i) { d0 += x[i] * qs[d + i]; d1 += x[i] * qs[64 + d + i]; d2 += x[i] * qs[128 + d + i]; d3 += x[i] * qs[192 + d + i]; }
                    }
                }
            }
            const float rel = (float)((nk - 1) - jj);
            const float NEG = -INFINITY;
            ps[jj] = valid ? d0 - sl0 * rel : NEG; ps[192 + jj] = valid ? d1 - sl1 * rel : NEG; ps[384 + jj] = valid ? d2 - sl2 * rel : NEG; ps[576 + jj] = valid ? d3 - sl3 * rel : NEG;
        }
        LDS_WAIT(); asm volatile("" ::: "memory");
#pragma unroll 1
        for (int g = 0; g < 4; ++g) {
            const float sk = sinks[kh * 4 + g];
            const float s0 = ps[g * 192 + lane], s1 = ps[g * 192 + 64 + lane], s2 = ps[g * 192 + 128 + lane];
            float m = wave_max(fmaxf(fmaxf(s0, s1), s2)); m = fmaxf(m, sk);
            const float p0 = __expf(s0 - m), p1 = __expf(s1 - m), p2 = __expf(s2 - m);
            const float den = wave_sum(p0 + p1 + p2) + __expf(sk - m); const float inv = 1.f / den;
            ps[g * 192 + lane] = p0 * inv; ps[g * 192 + 64 + lane] = p1 * inv; ps[g * 192 + 128 + lane] = p2 * inv;
        }
        LDS_WAIT(); asm volatile("" ::: "memory");
        float o0 = 0.f, o1 = 0.f, o2 = 0.f, o3 = 0.f;
        if (prompt) {
            const bf16* vp = VB + (size_t)(t - (nk - 1)) * 256 + kh * 64 + lane;
#pragma unroll 4
            for (int jj = 0; jj < nk; ++jj) { const float vv = bf2f(vp[(size_t)jj * 256]);
                o0 += ps[jj] * vv; o1 += ps[192 + jj] * vv; o2 += ps[384 + jj] * vv; o3 += ps[576 + jj] * vv; }
        } else {
#pragma unroll 4
            for (int jj = 0; jj < 129; ++jj) { const int cj = l + jj;
                const float vv = (cj < 128) ? cv[(size_t)(b * 128 + cj) * 256 + kh * 64 + lane] : bf2f(VB[(size_t)(TP + b * 4 + (cj - 128)) * 256 + kh * 64 + lane]);
                o0 += ps[jj] * vv; o1 += ps[192 + jj] * vv; o2 += ps[384 + jj] * vv; o3 += ps[576 + jj] * vv; }
        }
        bf16* op = ATT + (size_t)t * DM + kh * 256 + lane;
        op[0] = (bf16)f2bf(o0); op[64] = (bf16)f2bf(o1); op[128] = (bf16)f2bf(o2); op[192] = (bf16)f2bf(o3);
        LDS_WAIT(); asm volatile("" ::: "memory");
    }
}

__device__ __forceinline__ void phase_final(CArgs ap) {
    int tid_ = threadIdx.x; asm volatile("" : "+v"(tid_)); const int tid = tid_, lane = tid & 63, wave = __builtin_amdgcn_readfirstlane(tid >> 6);
    const int gw = blockIdx.x * NWAVES + wave, NGW = gridDim.x * NWAVES;
    const float* X = (const float*)(ap->ws + WS_X); const float* nw = ap->in[8];
    for (int m = gw; m < T; m += NGW) {
        f32x4 v[4]; float s = 0.f;
#pragma unroll
        for (int j = 0; j < 4; ++j) { v[j] = *((const f32x4*)(X + (size_t)m * DM) + lane + 64 * j); s += (v[j][0] * v[j][0] + v[j][1] * v[j][1]) + (v[j][2] * v[j][2] + v[j][3] * v[j][3]); }
        const float rs = rsqrtf(wave_sum(s) * (1.f / 1024.f) + RMS_EPS);
        float* o = ap->out + (size_t)m * DM;
#pragma unroll
        for (int j = 0; j < 4; ++j) { const f32x4 w = *((const f32x4*)nw + lane + 64 * j); *((f32x4*)o + lane + 64 * j) = v[j] * rs * w; }
    }
}

constexpr int REC_WNEG = 0, REC_QG = 16384, REC_KGT = 32768, REC_AQK = 49152, REC_U = 57344, REC_BYTES = 73728, REC_STAGE = 57344;
typedef short bf16x8_t __attribute__((ext_vector_type(8)));

__device__ __forceinline__ int swz256(int row, int ch) { return row * 256 + ((ch ^ (row & 15)) << 4); }
__device__ __forceinline__ int swz128(int row, int ch) { return row * 128 + ((ch ^ (row & 7)) << 4); }

__device__ __forceinline__ void phase_dn_prep(CArgs ap, int j, LAS unsigned char* lds) {
    int tid_ = threadIdx.x; asm volatile("" : "+v"(tid_)); const int tid = tid_, lane = tid & 63, wave = __builtin_amdgcn_readfirstlane(tid >> 6);
    const int role = wave >> 1;
    unsigned char* ws0 = ap->ws;
    LAS unsigned char* kb16 = lds;
    LAS unsigned char* qb16 = lds + 16384;
    LAS float* k32 = (LAS float*)(lds + 32768);
    LAS float* bmt = (LAS float*)(lds + 65536);
    LAS float* Gs = (LAS float*)(lds + 98304);
    LAS float* Bs = Gs + 128;
    LAS float* rowss = Bs + 128;
    for (int unit = blockIdx.x; unit < 2048; unit += gridDim.x) {
        const int b = unit >> 8, hq = (unit >> 5) & 7, n = unit & 31, trow0 = b * SEQ + n * 64;
        int cidx = tid & 127; asm volatile("" : "+v"(cidx));
        unsigned char* ws = ws0; asm volatile("" : "+s"(ws));
        const bf16* PROJ = (const bf16*)(ws + WS_PROJ); const float* BA = (const float*)(ws + WS_BA);
        unsigned char* DREC = ws + WS_DREC; float* EGL = (float*)(ws + WS_EGL);
        const float* cw = ap->in[10] + (size_t)j * 4 * CONV_DIM;
        float* oconvp = ap->out + O_CONVP + (size_t)j * NB_P * 3 * CONV_DIM;
        __syncthreads();
        if (wave < 2) {
            const int h = 2 * hq + wave; const size_t t = (size_t)(trow0 + lane);
            const float bv = BA[t * 32 + h], av = BA[t * 32 + 16 + h];
            const float x = av + ap->in[12][j * 16 + h]; const float sp = (x > 20.f) ? x : log1pf(__expf(x));
            float g = -__expf(ap->in[11][j * 16 + h]) * sp;
#pragma unroll
            for (int off = 1; off < 64; off <<= 1) { const float o = __shfl_up(g, off); if (lane >= off) g += o; }
            Gs[wave * 64 + lane] = g; Bs[wave * 64 + lane] = 1.f / (1.f + __expf(-bv));
        }
        const int col = (role == 0) ? hq * 128 + cidx : (role == 1) ? 1024 + hq * 128 + cidx : 2048 + (2 * hq + role - 2) * 128 + cidx;
        float val[64];
        {
            const float w0 = cw[col], w1 = cw[CONV_DIM + col], w2 = cw[2 * CONV_DIM + col], w3 = cw[3 * CONV_DIM + col];
            const bf16* pp = PROJ + (size_t)trow0 * PROJ_LD + col;
            float um3 = 0.f, um2 = 0.f, um1 = 0.f;
            if (n > 0) { um3 = bf2f(*(pp - 3 * PROJ_LD)); um2 = bf2f(*(pp - 2 * PROJ_LD)); um1 = bf2f(*(pp - PROJ_LD)); }
#pragma unroll
            for (int c = 0; c < 64; ++c) {
                const float uc = bf2f(pp[(size_t)c * PROJ_LD]);
                val[c] = silu_f(w3 * uc + w2 * um1 + w1 * um2 + w0 * um3);
                um3 = um2; um2 = um1; um1 = uc;
                if (c >= 61 && n == 31) oconvp[(size_t)(b * 3 + c - 61) * CONV_DIM + col] = uc;
            }
        }
        if (role < 2) {
#pragma unroll
            for (int c = 0; c < 64; ++c) { const float s = wave_sum(val[c] * val[c]); if (lane == 0) rowss[(role * 2 + (wave & 1)) * 64 + c] = s; }
        }
        __syncthreads();
        if (role == 0) {
            unsigned char* r0 = DREC + (size_t)((b * 16 + 2 * hq) * 32 + n) * REC_BYTES; unsigned char* r1 = r0 + (size_t)32 * REC_BYTES;
            bf16* qg0 = (bf16*)(r0 + REC_QG); bf16* qg1 = (bf16*)(r1 + REC_QG);
#pragma unroll
            for (int c = 0; c < 64; ++c) {
                const float inv = rsqrtf(rowss[c] + rowss[64 + c] + L2_EPS) * 0.08838834764831845f;
                const float q = val[c] * inv;
                *(LAS bf16*)(qb16 + swz256(c, cidx >> 3) + (cidx & 7) * 2) = (bf16)f2bf(q);
                qg0[c * 128 + cidx] = (bf16)f2bf(q * __expf(Gs[c])); qg1[c * 128 + cidx] = (bf16)f2bf(q * __expf(Gs[64 + c]));
            }
        } else if (role == 1) {
            unsigned char* r0 = DREC + (size_t)((b * 16 + 2 * hq) * 32 + n) * REC_BYTES; unsigned char* r1 = r0 + (size_t)32 * REC_BYTES;
            const float gl0 = Gs[63], gl1 = Gs[127];
#pragma unroll
            for (int c = 0; c < 64; ++c) {
                const float inv = rsqrtf(rowss[128 + c] + rowss[192 + c] + L2_EPS);
                val[c] *= inv;
                *(LAS bf16*)(kb16 + swz256(c, cidx >> 3) + (cidx & 7) * 2) = (bf16)f2bf(val[c]);
                k32[c * 128 + cidx] = val[c];
            }
#pragma unroll
            for (int c8 = 0; c8 < 8; ++c8) {
                v4u w0, w1;
                w0.x = pk2(val[c8 * 8 + 0] * __expf(gl0 - Gs[c8 * 8 + 0]), val[c8 * 8 + 1] * __expf(gl0 - Gs[c8 * 8 + 1]));
                w0.y = pk2(val[c8 * 8 + 2] * __expf(gl0 - Gs[c8 * 8 + 2]), val[c8 * 8 + 3] * __expf(gl0 - Gs[c8 * 8 + 3]));
                w0.z = pk2(val[c8 * 8 + 4] * __expf(gl0 - Gs[c8 * 8 + 4]), val[c8 * 8 + 5] * __expf(gl0 - Gs[c8 * 8 + 5]));
                w0.w = pk2(val[c8 * 8 + 6] * __expf(gl0 - Gs[c8 * 8 + 6]), val[c8 * 8 + 7] * __expf(gl0 - Gs[c8 * 8 + 7]));
                w1.x = pk2(val[c8 * 8 + 0] * __expf(gl1 - Gs[64 + c8 * 8 + 0]), val[c8 * 8 + 1] * __expf(gl1 - Gs[64 + c8 * 8 + 1]));
                w1.y = pk2(val[c8 * 8 + 2] * __expf(gl1 - Gs[64 + c8 * 8 + 2]), val[c8 * 8 + 3] * __expf(gl1 - Gs[64 + c8 * 8 + 3]));
                w1.z = pk2(val[c8 * 8 + 4] * __expf(gl1 - Gs[64 + c8 * 8 + 4]), val[c8 * 8 + 5] * __expf(gl1 - Gs[64 + c8 * 8 + 5]));
                w1.w = pk2(val[c8 * 8 + 6] * __expf(gl1 - Gs[64 + c8 * 8 + 6]), val[c8 * 8 + 7] * __expf(gl1 - Gs[64 + c8 * 8 + 7]));
                *(v4u*)(r0 + REC_KGT + cidx * 128 + c8 * 16) = w0; *(v4u*)(r1 + REC_KGT + cidx * 128 + c8 * 16) = w1;
            }
            if (cidx == 0) { EGL[(b * 16 + 2 * hq) * 32 + n] = __expf(gl0); EGL[(b * 16 + 2 * hq + 1) * 32 + n] = __expf(gl1); }
        } else {
            const int hh = role - 2;
#pragma unroll
            for (int c = 0; c < 64; ++c) val[c] *= Bs[hh * 64 + c];
        }
        __syncthreads();
        {
            const int prod = wave >> 2, tr = wave & 3, fr = lane & 15, fq = lane >> 4;
            f32x4 acc[4];
#pragma unroll
            for (int tc = 0; tc < 4; ++tc) acc[tc] = (f32x4){0.f, 0.f, 0.f, 0.f};
            LAS unsigned char* bsrc = prod ? qb16 : kb16;
#pragma unroll
            for (int ks = 0; ks < 4; ++ks) {
                const bf16x8_t af = *(LAS bf16x8_t*)(kb16 + swz256(16 * tr + fr, ks * 4 + fq));
#pragma unroll
                for (int tc = 0; tc < 4; ++tc) { const bf16x8_t bfr = *(LAS bf16x8_t*)(bsrc + swz256(16 * tc + fr, ks * 4 + fq));
                    acc[tc] = __builtin_amdgcn_mfma_f32_16x16x32_bf16(af, bfr, acc[tc], 0, 0, 0); }
            }
            const int i0 = 16 * tr + 4 * fq;
#pragma unroll
            for (int hh = 0; hh < 2; ++hh) {
                unsigned char* rec = DREC + (size_t)((b * 16 + 2 * hq + hh) * 32 + n) * REC_BYTES;
#pragma unroll
                for (int tc = 0; tc < 4; ++tc) { const int jc = 16 * tc + fr; const float gj = Gs[hh * 64 + jc];
                    float o[4];
#pragma unroll
                    for (int r = 0; r < 4; ++r) { const int i = i0 + r; const float gi = Gs[hh * 64 + i];
                        if (prod == 0) o[r] = (i > jc) ? Bs[hh * 64 + i] * acc[tc][r] * __expf(gi - gj) : 0.f;
                        else o[r] = (jc >= i) ? acc[tc][r] * __expf(gj - gi) : 0.f; }
                    if (prod == 0) *(LAS f32x4*)(bmt + hh * 4096 + jc * 64 + i0) = (f32x4){o[0], o[1], o[2], o[3]};
                    else { v2u w; w.x = pk2(o[0], o[1]); w.y = pk2(o[2], o[3]); *(v2u*)(rec + REC_AQK + jc * 128 + i0 * 2) = w; } }
            }
        }
        __syncthreads();
        {
            const int hh = (role >= 2) ? role - 2 : role;
            if (role == 0) {
#pragma unroll
                for (int c = 0; c < 64; ++c) val[c] = k32[c * 128 + cidx] * Bs[c] * __expf(Gs[c]);
            } else if (role == 1) {
#pragma unroll
                for (int c = 0; c < 64; ++c) val[c] = val[c] * Bs[64 + c] * __expf(Gs[64 + c]);
            }
            const LAS float* bm = bmt + hh * 4096;
#pragma unroll
            for (int s = 0; s < 63; ++s) {
                const float xs = val[s];
#pragma unroll
                for (int cg = (s + 1) / 4; cg < 16; ++cg) { const f32x4 m = *(const LAS f32x4*)(bm + s * 64 + cg * 4);
#pragma unroll
                    for (int e = 0; e < 4; ++e) { const int c = cg * 4 + e; if (c > s) val[c] -= m[e] * xs; } }
            }
            unsigned char* rec = DREC + (size_t)((b * 16 + 2 * hq + hh) * 32 + n) * REC_BYTES;
            if (role >= 2) { bf16* U = (bf16*)(rec + REC_U);
#pragma unroll
                for (int c = 0; c < 64; ++c) U[c * 128 + cidx] = (bf16)f2bf(val[c]);
            } else { bf16* W = (bf16*)(rec + REC_WNEG);
#pragma unroll
                for (int c = 0; c < 64; ++c) W[c * 128 + cidx] = (bf16)f2bf(-val[c]);
            }
        }
    }
    phase_dn_post(ap, j, TP);
}

constexpr int SC_STAGE0 = 0, SC_STAGE1 = REC_STAGE, SC_SCR = 2 * REC_STAGE, SC_RED = SC_SCR + 8 * 4096;
__device__ __forceinline__ int stage_dst(int q) {
    const int off = q * 16;
    if (off < REC_KGT) { const int base = off & ~16383, local = off & 16383; return base + swz256(local >> 8, (local >> 4) & 15); }
    const int base = (off < REC_AQK) ? REC_KGT : REC_AQK, local = off - base; return base + swz128(local >> 7, (local >> 4) & 7);
}
__device__ __forceinline__ void scan_unit(CArgs ap, int j, int unit, LAS unsigned char* lds) {
    int tid_ = threadIdx.x; asm volatile("" : "+v"(tid_)); const int tid = tid_, lane = tid & 63, wave = __builtin_amdgcn_readfirstlane(tid >> 6);
    const int fr = lane & 15, fq = lane >> 4, e0 = 16 * wave;
    const int b = unit >> 4, h = unit & 15;
    unsigned char* ws = ap->ws;
    const unsigned char* rec0 = ws + WS_DREC + (size_t)(unit * 32) * REC_BYTES;
    const float* EGL = (const float*)(ws + WS_EGL) + unit * 32;
    const bf16* PROJ = (const bf16*)(ws + WS_PROJ); bf16* OG = (bf16*)(ws + WS_OG);
    const float* nw = ap->in[13] + j * 128;
    LAS unsigned char* scr = lds + SC_SCR + wave * 4096;
    LAS float* red = (LAS float*)(lds + SC_RED);
    f32x4 Sacc[8];
#pragma unroll
    for (int dt = 0; dt < 8; ++dt) Sacc[dt] = (f32x4){0.f, 0.f, 0.f, 0.f};
    const f32x4 nwv = *(const f32x4*)(nw + e0 + 4 * fq);
    __syncthreads();
#pragma unroll
    for (int i = 0; i < 7; ++i) { const int q = tid + 512 * i; *(LAS v4u*)(lds + SC_STAGE0 + stage_dst(q)) = *(const v4u*)(rec0 + (size_t)q * 16); }
#pragma unroll 1
    for (int n = 0; n < 32; ++n) {
        LAS unsigned char* sb = lds + ((n & 1) ? SC_STAGE1 : SC_STAGE0);
        LAS unsigned char* sbn = lds + ((n & 1) ? SC_STAGE0 : SC_STAGE1);
        const unsigned char* rec = rec0 + (size_t)n * REC_BYTES;
        __syncthreads();
        v4u pre[7];
        if (n + 1 < 32) {
#pragma unroll
            for (int i = 0; i < 7; ++i) pre[i] = *(const v4u*)(rec + REC_BYTES + (size_t)(tid + 512 * i) * 16);
        }
        f32x4 accu[4];
#pragma unroll
        for (int tc = 0; tc < 4; ++tc) { const v2u w = *(const v2u*)(rec + REC_U + (size_t)(16 * tc + fr) * 256 + (e0 + 4 * fq) * 2);
            accu[tc] = (f32x4){bflo(w.x), bfhi(w.x), bflo(w.y), bfhi(w.y)}; }
        const float egl = EGL[n];
#pragma unroll
        for (int dt = 0; dt < 8; ++dt)
#pragma unroll
            for (int r = 0; r < 4; ++r) { const int el = 4 * fq + r, d = 16 * dt + fr;
                *(LAS bf16*)(scr + swz256(el, d >> 3) + (d & 7) * 2) = (bf16)f2bf(Sacc[dt][r]); }
        bf16x8_t Sa[4];
#pragma unroll
        for (int ks = 0; ks < 4; ++ks) Sa[ks] = *(LAS bf16x8_t*)(scr + swz256(fr, ks * 4 + fq));
#pragma unroll
        for (int tc = 0; tc < 4; ++tc)
#pragma unroll
            for (int ks = 0; ks < 4; ++ks) { const bf16x8_t bw = *(LAS bf16x8_t*)(sb + REC_WNEG + swz256(16 * tc + fr, ks * 4 + fq));
                accu[tc] = __builtin_amdgcn_mfma_f32_16x16x32_bf16(Sa[ks], bw, accu[tc], 0, 0, 0); }
#pragma unroll
        for (int tc = 0; tc < 4; ++tc)
#pragma unroll
            for (int r = 0; r < 4; ++r) { const int el = 4 * fq + r, c = 16 * tc + fr;
                *(LAS bf16*)(scr + swz128(el, c >> 3) + (c & 7) * 2) = (bf16)f2bf(accu[tc][r]); }
        bf16x8_t Ua[2];
#pragma unroll
        for (int k2 = 0; k2 < 2; ++k2) Ua[k2] = *(LAS bf16x8_t*)(scr + swz128(fr, k2 * 4 + fq));
        f32x4 acco[4];
#pragma unroll
        for (int tc = 0; tc < 4; ++tc) { acco[tc] = (f32x4){0.f, 0.f, 0.f, 0.f};
#pragma unroll
            for (int ks = 0; ks < 4; ++ks) { const bf16x8_t bq = *(LAS bf16x8_t*)(sb + REC_QG + swz256(16 * tc + fr, ks * 4 + fq));
                acco[tc] = __builtin_amdgcn_mfma_f32_16x16x32_bf16(Sa[ks], bq, acco[tc], 0, 0, 0); }
#pragma unroll
            for (int k2 = 0; k2 < 2; ++k2) { const bf16x8_t ba = *(LAS bf16x8_t*)(sb + REC_AQK + swz128(16 * tc + fr, k2 * 4 + fq));
                acco[tc] = __builtin_amdgcn_mfma_f32_16x16x32_bf16(Ua[k2], ba, acco[tc], 0, 0, 0); } }
#pragma unroll
        for (int dt = 0; dt < 8; ++dt) { Sacc[dt] = Sacc[dt] * egl;
#pragma unroll
            for (int k2 = 0; k2 < 2; ++k2) { const bf16x8_t bk = *(LAS bf16x8_t*)(sb + REC_KGT + swz128(16 * dt + fr, k2 * 4 + fq));
                Sacc[dt] = __builtin_amdgcn_mfma_f32_16x16x32_bf16(Ua[k2], bk, Sacc[dt], 0, 0, 0); } }
#pragma unroll
        for (int tc = 0; tc < 4; ++tc) { float p = (acco[tc][0] * acco[tc][0] + acco[tc][1] * acco[tc][1]) + (acco[tc][2] * acco[tc][2] + acco[tc][3] * acco[tc][3]);
            p += __shfl_xor(p, 16); p += __shfl_xor(p, 32);
            if (fq == 0) red[wave * 64 + 16 * tc + fr] = p; }
        __syncthreads();
#pragma unroll
        for (int tc = 0; tc < 4; ++tc) { const int c = 16 * tc + fr; float tot = 0.f;
#pragma unroll
            for (int w8 = 0; w8 < 8; ++w8) tot += red[w8 * 64 + c];
            const float rs = rsqrtf(tot * (1.f / 128.f) + RMS_EPS);
            const size_t tok = (size_t)(b * SEQ + n * 64 + c);
            const v2u zw = *(const v2u*)(PROJ + tok * PROJ_LD + 4096 + h * 128 + e0 + 4 * fq);
            const float z0 = bflo(zw.x), z1 = bfhi(zw.x), z2 = bflo(zw.y), z3 = bfhi(zw.y);
            v2u ow; ow.x = pk2(acco[tc][0] * rs * nwv[0] * silu_f(z0), acco[tc][1] * rs * nwv[1] * silu_f(z1));
            ow.y = pk2(acco[tc][2] * rs * nwv[2] * silu_f(z2), acco[tc][3] * rs * nwv[3] * silu_f(z3));
            *(v2u*)(OG + tok * VAL_DIM + h * 128 + e0 + 4 * fq) = ow; }
        if (n + 1 < 32) {
#pragma unroll
            for (int i = 0; i < 7; ++i) *(LAS v4u*)(sbn + stage_dst(tid + 512 * i)) = pre[i];
        }
    }
    float* sout = ap->out + O_DELTAP + ((size_t)(j * NB_P + b) * 16 + h) * 16384;
#pragma unroll
    for (int dt = 0; dt < 8; ++dt) *(f32x4*)(sout + (size_t)(16 * dt + fr) * 128 + e0 + 4 * fq) = Sacc[dt];
}
__device__ __forceinline__ void phase_dn_scan(CArgs ap, int j, LAS unsigned char* lds) {
    const int G = gridDim.x, half = G >> 1;
    if ((int)blockIdx.x < half) { for (int unit = blockIdx.x; unit < 128; unit += half) scan_unit(ap, j, unit, lds); }
    else phase_delta_rec(ap, j, lds, 128 + (int)blockIdx.x - half, G - half);
}

#define XB_TMO      128
#define XB_XCNT(j)  (256  + 64 * (j))
#define XB_XSUB(j)  (1280 + 64 * (j))
#define XB_XGEN(j)  (2304 + 64 * (j))
#define XB_TOP      3328
#define XB_TOPGEN   3392
#define XCD_BAR_WORDS 3456
#define XB_SPIN_CAP (1u << 18)

__device__ __forceinline__ unsigned xb_ld(unsigned* p)              { return __hip_atomic_load(p, __ATOMIC_RELAXED, __HIP_MEMORY_SCOPE_AGENT); }
__device__ __forceinline__ unsigned xb_add(unsigned* p, unsigned v) { return __hip_atomic_fetch_add(p, v, __ATOMIC_RELAXED, __HIP_MEMORY_SCOPE_AGENT); }
__device__ __forceinline__ unsigned xb_xcc_id() { return (unsigned)__builtin_amdgcn_s_getreg((3 << 11) | 20) & 0xFu; }
#define XB_SPIN(cond, bar) do { unsigned _sp = 0; while (cond) { __builtin_amdgcn_s_sleep(1); \
    if ((++_sp & 255u) == 0u) { if (xb_ld(&(bar)[XB_TMO])) break; if (_sp > XB_SPIN_CAP) { atomicAdd(&(bar)[XB_TMO], 1u); break; } } } } while (0)

struct XcdBarrier {
    unsigned* bar; unsigned x;
    volatile LAS unsigned* st;
};

__device__ __forceinline__ XcdBarrier xcd_barrier_post(unsigned* bar, volatile LAS unsigned* st) {
    XcdBarrier b; b.bar = bar; b.x = xb_xcc_id(); b.st = st;
    if (threadIdx.x == 0) (void)xb_add(&bar[XB_XCNT(b.x)], 1u);
    return b;
}
__device__ __forceinline__ void xcd_barrier_complete(unsigned* bar, unsigned x, unsigned& nloc, unsigned& nx) {
    const unsigned G = gridDim.x * gridDim.y * gridDim.z;
    unsigned sum, cnt, mine, sp = 0u;
    for (;;) {
        sum = 0u; cnt = 0u; mine = 0u;
#pragma unroll
        for (unsigned j = 0; j < 16; ++j) { const unsigned c = xb_ld(&bar[XB_XCNT(j)]); sum += c; cnt += (c > 0u) ? 1u : 0u; mine = (j == x) ? c : mine; }
        if (sum == G) break;
        __builtin_amdgcn_s_sleep(1);
        if ((++sp & 255u) == 0u) { if (xb_ld(&bar[XB_TMO])) break; if (sp > XB_SPIN_CAP) { atomicAdd(&bar[XB_TMO], 1u); break; } }
    }
    nloc = mine > 0u ? mine : 1u; nx = cnt > 0u ? cnt : 1u;
}

__device__ __forceinline__ void xcd_barrier(const XcdBarrier& b) {
    asm volatile("s_waitcnt vmcnt(0)" ::: "memory");
    __syncthreads();
    if (threadIdx.x == 0) {
        unsigned* bar = b.bar;
        __builtin_amdgcn_s_waitcnt(0);
        unsigned nloc = b.st[0], nx = b.st[1];
        if (nloc == 0u) { xcd_barrier_complete(bar, b.x, nloc, nx); b.st[0] = nloc; b.st[1] = nx; }
        const unsigned old = xb_add(&bar[XB_XSUB(b.x)], 1u);
        const unsigned gen = old / nloc;
        if (old + 1u == (gen + 1u) * nloc) {
            __builtin_amdgcn_fence(__ATOMIC_RELEASE, "agent");
            asm volatile("s_waitcnt vmcnt(0)" ::: "memory");
            const unsigned og = xb_add(&bar[XB_TOP], 1u);
            const unsigned tg = og / nx;
            if (og + 1u == (tg + 1u) * nx) xb_add(&bar[XB_TOPGEN], 1u);
            else XB_SPIN(xb_ld(&bar[XB_TOPGEN]) == tg, bar);
            __builtin_amdgcn_fence(__ATOMIC_ACQUIRE, "agent");
            xb_add(&bar[XB_XGEN(b.x)], 1u);
            asm volatile("s_waitcnt vmcnt(0)" ::: "memory");
        } else {
            XB_SPIN(xb_ld(&bar[XB_XGEN(b.x)]) == gen, bar);
            __builtin_amdgcn_fence(__ATOMIC_ACQUIRE, "agent");
            asm volatile("s_waitcnt vmcnt(0)" ::: "memory");
        }
    }
    __syncthreads();
}

constexpr int CW_BAR = 4096;
constexpr int MISC_OFF = 151552;

template <class Epi>
__device__ __forceinline__ void run_gemm(LAS unsigned char* lds, const bf16* A, const bf16* Bt, int N, int K, const Epi& E) {
    pg8::Gemm g{A, Bt, T, N, K}; pg8::StaticOrder S; S.init(T, N, (int)gridDim.x, (int)blockIdx.x);
    pg8::gemm_phase<Epi, pg8::StaticOrder, true, true>(lds, g, S, E);
}

__global__ void __launch_bounds__(NTHREADS, 2) mk_fwd(Args a) {
    extern __shared__ __attribute__((aligned(16))) unsigned char lds_raw[];
    LAS unsigned char* lds = (LAS unsigned char*)lds_raw;
    unsigned char* ws = kargs()->ws;
    for (int u = threadIdx.x; u < (LDS_BYTES - MISC_OFF) / 4; u += NTHREADS) ((LAS unsigned*)(lds + MISC_OFF))[u] = 0u;
    __syncthreads();
    (void)xcd_barrier_post((unsigned*)(ws + WS_CTL) + CW_BAR, (volatile LAS unsigned*)(lds + MISC_OFF));
#define GRID_BAR() do { XcdBarrier b_; b_.bar = (unsigned*)(kargs()->ws + WS_CTL) + CW_BAR; b_.x = xb_xcc_id(); b_.st = (volatile LAS unsigned*)(lds + MISC_OFF); xcd_barrier(b_); } while (0)
    float* X = (float*)(ws + WS_X); bf16* XB = (bf16*)(ws + WS_XB); float* SSQ = (float*)(ws + WS_SSQ);

    phase_prologue(kargs(), lds);
    GRID_BAR();
#pragma unroll 1
    for (int li = 0; li < 4; ++li) {
        const int j = li >> 1;
        if ((li & 1) == 0) {
            { EpiDnIn E{(bf16*)(ws + WS_PROJ), (float*)(ws + WS_BA), SSQ};
              run_gemm(lds, XB, (const bf16*)(ws + WS_WIN) + (size_t)j * DN_INP * DM, DN_INP, DM, E); }
            GRID_BAR();
            phase_dn_prep(kargs(), j, lds);
            GRID_BAR();
            phase_dn_scan(kargs(), j, lds);
            GRID_BAR();
            { EpiRes E{X, XB, SSQ, nullptr};
              run_gemm(lds, (const bf16*)(ws + WS_OG), (const bf16*)(ws + WS_WOUT) + (size_t)j * DM * VAL_DIM, DM, VAL_DIM, E); }
            GRID_BAR();
        } else {
            { EpiQkv E{(bf16*)(ws + WS_Q), (bf16*)(ws + WS_KB), SSQ, kargs()->in[16] + j * QKV_N,
                       kargs()->out + O_KP + (size_t)j * NB_P * 128 * 256, kargs()->out + O_KS + (size_t)j * NB_S * 4 * 256};
              run_gemm(lds, XB, (const bf16*)(ws + WS_WQKV) + (size_t)j * QKV_N * DM, QKV_N, DM, E); }
            GRID_BAR();
            phase_swa_attn(kargs(), j, lds);
            GRID_BAR();
            { EpiRes E{X, XB, SSQ, kargs()->in[19] + j * DM};
              run_gemm(lds, (const bf16*)(ws + WS_ATT), (const bf16*)(ws + WS_WO) + (size_t)j * DM * DM, DM, DM, E); }
            GRID_BAR();
        }
        { EpiGu E{(bf16*)(ws + WS_ACT), SSQ};
          run_gemm(lds, XB, (const bf16*)(ws + WS_WGU) + (size_t)li * GU_N * DM, GU_N, DM, E); }
        GRID_BAR();
        { EpiRes E{X, XB, SSQ, nullptr};
          run_gemm(lds, (const bf16*)(ws + WS_ACT), (const bf16*)(ws + WS_WDOWN) + (size_t)li * DM * DFF, DM, DFF, E); }
        GRID_BAR();
    }
    phase_final(kargs());
}

extern "C" void kernel_launch(void* const* d_in, const int* in_sizes, int n_in, void* d_out, int out_size, void* d_ws, size_t ws_size, hipStream_t stream) {
    static int grid = 0;
    if (grid == 0) {
        if (n_in != 22 || (size_t)out_size != O_END || ws_size < WS_END) { fprintf(stderr, "kernel_launch: unexpected shapes: n_in %d out %d ws %zu\n", n_in, out_size, ws_size); grid = -1; return; }
        int dev = 0, cus = 0, per_cu = 0;
        if (hipGetDevice(&dev) != hipSuccess || hipDeviceGetAttribute(&cus, hipDeviceAttributeMultiprocessorCount, dev) != hipSuccess) { grid = -1; return; }
        if (hipFuncSetAttribute((const void*)mk_fwd, hipFuncAttributeMaxDynamicSharedMemorySize, LDS_BYTES) != hipSuccess) { fprintf(stderr, "kernel_launch: hipFuncSetAttribute failed\n"); grid = -1; return; }
        if (hipOccupancyMaxActiveBlocksPerMultiprocessor(&per_cu, (const void*)mk_fwd, NTHREADS, LDS_BYTES) != hipSuccess || per_cu < 1) { fprintf(stderr, "kernel_launch: occupancy query reports %d blocks per CU\n", per_cu); (void)hipGetLastError(); }
        grid = cus;
    }
    if (grid < 0) return;
    (void)hipMemsetAsync((char*)d_ws + WS_CTL, 0, CTL_ZERO_BYTES, stream);
    Args a{};
    for (int i = 0; i < 22; ++i) a.in[i] = (const float*)d_in[i];
    a.out = (float*)d_out; a.ws = (unsigned char*)d_ws;
    hipLaunchKernelGGL(mk_fwd, dim3(grid), dim3(NTHREADS), LDS_BYTES, stream, a);
}
```

```cpp
#include <hip/hip_runtime.h>
#include <cstdio>
#include <cstdint>
namespace pg8 {
#define PG8_LAS __attribute__((address_space(3)))
typedef unsigned short bf16_t;
typedef short bf16x8 __attribute__((ext_vector_type(8)));
typedef float f32x4 __attribute__((ext_vector_type(4)));
typedef unsigned u32x4 __attribute__((ext_vector_type(4)));
constexpr int BM = 256, BK = 64, HALF = 128, HTB = HALF * BK * 2  , STAGE_BYTES = 8 * HTB, NXCD = 8, WGM = 8;

__host__ __device__ __forceinline__ int lds_byte(int r, int c) { const int st = (r >> 4) * 2 + (c >> 5), rr = r & 15, cc = c & 31, ob = rr * 64 + cc * 2; return st * 1024 + (ob ^ (((ob >> 9) & 1) << 5)); }
__host__ __device__ __forceinline__ void stage_rc(int b, int& R, int& C) { const int st = b / 1024, sb = b % 1024, swz = sb ^ (((sb >> 9) & 1) << 5); R = (st >> 1) * 16 + swz / 64; C = (st & 1) * 32 + (swz % 64) / 2; }
__host__ __device__ __forceinline__ int perm32(int rho) { const int n = rho >> 4, i = rho & 15; return 8 * (i >> 2) + 4 * n + (i & 3); }

struct Unit { int pm, pn; };
struct Gemm { const bf16_t* A; const bf16_t* Bt; int M, N, K; };

struct StaticOrder {
    int nM, nN, nwg, G, c;
    __host__ __device__ void init(int M, int N, int G_, int c_) { nM = M / BM; nN = N / BM; nwg = nM * nN; G = G_; c = c_; }
    __host__ __device__ bool next(int i, Unit& u) const {
        const long L = (long)i * G + c; if (L >= nwg) return false;
        int wgid = (int)L; { const int q = nwg / NXCD, r = nwg % NXCD, xcd = wgid % NXCD, off = wgid / NXCD; wgid = (xcd < r ? xcd * (q + 1) : r * (q + 1) + (xcd - r) * q) + off; }
        const int nig = WGM * nN, gid = wgid / nig, fm = gid * WGM, gsz = (nM - fm) < WGM ? (nM - fm) : WGM;
        u.pm = fm + ((wgid % nig) % gsz); u.pn = (wgid % nig) / gsz; return true;
    }
    __device__ __forceinline__ void a_ready(const Unit&) const {}
    __device__ __forceinline__ void done(const Unit&) const {}
};
__device__ __forceinline__ unsigned cvt_pk_bf16(float lo, float hi) { unsigned r; asm volatile("v_cvt_pk_bf16_f32 %0, %1, %2" : "=v"(r) : "v"(lo), "v"(hi)); return r; }
typedef float f32x2 __attribute__((ext_vector_type(2)));
template <class Epi, class Sched, bool ALIGN_EPI = false, bool SP2 = false>
__device__ __forceinline__ void gemm_phase(PG8_LAS unsigned char* lds, const Gemm g, const Sched& S, const Epi& E) {
    int tid_ = threadIdx.x; asm volatile("" : "+v"(tid_)); const int tid = tid_, wid = __builtin_amdgcn_readfirstlane(tid >> 6), lane = tid & 63, wr = wid >> 2, wc = wid & 3, fr = lane & 15, fq = lane >> 4;
    const int K = g.K, nt = K / BK;
    unsigned voffA[2], voffB[2];
#pragma unroll
    for (int i = 0; i < 2; ++i) { int R, C; stage_rc(tid * 16 + i * 8192, R, C); const int Rb = Epi::PERM ? ((R & ~31) + perm32(R & 31)) : R;
        voffA[i] = (unsigned)(R * K + C) * 2u; voffB[i] = (unsigned)(Rb * K + C) * 2u; }
    const size_t kstep = (size_t)(BK * 2);
    const size_t hstep = (size_t)HALF * K * 2;
    const size_t tstep = 2 * hstep;
    const unsigned ldsw = (unsigned)wid * 1024u;
    const int aoff = lds_byte(wr * 64 + fr, fq * 8), boff = lds_byte(wc * 32 + fr, fq * 8);
#define PG8_SA(b, h) (((b) * 2 + (h)) * HTB)
#define PG8_SB(b, h) ((4 + (b) * 2 + (h)) * HTB)
#define PG8_STAGE(bufoff, gbase, voff) do { _Pragma("unroll") for (int _i = 0; _i < 2; ++_i) \
        __builtin_amdgcn_global_load_lds((const unsigned*)((const char*)(gbase) + (voff)[_i]), (PG8_LAS unsigned*)(lds + (bufoff) + ldsw + _i * 8192), 16, 0, 0); } while (0)
#define PG8_LDA(dst, b, h) do { _Pragma("unroll") for (int m = 0; m < 4; ++m) _Pragma("unroll") for (int k = 0; k < 2; ++k) dst[m][k] = *(const PG8_LAS bf16x8*)(lds + PG8_SA(b, h) + aoff + m * 2048 + k * 1024); } while (0)
#define PG8_LDB(dst, b, h) do { _Pragma("unroll") for (int n = 0; n < 2; ++n) _Pragma("unroll") for (int k = 0; k < 2; ++k) dst[n][k] = *(const PG8_LAS bf16x8*)(lds + PG8_SB(b, h) + boff + n * 2048 + k * 1024); } while (0)
#define PG8_MMA(ai, bj, At, Bt) do { __builtin_amdgcn_s_setprio(1); _Pragma("unroll") for (int m = 0; m < 4; ++m) _Pragma("unroll") for (int n = 0; n < 2; ++n) _Pragma("unroll") for (int k = 0; k < 2; ++k) \
        acc[ai][bj][m][n] = __builtin_amdgcn_mfma_f32_16x16x32_bf16(Bt[n][k], At[m][k], acc[ai][bj][m][n], 0, 0, 0); __builtin_amdgcn_s_setprio(0); } while (0)
#define PG8_WAIT_V(n) asm volatile("s_waitcnt vmcnt(" #n ")" ::: "memory")
#define PG8_WAIT_L(n) asm volatile("s_waitcnt lgkmcnt(" #n ")" ::: "memory")
#define PG8_BAR __builtin_amdgcn_s_barrier()
#define PG8_SCHED __builtin_amdgcn_sched_barrier(0)
    Unit cur, nxt; int ui = 0;
    if (!S.next(0, cur)) return;
    f32x4 acc[2][2][4][2];
#pragma unroll
    for (int a = 0; a < 2; ++a)
#pragma unroll
        for (int b = 0; b < 2; ++b)
#pragma unroll
            for (int m = 0; m < 4; ++m)
#pragma unroll
                for (int n = 0; n < 2; ++n) acc[a][b][m][n] = (f32x4){0.f, 0.f, 0.f, 0.f};
    bf16x8 At[4][2], B0[2][2], B1[2][2];
    const char* cA = (const char*)g.A + (size_t)cur.pm * tstep; const char* cB = (const char*)g.Bt + (size_t)cur.pn * tstep;
    S.a_ready(cur);
    if constexpr (SP2) {
        PG8_STAGE(PG8_SB(0, 0), cB, voffB); PG8_STAGE(PG8_SB(0, 1), cB + hstep, voffB); PG8_STAGE(PG8_SA(0, 0), cA, voffA); PG8_STAGE(PG8_SA(0, 1), cA + hstep, voffA);
        if (wr == 1) PG8_BAR;
        PG8_WAIT_V(2); PG8_BAR;
        PG8_STAGE(PG8_SB(1, 0), cB + kstep, voffB); PG8_STAGE(PG8_SA(1, 0), cA + kstep, voffA); PG8_STAGE(PG8_SB(1, 1), cB + hstep + kstep, voffB);
        PG8_WAIT_V(6); PG8_BAR;
    } else {
        PG8_STAGE(PG8_SB(0, 0), cB, voffB); PG8_STAGE(PG8_SA(0, 0), cA, voffA); PG8_STAGE(PG8_SB(0, 1), cB + hstep, voffB); PG8_STAGE(PG8_SA(0, 1), cA + hstep, voffA);
        if (wr == 1) PG8_BAR;
        PG8_WAIT_V(4); PG8_BAR;
        PG8_STAGE(PG8_SB(1, 0), cB + kstep, voffB); PG8_STAGE(PG8_SA(1, 0), cA + kstep, voffA); PG8_STAGE(PG8_SB(1, 1), cB + hstep + kstep, voffB);
        PG8_WAIT_V(6); PG8_BAR;
    }
    for (;;) {
        const bool has_next = S.next(ui + 1, nxt);
        const char* nA = has_next ? (const char*)g.A + (size_t)nxt.pm * tstep : cA; const char* nB = has_next ? (const char*)g.Bt + (size_t)nxt.pn * tstep : cB;
        for (int t = 0; t < nt; t += 2) {
            const bool last = (t == nt - 2);
            const char* a1 = cA + (size_t)(t + 1) * kstep;
            const char* a2 = last ? nA : cA + (size_t)(t + 2) * kstep; const char* b2 = last ? nB : cB + (size_t)(t + 2) * kstep;
            const char* a3 = a2 + kstep; const char* b3 = b2 + kstep;
            if (last && has_next) S.a_ready(nxt);
            if constexpr (SP2) {
            PG8_LDB(B0, 0, 0); PG8_LDB(B1, 0, 1); PG8_SCHED; PG8_LDA(At, 0, 0); PG8_STAGE(PG8_SA(1, 1), a1 + hstep, voffA);
            PG8_WAIT_V(8); PG8_WAIT_L(0); PG8_BAR; PG8_MMA(0, 0, At, B0); PG8_MMA(0, 1, At, B1); PG8_BAR; PG8_SCHED;
            PG8_LDA(At, 0, 1); PG8_STAGE(PG8_SB(0, 0), b2, voffB); PG8_STAGE(PG8_SB(0, 1), b2 + hstep, voffB); PG8_STAGE(PG8_SA(0, 0), a2, voffA);
            PG8_WAIT_V(8); PG8_WAIT_L(0); PG8_BAR; PG8_MMA(1, 0, At, B0); PG8_MMA(1, 1, At, B1); PG8_BAR; PG8_SCHED;
            PG8_LDB(B0, 1, 0); PG8_LDB(B1, 1, 1); PG8_SCHED; PG8_LDA(At, 1, 0); PG8_STAGE(PG8_SA(0, 1), a2 + hstep, voffA);
            PG8_WAIT_V(8); PG8_WAIT_L(0); PG8_BAR; PG8_MMA(0, 0, At, B0); PG8_MMA(0, 1, At, B1); PG8_BAR; PG8_SCHED;
            PG8_LDA(At, 1, 1); PG8_STAGE(PG8_SB(1, 0), b3, voffB); PG8_STAGE(PG8_SB(1, 1), b3 + hstep, voffB); PG8_STAGE(PG8_SA(1, 0), a3, voffA);
            PG8_WAIT_V(8); PG8_WAIT_L(0); PG8_BAR; PG8_MMA(1, 0, At, B0); PG8_MMA(1, 1, At, B1); PG8_BAR; PG8_SCHED;
            } else {
            PG8_LDB(B0, 0, 0); PG8_SCHED; PG8_LDA(At, 0, 0); PG8_STAGE(PG8_SA(1, 1), a1 + hstep, voffA);
            PG8_WAIT_L(8); PG8_BAR; PG8_WAIT_L(0); PG8_MMA(0, 0, At, B0); PG8_BAR; PG8_SCHED;
            PG8_LDB(B1, 0, 1); PG8_STAGE(PG8_SB(0, 0), b2, voffB);
            PG8_BAR; PG8_WAIT_L(0); PG8_MMA(0, 1, At, B1); PG8_BAR;
            PG8_LDA(At, 0, 1); PG8_STAGE(PG8_SA(0, 0), a2, voffA);
            PG8_BAR; PG8_WAIT_L(0); PG8_MMA(1, 0, At, B0); PG8_BAR; PG8_SCHED;
            PG8_STAGE(PG8_SB(0, 1), b2 + hstep, voffB);
            PG8_WAIT_V(6); PG8_BAR; PG8_MMA(1, 1, At, B1); PG8_BAR;
            PG8_LDB(B0, 1, 0); PG8_SCHED; PG8_LDA(At, 1, 0); PG8_STAGE(PG8_SA(0, 1), a2 + hstep, voffA);
            PG8_WAIT_L(8); PG8_BAR; PG8_WAIT_L(0); PG8_MMA(0, 0, At, B0); PG8_BAR; PG8_SCHED;
            PG8_LDB(B1, 1, 1); PG8_STAGE(PG8_SB(1, 0), b3, voffB);
            PG8_BAR; PG8_WAIT_L(0); PG8_MMA(0, 1, At, B1); PG8_BAR;
            PG8_LDA(At, 1, 1); PG8_STAGE(PG8_SA(1, 0), a3, voffA);
            PG8_BAR; PG8_WAIT_L(0); PG8_MMA(1, 0, At, B0); PG8_BAR; PG8_SCHED;
            PG8_STAGE(PG8_SB(1, 1), b3 + hstep, voffB);
            PG8_WAIT_V(6); PG8_BAR; PG8_MMA(1, 1, At, B1); PG8_BAR;
            }
        }
        if constexpr (ALIGN_EPI) { if (wr == 0) PG8_BAR; }
        if constexpr (!Epi::AFTER_DRAIN) { E(acc, cur, wr, wc, fr, fq); S.done(cur); }
        if (!has_next) break;
#pragma unroll
        for (int a = 0; a < 2; ++a)
#pragma unroll
            for (int b = 0; b < 2; ++b)
#pragma unroll
                for (int m = 0; m < 4; ++m)
#pragma unroll
                    for (int n = 0; n < 2; ++n) acc[a][b][m][n] = (f32x4){0.f, 0.f, 0.f, 0.f};
        cur = nxt; cA = nA; cB = nB; ++ui;
        if constexpr (ALIGN_EPI) { if (wr == 1) PG8_BAR; }
    }
    PG8_WAIT_V(0);
    if constexpr (!ALIGN_EPI) { if (wr == 0) PG8_BAR; }
    PG8_BAR;
    if constexpr (Epi::AFTER_DRAIN) { E.fused(acc, cur, wr, wc, fr, fq, lds, wid, lane); S.done(cur); }
#undef PG8_SA
#undef PG8_SB
#undef PG8_STAGE
#undef PG8_LDA
#undef PG8_LDB
#undef PG8_MMA
#undef PG8_WAIT_V
#undef PG8_WAIT_L
#undef PG8_BAR
#undef PG8_SCHED
}
}

#define GAS __attribute__((address_space(1)))
#define LAS __attribute__((address_space(3)))
typedef unsigned short bf16;
typedef unsigned v4u __attribute__((ext_vector_type(4)));
typedef unsigned v2u __attribute__((ext_vector_type(2)));
typedef float f32x4 __attribute__((ext_vector_type(4)));
typedef float f32x2v __attribute__((ext_vector_type(2)));

constexpr int DM = 1024, NB_P = 8, SEQ = 2048, NB_S = 128, DSEQ = 4;
constexpr int TP = NB_P * SEQ, TS = NB_S * DSEQ, T = TP + TS;
constexpr int DN_IN = 6176, DN_INP = 6400, PROJ_LD = 6144, CONV_DIM = 4096, VAL_DIM = 2048;
constexpr int QKV_N = 1536, DFF = 2816, GU_N = 5632;
constexpr float RMS_EPS = 1e-6f, L2_EPS = 1e-6f;

constexpr size_t O_YP = 0, O_YS = 16777216, O_CONVP = 17301504, O_DELTAP = 17498112, O_KP = 21692416, O_VP = 22216704,
                 O_CONVS = 22740992, O_DELTAS = 25886720, O_KS = 92995584, O_VS = 93257728, O_END = 93519872;

constexpr size_t MiB = 1u << 20;
constexpr size_t WS_CTL = 0, CTL_ZERO_BYTES = 1 * MiB;
constexpr size_t WS_WIN = 2 * MiB;
constexpr size_t WS_WOUT = 27 * MiB;
constexpr size_t WS_WQKV = 35 * MiB;
constexpr size_t WS_WO = 41 * MiB;
constexpr size_t WS_WGU = 45 * MiB;
constexpr size_t WS_WDOWN = 89 * MiB;
constexpr size_t WS_X = 112 * MiB;
constexpr size_t WS_XB = 178 * MiB;
constexpr size_t WS_SSQ = 211 * MiB;
constexpr size_t WS_BA = 213 * MiB;
constexpr size_t WS_BG = 216 * MiB;
constexpr size_t WS_PROJ = 220 * MiB;
constexpr size_t WS_Q = 220 * MiB;
constexpr size_t WS_KB = 253 * MiB;
constexpr size_t WS_VB = 262 * MiB;
constexpr size_t WS_ATT = 271 * MiB;
constexpr size_t WS_QKV = 418 * MiB;
constexpr size_t WS_DREC = 428 * MiB;
constexpr size_t WS_OG = 716 * MiB;
constexpr size_t WS_ACT = 782 * MiB;
constexpr size_t WS_EGL = 874 * MiB;
constexpr size_t WS_END = 876 * MiB;
constexpr size_t KV_DELTA = (WS_VB - WS_KB) / 2;

constexpr int NWAVES = 8, NTHREADS = 512;
constexpr int LDS_BYTES = 155648;

#define LDS_WAIT() asm volatile("s_waitcnt lgkmcnt(0)" ::: "memory")
__device__ __forceinline__ unsigned f2bf(float f) { unsigned u = __builtin_bit_cast(unsigned, f); return (u + 0x7fffu + ((u >> 16) & 1u)) >> 16; }
__device__ __forceinline__ unsigned pk2(float lo, float hi) { return f2bf(lo) | (f2bf(hi) << 16); }
__device__ __forceinline__ float bf2f(unsigned short b) { return __builtin_bit_cast(float, (unsigned)b << 16); }
__device__ __forceinline__ float bflo(unsigned w) { return __builtin_bit_cast(float, w << 16); }
__device__ __forceinline__ float bfhi(unsigned w) { return __builtin_bit_cast(float, w & 0xffff0000u); }
__device__ __forceinline__ float wave_sum(float v) {
#pragma unroll
    for (int o = 1; o < 64; o <<= 1) v += __shfl_xor(v, o);
    return v;
}
__device__ __forceinline__ float wave_max(float v) {
#pragma unroll
    for (int o = 1; o < 64; o <<= 1) v = fmaxf(v, __shfl_xor(v, o));
    return v;
}
__device__ __forceinline__ float silu_f(float x) { return x / (1.f + __expf(-x)); }
__device__ __forceinline__ float row_rstd(const float* ssq, int row) {
    const f32x4* p = (const f32x4*)(ssq + (size_t)row * 16);
    const f32x4 a = p[0], b = p[1], c = p[2], d = p[3];
    const float s = ((a[0] + a[1]) + (a[2] + a[3])) + ((b[0] + b[1]) + (b[2] + b[3])) + ((c[0] + c[1]) + (c[2] + c[3])) + ((d[0] + d[1]) + (d[2] + d[3]));
    return rsqrtf(s * (1.f / 1024.f) + RMS_EPS);
}

using pg8::Unit; using pg8::cvt_pk_bf16;
struct EpiDnIn {
    static constexpr bool PERM = true, AFTER_DRAIN = false;
    bf16* proj; float* ba; const float* ssq;
    __device__ __forceinline__ void operator()(const f32x4 (&acc)[2][2][4][2], const Unit& u, int wr, int wc, int fr, int fq) const {
        const int row0 = u.pm * 256 + wr * 64 + fr;
        if (u.pn < 24) {
            const int col0 = u.pn * 256 + wc * 32 + 8 * fq;
#pragma unroll
            for (int ai = 0; ai < 2; ++ai)
#pragma unroll
                for (int m = 0; m < 4; ++m) { const int row = row0 + ai * 128 + m * 16; const float rs = row_rstd(ssq, row);
                    bf16* rowp = proj + (size_t)row * PROJ_LD + col0;
#pragma unroll
                    for (int bj = 0; bj < 2; ++bj) { const f32x4 v0 = acc[ai][bj][m][0] * rs, v1 = acc[ai][bj][m][1] * rs;
                        v4u w; w.x = cvt_pk_bf16(v0[0], v0[1]); w.y = cvt_pk_bf16(v0[2], v0[3]); w.z = cvt_pk_bf16(v1[0], v1[1]); w.w = cvt_pk_bf16(v1[2], v1[3]);
                        *(v4u*)(rowp + bj * 128) = w; } }
        } else if (wc == 0) {
#pragma unroll
            for (int ai = 0; ai < 2; ++ai)
#pragma unroll
                for (int m = 0; m < 4; ++m) { const int row = row0 + ai * 128 + m * 16; const float rs = row_rstd(ssq, row);
                    float* o = ba + (size_t)row * 32 + 8 * fq;
                    *(f32x4*)o = acc[ai][0][m][0] * rs; *(f32x4*)(o + 4) = acc[ai][0][m][1] * rs; }
        }
    }
};
struct EpiRes {
    static constexpr bool PERM = false, AFTER_DRAIN = false;
    float* X; bf16* XB; float* ssq; const float* bias;
    __device__ __forceinline__ void operator()(const f32x4 (&acc)[2][2][4][2], const Unit& u, int wr, int wc, int fr, int fq) const {
        const int row0 = u.pm * 256 + wr * 64 + fr, col0 = u.pn * 256 + wc * 32 + 4 * fq;
#pragma unroll
        for (int ai = 0; ai < 2; ++ai)
#pragma unroll
            for (int m = 0; m < 4; ++m) { const int row = row0 + ai * 128 + m * 16; float s = 0.f;
#pragma unroll
                for (int bj = 0; bj < 2; ++bj)
#pragma unroll
                    for (int n = 0; n < 2; ++n) { const int c = col0 + bj * 128 + n * 16; float* xp = X + (size_t)row * DM + c;
                        f32x4 x = *(const f32x4*)xp + acc[ai][bj][m][n];
                        if (bias) x = x + *(const f32x4*)(bias + c);
                        *(f32x4*)xp = x; v2u w; w.x = cvt_pk_bf16(x[0], x[1]); w.y = cvt_pk_bf16(x[2], x[3]);
                        *(v2u*)(XB + (size_t)row * DM + c) = w;
                        s += (x[0] * x[0] + x[1] * x[1]) + (x[2] * x[2] + x[3] * x[3]); }
                s += __shfl_xor(s, 16); s += __shfl_xor(s, 32);
                if (fq == 0) ssq[(size_t)row * 16 + u.pn * 4 + wc] = s; }
    }
};
struct EpiQkv {
    static constexpr bool PERM = true, AFTER_DRAIN = false;
    bf16 *Q, *KB; const float* ssq; const float* bias; float *okp, *oks;
    __device__ __forceinline__ void operator()(const f32x4 (&acc)[2][2][4][2], const Unit& u, int wr, int wc, int fr, int fq) const {
        const int row0 = u.pm * 256 + wr * 64 + fr, cw = wc * 32 + 8 * fq;
        const bool isq = u.pn < 4; const size_t kvsel = (u.pn == 5) ? 1 : 0;
        const float qs = isq ? 0.125f : 1.f;
#pragma unroll
        for (int ai = 0; ai < 2; ++ai)
#pragma unroll
            for (int m = 0; m < 4; ++m) { const int row = row0 + ai * 128 + m * 16; const float rs = row_rstd(ssq, row);
#pragma unroll
                for (int bj = 0; bj < 2; ++bj) { const int colk = bj * 128 + cw, gcol = u.pn * 256 + colk;
                    const f32x4 v0 = (acc[ai][bj][m][0] * rs + *(const f32x4*)(bias + gcol)) * qs, v1 = (acc[ai][bj][m][1] * rs + *(const f32x4*)(bias + gcol + 4)) * qs;
                    v4u w; w.x = cvt_pk_bf16(v0[0], v0[1]); w.y = cvt_pk_bf16(v0[2], v0[3]); w.z = cvt_pk_bf16(v1[0], v1[1]); w.w = cvt_pk_bf16(v1[2], v1[3]);
                    if (isq) *(v4u*)(Q + (size_t)row * DM + gcol) = w;
                    else {
                        *(v4u*)(KB + kvsel * KV_DELTA + (size_t)row * 256 + colk) = w;
                        if (row < TP) { const int b = row >> 11, pos = row & 2047;
                            if (pos >= 1920) { float* o = okp + kvsel * (O_VP - O_KP) + (size_t)(b * 128 + pos - 1920) * 256 + colk; *(f32x4*)o = v0; *(f32x4*)(o + 4) = v1; } }
                        else { float* o = oks + kvsel * (O_VS - O_KS) + (size_t)(row - TP) * 256 + colk; *(f32x4*)o = v0; *(f32x4*)(o + 4) = v1; } } } }
    }
};
struct EpiGu {
    static constexpr bool PERM = true, AFTER_DRAIN = false;
    bf16* act; const float* ssq;
    __device__ __forceinline__ void operator()(const f32x4 (&acc)[2][2][4][2], const Unit& u, int wr, int wc, int fr, int fq) const {
        const int row0 = u.pm * 256 + wr * 64 + fr, col0 = u.pn * 128 + wc * 32 + 8 * fq;
#pragma unroll
        for (int ai = 0; ai < 2; ++ai)
#pragma unroll
            for (int m = 0; m < 4; ++m) { const int row = row0 + ai * 128 + m * 16; const float rs = row_rstd(ssq, row);
                float r[8];
#pragma unroll
                for (int n = 0; n < 2; ++n)
#pragma unroll
                    for (int e = 0; e < 4; ++e) { const float g = acc[ai][0][m][n][e] * rs, uu = acc[ai][1][m][n][e] * rs; r[n * 4 + e] = silu_f(g) * uu; }
                v4u w; w.x = cvt_pk_bf16(r[0], r[1]); w.y = cvt_pk_bf16(r[2], r[3]); w.z = cvt_pk_bf16(r[4], r[5]); w.w = cvt_pk_bf16(r[6], r[7]);
                *(v4u*)(act + (size_t)row * DFF + col0) = w; }
    }
};

struct Args { const float* in[22]; float* out; unsigned char* ws; int ph_lo, ph_hi; };
typedef const __attribute__((address_space(4))) Args* CArgs;
__device__ __forceinline__ CArgs kargs() { CArgs p = (CArgs)__builtin_amdgcn_kernarg_segment_ptr(); asm volatile("" : "+s"(p)); return p; }

__device__ __forceinline__ void tr_item(const float* W, int K, int N, const float* nw, bf16* WT, int dst_row0, LAS float* scr, int k0, int n0, int lane) {
#pragma unroll 8
    for (int i = 0; i < 32; ++i) { const int kk = 2 * i + (lane >> 5); const float s = nw ? nw[k0 + kk] : 1.f;
        scr[kk * 33 + (lane & 31)] = W[(size_t)(k0 + kk) * N + n0 + (lane & 31)] * s; }
    LDS_WAIT(); asm volatile("" ::: "memory");
    const int c = lane & 7;
#pragma unroll
    for (int j = 0; j < 4; ++j) { const int n = (lane >> 3) + 8 * j; const LAS float* s = scr + (8 * c) * 33 + n;
        v4u o; o.x = pk2(s[0 * 33], s[1 * 33]); o.y = pk2(s[2 * 33], s[3 * 33]); o.z = pk2(s[4 * 33], s[5 * 33]); o.w = pk2(s[6 * 33], s[7 * 33]);
        *(v4u*)(WT + (size_t)(dst_row0 + n) * K + k0 + 8 * c) = o; }
    LDS_WAIT(); asm volatile("" ::: "memory");
}
__device__ __forceinline__ void tr_matrix_item(const float* W, int K, int N, const float* nw, bf16* WT, int gu, LAS float* scr, int r, int lane) {
    const int nblk = N / 32, kb = r / nblk, nb = r % nblk, k0 = 64 * kb, n0 = 32 * nb;
    int dr = n0;
    if (gu) dr = (n0 < DFF) ? (n0 / 128) * 256 + (n0 % 128) : ((n0 - DFF) / 128) * 256 + 128 + ((n0 - DFF) % 128);
    tr_item(W, K, N, nw, WT, dr, scr, k0, n0, lane);
}
__device__ __forceinline__ void phase_prologue(CArgs ap, LAS unsigned char* lds) {
    int tid_ = threadIdx.x; asm volatile("" : "+v"(tid_)); const int tid = tid_, lane = tid & 63, wave = __builtin_amdgcn_readfirstlane(tid >> 6);
    LAS float* scr = (LAS float*)(lds + wave * 16384);
    const int gw = blockIdx.x * NWAVES + wave, NGW = gridDim.x * NWAVES;
    unsigned char* ws = ap->ws;
    constexpr int I_IN = 16 * 193, I_OUT = 32 * 32, I_QKV = 16 * 48, I_O = 16 * 32, I_GU = 16 * 176, I_DN = 44 * 32;
    constexpr int NITEMS = 2 * I_IN + 2 * I_OUT + 2 * I_QKV + 2 * I_O + 4 * I_GU + 4 * I_DN;
    for (int it = gw; it < NITEMS; it += NGW) {
        int r = it;
        if (r < 2 * I_IN) { const int j = r / I_IN; r -= j * I_IN;
            tr_matrix_item(ap->in[9] + (size_t)j * DM * DN_IN, DM, DN_IN, ap->in[6] + (2 * j) * DM, (bf16*)(ws + WS_WIN) + (size_t)j * DN_INP * DM, 0, scr, r, lane); continue; }
        r -= 2 * I_IN;
        if (r < 2 * I_OUT) { const int j = r / I_OUT; r -= j * I_OUT;
            tr_matrix_item(ap->in[14] + (size_t)j * VAL_DIM * DM, VAL_DIM, DM, nullptr, (bf16*)(ws + WS_WOUT) + (size_t)j * DM * VAL_DIM, 0, scr, r, lane); continue; }
        r -= 2 * I_OUT;
        if (r < 2 * I_QKV) { const int j = r / I_QKV; r -= j * I_QKV;
            tr_matrix_item(ap->in[15] + (size_t)j * DM * QKV_N, DM, QKV_N, ap->in[6] + (2 * j + 1) * DM, (bf16*)(ws + WS_WQKV) + (size_t)j * QKV_N * DM, 0, scr, r, lane); continue; }
        r -= 2 * I_QKV;
        if (r < 2 * I_O) { const int j = r / I_O; r -= j * I_O;
            tr_matrix_item(ap->in[18] + (size_t)j * DM * DM, DM, DM, nullptr, (bf16*)(ws + WS_WO) + (size_t)j * DM * DM, 0, scr, r, lane); continue; }
        r -= 2 * I_O;
        if (r < 4 * I_GU) { const int i = r / I_GU; r -= i * I_GU;
            tr_matrix_item(ap->in[20] + (size_t)i * DM * GU_N, DM, GU_N, ap->in[7] + i * DM, (bf16*)(ws + WS_WGU) + (size_t)i * GU_N * DM, 1, scr, r, lane); continue; }
        r -= 4 * I_GU;
        { const int i = r / I_DN; r -= i * I_DN;
            tr_matrix_item(ap->in[21] + (size_t)i * DFF * DM, DFF, DM, nullptr, (bf16*)(ws + WS_WDOWN) + (size_t)i * DM * DFF, 0, scr, r, lane); }
    }
    for (int i = blockIdx.x * NTHREADS + tid; i < 2 * 28672; i += gridDim.x * NTHREADS) { const int j = i / 28672, o = i % 28672;
        *(v4u*)((bf16*)(ws + WS_WIN) + (size_t)j * DN_INP * DM + (size_t)DN_IN * DM + (size_t)o * 8) = (v4u){0u, 0u, 0u, 0u}; }
    float* X = (float*)(ws + WS_X); bf16* XB = (bf16*)(ws + WS_XB); float* SSQ = (float*)(ws + WS_SSQ);
    for (int m = gw; m < T; m += NGW) {
        const float* src = (m < TP) ? ap->in[0] + (size_t)m * DM : ap->in[1] + (size_t)(m - TP) * DM;
        float s = 0.f;
#pragma unroll
        for (int j = 0; j < 4; ++j) { const f32x4 v = *((const f32x4*)src + lane + 64 * j);
            *((f32x4*)(X + (size_t)m * DM) + lane + 64 * j) = v;
            v2u w; w.x = pk2(v[0], v[1]); w.y = pk2(v[2], v[3]); *((v2u*)(XB + (size_t)m * DM) + lane + 64 * j) = w;
            s += (v[0] * v[0] + v[1] * v[1]) + (v[2] * v[2] + v[3] * v[3]); }
        s = wave_sum(s);
        if (lane < 16) SSQ[(size_t)m * 16 + lane] = (lane == 0) ? s : 0.f;
    }
}

__device__ __forceinline__ void phase_dn_post(CArgs ap, int j, int tstart) {
    int tid_ = threadIdx.x; asm volatile("" : "+v"(tid_)); const int tid = tid_, lane = tid & 63, wave = __builtin_amdgcn_readfirstlane(tid >> 6);
    const int gw = blockIdx.x * NWAVES + wave, NGW = gridDim.x * NWAVES;
    unsigned char* ws = ap->ws;
    const bf16* PROJ = (const bf16*)(ws + WS_PROJ); const float* BA = (const float*)(ws + WS_BA);
    float* QKV = (float*)(ws + WS_QKV) - (size_t)TP * CONV_DIM; float* BG = (float*)(ws + WS_BG);
    const float* cw = ap->in[10] + (size_t)j * 4 * CONV_DIM;
    const float* sconv = ap->in[2] + (size_t)j * NB_S * 3 * CONV_DIM;
    float* oconvp = ap->out + O_CONVP + (size_t)j * NB_P * 3 * CONV_DIM;
    float* oconvs = ap->out + O_CONVS + (size_t)j * NB_S * 3 * CONV_DIM;
    for (int task = tstart * 32 + gw; task < T * 32; task += NGW) {
        const int t = task >> 5, hc = task & 31, col0 = hc * 128 + 2 * lane;
        const bool prompt = t < TP; const int pos = prompt ? (t & 2047) : ((t - TP) & 3); const int b = prompt ? (t >> 11) : ((t - TP) >> 2);
        float y0 = 0.f, y1 = 0.f, u00 = 0.f, u01 = 0.f;
#pragma unroll
        for (int k = 0; k < 4; ++k) {
            float u0 = 0.f, u1 = 0.f;
            if (pos - k >= 0) { const unsigned w = *(const unsigned*)(PROJ + (size_t)(t - k) * PROJ_LD + col0); u0 = bflo(w); u1 = bfhi(w); }
            else if (!prompt) { const f32x2v v = *(const f32x2v*)(sconv + (size_t)(b * 3 + (3 + pos - k)) * CONV_DIM + col0); u0 = v[0]; u1 = v[1]; }
            const f32x2v wv = *(const f32x2v*)(cw + (size_t)(3 - k) * CONV_DIM + col0);
            y0 += u0 * wv[0]; y1 += u1 * wv[1];
            if (k == 0) { u00 = u0; u01 = u1; }
        }
        y0 = silu_f(y0); y1 = silu_f(y1);
        if (hc < 16) {
            const float ss = wave_sum(y0 * y0 + y1 * y1);
            float inv = rsqrtf(ss + L2_EPS); if (hc < 8) inv *= 0.08838834764831845f;
            y0 *= inv; y1 *= inv;
        }
        *(f32x2v*)(QKV + (size_t)t * CONV_DIM + col0) = (f32x2v){y0, y1};
        if (prompt) { if (pos >= SEQ - 3) *(f32x2v*)(oconvp + (size_t)(b * 3 + pos - (SEQ - 3)) * CONV_DIM + col0) = (f32x2v){u00, u01}; }
        else if (pos >= 1) *(f32x2v*)(oconvs + (size_t)(b * 3 + pos - 1) * CONV_DIM + col0) = (f32x2v){u00, u01};
        if (hc == 0 && lane < 32) {
            const int h = lane & 15; const float v = BA[(size_t)t * 32 + lane];
            float r;
            if (lane < 16) r = 1.f / (1.f + __expf(-v));
            else { const float x = v + ap->in[12][j * 16 + h]; const float sp = (x > 20.f) ? x : log1pf(__expf(x)); r = -__expf(ap->in[11][j * 16 + h]) * sp; }
            BG[(size_t)t * 32 + lane] = r;
        }
    }
}

__device__ __forceinline__ void phase_delta_rec(CArgs ap, int j, LAS unsigned char* lds, int ufirst, int ustride) {
    int tid_ = threadIdx.x; asm volatile("" : "+v"(tid_)); const int tid = tid_, lane = tid & 63, wave = __builtin_amdgcn_readfirstlane(tid >> 6);
    const int e = tid & 127, dq = tid >> 7;
    unsigned char* ws = ap->ws;
    const float* QKV = (const float*)(ws + WS_QKV) - (size_t)TP * CONV_DIM; const float* BG = (const float*)(ws + WS_BG); const bf16* PROJ = (const bf16*)(ws + WS_PROJ);
    bf16* OG = (bf16*)(ws + WS_OG);
    const float* nw = ap->in[13] + j * 128;
    constexpr int NTB = 16;
    LAS float* qs = (LAS float*)lds;
    LAS float* ks = qs + NTB * 128;
    LAS float* vs = ks + NTB * 128;
    LAS float* ob = vs + NTB * 128;
    LAS float* red = ob + NTB * 128;
    LAS float* red2 = red + 512;
    LAS float* ab = red2 + 512;
    for (int unit = ufirst; unit < 128 + 2048; unit += ustride) {
        int b, h, L, t0; const float* s0 = nullptr; float* sout;
        if (unit < 128) { b = unit >> 4; h = unit & 15; L = SEQ; t0 = b * SEQ; sout = ap->out + O_DELTAP + ((size_t)(j * NB_P + b) * 16 + h) * 16384; }
        else { const int su = unit - 128; b = su >> 4; h = su & 15; L = DSEQ; t0 = TP + b * DSEQ;
            s0 = ap->in[3] + ((size_t)(j * NB_S + b) * 16 + h) * 16384; sout = ap->out + O_DELTAS + ((size_t)(j * NB_S + b) * 16 + h) * 16384; }
        const int hq = h >> 1;
        float S[32];
#pragma unroll
        for (int i = 0; i < 32; ++i) S[i] = s0 ? s0[(size_t)(32 * dq + i) * 128 + e] : 0.f;
        for (int tb = 0; tb < L; tb += NTB) {
            const int nb = (L - tb) < NTB ? (L - tb) : NTB;
            __syncthreads();
            for (int i = tid; i < nb * 384; i += NTHREADS) { const int tt = i / 384, rem = i % 384, which = rem >> 7, ee = rem & 127;
                const int col = (which == 0) ? hq * 128 + ee : (which == 1) ? 1024 + hq * 128 + ee : 2048 + h * 128 + ee;
                qs[which * (NTB * 128) + tt * 128 + ee] = QKV[(size_t)(t0 + tb + tt) * CONV_DIM + col]; }
            if (tid < nb) { ab[tid * 2] = __expf(BG[(size_t)(t0 + tb + tid) * 32 + 16 + h]); ab[tid * 2 + 1] = BG[(size_t)(t0 + tb + tid) * 32 + h]; }
            __syncthreads();
            for (int tt = 0; tt < nb; ++tt) {
                const float av = ab[tt * 2], bt = ab[tt * 2 + 1];
                float part = 0.f;
#pragma unroll
                for (int i = 0; i < 32; ++i) part += ks[tt * 128 + 32 * dq + i] * S[i];
                red[dq * 128 + e] = part;
                __syncthreads();
                const float kS = (red[e] + red[128 + e]) + (red[256 + e] + red[384 + e]);
                const float vv = bt * (vs[tt * 128 + e] - av * kS);
                float po = 0.f;
#pragma unroll
                for (int i = 0; i < 32; ++i) { S[i] = av * S[i] + ks[tt * 128 + 32 * dq + i] * vv; po += S[i] * qs[tt * 128 + 32 * dq + i]; }
                red2[dq * 128 + e] = po;
                __syncthreads();
                if (dq == 0) ob[tt * 128 + e] = (red2[e] + red2[128 + e]) + (red2[256 + e] + red2[384 + e]);
            }
            __syncthreads();
            for (int tt = wave; tt < nb; tt += NWAVES) {
                const float o0 = ob[tt * 128 + lane], o1 = ob[tt * 128 + 64 + lane];
                const float ss = wave_sum(o0 * o0 + o1 * o1);
                const float rs = rsqrtf(ss * (1.f / 128.f) + RMS_EPS);
                const size_t tok = (size_t)(t0 + tb + tt);
                const float z0 = bf2f(PROJ[tok * PROJ_LD + 4096 + h * 128 + lane]), z1 = bf2f(PROJ[tok * PROJ_LD + 4096 + h * 128 + 64 + lane]);
                OG[tok * VAL_DIM + h * 128 + lane] = (bf16)f2bf(o0 * rs * nw[lane] * silu_f(z0));
                OG[tok * VAL_DIM + h * 128 + 64 + lane] = (bf16)f2bf(o1 * rs * nw[64 + lane] * silu_f(z1));
            }
        }
#pragma unroll
        for (int i = 0; i < 32; ++i) sout[(size_t)(32 * dq + i) * 128 + e] = S[i];
        __syncthreads();
    }
}

__device__ __forceinline__ void phase_swa_attn(CArgs ap, int j, LAS unsigned char* lds) {
    int tid_ = threadIdx.x; asm volatile("" : "+v"(tid_)); const int tid = tid_, lane = tid & 63, wave = __builtin_amdgcn_readfirstlane(tid >> 6);
    const int gw = blockIdx.x * NWAVES + wave, NGW = gridDim.x * NWAVES;
    unsigned char* ws = ap->ws;
    const bf16* Q = (const bf16*)(ws + WS_Q); const bf16* KB = (const bf16*)(ws + WS_KB); const bf16* VB = (const bf16*)(ws + WS_VB);
    bf16* ATT = (bf16*)(ws + WS_ATT);
    const float* ck = ap->in[4] + (size_t)j * NB_S * 128 * 256; const float* cv = ap->in[5] + (size_t)j * NB_S * 128 * 256;
    const float* sinks = ap->in[17] + j * 16;
    LAS float* qs = (LAS float*)(lds + wave * 4096);
    LAS float* ps = qs + 256;
    for (int task = gw; task < T * 4; task += NGW) {
        const int t = task >> 2, kh = task & 3;
#pragma unroll
        for (int g = 0; g < 4; ++g) qs[g * 64 + lane] = bf2f(Q[(size_t)t * DM + (kh * 4 + g) * 64 + lane]);
        LDS_WAIT(); asm volatile("" ::: "memory");
        const bool prompt = t < TP; int nk, b = 0, l = 0;
        if (prompt) { const int pos = t & 2047; nk = (pos < 128 ? pos : 128) + 1; } else { const int r = t - TP; b = r >> 2; l = r & 3; nk = 129; }
        const float sl0 = exp2f(-0.5f * (float)(kh * 4 + 1)), sl1 = exp2f(-0.5f * (float)(kh * 4 + 2)), sl2 = exp2f(-0.5f * (float)(kh * 4 + 3)), sl3 = exp2f(-0.5f * (float)(kh * 4 + 4));
#pragma unroll 1
        for (int kb = 0; kb < 3; ++kb) {
            const int jj = kb * 64 + lane; const bool valid = jj < nk;
            float d0 = 0.f, d1 = 0.f, d2 = 0.f, d3 = 0.f;
            if (valid) {
                const int cj = l + jj;
                if (prompt || cj >= 128) {
                    const bf16* kp = prompt ? KB + (size_t)(t - (nk - 1) + jj) * 256 + kh * 64 : KB + (size_t)(TP + b * 4 + (cj - 128)) * 256 + kh * 64;
#pragma unroll 1
                    for (int d = 0; d < 64; d += 8) {
                        const v4u w = *(const v4u*)(kp + d);
                        const float kv[8] = {bflo(w.x), bfhi(w.x), bflo(w.y), bfhi(w.y), bflo(w.z), bfhi(w.z), bflo(w.w), bfhi(w.w)};
#pragma unroll
                        for (int i = 0; i < 8; ++i) { d0 += kv[i] * qs[d + i]; d1 += kv[i] * qs[64 + d + i]; d2 += kv[i] * qs[128 + d + i]; d3 += kv[i] * qs[192 + d + i]; }
                    }
                } else {
                    const float* kf = ck + (size_t)(b * 128 + cj) * 256 + kh * 64;
#pragma unroll 1
                    for (int d = 0; d < 64; d += 4) {
                        const f32x4 x = *(const f32x4*)(kf + d);
#pragma unroll
                        for (int i = 0; i < 4; ++i) { d0 += x[i] * qs[d + i]; d1 += x[i] * qs[64 + d + i]; d2 += x[i] * qs[128 + d + i]; d3 += x[i] * qs[192 + d + i]; }
                    }
                }
            }
            const float rel = (float)((nk - 1) - jj);
            const float NEG = -INFINITY;
            ps[jj] = valid ? d0 - sl0 * rel : NEG; ps[192 + jj] = valid ? d1 - sl1 * rel : NEG; ps[384 + jj] = valid ? d2 - sl2 * rel : NEG; ps[576 + jj] = valid ? d3 - sl3 * rel : NEG;
        }
        LDS_WAIT(); asm volatile("" ::: "memory");
#pragma unroll 1
        for (int g = 0; g < 4; ++g) {
            const float sk = sinks[kh * 4 + g];
            const float s0 = ps[g * 192 + lane], s1 = ps[g * 192 + 64 + lane], s2 = ps[g * 192 + 128 + lane];
            float m = wave_max(fmaxf(fmaxf(s0, s1), s2)); m = fmaxf(m, sk);
            const float p0 = __expf(s0 - m), p1 = __expf(s1 - m), p2 = __expf(s2 - m);
            const float den = wave_sum(p0 + p1 + p2) + __expf(sk - m); const float inv = 1.f / den;
            ps[g * 192 + lane] = p0 * inv; ps[g * 192 + 64 + lane] = p1 * inv; ps[g * 192 + 128 + lane] = p2 * inv;
        }
        LDS_WAIT(); asm volatile("" ::: "memory");
        float o0 = 0.f, o1 = 0.f, o2 = 0.f, o3 = 0.f;
        if (prompt) {
            const bf16* vp = VB + (size_t)(t - (nk - 1)) * 256 + kh * 64 + lane;
#pragma unroll 4
            for (int jj = 0; jj < nk; ++jj) { const float vv = bf2f(vp[(size_t)jj * 256]);
                o0 += ps[jj] * vv; o1 += ps[192 + jj] * vv; o2 += ps[384 + jj] * vv; o3 += ps[576 + jj] * vv; }
        } else {
#pragma unroll 4
            for (int jj = 0; jj < 129; ++jj) { const int cj = l + jj;
                const float vv = (cj < 128) ? cv[(size_t)(b * 128 + cj) * 256 + kh * 64 + lane] : bf2f(VB[(size_t)(TP + b * 4 + (cj - 128)) * 256 + kh * 64 + lane]);
                o0 += ps[jj] * vv; o1 += ps[192 + jj] * vv; o2 += ps[384 + jj] * vv; o3 += ps[576 + jj] * vv; }
        }
        bf16* op = ATT + (size_t)t * DM + kh * 256 + lane;
        op[0] = (bf16)f2bf(o0); op[64] = (bf16)f2bf(o1); op[128] = (bf16)f2bf(o2); op[192] = (bf16)f2bf(o3);
        LDS_WAIT(); asm volatile("" ::: "memory");
    }
}

__device__ __forceinline__ void phase_final(CArgs ap) {
    int tid_ = threadIdx.x; asm volatile("" : "+v"(tid_)); const int tid = tid_, lane = tid & 63, wave = __builtin_amdgcn_readfirstlane(tid >> 6);
    const int gw = blockIdx.x * NWAVES + wave, NGW = gridDim.x * NWAVES;
    const float* X = (const float*)(ap->ws + WS_X); const float* nw = ap->in[8];
    for (int m = gw; m < T; m += NGW) {
        f32x4 v[4]; float s = 0.f;
#pragma unroll
        for (int j = 0; j < 4; ++j) { v[j] = *((const f32x4*)(X + (size_t)m * DM) + lane + 64 * j); s += (v[j][0] * v[j][0] + v[j][1] * v[j][1]) + (v[j][2] * v[j][2] + v[j][3] * v[j][3]); }
        const float rs = rsqrtf(wave_sum(s) * (1.f / 1024.f) + RMS_EPS);
        float* o = ap->out + (size_t)m * DM;
#pragma unroll
        for (int j = 0; j < 4; ++j) { const f32x4 w = *((const f32x4*)nw + lane + 64 * j); *((f32x4*)o + lane + 64 * j) = v[j] * rs * w; }
    }
}

constexpr int REC_WNEG = 0, REC_QG = 16384, REC_KGT = 32768, REC_AQK = 49152, REC_U = 57344, REC_BYTES = 73728, REC_STAGE = 57344;
typedef short bf16x8_t __attribute__((ext_vector_type(8)));

__device__ __forceinline__ int swz256(int row, int ch) { return row * 256 + ((ch ^ (row & 15)) << 4); }
__device__ __forceinline__ int swz128(int row, int ch) { return row * 128 + ((ch ^ (row & 7)) << 4); }

__device__ __forceinline__ void phase_dn_prep(CArgs ap, int j, LAS unsigned char* lds) {
    int tid_ = threadIdx.x; asm volatile("" : "+v"(tid_)); const int tid = tid_, lane = tid & 63, wave = __builtin_amdgcn_readfirstlane(tid >> 6);
    const int role = wave >> 1;
    unsigned char* ws0 = ap->ws;
    for (int unit = blockIdx.x; unit < 2048; unit += gridDim.x) {
        const int b = unit >> 8, hq = (unit >> 5) & 7, n = unit & 31, trow0 = b * SEQ + n * 64;
        int cidx = tid & 127; asm volatile("" : "+v"(cidx));
        unsigned char* ws = ws0; asm volatile("" : "+s"(ws));
        const GAS bf16* PROJ = (const GAS bf16*)(ws + WS_PROJ); const GAS float* BA = (const GAS float*)(ws + WS_BA);
        GAS unsigned char* DREC = (GAS unsigned char*)(ws + WS_DREC); GAS float* EGL = (GAS float*)(ws + WS_EGL);
        const GAS float* cw = (const GAS float*)(ap->in[10] + (size_t)j * 4 * CONV_DIM);
        GAS float* oconvp = (GAS float*)(ap->out + O_CONVP + (size_t)j * NB_P * 3 * CONV_DIM);
        unsigned lb0 = 0u, lb1 = 32768u, lb2 = 65536u, lb3 = 98304u; asm volatile("" : "+v"(lb0), "+v"(lb1), "+v"(lb2), "+v"(lb3));
        LAS unsigned char* kb16 = lds + lb0;
        LAS unsigned char* qb16 = lds + lb0 + 16384;
        LAS float* k32 = (LAS float*)(lds + lb1);
        LAS float* bmt = (LAS float*)(lds + lb2);
        LAS float* Gs = (LAS float*)(lds + lb3);
        LAS float* Bs = Gs + 128;
        LAS float* rowss = Bs + 128;
        __syncthreads();
        if (wave < 2) {
            const int h = 2 * hq + wave; const size_t t = (size_t)(trow0 + lane);
            const float bv = BA[t * 32 + h], av = BA[t * 32 + 16 + h];
            const float x = av + ap->in[12][j * 16 + h]; const float sp = (x > 20.f) ? x : log1pf(__expf(x));
            float g = -__expf(ap->in[11][j * 16 + h]) * sp;
#pragma unroll
            for (int off = 1; off < 64; off <<= 1) { const float o = __shfl_up(g, off); if (lane >= off) g += o; }
            Gs[wave * 64 + lane] = g; Bs[wave * 64 + lane] = 1.f / (1.f + __expf(-bv));
        }
        const int col = (role == 0) ? hq * 128 + cidx : (role == 1) ? 1024 + hq * 128 + cidx : 2048 + (2 * hq + role - 2) * 128 + cidx;
        float val[64];
        {
            const float w0 = cw[col], w1 = cw[CONV_DIM + col], w2 = cw[2 * CONV_DIM + col], w3 = cw[3 * CONV_DIM + col];
            const GAS bf16* pp = PROJ + (size_t)trow0 * PROJ_LD + col;
            float um3 = 0.f, um2 = 0.f, um1 = 0.f;
            if (n > 0) { um3 = bf2f(*(pp - 3 * PROJ_LD)); um2 = bf2f(*(pp - 2 * PROJ_LD)); um1 = bf2f(*(pp - PROJ_LD)); }
#pragma unroll
            for (int c = 0; c < 64; ++c) {
                const float uc = bf2f(pp[(size_t)c * PROJ_LD]);
                val[c] = silu_f(w3 * uc + w2 * um1 + w1 * um2 + w0 * um3);
                um3 = um2; um2 = um1; um1 = uc;
                if (c >= 61 && n == 31) oconvp[(size_t)(b * 3 + c - 61) * CONV_DIM + col] = uc;
            }
        }
        if (role < 2) {
#pragma unroll
            for (int c = 0; c < 64; ++c) { const float s = wave_sum(val[c] * val[c]); if (lane == 0) rowss[(role * 2 + (wave & 1)) * 64 + c] = s; }
        }
        __syncthreads();
        if (role == 0) {
            GAS unsigned char* r0 = DREC + (size_t)((b * 16 + 2 * hq) * 32 + n) * REC_BYTES; GAS unsigned char* r1 = r0 + (size_t)32 * REC_BYTES;
            GAS bf16* qg0 = (GAS bf16*)(r0 + REC_QG); GAS bf16* qg1 = (GAS bf16*)(r1 + REC_QG);
#pragma unroll
            for (int c = 0; c < 64; ++c) {
                const float inv = rsqrtf(rowss[c] + rowss[64 + c] + L2_EPS) * 0.08838834764831845f;
                const float q = val[c] * inv;
                *(LAS bf16*)(qb16 + swz256(c, cidx >> 3) + (cidx & 7) * 2) = (bf16)f2bf(q);
                qg0[c * 128 + cidx] = (bf16)f2bf(q * __expf(Gs[c])); qg1[c * 128 + cidx] = (bf16)f2bf(q * __expf(Gs[64 + c]));
            }
        } else if (role == 1) {
            GAS unsigned char* r0 = DREC + (size_t)((b * 16 + 2 * hq) * 32 + n) * REC_BYTES; GAS unsigned char* r1 = r0 + (size_t)32 * REC_BYTES;
            const float gl0 = Gs[63], gl1 = Gs[127];
#pragma unroll
            for (int c = 0; c < 64; ++c) {
                const float inv = rsqrtf(rowss[128 + c] + rowss[192 + c] + L2_EPS);
                val[c] *= inv;
                *(LAS bf16*)(kb16 + swz256(c, cidx >> 3) + (cidx & 7) * 2) = (bf16)f2bf(val[c]);
                k32[c * 128 + cidx] = val[c];
            }
#pragma unroll
            for (int c8 = 0; c8 < 8; ++c8) {
                v4u w0, w1;
                w0.x = pk2(val[c8 * 8 + 0] * __expf(gl0 - Gs[c8 * 8 + 0]), val[c8 * 8 + 1] * __expf(gl0 - Gs[c8 * 8 + 1]));
                w0.y = pk2(val[c8 * 8 + 2] * __expf(gl0 - Gs[c8 * 8 + 2]), val[c8 * 8 + 3] * __expf(gl0 - Gs[c8 * 8 + 3]));
                w0.z = pk2(val[c8 * 8 + 4] * __expf(gl0 - Gs[c8 * 8 + 4]), val[c8 * 8 + 5] * __expf(gl0 - Gs[c8 * 8 + 5]));
                w0.w = pk2(val[c8 * 8 + 6] * __expf(gl0 - Gs[c8 * 8 + 6]), val[c8 * 8 + 7] * __expf(gl0 - Gs[c8 * 8 + 7]));
                w1.x = pk2(val[c8 * 8 + 0] * __expf(gl1 - Gs[64 + c8 * 8 + 0]), val[c8 * 8 + 1] * __expf(gl1 - Gs[64 + c8 * 8 + 1]));
                w1.y = pk2(val[c8 * 8 + 2] * __expf(gl1 - Gs[64 + c8 * 8 + 2]), val[c8 * 8 + 3] * __expf(gl1 - Gs[64 + c8 * 8 + 3]));
                w1.z = pk2(val[c8 * 8 + 4] * __expf(gl1 - Gs[64 + c8 * 8 + 4]), val[c8 * 8 + 5] * __expf(gl1 - Gs[64 + c8 * 8 + 5]));
                w1.w = pk2(val[c8 * 8 + 6] * __expf(gl1 - Gs[64 + c8 * 8 + 6]), val[c8 * 8 + 7] * __expf(gl1 - Gs[64 + c8 * 8 + 7]));
                *(GAS v4u*)(r0 + REC_KGT + cidx * 128 + c8 * 16) = w0; *(GAS v4u*)(r1 + REC_KGT + cidx * 128 + c8 * 16) = w1;
            }
            if (cidx == 0) { EGL[(b * 16 + 2 * hq) * 32 + n] = __expf(gl0); EGL[(b * 16 + 2 * hq + 1) * 32 + n] = __expf(gl1); }
        } else {
            const int hh = role - 2;
#pragma unroll
            for (int c = 0; c < 64; ++c) val[c] *= Bs[hh * 64 + c];
        }
        __syncthreads();
        {
            const int prod = wave >> 2, tr = wave & 3, fr = lane & 15, fq = lane >> 4;
            f32x4 acc[4];
#pragma unroll
            for (int tc = 0; tc < 4; ++tc) acc[tc] = (f32x4){0.f, 0.f, 0.f, 0.f};
            LAS unsigned char* bsrc = prod ? qb16 : kb16;
#pragma unroll
            for (int ks = 0; ks < 4; ++ks) {
                const bf16x8_t af = *(LAS bf16x8_t*)(kb16 + swz256(16 * tr + fr, ks * 4 + fq));
#pragma unroll
                for (int tc = 0; tc < 4; ++tc) { const bf16x8_t bfr = *(LAS bf16x8_t*)(bsrc + swz256(16 * tc + fr, ks * 4 + fq));
                    acc[tc] = __builtin_amdgcn_mfma_f32_16x16x32_bf16(af, bfr, acc[tc], 0, 0, 0); }
            }
            const int i0 = 16 * tr + 4 * fq;
#pragma unroll
            for (int hh = 0; hh < 2; ++hh) {
                GAS unsigned char* rec = DREC + (size_t)((b * 16 + 2 * hq + hh) * 32 + n) * REC_BYTES;
#pragma unroll
                for (int tc = 0; tc < 4; ++tc) { const int jc = 16 * tc + fr; const float gj = Gs[hh * 64 + jc];
                    float o[4];
#pragma unroll
                    for (int r = 0; r < 4; ++r) { const int i = i0 + r; const float gi = Gs[hh * 64 + i];
                        if (prod == 0) o[r] = (i > jc) ? Bs[hh * 64 + i] * acc[tc][r] * __expf(gi - gj) : 0.f;
                        else o[r] = (jc >= i) ? acc[tc][r] * __expf(gj - gi) : 0.f; }
                    if (prod == 0) *(LAS f32x4*)(bmt + hh * 4096 + jc * 64 + i0) = (f32x4){o[0], o[1], o[2], o[3]};
                    else { v2u w; w.x = pk2(o[0], o[1]); w.y = pk2(o[2], o[3]); *(GAS v2u*)(rec + REC_AQK + jc * 128 + i0 * 2) = w; } }
            }
        }
        __syncthreads();
        {
            const int hh = (role >= 2) ? role - 2 : role;
            if (role == 0) {
#pragma unroll
                for (int c = 0; c < 64; ++c) val[c] = k32[c * 128 + cidx] * Bs[c] * __expf(Gs[c]);
            } else if (role == 1) {
#pragma unroll
                for (int c = 0; c < 64; ++c) val[c] = val[c] * Bs[64 + c] * __expf(Gs[64 + c]);
            }
            const LAS float* bm = bmt + hh * 4096;
#pragma unroll
            for (int s = 0; s < 63; ++s) {
                const float xs = val[s];
#pragma unroll
                for (int cg = (s + 1) / 4; cg < 16; ++cg) { const f32x4 m = *(const LAS f32x4*)(bm + s * 64 + cg * 4);
#pragma unroll
                    for (int e = 0; e < 4; ++e) { const int c = cg * 4 + e; if (c > s) val[c] -= m[e] * xs; } }
            }
            GAS unsigned char* rec = DREC + (size_t)((b * 16 + 2 * hq + hh) * 32 + n) * REC_BYTES;
            if (role >= 2) { GAS bf16* U = (GAS bf16*)(rec + REC_U);
#pragma unroll
                for (int c = 0; c < 64; ++c) U[c * 128 + cidx] = (bf16)f2bf(val[c]);
            } else { GAS bf16* W = (GAS bf16*)(rec + REC_WNEG);
#pragma unroll
                for (int c = 0; c < 64; ++c) W[c * 128 + cidx] = (bf16)f2bf(-val[c]);
            }
        }
    }
    phase_dn_post(ap, j, TP);
}

constexpr int SC_STAGE0 = 0, SC_STAGE1 = REC_STAGE, SC_SCR = 2 * REC_STAGE, SC_RED = SC_SCR + 8 * 4096;
__device__ __forceinline__ int stage_dst(int q) {
    const int off = q * 16;
    if (off < REC_KGT) { const int base = off & ~16383, local = off & 16383; return base + swz256(local >> 8, (local >> 4) & 15); }
    const int base = (off < REC_AQK) ? REC_KGT : REC_AQK, local = off - base; return base + swz128(local >> 7, (local >> 4) & 7);
}
__device__ __forceinline__ void scan_unit(CArgs ap, int j, int unit, LAS unsigned char* lds) {
    int tid_ = threadIdx.x; asm volatile("" : "+v"(tid_)); const int tid = tid_, lane = tid & 63, wave = __builtin_amdgcn_readfirstlane(tid >> 6);
    const int fr = lane & 15, fq = lane >> 4, e0 = 16 * wave;
    const int b = unit >> 4, h = unit & 15;
    unsigned char* ws = ap->ws;
    const unsigned char* rec0 = ws + WS_DREC + (size_t)(unit * 32) * REC_BYTES;
    const float* EGL = (const float*)(ws + WS_EGL) + unit * 32;
    const bf16* PROJ = (const bf16*)(ws + WS_PROJ); bf16* OG = (bf16*)(ws + WS_OG);
    const float* nw = ap->in[13] + j * 128;
    LAS unsigned char* scr = lds + SC_SCR + wave * 4096;
    LAS float* red = (LAS float*)(lds + SC_RED);
    f32x4 Sacc[8];
#pragma unroll
    for (int dt = 0; dt < 8; ++dt) Sacc[dt] = (f32x4){0.f, 0.f, 0.f, 0.f};
    const f32x4 nwv = *(const f32x4*)(nw + e0 + 4 * fq);
    __syncthreads();
#pragma unroll
    for (int i = 0; i < 7; ++i) { const int q = tid + 512 * i; *(LAS v4u*)(lds + SC_STAGE0 + stage_dst(q)) = *(const v4u*)(rec0 + (size_t)q * 16); }
#pragma unroll 1
    for (int n = 0; n < 32; ++n) {
        LAS unsigned char* sb = lds + ((n & 1) ? SC_STAGE1 : SC_STAGE0);
        LAS unsigned char* sbn = lds + ((n & 1) ? SC_STAGE0 : SC_STAGE1);
        const unsigned char* rec = rec0 + (size_t)n * REC_BYTES;
        __syncthreads();
        v4u pre[7];
        if (n + 1 < 32) {
#pragma unroll
            for (int i = 0; i < 7; ++i) pre[i] = *(const v4u*)(rec + REC_BYTES + (size_t)(tid + 512 * i) * 16);
        }
        f32x4 accu[4];
#pragma unroll
        for (int tc = 0; tc < 4; ++tc) { const v2u w = *(const v2u*)(rec + REC_U + (size_t)(16 * tc + fr) * 256 + (e0 + 4 * fq) * 2);
            accu[tc] = (f32x4){bflo(w.x), bfhi(w.x), bflo(w.y), bfhi(w.y)}; }
        const float egl = EGL[n];
#pragma unroll
        for (int dt = 0; dt < 8; ++dt)
#pragma unroll
            for (int r = 0; r < 4; ++r) { const int el = 4 * fq + r, d = 16 * dt + fr;
                *(LAS bf16*)(scr + swz256(el, d >> 3) + (d & 7) * 2) = (bf16)f2bf(Sacc[dt][r]); }
        bf16x8_t Sa[4];
#pragma unroll
        for (int ks = 0; ks < 4; ++ks) Sa[ks] = *(LAS bf16x8_t*)(scr + swz256(fr, ks * 4 + fq));
#pragma unroll
        for (int tc = 0; tc < 4; ++tc)
#pragma unroll
            for (int ks = 0; ks < 4; ++ks) { const bf16x8_t bw = *(LAS bf16x8_t*)(sb + REC_WNEG + swz256(16 * tc + fr, ks * 4 + fq));
                accu[tc] = __builtin_amdgcn_mfma_f32_16x16x32_bf16(Sa[ks], bw, accu[tc], 0, 0, 0); }
#pragma unroll
        for (int tc = 0; tc < 4; ++tc)
#pragma unroll
            for (int r = 0; r < 4; ++r) { const int el = 4 * fq + r, c = 16 * tc + fr;
                *(LAS bf16*)(scr + swz128(el, c >> 3) + (c & 7) * 2) = (bf16)f2bf(accu[tc][r]); }
        bf16x8_t Ua[2];
#pragma unroll
        for (int k2 = 0; k2 < 2; ++k2) Ua[k2] = *(LAS bf16x8_t*)(scr + swz128(fr, k2 * 4 + fq));
        f32x4 acco[4];
#pragma unroll
        for (int tc = 0; tc < 4; ++tc) { acco[tc] = (f32x4){0.f, 0.f, 0.f, 0.f};
#pragma unroll
            for (int ks = 0; ks < 4; ++ks) { const bf16x8_t bq = *(LAS bf16x8_t*)(sb + REC_QG + swz256(16 * tc + fr, ks * 4 + fq));
                acco[tc] = __builtin_amdgcn_mfma_f32_16x16x32_bf16(Sa[ks], bq, acco[tc], 0, 0, 0); }
#pragma unroll
            for (int k2 = 0; k2 < 2; ++k2) { const bf16x8_t ba = *(LAS bf16x8_t*)(sb + REC_AQK + swz128(16 * tc + fr, k2 * 4 + fq));
                acco[tc] = __builtin_amdgcn_mfma_f32_16x16x32_bf16(Ua[k2], ba, acco[tc], 0, 0, 0); } }
#pragma unroll
        for (int dt = 0; dt < 8; ++dt) { Sacc[dt] = Sacc[dt] * egl;
#pragma unroll
            for (int k2 = 0; k2 < 2; ++k2) { const bf16x8_t bk = *(LAS bf16x8_t*)(sb + REC_KGT + swz128(16 * dt + fr, k2 * 4 + fq));
                Sacc[dt] = __builtin_amdgcn_mfma_f32_16x16x32_bf16(Ua[k2], bk, Sacc[dt], 0, 0, 0); } }
#pragma unroll
        for (int tc = 0; tc < 4; ++tc) { float p = (acco[tc][0] * acco[tc][0] + acco[tc][1] * acco[tc][1]) + (acco[tc][2] * acco[tc][2] + acco[tc][3] * acco[tc][3]);
            p += __shfl_xor(p, 16); p += __shfl_xor(p, 32);
            if (fq == 0) red[wave * 64 + 16 * tc + fr] = p; }
        __syncthreads();
#pragma unroll
        for (int tc = 0; tc < 4; ++tc) { const int c = 16 * tc + fr; float tot = 0.f;
#pragma unroll
            for (int w8 = 0; w8 < 8; ++w8) tot += red[w8 * 64 + c];
            const float rs = rsqrtf(tot * (1.f / 128.f) + RMS_EPS);
            const size_t tok = (size_t)(b * SEQ + n * 64 + c);
            const v2u zw = *(const v2u*)(PROJ + tok * PROJ_LD + 4096 + h * 128 + e0 + 4 * fq);
            const float z0 = bflo(zw.x), z1 = bfhi(zw.x), z2 = bflo(zw.y), z3 = bfhi(zw.y);
            v2u ow; ow.x = pk2(acco[tc][0] * rs * nwv[0] * silu_f(z0), acco[tc][1] * rs * nwv[1] * silu_f(z1));
            ow.y = pk2(acco[tc][2] * rs * nwv[2] * silu_f(z2), acco[tc][3] * rs * nwv[3] * silu_f(z3));
            *(v2u*)(OG + tok * VAL_DIM + h * 128 + e0 + 4 * fq) = ow; }
        if (n + 1 < 32) {
#pragma unroll
            for (int i = 0; i < 7; ++i) *(LAS v4u*)(sbn + stage_dst(tid + 512 * i)) = pre[i];
        }
    }
    float* sout = ap->out + O_DELTAP + ((size_t)(j * NB_P + b) * 16 + h) * 16384;
#pragma unroll
    for (int dt = 0; dt < 8; ++dt) *(f32x4*)(sout + (size_t)(16 * dt + fr) * 128 + e0 + 4 * fq) = Sacc[dt];
}
__device__ __forceinline__ void phase_dn_scan(CArgs ap, int j, LAS unsigned char* lds) {
    const int G = gridDim.x, half = G >> 1;
    if ((int)blockIdx.x < half) { for (int unit = blockIdx.x; unit < 128; unit += half) scan_unit(ap, j, unit, lds); }
    else phase_delta_rec(ap, j, lds, 128 + (int)blockIdx.x - half, G - half);
}

constexpr int AT_K = 0, AT_V = 32768, AT_VROW = 528;
__device__ __forceinline__ void attn_qtile(LAS unsigned char* Kl, LAS unsigned char* Vl, int kt0, const bf16* qptr, bf16* optr, int lo, int hi, float slope, float sink, int fr, int fq) {
    const bf16x8_t qb0 = *(const bf16x8_t*)qptr, qb1 = *(const bf16x8_t*)(qptr + 32);
    f32x4 acc[9];
#pragma unroll
    for (int i = 0; i < 9; ++i) {
        const bf16x8_t k0 = *(LAS bf16x8_t*)(Kl + swz128(16 * (kt0 + i) + fr, fq)), k1 = *(LAS bf16x8_t*)(Kl + swz128(16 * (kt0 + i) + fr, 4 + fq));
        acc[i] = __builtin_amdgcn_mfma_f32_16x16x32_bf16(k0, qb0, (f32x4){0.f, 0.f, 0.f, 0.f}, 0, 0, 0);
        acc[i] = __builtin_amdgcn_mfma_f32_16x16x32_bf16(k1, qb1, acc[i], 0, 0, 0);
    }
    float m = sink;
#pragma unroll
    for (int i = 0; i < 9; ++i)
#pragma unroll
        for (int r = 0; r < 4; ++r) { const int kc = 16 * (kt0 + i) + 4 * fq + r; const bool valid = (kc >= lo) && (kc <= hi);
            const float s = valid ? acc[i][r] - slope * (float)(hi - kc) : -INFINITY; acc[i][r] = s; m = fmaxf(m, s); }
    m = fmaxf(m, __shfl_xor(m, 16)); m = fmaxf(m, __shfl_xor(m, 32));
    float sum = 0.f;
#pragma unroll
    for (int i = 0; i < 9; ++i)
#pragma unroll
        for (int r = 0; r < 4; ++r) { const float p = __expf(acc[i][r] - m); acc[i][r] = p; sum += p; }
    sum += __shfl_xor(sum, 16); sum += __shfl_xor(sum, 32);
    const float inv = 1.f / (sum + __expf(sink - m));
    f32x4 o[4];
#pragma unroll
    for (int dt = 0; dt < 4; ++dt) o[dt] = (f32x4){0.f, 0.f, 0.f, 0.f};
#pragma unroll
    for (int i2 = 0; i2 < 5; ++i2) {
        const int ia = 2 * i2, ib = 2 * i2 + 1;
        v4u pw; pw.x = pk2(acc[ia][0], acc[ia][1]); pw.y = pk2(acc[ia][2], acc[ia][3]);
        if (ib < 9) { pw.z = pk2(acc[ib < 9 ? ib : 8][0], acc[ib < 9 ? ib : 8][1]); pw.w = pk2(acc[ib < 9 ? ib : 8][2], acc[ib < 9 ? ib : 8][3]); } else { pw.z = 0u; pw.w = 0u; }
        const bf16x8_t pf = __builtin_bit_cast(bf16x8_t, pw);
        const int kta = kt0 + ia; int ktb = kt0 + ib; ktb = ktb > 15 ? 15 : ktb;
#pragma unroll
        for (int dt = 0; dt < 4; ++dt) {
            const v2u va = *(LAS v2u*)(Vl + (16 * dt + fr) * AT_VROW + (16 * kta + 4 * fq) * 2), vb = *(LAS v2u*)(Vl + (16 * dt + fr) * AT_VROW + (16 * ktb + 4 * fq) * 2);
            const v4u vw = (v4u){va.x, va.y, vb.x, vb.y};
            o[dt] = __builtin_amdgcn_mfma_f32_16x16x32_bf16(__builtin_bit_cast(bf16x8_t, vw), pf, o[dt], 0, 0, 0);
        }
    }
#pragma unroll
    for (int dt = 0; dt < 4; ++dt) { v2u w; w.x = pk2(o[dt][0] * inv, o[dt][1] * inv); w.y = pk2(o[dt][2] * inv, o[dt][3] * inv); *(v2u*)(optr + 16 * dt) = w; }
}

__device__ __forceinline__ void phase_swa_attn_mfma(CArgs ap, int j, LAS unsigned char* lds) {
    int tid_ = threadIdx.x; asm volatile("" : "+v"(tid_)); const int tid = tid_, lane = tid & 63, wave = __builtin_amdgcn_readfirstlane(tid >> 6);
    const int fr = lane & 15, fq = lane >> 4;
    unsigned char* ws = ap->ws;
    const bf16* Q = (const bf16*)(ws + WS_Q); const bf16* KB = (const bf16*)(ws + WS_KB); const bf16* VB = (const bf16*)(ws + WS_VB);
    bf16* ATT = (bf16*)(ws + WS_ATT);
    const float* ck = ap->in[4] + (size_t)j * NB_S * 128 * 256; const float* cv = ap->in[5] + (size_t)j * NB_S * 128 * 256;
    const float* sinks = ap->in[17] + j * 16;
    LAS unsigned char* Kl = lds + AT_K; LAS unsigned char* Vl = lds + AT_V;
    for (int unit = blockIdx.x; unit < 1024; unit += gridDim.x) {
        __syncthreads();
        if (unit < 512) {
            const int b = unit >> 6, nb = (unit >> 2) & 15, kh = unit & 3;
            const int trow0 = b * SEQ + nb * 128 - 128;
#pragma unroll
            for (int it = 0; it < 4; ++it) { const int q = tid + 512 * it;
                { const int key = q >> 3, ch = q & 7; v4u w = (v4u){0u, 0u, 0u, 0u};
                  if (nb > 0 || key >= 128) w = *(const v4u*)(KB + (size_t)(trow0 + key) * 256 + kh * 64 + ch * 8);
                  *(LAS v4u*)(Kl + swz128(key, ch)) = w; }
                { const int key = q & 255, dc = q >> 8; v4u w = (v4u){0u, 0u, 0u, 0u};
                  if (nb > 0 || key >= 128) w = *(const v4u*)(VB + (size_t)(trow0 + key) * 256 + kh * 64 + dc * 8);
                  LAS bf16* vp = (LAS bf16*)(Vl + (8 * dc) * AT_VROW + key * 2);
                  vp[0 * (AT_VROW / 2)] = (bf16)(w.x & 0xffff); vp[1 * (AT_VROW / 2)] = (bf16)(w.x >> 16); vp[2 * (AT_VROW / 2)] = (bf16)(w.y & 0xffff); vp[3 * (AT_VROW / 2)] = (bf16)(w.y >> 16);
                  vp[4 * (AT_VROW / 2)] = (bf16)(w.z & 0xffff); vp[5 * (AT_VROW / 2)] = (bf16)(w.z >> 16); vp[6 * (AT_VROW / 2)] = (bf16)(w.w & 0xffff); vp[7 * (AT_VROW / 2)] = (bf16)(w.w >> 16); }
            }
            __syncthreads();
            const int g = wave >> 1, qh = wave & 1, head = kh * 4 + g;
            const float slope = exp2f(-0.5f * (float)(head + 1)), sink = sinks[head];
#pragma unroll 1
            for (int qt = 0; qt < 4; ++qt) {
                const int o = 64 * qh + 16 * qt, qi = o + fr;
                const size_t tq = (size_t)(b * SEQ + nb * 128 + qi);
                attn_qtile(Kl, Vl, 4 * qh + qt, Q + tq * DM + head * 64 + 8 * fq, ATT + tq * DM + head * 64 + 4 * fq, (nb == 0 && qi < 128) ? 128 : qi, 128 + qi, slope, sink, fr, fq);
            }
        } else {
            const int su = unit - 512, b = su >> 2, kh = su & 3;
            for (int q = tid; q < 1280; q += 512) {
                { const int key = q >> 3, ch = q & 7; v4u w = (v4u){0u, 0u, 0u, 0u};
                  if (key < 128) { const float* p = ck + (size_t)(b * 128 + key) * 256 + kh * 64 + ch * 8; const f32x4 x0 = *(const f32x4*)p, x1 = *(const f32x4*)(p + 4);
                      w.x = pk2(x0[0], x0[1]); w.y = pk2(x0[2], x0[3]); w.z = pk2(x1[0], x1[1]); w.w = pk2(x1[2], x1[3]); }
                  else if (key < 132) w = *(const v4u*)(KB + (size_t)(TP + b * 4 + key - 128) * 256 + kh * 64 + ch * 8);
                  *(LAS v4u*)(Kl + swz128(key, ch)) = w; }
                { const int key = q % 160, dc = q / 160; v4u w = (v4u){0u, 0u, 0u, 0u};
                  if (key < 128) { const float* p = cv + (size_t)(b * 128 + key) * 256 + kh * 64 + dc * 8; const f32x4 x0 = *(const f32x4*)p, x1 = *(const f32x4*)(p + 4);
                      w.x = pk2(x0[0], x0[1]); w.y = pk2(x0[2], x0[3]); w.z = pk2(x1[0], x1[1]); w.w = pk2(x1[2], x1[3]); }
                  else if (key < 132) w = *(const v4u*)(VB + (size_t)(TP + b * 4 + key - 128) * 256 + kh * 64 + dc * 8);
                  LAS bf16* vp = (LAS bf16*)(Vl + (8 * dc) * AT_VROW + key * 2);
                  vp[0 * (AT_VROW / 2)] = (bf16)(w.x & 0xffff); vp[1 * (AT_VROW / 2)] = (bf16)(w.x >> 16); vp[2 * (AT_VROW / 2)] = (bf16)(w.y & 0xffff); vp[3 * (AT_VROW / 2)] = (bf16)(w.y >> 16);
                  vp[4 * (AT_VROW / 2)] = (bf16)(w.z & 0xffff); vp[5 * (AT_VROW / 2)] = (bf16)(w.z >> 16); vp[6 * (AT_VROW / 2)] = (bf16)(w.w & 0xffff); vp[7 * (AT_VROW / 2)] = (bf16)(w.w >> 16); }
            }
            __syncthreads();
            if (wave == 0) {
                const int tok = fr & 3, g = fr >> 2, head = kh * 4 + g;
                const float slope = exp2f(-0.5f * (float)(head + 1)), sink = sinks[head];
                const size_t tq = (size_t)(TP + b * 4 + tok);
                attn_qtile(Kl, Vl, 0, Q + tq * DM + head * 64 + 8 * fq, ATT + tq * DM + head * 64 + 4 * fq, tok, 128 + tok, slope, sink, fr, fq);
            }
        }
    }
}

#define XB_TMO      128
#define XB_XCNT(j)  (256  + 64 * (j))
#define XB_XSUB(j)  (1280 + 64 * (j))
#define XB_XGEN(j)  (2304 + 64 * (j))
#define XB_TOP      3328
#define XB_TOPGEN   3392
#define XCD_BAR_WORDS 3456
#define XB_SPIN_CAP (1u << 18)

__device__ __forceinline__ unsigned xb_ld(unsigned* p)              { return __hip_atomic_load(p, __ATOMIC_RELAXED, __HIP_MEMORY_SCOPE_AGENT); }
__device__ __forceinline__ unsigned xb_add(unsigned* p, unsigned v) { return __hip_atomic_fetch_add(p, v, __ATOMIC_RELAXED, __HIP_MEMORY_SCOPE_AGENT); }
__device__ __forceinline__ unsigned xb_xcc_id() { return (unsigned)__builtin_amdgcn_s_getreg((3 << 11) | 20) & 0xFu; }
#define XB_SPIN(cond, bar) do { unsigned _sp = 0; while (cond) { __builtin_amdgcn_s_sleep(1); \
    if ((++_sp & 255u) == 0u) { if (xb_ld(&(bar)[XB_TMO])) break; if (_sp > XB_SPIN_CAP) { atomicAdd(&(bar)[XB_TMO], 1u); break; } } } } while (0)

struct XcdBarrier {
    unsigned* bar; unsigned x;
    volatile LAS unsigned* st;
};

__device__ __forceinline__ XcdBarrier xcd_barrier_post(unsigned* bar, volatile LAS unsigned* st) {
    XcdBarrier b; b.bar = bar; b.x = xb_xcc_id(); b.st = st;
    if (threadIdx.x == 0) (void)xb_add(&bar[XB_XCNT(b.x)], 1u);
    return b;
}
__device__ __forceinline__ void xcd_barrier_complete(unsigned* bar, unsigned x, unsigned& nloc, unsigned& nx) {
    const unsigned G = gridDim.x * gridDim.y * gridDim.z;
    unsigned sum, cnt, mine, sp = 0u;
    for (;;) {
        sum = 0u; cnt = 0u; mine = 0u;
#pragma unroll
        for (unsigned j = 0; j < 16; ++j) { const unsigned c = xb_ld(&bar[XB_XCNT(j)]); sum += c; cnt += (c > 0u) ? 1u : 0u; mine = (j == x) ? c : mine; }
        if (sum == G) break;
        __builtin_amdgcn_s_sleep(1);
        if ((++sp & 255u) == 0u) { if (xb_ld(&bar[XB_TMO])) break; if (sp > XB_SPIN_CAP) { atomicAdd(&bar[XB_TMO], 1u); break; } }
    }
    nloc = mine > 0u ? mine : 1u; nx = cnt > 0u ? cnt : 1u;
}

__device__ __forceinline__ void xcd_barrier(const XcdBarrier& b) {
    asm volatile("s_waitcnt vmcnt(0)" ::: "memory");
    __syncthreads();
    if (threadIdx.x == 0) {
        unsigned* bar = b.bar;
        __builtin_amdgcn_s_waitcnt(0);
        unsigned nloc = b.st[0], nx = b.st[1];
        if (nloc == 0u) { xcd_barrier_complete(bar, b.x, nloc, nx); b.st[0] = nloc; b.st[1] = nx; }
        const unsigned old = xb_add(&bar[XB_XSUB(b.x)], 1u);
        const unsigned gen = old / nloc;
        if (old + 1u == (gen + 1u) * nloc) {
            __builtin_amdgcn_fence(__ATOMIC_RELEASE, "agent");
            asm volatile("s_waitcnt vmcnt(0)" ::: "memory");
            const unsigned og = xb_add(&bar[XB_TOP], 1u);
            const unsigned tg = og / nx;
            if (og + 1u == (tg + 1u) * nx) xb_add(&bar[XB_TOPGEN], 1u);
            else XB_SPIN(xb_ld(&bar[XB_TOPGEN]) == tg, bar);
            __builtin_amdgcn_fence(__ATOMIC_ACQUIRE, "agent");
            xb_add(&bar[XB_XGEN(b.x)], 1u);
            asm volatile("s_waitcnt vmcnt(0)" ::: "memory");
        } else {
            XB_SPIN(xb_ld(&bar[XB_XGEN(b.x)]) == gen, bar);
            __builtin_amdgcn_fence(__ATOMIC_ACQUIRE, "agent");
            asm volatile("s_waitcnt vmcnt(0)" ::: "memory");
        }
    }
    __syncthreads();
}

constexpr int CW_BAR = 4096;
constexpr int MISC_OFF = 151552;

#ifndef REP_PREP
#define REP_PREP 1
#endif
#ifndef REP_SCAN
#define REP_SCAN 1
#endif
#ifndef REP_ATTN
#define REP_ATTN 1
#endif
#ifndef REP_GIN
#define REP_GIN 1
#endif
#ifndef REP_GGU
#define REP_GGU 1
#endif
#ifndef REP_GQKV
#define REP_GQKV 1
#endif
template <class Epi>
__device__ __forceinline__ void run_gemm(LAS unsigned char* lds, const bf16* A, const bf16* Bt, int N, int K, const Epi& E) {
    pg8::Gemm g{A, Bt, T, N, K}; pg8::StaticOrder S; S.init(T, N, (int)gridDim.x, (int)blockIdx.x);
    pg8::gemm_phase<Epi, pg8::StaticOrder, true, true>(lds, g, S, E);
}

__global__ void __launch_bounds__(NTHREADS, 2) mk_fwd(Args a) {
    extern __shared__ __attribute__((aligned(16))) unsigned char lds_raw[];
    LAS unsigned char* lds = (LAS unsigned char*)lds_raw;
    unsigned char* ws = kargs()->ws;
    for (int u = threadIdx.x; u < (LDS_BYTES - MISC_OFF) / 4; u += NTHREADS) ((LAS unsigned*)(lds + MISC_OFF))[u] = 0u;
    __syncthreads();
    (void)xcd_barrier_post((unsigned*)(ws + WS_CTL) + CW_BAR, (volatile LAS unsigned*)(lds + MISC_OFF));
#define GRID_BAR() do { XcdBarrier b_; b_.bar = (unsigned*)(kargs()->ws + WS_CTL) + CW_BAR; b_.x = xb_xcc_id(); b_.st = (volatile LAS unsigned*)(lds + MISC_OFF); xcd_barrier(b_); } while (0)
    float* X = (float*)(ws + WS_X); bf16* XB = (bf16*)(ws + WS_XB); float* SSQ = (float*)(ws + WS_SSQ);

    phase_prologue(kargs(), lds);
    GRID_BAR();
#pragma unroll 1
    for (int li = 0; li < 4; ++li) {
        const int j = li >> 1;
        if ((li & 1) == 0) {
            for (int rep = 0; rep < REP_GIN; ++rep) { EpiDnIn E{(bf16*)(ws + WS_PROJ), (float*)(ws + WS_BA), SSQ};
              run_gemm(lds, XB, (const bf16*)(ws + WS_WIN) + (size_t)j * DN_INP * DM, DN_INP, DM, E);
            GRID_BAR(); }
            for (int rep = 0; rep < REP_PREP; ++rep) { phase_dn_prep(kargs(), j, lds);
            GRID_BAR(); }
            for (int rep = 0; rep < REP_SCAN; ++rep) { phase_dn_scan(kargs(), j, lds);
            GRID_BAR(); }
            { EpiRes E{X, XB, SSQ, nullptr};
              run_gemm(lds, (const bf16*)(ws + WS_OG), (const bf16*)(ws + WS_WOUT) + (size_t)j * DM * VAL_DIM, DM, VAL_DIM, E); }
            GRID_BAR();
        } else {
            { EpiQkv E{(bf16*)(ws + WS_Q), (bf16*)(ws + WS_KB), SSQ, kargs()->in[16] + j * QKV_N,
                       kargs()->out + O_KP + (size_t)j * NB_P * 128 * 256, kargs()->out + O_KS + (size_t)j * NB_S * 4 * 256};
              run_gemm(lds, XB, (const bf16*)(ws + WS_WQKV) + (size_t)j * QKV_N * DM, QKV_N, DM, E); }
            GRID_BAR();
            for (int rep = 0; rep < REP_ATTN; ++rep) { phase_swa_attn_mfma(kargs(), j, lds);
            GRID_BAR(); }
            { EpiRes E{X, XB, SSQ, kargs()->in[19] + j * DM};
              run_gemm(lds, (const bf16*)(ws + WS_ATT), (const bf16*)(ws + WS_WO) + (size_t)j * DM * DM, DM, DM, E); }
            GRID_BAR();
        }
        for (int rep = 0; rep < REP_GGU; ++rep) { EpiGu E{(bf16*)(ws + WS_ACT), SSQ};
          run_gemm(lds, XB, (const bf16*)(ws + WS_WGU) + (size_t)li * GU_N * DM, GU_N, DM, E);
        GRID_BAR(); }
        { EpiRes E{X, XB, SSQ, nullptr};
          run_gemm(lds, (const bf16*)(ws + WS_ACT), (const bf16*)(ws + WS_WDOWN) + (size_t)li * DM * DFF, DM, DFF, E); }
        GRID_BAR();
    }
    phase_final(kargs());
}

extern "C" void kernel_launch(void* const* d_in, const int* in_sizes, int n_in, void* d_out, int out_size, void* d_ws, size_t ws_size, hipStream_t stream) {
    static int grid = 0;
    if (grid == 0) {
        if (n_in != 22 || (size_t)out_size != O_END || ws_size < WS_END) { fprintf(stderr, "kernel_launch: unexpected shapes: n_in %d out %d ws %zu\n", n_in, out_size, ws_size); grid = -1; return; }
        int dev = 0, cus = 0, per_cu = 0;
        if (hipGetDevice(&dev) != hipSuccess || hipDeviceGetAttribute(&cus, hipDeviceAttributeMultiprocessorCount, dev) != hipSuccess) { grid = -1; return; }
        if (hipFuncSetAttribute((const void*)mk_fwd, hipFuncAttributeMaxDynamicSharedMemorySize, LDS_BYTES) != hipSuccess) { fprintf(stderr, "kernel_launch: hipFuncSetAttribute failed\n"); grid = -1; return; }
        if (hipOccupancyMaxActiveBlocksPerMultiprocessor(&per_cu, (const void*)mk_fwd, NTHREADS, LDS_BYTES) != hipSuccess || per_cu < 1) { fprintf(stderr, "kernel_launch: occupancy query reports %d blocks per CU\n", per_cu); (void)hipGetLastError(); }
        grid = cus;
    }
    if (grid < 0) return;
    (void)hipMemsetAsync((char*)d_ws + WS_CTL, 0, CTL_ZERO_BYTES, stream);
    Args a{};
    for (int i = 0; i < 22; ++i) a.in[i] = (const float*)d_in[i];
    a.out = (float*)d_out; a.ws = (unsigned char*)d_ws;
    hipLaunchKernelGGL(mk_fwd, dim3(grid), dim3(NTHREADS), LDS_BYTES, stream, a);
}
```

```cpp
#include <hip/hip_runtime.h>
#include <cstdio>
#include <cstdint>
namespace pg8 {
#define PG8_LAS __attribute__((address_space(3)))
typedef unsigned short bf16_t;
typedef short bf16x8 __attribute__((ext_vector_type(8)));
typedef float f32x4 __attribute__((ext_vector_type(4)));
typedef unsigned u32x4 __attribute__((ext_vector_type(4)));
constexpr int BM = 256, BK = 64, HALF = 128, HTB = HALF * BK * 2  , STAGE_BYTES = 8 * HTB, NXCD = 8, WGM = 8;

__host__ __device__ __forceinline__ int lds_byte(int r, int c) { const int st = (r >> 4) * 2 + (c >> 5), rr = r & 15, cc = c & 31, ob = rr * 64 + cc * 2; return st * 1024 + (ob ^ (((ob >> 9) & 1) << 5)); }
__host__ __device__ __forceinline__ void stage_rc(int b, int& R, int& C) { const int st = b / 1024, sb = b % 1024, swz = sb ^ (((sb >> 9) & 1) << 5); R = (st >> 1) * 16 + swz / 64; C = (st & 1) * 32 + (swz % 64) / 2; }
__host__ __device__ __forceinline__ int perm32(int rho) { const int n = rho >> 4, i = rho & 15; return 8 * (i >> 2) + 4 * n + (i & 3); }

struct Unit { int pm, pn; };
struct Gemm { const bf16_t* A; const bf16_t* Bt; int M, N, K; };

struct StaticOrder {
    int nM, nN, nwg, G, c;
    __host__ __device__ void init(int M, int N, int G_, int c_) { nM = M / BM; nN = N / BM; nwg = nM * nN; G = G_; c = c_; }
    __host__ __device__ bool next(int i, Unit& u) const {
        const long L = (long)i * G + c; if (L >= nwg) return false;
        int wgid = (int)L; { const int q = nwg / NXCD, r = nwg % NXCD, xcd = wgid % NXCD, off = wgid / NXCD; wgid = (xcd < r ? xcd * (q + 1) : r * (q + 1) + (xcd - r) * q) + off; }
        const int nig = WGM * nN, gid = wgid / nig, fm = gid * WGM, gsz = (nM - fm) < WGM ? (nM - fm) : WGM;
        u.pm = fm + ((wgid % nig) % gsz); u.pn = (wgid % nig) / gsz; return true;
    }
    __device__ __forceinline__ void a_ready(const Unit&) const {}
    __device__ __forceinline__ void done(const Unit&) const {}
};
__device__ __forceinline__ unsigned cvt_pk_bf16(float lo, float hi) { unsigned r; asm volatile("v_cvt_pk_bf16_f32 %0, %1, %2" : "=v"(r) : "v"(lo), "v"(hi)); return r; }
typedef float f32x2 __attribute__((ext_vector_type(2)));
template <class Epi, class Sched, bool ALIGN_EPI = false, bool SP2 = false>
__device__ __forceinline__ void gemm_phase(PG8_LAS unsigned char* lds, const Gemm g, const Sched& S, const Epi& E) {
    int tid_ = threadIdx.x; asm volatile("" : "+v"(tid_)); const int tid = tid_, wid = __builtin_amdgcn_readfirstlane(tid >> 6), lane = tid & 63, wr = wid >> 2, wc = wid & 3, fr = lane & 15, fq = lane >> 4;
    const int K = g.K, nt = K / BK;
    unsigned voffA[2], voffB[2];
#pragma unroll
    for (int i = 0; i < 2; ++i) { int R, C; stage_rc(tid * 16 + i * 8192, R, C); const int Rb = Epi::PERM ? ((R & ~31) + perm32(R & 31)) : R;
        voffA[i] = (unsigned)(R * K + C) * 2u; voffB[i] = (unsigned)(Rb * K + C) * 2u; }
    const size_t kstep = (size_t)(BK * 2);
    const size_t hstep = (size_t)HALF * K * 2;
    const size_t tstep = 2 * hstep;
    const unsigned ldsw = (unsigned)wid * 1024u;
    const int aoff = lds_byte(wr * 64 + fr, fq * 8), boff = lds_byte(wc * 32 + fr, fq * 8);
#define PG8_SA(b, h) (((b) * 2 + (h)) * HTB)
#define PG8_SB(b, h) ((4 + (b) * 2 + (h)) * HTB)
#define PG8_STAGE(bufoff, gbase, voff) do { _Pragma("unroll") for (int _i = 0; _i < 2; ++_i) \
        __builtin_amdgcn_global_load_lds((const unsigned*)((const char*)(gbase) + (voff)[_i]), (PG8_LAS unsigned*)(lds + (bufoff) + ldsw + _i * 8192), 16, 0, 0); } while (0)
#define PG8_LDA(dst, b, h) do { _Pragma("unroll") for (int m = 0; m < 4; ++m) _Pragma("unroll") for (int k = 0; k < 2; ++k) dst[m][k] = *(const PG8_LAS bf16x8*)(lds + PG8_SA(b, h) + aoff + m * 2048 + k * 1024); } while (0)
#define PG8_LDB(dst, b, h) do { _Pragma("unroll") for (int n = 0; n < 2; ++n) _Pragma("unroll") for (int k = 0; k < 2; ++k) dst[n][k] = *(const PG8_LAS bf16x8*)(lds + PG8_SB(b, h) + boff + n * 2048 + k * 1024); } while (0)
#define PG8_MMA(ai, bj, At, Bt) do { __builtin_amdgcn_s_setprio(1); _Pragma("unroll") for (int m = 0; m < 4; ++m) _Pragma("unroll") for (int n = 0; n < 2; ++n) _Pragma("unroll") for (int k = 0; k < 2; ++k) \
        acc[ai][bj][m][n] = __builtin_amdgcn_mfma_f32_16x16x32_bf16(Bt[n][k], At[m][k], acc[ai][bj][m][n], 0, 0, 0); __builtin_amdgcn_s_setprio(0); } while (0)
#define PG8_WAIT_V(n) asm volatile("s_waitcnt vmcnt(" #n ")" ::: "memory")
#define PG8_WAIT_L(n) asm volatile("s_waitcnt lgkmcnt(" #n ")" ::: "memory")
#define PG8_BAR __builtin_amdgcn_s_barrier()
#define PG8_SCHED __builtin_amdgcn_sched_barrier(0)
    Unit cur, nxt; int ui = 0;
    if (!S.next(0, cur)) return;
    f32x4 acc[2][2][4][2];
#pragma unroll
    for (int a = 0; a < 2; ++a)
#pragma unroll
        for (int b = 0; b < 2; ++b)
#pragma unroll
            for (int m = 0; m < 4; ++m)
#pragma unroll
                for (int n = 0; n < 2; ++n) acc[a][b][m][n] = (f32x4){0.f, 0.f, 0.f, 0.f};
    bf16x8 At[4][2], B0[2][2], B1[2][2];
    const char* cA = (const char*)g.A + (size_t)cur.pm * tstep; const char* cB = (const char*)g.Bt + (size_t)cur.pn * tstep;
    S.a_ready(cur);
    if constexpr (SP2) {
        PG8_STAGE(PG8_SB(0, 0), cB, voffB); PG8_STAGE(PG8_SB(0, 1), cB + hstep, voffB); PG8_STAGE(PG8_SA(0, 0), cA, voffA); PG8_STAGE(PG8_SA(0, 1), cA + hstep, voffA);
        if (wr == 1) PG8_BAR;
        PG8_WAIT_V(2); PG8_BAR;
        PG8_STAGE(PG8_SB(1, 0), cB + kstep, voffB); PG8_STAGE(PG8_SA(1, 0), cA + kstep, voffA); PG8_STAGE(PG8_SB(1, 1), cB + hstep + kstep, voffB);
        PG8_WAIT_V(6); PG8_BAR;
    } else {
        PG8_STAGE(PG8_SB(0, 0), cB, voffB); PG8_STAGE(PG8_SA(0, 0), cA, voffA); PG8_STAGE(PG8_SB(0, 1), cB + hstep, voffB); PG8_STAGE(PG8_SA(0, 1), cA + hstep, voffA);
        if (wr == 1) PG8_BAR;
        PG8_WAIT_V(4); PG8_BAR;
        PG8_STAGE(PG8_SB(1, 0), cB + kstep, voffB); PG8_STAGE(PG8_SA(1, 0), cA + kstep, voffA); PG8_STAGE(PG8_SB(1, 1), cB + hstep + kstep, voffB);
        PG8_WAIT_V(6); PG8_BAR;
    }
    for (;;) {
        const bool has_next = S.next(ui + 1, nxt);
        const char* nA = has_next ? (const char*)g.A + (size_t)nxt.pm * tstep : cA; const char* nB = has_next ? (const char*)g.Bt + (size_t)nxt.pn * tstep : cB;
        for (int t = 0; t < nt; t += 2) {
            const bool last = (t == nt - 2);
            const char* a1 = cA + (size_t)(t + 1) * kstep;
            const char* a2 = last ? nA : cA + (size_t)(t + 2) * kstep; const char* b2 = last ? nB : cB + (size_t)(t + 2) * kstep;
            const char* a3 = a2 + kstep; const char* b3 = b2 + kstep;
            if (last && has_next) S.a_ready(nxt);
            if constexpr (SP2) {
            PG8_LDB(B0, 0, 0); PG8_LDB(B1, 0, 1); PG8_SCHED; PG8_LDA(At, 0, 0); PG8_STAGE(PG8_SA(1, 1), a1 + hstep, voffA);
            PG8_WAIT_V(8); PG8_WAIT_L(0); PG8_BAR; PG8_MMA(0, 0, At, B0); PG8_MMA(0, 1, At, B1); PG8_BAR; PG8_SCHED;
            PG8_LDA(At, 0, 1); PG8_STAGE(PG8_SB(0, 0), b2, voffB); PG8_STAGE(PG8_SB(0, 1), b2 + hstep, voffB); PG8_STAGE(PG8_SA(0, 0), a2, voffA);
            PG8_WAIT_V(8); PG8_WAIT_L(0); PG8_BAR; PG8_MMA(1, 0, At, B0); PG8_MMA(1, 1, At, B1); PG8_BAR; PG8_SCHED;
            PG8_LDB(B0, 1, 0); PG8_LDB(B1, 1, 1); PG8_SCHED; PG8_LDA(At, 1, 0); PG8_STAGE(PG8_SA(0, 1), a2 + hstep, voffA);
            PG8_WAIT_V(8); PG8_WAIT_L(0); PG8_BAR; PG8_MMA(0, 0, At, B0); PG8_MMA(0, 1, At, B1); PG8_BAR; PG8_SCHED;
            PG8_LDA(At, 1, 1); PG8_STAGE(PG8_SB(1, 0), b3, voffB); PG8_STAGE(PG8_SB(1, 1), b3 + hstep, voffB); PG8_STAGE(PG8_SA(1, 0), a3, voffA);
            PG8_WAIT_V(8); PG8_WAIT_L(0); PG8_BAR; PG8_MMA(1, 0, At, B0); PG8_MMA(1, 1, At, B1); PG8_BAR; PG8_SCHED;
            } else {
            PG8_LDB(B0, 0, 0); PG8_SCHED; PG8_LDA(At, 0, 0); PG8_STAGE(PG8_SA(1, 1), a1 + hstep, voffA);
            PG8_WAIT_L(8); PG8_BAR; PG8_WAIT_L(0); PG8_MMA(0, 0, At, B0); PG8_BAR; PG8_SCHED;
            PG8_LDB(B1, 0, 1); PG8_STAGE(PG8_SB(0, 0), b2, voffB);
            PG8_BAR; PG8_WAIT_L(0); PG8_MMA(0, 1, At, B1); PG8_BAR;
            PG8_LDA(At, 0, 1); PG8_STAGE(PG8_SA(0, 0), a2, voffA);
            PG8_BAR; PG8_WAIT_L(0); PG8_MMA(1, 0, At, B0); PG8_BAR; PG8_SCHED;
            PG8_STAGE(PG8_SB(0, 1), b2 + hstep, voffB);
            PG8_WAIT_V(6); PG8_BAR; PG8_MMA(1, 1, At, B1); PG8_BAR;
            PG8_LDB(B0, 1, 0); PG8_SCHED; PG8_LDA(At, 1, 0); PG8_STAGE(PG8_SA(0, 1), a2 + hstep, voffA);
            PG8_WAIT_L(8); PG8_BAR; PG8_WAIT_L(0); PG8_MMA(0, 0, At, B0); PG8_BAR; PG8_SCHED;
            PG8_LDB(B1, 1, 1); PG8_STAGE(PG8_SB(1, 0), b3, voffB);
            PG8_BAR; PG8_WAIT_L(0); PG8_MMA(0, 1, At, B1); PG8_BAR;
            PG8_LDA(At, 1, 1); PG8_STAGE(PG8_SA(1, 0), a3, voffA);
            PG8_BAR; PG8_WAIT_L(0); PG8_MMA(1, 0, At, B0); PG8_BAR; PG8_SCHED;
            PG8_STAGE(PG8_SB(1, 1), b3 + hstep, voffB);
            PG8_WAIT_V(6); PG8_BAR; PG8_MMA(1, 1, At, B1); PG8_BAR;
            }
        }
        if constexpr (ALIGN_EPI) { if (wr == 0) PG8_BAR; }
        if constexpr (!Epi::AFTER_DRAIN) { E(acc, cur, wr, wc, fr, fq); S.done(cur); }
        if (!has_next) break;
#pragma unroll
        for (int a = 0; a < 2; ++a)
#pragma unroll
            for (int b = 0; b < 2; ++b)
#pragma unroll
                for (int m = 0; m < 4; ++m)
#pragma unroll
                    for (int n = 0; n < 2; ++n) acc[a][b][m][n] = (f32x4){0.f, 0.f, 0.f, 0.f};
        cur = nxt; cA = nA; cB = nB; ++ui;
        if constexpr (ALIGN_EPI) { if (wr == 1) PG8_BAR; }
    }
    PG8_WAIT_V(0);
    if constexpr (!ALIGN_EPI) { if (wr == 0) PG8_BAR; }
    PG8_BAR;
    if constexpr (Epi::AFTER_DRAIN) { E.fused(acc, cur, wr, wc, fr, fq, lds, wid, lane); S.done(cur); }
#undef PG8_SA
#undef PG8_SB
#undef PG8_STAGE
#undef PG8_LDA
#undef PG8_LDB
#undef PG8_MMA
#undef PG8_WAIT_V
#undef PG8_WAIT_L
#undef PG8_BAR
#undef PG8_SCHED
}
}

#define GAS __attribute__((address_space(1)))
#define LAS __attribute__((address_space(3)))
typedef unsigned short bf16;
typedef unsigned v4u __attribute__((ext_vector_type(4)));
typedef unsigned v2u __attribute__((ext_vector_type(2)));
typedef float f32x4 __attribute__((ext_vector_type(4)));
typedef float f32x2v __attribute__((ext_vector_type(2)));

constexpr int DM = 1024, NB_P = 8, SEQ = 2048, NB_S = 128, DSEQ = 4;
constexpr int TP = NB_P * SEQ, TS = NB_S * DSEQ, T = TP + TS;
constexpr int DN_IN = 6176, DN_INP = 6400, PROJ_LD = 6144, CONV_DIM = 4096, VAL_DIM = 2048;
constexpr int QKV_N = 1536, DFF = 2816, GU_N = 5632;
constexpr float RMS_EPS = 1e-6f, L2_EPS = 1e-6f;

constexpr size_t O_YP = 0, O_YS = 16777216, O_CONVP = 17301504, O_DELTAP = 17498112, O_KP = 21692416, O_VP = 22216704,
                 O_CONVS = 22740992, O_DELTAS = 25886720, O_KS = 92995584, O_VS = 93257728, O_END = 93519872;

constexpr size_t MiB = 1u << 20;
constexpr size_t WS_CTL = 0, CTL_ZERO_BYTES = 1 * MiB;
constexpr size_t WS_WIN = 2 * MiB;
constexpr size_t WS_WOUT = 27 * MiB;
constexpr size_t WS_WQKV = 35 * MiB;
constexpr size_t WS_WO = 41 * MiB;
constexpr size_t WS_WGU = 45 * MiB;
constexpr size_t WS_WDOWN = 89 * MiB;
constexpr size_t WS_X = 112 * MiB;
constexpr size_t WS_XB = 178 * MiB;
constexpr size_t WS_SSQ = 211 * MiB;
constexpr size_t WS_BA = 213 * MiB;
constexpr size_t WS_BG = 216 * MiB;
constexpr size_t WS_PROJ = 220 * MiB;
constexpr size_t WS_Q = 220 * MiB;
constexpr size_t WS_KB = 253 * MiB;
constexpr size_t WS_VB = 262 * MiB;
constexpr size_t WS_ATT = 271 * MiB;
constexpr size_t WS_QKV = 418 * MiB;
constexpr size_t WS_DREC = 428 * MiB;
constexpr size_t WS_OG = 716 * MiB;
constexpr size_t WS_ACT = 782 * MiB;
constexpr size_t WS_EGL = 874 * MiB;
constexpr size_t WS_END = 876 * MiB;
constexpr size_t KV_DELTA = (WS_VB - WS_KB) / 2;

constexpr int CW_TICKET = 65536;
constexpr int NWAVES = 8, NTHREADS = 512;
constexpr int LDS_BYTES = 155648;

#define LDS_WAIT() asm volatile("s_waitcnt lgkmcnt(0)" ::: "memory")
__device__ __forceinline__ unsigned f2bf(float f) { unsigned u = __builtin_bit_cast(unsigned, f); return (u + 0x7fffu + ((u >> 16) & 1u)) >> 16; }
__device__ __forceinline__ unsigned pk2(float lo, float hi) { return f2bf(lo) | (f2bf(hi) << 16); }
__device__ __forceinline__ float bf2f(unsigned short b) { return __builtin_bit_cast(float, (unsigned)b << 16); }
__device__ __forceinline__ float bflo(unsigned w) { return __builtin_bit_cast(float, w << 16); }
__device__ __forceinline__ float bfhi(unsigned w) { return __builtin_bit_cast(float, w & 0xffff0000u); }
__device__ __forceinline__ float wave_sum(float v) {
#pragma unroll
    for (int o = 1; o < 64; o <<= 1) v += __shfl_xor(v, o);
    return v;
}
__device__ __forceinline__ float wave_max(float v) {
#pragma unroll
    for (int o = 1; o < 64; o <<= 1) v = fmaxf(v, __shfl_xor(v, o));
    return v;
}
__device__ __forceinline__ float silu_f(float x) { return x / (1.f + __expf(-x)); }
__device__ __forceinline__ float row_rstd(const float* ssq, int row) {
    const f32x4* p = (const f32x4*)(ssq + (size_t)row * 16);
    const f32x4 a = p[0], b = p[1], c = p[2], d = p[3];
    const float s = ((a[0] + a[1]) + (a[2] + a[3])) + ((b[0] + b[1]) + (b[2] + b[3])) + ((c[0] + c[1]) + (c[2] + c[3])) + ((d[0] + d[1]) + (d[2] + d[3]));
    return rsqrtf(s * (1.f / 1024.f) + RMS_EPS);
}

using pg8::Unit; using pg8::cvt_pk_bf16;
struct EpiDnIn {
    static constexpr bool PERM = true, AFTER_DRAIN = false;
    bf16* proj; float* ba; const float* ssq;
    __device__ __forceinline__ void operator()(const f32x4 (&acc)[2][2][4][2], const Unit& u, int wr, int wc, int fr, int fq) const {
        const int row0 = u.pm * 256 + wr * 64 + fr;
        if (u.pn < 24) {
            const int col0 = u.pn * 256 + wc * 32 + 8 * fq;
#pragma unroll
            for (int ai = 0; ai < 2; ++ai)
#pragma unroll
                for (int m = 0; m < 4; ++m) { const int row = row0 + ai * 128 + m * 16; const float rs = row_rstd(ssq, row);
                    bf16* rowp = proj + (size_t)row * PROJ_LD + col0;
#pragma unroll
                    for (int bj = 0; bj < 2; ++bj) { const f32x4 v0 = acc[ai][bj][m][0] * rs, v1 = acc[ai][bj][m][1] * rs;
                        v4u w; w.x = cvt_pk_bf16(v0[0], v0[1]); w.y = cvt_pk_bf16(v0[2], v0[3]); w.z = cvt_pk_bf16(v1[0], v1[1]); w.w = cvt_pk_bf16(v1[2], v1[3]);
                        *(v4u*)(rowp + bj * 128) = w; } }
        } else if (wc == 0) {
#pragma unroll
            for (int ai = 0; ai < 2; ++ai)
#pragma unroll
                for (int m = 0; m < 4; ++m) { const int row = row0 + ai * 128 + m * 16; const float rs = row_rstd(ssq, row);
                    float* o = ba + (size_t)row * 32 + 8 * fq;
                    *(f32x4*)o = acc[ai][0][m][0] * rs; *(f32x4*)(o + 4) = acc[ai][0][m][1] * rs; }
        }
    }
};
struct EpiRes {
    static constexpr bool PERM = false, AFTER_DRAIN = false;
    bf16* XB; float* ssq; const float* bias;
    __device__ __forceinline__ void operator()(const f32x4 (&acc)[2][2][4][2], const Unit& u, int wr, int wc, int fr, int fq) const {
        const int row0 = u.pm * 256 + wr * 64 + fr, col0 = u.pn * 256 + wc * 32 + 4 * fq;
#pragma unroll
        for (int ai = 0; ai < 2; ++ai)
#pragma unroll
            for (int m = 0; m < 4; ++m) { const int row = row0 + ai * 128 + m * 16; float s = 0.f;
#pragma unroll
                for (int bj = 0; bj < 2; ++bj)
#pragma unroll
                    for (int n = 0; n < 2; ++n) { const int c = col0 + bj * 128 + n * 16; bf16* xp = XB + (size_t)row * DM + c;
                        const v2u xo = *(const v2u*)xp;
                        f32x4 x = (f32x4){bflo(xo.x), bfhi(xo.x), bflo(xo.y), bfhi(xo.y)} + acc[ai][bj][m][n];
                        if (bias) x = x + *(const f32x4*)(bias + c);
                        v2u w; w.x = cvt_pk_bf16(x[0], x[1]); w.y = cvt_pk_bf16(x[2], x[3]);
                        *(v2u*)xp = w;
                        const float r0 = bflo(w.x), r1 = bfhi(w.x), r2 = bflo(w.y), r3 = bfhi(w.y);
                        s += (r0 * r0 + r1 * r1) + (r2 * r2 + r3 * r3); }
                s += __shfl_xor(s, 16); s += __shfl_xor(s, 32);
                if (fq == 0) ssq[(size_t)row * 16 + u.pn * 4 + wc] = s; }
    }
};
struct EpiQkv {
    static constexpr bool PERM = true, AFTER_DRAIN = false;
    bf16 *Q, *KB; const float* ssq; const float* bias; float *okp, *oks;
    __device__ __forceinline__ void operator()(const f32x4 (&acc)[2][2][4][2], const Unit& u, int wr, int wc, int fr, int fq) const {
        const int row0 = u.pm * 256 + wr * 64 + fr, cw = wc * 32 + 8 * fq;
        const bool isq = u.pn < 4; const size_t kvsel = (u.pn == 5) ? 1 : 0;
        const float qs = isq ? 0.125f : 1.f;
#pragma unroll
        for (int ai = 0; ai < 2; ++ai)
#pragma unroll
            for (int m = 0; m < 4; ++m) { const int row = row0 + ai * 128 + m * 16; const float rs = row_rstd(ssq, row);
#pragma unroll
                for (int bj = 0; bj < 2; ++bj) { const int colk = bj * 128 + cw, gcol = u.pn * 256 + colk;
                    const f32x4 v0 = (acc[ai][bj][m][0] * rs + *(const f32x4*)(bias + gcol)) * qs, v1 = (acc[ai][bj][m][1] * rs + *(const f32x4*)(bias + gcol + 4)) * qs;
                    v4u w; w.x = cvt_pk_bf16(v0[0], v0[1]); w.y = cvt_pk_bf16(v0[2], v0[3]); w.z = cvt_pk_bf16(v1[0], v1[1]); w.w = cvt_pk_bf16(v1[2], v1[3]);
                    if (isq) *(v4u*)(Q + (size_t)row * DM + gcol) = w;
                    else {
                        *(v4u*)(KB + kvsel * KV_DELTA + (size_t)row * 256 + colk) = w;
                        if (row < TP) { const int b = row >> 11, pos = row & 2047;
                            if (pos >= 1920) { float* o = okp + kvsel * (O_VP - O_KP) + (size_t)(b * 128 + pos - 1920) * 256 + colk; *(f32x4*)o = v0; *(f32x4*)(o + 4) = v1; } }
                        else { float* o = oks + kvsel * (O_VS - O_KS) + (size_t)(row - TP) * 256 + colk; *(f32x4*)o = v0; *(f32x4*)(o + 4) = v1; } } } }
    }
};
struct EpiGu {
    static constexpr bool PERM = true, AFTER_DRAIN = false;
    bf16* act; const float* ssq;
    __device__ __forceinline__ void operator()(const f32x4 (&acc)[2][2][4][2], const Unit& u, int wr, int wc, int fr, int fq) const {
        const int row0 = u.pm * 256 + wr * 64 + fr, col0 = u.pn * 128 + wc * 32 + 8 * fq;
#pragma unroll
        for (int ai = 0; ai < 2; ++ai)
#pragma unroll
            for (int m = 0; m < 4; ++m) { const int row = row0 + ai * 128 + m * 16; const float rs = row_rstd(ssq, row);
                float r[8];
#pragma unroll
                for (int n = 0; n < 2; ++n)
#pragma unroll
                    for (int e = 0; e < 4; ++e) { const float g = acc[ai][0][m][n][e] * rs, uu = acc[ai][1][m][n][e] * rs; r[n * 4 + e] = silu_f(g) * uu; }
                v4u w; w.x = cvt_pk_bf16(r[0], r[1]); w.y = cvt_pk_bf16(r[2], r[3]); w.z = cvt_pk_bf16(r[4], r[5]); w.w = cvt_pk_bf16(r[6], r[7]);
                *(v4u*)(act + (size_t)row * DFF + col0) = w; }
    }
};

struct Args { const float* in[22]; float* out; unsigned char* ws; int ph_lo, ph_hi; };
typedef const __attribute__((address_space(4))) Args* CArgs;
__device__ __forceinline__ CArgs kargs() { CArgs p = (CArgs)__builtin_amdgcn_kernarg_segment_ptr(); asm volatile("" : "+s"(p)); return p; }

__device__ __forceinline__ void tr_item(const float* W, int K, int N, const float* nw, bf16* WT, int dst_row0, LAS float* scr, int k0, int n0, int lane) {
#pragma unroll 8
    for (int i = 0; i < 32; ++i) { const int kk = 2 * i + (lane >> 5); const float s = nw ? nw[k0 + kk] : 1.f;
        scr[kk * 33 + (lane & 31)] = W[(size_t)(k0 + kk) * N + n0 + (lane & 31)] * s; }
    LDS_WAIT(); asm volatile("" ::: "memory");
    const int c = lane & 7;
#pragma unroll
    for (int j = 0; j < 4; ++j) { const int n = (lane >> 3) + 8 * j; const LAS float* s = scr + (8 * c) * 33 + n;
        v4u o; o.x = pk2(s[0 * 33], s[1 * 33]); o.y = pk2(s[2 * 33], s[3 * 33]); o.z = pk2(s[4 * 33], s[5 * 33]); o.w = pk2(s[6 * 33], s[7 * 33]);
        *(v4u*)(WT + (size_t)(dst_row0 + n) * K + k0 + 8 * c) = o; }
    LDS_WAIT(); asm volatile("" ::: "memory");
}
__device__ __forceinline__ void tr_matrix_item(const float* W, int K, int N, const float* nw, bf16* WT, int gu, LAS float* scr, int r, int lane) {
    const int nblk = N / 32, kb = r / nblk, nb = r % nblk, k0 = 64 * kb, n0 = 32 * nb;
    int dr = n0;
    if (gu) dr = (n0 < DFF) ? (n0 / 128) * 256 + (n0 % 128) : ((n0 - DFF) / 128) * 256 + 128 + ((n0 - DFF) % 128);
    tr_item(W, K, N, nw, WT, dr, scr, k0, n0, lane);
}
__device__ __forceinline__ void phase_prologue(CArgs ap, LAS unsigned char* lds) {
    int tid_ = threadIdx.x; asm volatile("" : "+v"(tid_)); const int tid = tid_, lane = tid & 63, wave = __builtin_amdgcn_readfirstlane(tid >> 6);
    LAS float* scr = (LAS float*)(lds + wave * 16384);
    const int gw = blockIdx.x * NWAVES + wave, NGW = gridDim.x * NWAVES;
    unsigned char* ws = ap->ws;
    constexpr int I_IN = 16 * 193, I_OUT = 32 * 32, I_QKV = 16 * 48, I_O = 16 * 32, I_GU = 16 * 176, I_DN = 44 * 32;
    constexpr int NITEMS = 2 * I_IN + 2 * I_OUT + 2 * I_QKV + 2 * I_O + 4 * I_GU + 4 * I_DN;
    for (int it = gw; it < NITEMS; it += NGW) {
        int r = it;
        if (r < 2 * I_IN) { const int j = r / I_IN; r -= j * I_IN;
            tr_matrix_item(ap->in[9] + (size_t)j * DM * DN_IN, DM, DN_IN, ap->in[6] + (2 * j) * DM, (bf16*)(ws + WS_WIN) + (size_t)j * DN_INP * DM, 0, scr, r, lane); continue; }
        r -= 2 * I_IN;
        if (r < 2 * I_OUT) { const int j = r / I_OUT; r -= j * I_OUT;
            tr_matrix_item(ap->in[14] + (size_t)j * VAL_DIM * DM, VAL_DIM, DM, nullptr, (bf16*)(ws + WS_WOUT) + (size_t)j * DM * VAL_DIM, 0, scr, r, lane); continue; }
        r -= 2 * I_OUT;
        if (r < 2 * I_QKV) { const int j = r / I_QKV; r -= j * I_QKV;
            tr_matrix_item(ap->in[15] + (size_t)j * DM * QKV_N, DM, QKV_N, ap->in[6] + (2 * j + 1) * DM, (bf16*)(ws + WS_WQKV) + (size_t)j * QKV_N * DM, 0, scr, r, lane); continue; }
        r -= 2 * I_QKV;
        if (r < 2 * I_O) { const int j = r / I_O; r -= j * I_O;
            tr_matrix_item(ap->in[18] + (size_t)j * DM * DM, DM, DM, nullptr, (bf16*)(ws + WS_WO) + (size_t)j * DM * DM, 0, scr, r, lane); continue; }
        r -= 2 * I_O;
        if (r < 4 * I_GU) { const int i = r / I_GU; r -= i * I_GU;
            tr_matrix_item(ap->in[20] + (size_t)i * DM * GU_N, DM, GU_N, ap->in[7] + i * DM, (bf16*)(ws + WS_WGU) + (size_t)i * GU_N * DM, 1, scr, r, lane); continue; }
        r -= 4 * I_GU;
        { const int i = r / I_DN; r -= i * I_DN;
            tr_matrix_item(ap->in[21] + (size_t)i * DFF * DM, DFF, DM, nullptr, (bf16*)(ws + WS_WDOWN) + (size_t)i * DM * DFF, 0, scr, r, lane); }
    }
    for (int i = blockIdx.x * NTHREADS + tid; i < 2 * 28672; i += gridDim.x * NTHREADS) { const int j = i / 28672, o = i % 28672;
        *(v4u*)((bf16*)(ws + WS_WIN) + (size_t)j * DN_INP * DM + (size_t)DN_IN * DM + (size_t)o * 8) = (v4u){0u, 0u, 0u, 0u}; }
    bf16* XB = (bf16*)(ws + WS_XB); float* SSQ = (float*)(ws + WS_SSQ);
    for (int m = gw; m < T; m += NGW) {
        const float* src = (m < TP) ? ap->in[0] + (size_t)m * DM : ap->in[1] + (size_t)(m - TP) * DM;
        float s = 0.f;
#pragma unroll
        for (int j = 0; j < 4; ++j) { const f32x4 v = *((const f32x4*)src + lane + 64 * j);
            v2u w; w.x = pk2(v[0], v[1]); w.y = pk2(v[2], v[3]); *((v2u*)(XB + (size_t)m * DM) + lane + 64 * j) = w;
            const float r0 = bflo(w.x), r1 = bfhi(w.x), r2 = bflo(w.y), r3 = bfhi(w.y);
            s += (r0 * r0 + r1 * r1) + (r2 * r2 + r3 * r3); }
        s = wave_sum(s);
        if (lane < 16) SSQ[(size_t)m * 16 + lane] = (lane == 0) ? s : 0.f;
    }
}

__device__ __forceinline__ void phase_dn_post(CArgs ap, int j, int tstart) {
    int tid_ = threadIdx.x; asm volatile("" : "+v"(tid_)); const int tid = tid_, lane = tid & 63, wave = __builtin_amdgcn_readfirstlane(tid >> 6);
    const int gw = blockIdx.x * NWAVES + wave, NGW = gridDim.x * NWAVES;
    unsigned char* ws = ap->ws;
    const bf16* PROJ = (const bf16*)(ws + WS_PROJ); const float* BA = (const float*)(ws + WS_BA);
    float* QKV = (float*)(ws + WS_QKV) - (size_t)TP * CONV_DIM; float* BG = (float*)(ws + WS_BG);
    const float* cw = ap->in[10] + (size_t)j * 4 * CONV_DIM;
    const float* sconv = ap->in[2] + (size_t)j * NB_S * 3 * CONV_DIM;
    float* oconvp = ap->out + O_CONVP + (size_t)j * NB_P * 3 * CONV_DIM;
    float* oconvs = ap->out + O_CONVS + (size_t)j * NB_S * 3 * CONV_DIM;
    for (int task = tstart * 32 + gw; task < T * 32; task += NGW) {
        const int t = task >> 5, hc = task & 31, col0 = hc * 128 + 2 * lane;
        const bool prompt = t < TP; const int pos = prompt ? (t & 2047) : ((t - TP) & 3); const int b = prompt ? (t >> 11) : ((t - TP) >> 2);
        float y0 = 0.f, y1 = 0.f, u00 = 0.f, u01 = 0.f;
#pragma unroll
        for (int k = 0; k < 4; ++k) {
            float u0 = 0.f, u1 = 0.f;
            if (pos - k >= 0) { const unsigned w = *(const unsigned*)(PROJ + (size_t)(t - k) * PROJ_LD + col0); u0 = bflo(w); u1 = bfhi(w); }
            else if (!prompt) { const f32x2v v = *(const f32x2v*)(sconv + (size_t)(b * 3 + (3 + pos - k)) * CONV_DIM + col0); u0 = v[0]; u1 = v[1]; }
            const f32x2v wv = *(const f32x2v*)(cw + (size_t)(3 - k) * CONV_DIM + col0);
            y0 += u0 * wv[0]; y1 += u1 * wv[1];
            if (k == 0) { u00 = u0; u01 = u1; }
        }
        y0 = silu_f(y0); y1 = silu_f(y1);
        if (hc < 16) {
            const float ss = wave_sum(y0 * y0 + y1 * y1);
            float inv = rsqrtf(ss + L2_EPS); if (hc < 8) inv *= 0.08838834764831845f;
            y0 *= inv; y1 *= inv;
        }
        *(f32x2v*)(QKV + (size_t)t * CONV_DIM + col0) = (f32x2v){y0, y1};
        if (prompt) { if (pos >= SEQ - 3) *(f32x2v*)(oconvp + (size_t)(b * 3 + pos - (SEQ - 3)) * CONV_DIM + col0) = (f32x2v){u00, u01}; }
        else if (pos >= 1) *(f32x2v*)(oconvs + (size_t)(b * 3 + pos - 1) * CONV_DIM + col0) = (f32x2v){u00, u01};
        if (hc == 0 && lane < 32) {
            const int h = lane & 15; const float v = BA[(size_t)t * 32 + lane];
            float r;
            if (lane < 16) r = 1.f / (1.f + __expf(-v));
            else { const float x = v + ap->in[12][j * 16 + h]; const float sp = (x > 20.f) ? x : log1pf(__expf(x)); r = -__expf(ap->in[11][j * 16 + h]) * sp; }
            BG[(size_t)t * 32 + lane] = r;
        }
    }
}

__device__ __forceinline__ void phase_delta_rec(CArgs ap, int j, LAS unsigned char* lds, unsigned* ticket) {
    int tid_ = threadIdx.x; asm volatile("" : "+v"(tid_)); const int tid = tid_, lane = tid & 63, wave = __builtin_amdgcn_readfirstlane(tid >> 6);
    const int e = tid & 127, dq = tid >> 7;
    unsigned char* ws = ap->ws;
    const float* QKV = (const float*)(ws + WS_QKV) - (size_t)TP * CONV_DIM; const float* BG = (const float*)(ws + WS_BG); const bf16* PROJ = (const bf16*)(ws + WS_PROJ);
    bf16* OG = (bf16*)(ws + WS_OG);
    const float* nw = ap->in[13] + j * 128;
    constexpr int NTB = 16;
    LAS float* qs = (LAS float*)lds;
    LAS float* ks = qs + NTB * 128;
    LAS float* vs = ks + NTB * 128;
    LAS float* ob = vs + NTB * 128;
    LAS float* red = ob + NTB * 128;
    LAS float* red2 = red + 512;
    LAS float* ab = red2 + 512;
    LAS int* tk = (LAS int*)(ab + 32);
    for (;;) {
        if (tid == 0) *tk = (int)__hip_atomic_fetch_add(ticket, 1u, __ATOMIC_RELAXED, __HIP_MEMORY_SCOPE_AGENT);
        __syncthreads();
        const int unit = 128 + *tk;
        if (unit >= 128 + 2048) break;
        int b, h, L, t0; const float* s0 = nullptr; float* sout;
        if (unit < 128) { b = unit >> 4; h = unit & 15; L = SEQ; t0 = b * SEQ; sout = ap->out + O_DELTAP + ((size_t)(j * NB_P + b) * 16 + h) * 16384; }
        else { const int su = unit - 128; b = su >> 4; h = su & 15; L = DSEQ; t0 = TP + b * DSEQ;
            s0 = ap->in[3] + ((size_t)(j * NB_S + b) * 16 + h) * 16384; sout = ap->out + O_DELTAS + ((size_t)(j * NB_S + b) * 16 + h) * 16384; }
        const int hq = h >> 1;
        float S[32];
#pragma unroll
        for (int i = 0; i < 32; ++i) S[i] = s0 ? s0[(size_t)(32 * dq + i) * 128 + e] : 0.f;
        for (int tb = 0; tb < L; tb += NTB) {
            const int nb = (L - tb) < NTB ? (L - tb) : NTB;
            __syncthreads();
            for (int i = tid; i < nb * 384; i += NTHREADS) { const int tt = i / 384, rem = i % 384, which = rem >> 7, ee = rem & 127;
                const int col = (which == 0) ? hq * 128 + ee : (which == 1) ? 1024 + hq * 128 + ee : 2048 + h * 128 + ee;
                qs[which * (NTB * 128) + tt * 128 + ee] = QKV[(size_t)(t0 + tb + tt) * CONV_DIM + col]; }
            if (tid < nb) { ab[tid * 2] = __expf(BG[(size_t)(t0 + tb + tid) * 32 + 16 + h]); ab[tid * 2 + 1] = BG[(size_t)(t0 + tb + tid) * 32 + h]; }
            __syncthreads();
            for (int tt = 0; tt < nb; ++tt) {
                const float av = ab[tt * 2], bt = ab[tt * 2 + 1];
                float part = 0.f;
#pragma unroll
                for (int i = 0; i < 32; ++i) part += ks[tt * 128 + 32 * dq + i] * S[i];
                red[dq * 128 + e] = part;
                __syncthreads();
                const float kS = (red[e] + red[128 + e]) + (red[256 + e] + red[384 + e]);
                const float vv = bt * (vs[tt * 128 + e] - av * kS);
                float po = 0.f;
#pragma unroll
                for (int i = 0; i < 32; ++i) { S[i] = av * S[i] + ks[tt * 128 + 32 * dq + i] * vv; po += S[i] * qs[tt * 128 + 32 * dq + i]; }
                red2[dq * 128 + e] = po;
                __syncthreads();
                if (dq == 0) ob[tt * 128 + e] = (red2[e] + red2[128 + e]) + (red2[256 + e] + red2[384 + e]);
            }
            __syncthreads();
            for (int tt = wave; tt < nb; tt += NWAVES) {
                const float o0 = ob[tt * 128 + lane], o1 = ob[tt * 128 + 64 + lane];
                const float ss = wave_sum(o0 * o0 + o1 * o1);
                const float rs = rsqrtf(ss * (1.f / 128.f) + RMS_EPS);
                const size_t tok = (size_t)(t0 + tb + tt);
                const float z0 = bf2f(PROJ[tok * PROJ_LD + 4096 + h * 128 + lane]), z1 = bf2f(PROJ[tok * PROJ_LD + 4096 + h * 128 + 64 + lane]);
                OG[tok * VAL_DIM + h * 128 + lane] = (bf16)f2bf(o0 * rs * nw[lane] * silu_f(z0));
                OG[tok * VAL_DIM + h * 128 + 64 + lane] = (bf16)f2bf(o1 * rs * nw[64 + lane] * silu_f(z1));
            }
        }
#pragma unroll
        for (int i = 0; i < 32; ++i) sout[(size_t)(32 * dq + i) * 128 + e] = S[i];
        __syncthreads();
    }
}

__device__ __forceinline__ void phase_swa_attn(CArgs ap, int j, LAS unsigned char* lds) {
    int tid_ = threadIdx.x; asm volatile("" : "+v"(tid_)); const int tid = tid_, lane = tid & 63, wave = __builtin_amdgcn_readfirstlane(tid >> 6);
    const int gw = blockIdx.x * NWAVES + wave, NGW = gridDim.x * NWAVES;
    unsigned char* ws = ap->ws;
    const bf16* Q = (const bf16*)(ws + WS_Q); const bf16* KB = (const bf16*)(ws + WS_KB); const bf16* VB = (const bf16*)(ws + WS_VB);
    bf16* ATT = (bf16*)(ws + WS_ATT);
    const float* ck = ap->in[4] + (size_t)j * NB_S * 128 * 256; const float* cv = ap->in[5] + (size_t)j * NB_S * 128 * 256;
    const float* sinks = ap->in[17] + j * 16;
    LAS float* qs = (LAS float*)(lds + wave * 4096);
    LAS float* ps = qs + 256;
    for (int task = gw; task < T * 4; task += NGW) {
        const int t = task >> 2, kh = task & 3;
#pragma unroll
        for (int g = 0; g < 4; ++g) qs[g * 64 + lane] = bf2f(Q[(size_t)t * DM + (kh * 4 + g) * 64 + lane]);
        LDS_WAIT(); asm volatile("" ::: "memory");
        const bool prompt = t < TP; int nk, b = 0, l = 0;
        if (prompt) { const int pos = t & 2047; nk = (pos < 128 ? pos : 128) + 1; } else { const int r = t - TP; b = r >> 2; l = r & 3; nk = 129; }
        const float sl0 = exp2f(-0.5f * (float)(kh * 4 + 1)), sl1 = exp2f(-0.5f * (float)(kh * 4 + 2)), sl2 = exp2f(-0.5f * (float)(kh * 4 + 3)), sl3 = exp2f(-0.5f * (float)(kh * 4 + 4));
#pragma unroll 1
        for (int kb = 0; kb < 3; ++kb) {
            const int jj = kb * 64 + lane; const bool valid = jj < nk;
            float d0 = 0.f, d1 = 0.f, d2 = 0.f, d3 = 0.f;
            if (valid) {
                const int cj = l + jj;
                if (prompt || cj >= 128) {
                    const bf16* kp = prompt ? KB + (size_t)(t - (nk - 1) + jj) * 256 + kh * 64 : KB + (size_t)(TP + b * 4 + (cj - 128)) * 256 + kh * 64;
#pragma unroll 1
                    for (int d = 0; d < 64; d += 8) {
                        const v4u w = *(const v4u*)(kp + d);
                        const float kv[8] = {bflo(w.x), bfhi(w.x), bflo(w.y), bfhi(w.y), bflo(w.z), bfhi(w.z), bflo(w.w), bfhi(w.w)};
#pragma unroll
                        for (int i = 0; i < 8; ++i) { d0 += kv[i] * qs[d + i]; d1 += kv[i] * qs[64 + d + i]; d2 += kv[i] * qs[128 + d + i]; d3 += kv[i] * qs[192 + d + i]; }
                    }
                } else {
                    const float* kf = ck + (size_t)(b * 128 + cj) * 256 + kh * 64;
#pragma unroll 1
                    for (int d = 0; d < 64; d += 4) {
                        const f32x4 x = *(const f32x4*)(kf + d);
#pragma unroll
                        for (int i = 0; i < 4; ++i) { d0 += x[i] * qs[d + i]; d1 += x[i] * qs[64 + d + i]; d2 += x[i] * qs[128 + d + i]; d3 += x[i] * qs[192 + d + i]; }
                    }
                }
            }
            const float rel = (float)((nk - 1) - jj);
            const float NEG = -INFINITY;
            ps[jj] = valid ? d0 - sl0 * rel : NEG; ps[192 + jj] = valid ? d1 - sl1 * rel : NEG; ps[384 + jj] = valid ? d2 - sl2 * rel : NEG; ps[576 + jj] = valid ? d3 - sl3 * rel : NEG;
        }
        LDS_WAIT(); asm volatile("" ::: "memory");
#pragma unroll 1
        for (int g = 0; g < 4; ++g) {
            const float sk = sinks[kh * 4 + g];
            const float s0 = ps[g * 192 + lane], s1 = ps[g * 192 + 64 + lane], s2 = ps[g * 192 + 128 + lane];
            float m = wave_max(fmaxf(fmaxf(s0, s1), s2)); m = fmaxf(m, sk);
            const float p0 = __expf(s0 - m), p1 = __expf(s1 - m), p2 = __expf(s2 - m);
            const float den = wave_sum(p0 + p1 + p2) + __expf(sk - m); const float inv = 1.f / den;
            ps[g * 192 + lane] = p0 * inv; ps[g * 192 + 64 + lane] = p1 * inv; ps[g * 192 + 128 + lane] = p2 * inv;
        }
        LDS_WAIT(); asm volatile("" ::: "memory");
        float o0 = 0.f, o1 = 0.f, o2 = 0.f, o3 = 0.f;
        if (prompt) {
            const bf16* vp = VB + (size_t)(t - (nk - 1)) * 256 + kh * 64 + lane;
#pragma unroll 4
            for (int jj = 0; jj < nk; ++jj) { const float vv = bf2f(vp[(size_t)jj * 256]);
                o0 += ps[jj] * vv; o1 += ps[192 + jj] * vv; o2 += ps[384 + jj] * vv; o3 += ps[576 + jj] * vv; }
        } else {
#pragma unroll 4
            for (int jj = 0; jj < 129; ++jj) { const int cj = l + jj;
                const float vv = (cj < 128) ? cv[(size_t)(b * 128 + cj) * 256 + kh * 64 + lane] : bf2f(VB[(size_t)(TP + b * 4 + (cj - 128)) * 256 + kh * 64 + lane]);
                o0 += ps[jj] * vv; o1 += ps[192 + jj] * vv; o2 += ps[384 + jj] * vv; o3 += ps[576 + jj] * vv; }
        }
        bf16* op = ATT + (size_t)t * DM + kh * 256 + lane;
        op[0] = (bf16)f2bf(o0); op[64] = (bf16)f2bf(o1); op[128] = (bf16)f2bf(o2); op[192] = (bf16)f2bf(o3);
        LDS_WAIT(); asm volatile("" ::: "memory");
    }
}

__device__ __forceinline__ void phase_final(CArgs ap) {
    int tid_ = threadIdx.x; asm volatile("" : "+v"(tid_)); const int tid = tid_, lane = tid & 63, wave = __builtin_amdgcn_readfirstlane(tid >> 6);
    const int gw = blockIdx.x * NWAVES + wave, NGW = gridDim.x * NWAVES;
    const bf16* XB = (const bf16*)(ap->ws + WS_XB); const float* nw = ap->in[8];
    for (int m = gw; m < T; m += NGW) {
        f32x4 v[4]; float s = 0.f;
#pragma unroll
        for (int j = 0; j < 4; ++j) { const v2u w = *((const v2u*)(XB + (size_t)m * DM) + lane + 64 * j); v[j] = (f32x4){bflo(w.x), bfhi(w.x), bflo(w.y), bfhi(w.y)};
            s += (v[j][0] * v[j][0] + v[j][1] * v[j][1]) + (v[j][2] * v[j][2] + v[j][3] * v[j][3]); }
        const float rs = rsqrtf(wave_sum(s) * (1.f / 1024.f) + RMS_EPS);
        float* o = ap->out + (size_t)m * DM;
#pragma unroll
        for (int j = 0; j < 4; ++j) { const f32x4 w = *((const f32x4*)nw + lane + 64 * j); *((f32x4*)o + lane + 64 * j) = v[j] * rs * w; }
    }
}

constexpr int REC_WNEG = 0, REC_QG = 16384, REC_KGT = 32768, REC_AQK = 49152, REC_U = 57344, REC_BYTES = 73728, REC_STAGE = 57344;
typedef short bf16x8_t __attribute__((ext_vector_type(8)));

__device__ __forceinline__ int swz256(int row, int ch) { return row * 256 + ((ch ^ (row & 15)) << 4); }
__device__ __forceinline__ int swz128(int row, int ch) { return row * 128 + ((ch ^ (row & 7)) << 4); }

__device__ __forceinline__ void phase_dn_prep(CArgs ap, int j, LAS unsigned char* lds) {
    int tid_ = threadIdx.x; asm volatile("" : "+v"(tid_)); const int tid = tid_, lane = tid & 63, wave = __builtin_amdgcn_readfirstlane(tid >> 6);
    const int role = wave >> 1;
    unsigned char* ws0 = ap->ws;
    int bid_ = blockIdx.x; asm volatile("" : "+s"(bid_));
    for (int unit = bid_; unit < 2048; unit += gridDim.x) {
        const int b = unit >> 8, hq = (unit >> 5) & 7, n = unit & 31, trow0 = b * SEQ + n * 64;
        int cidx = tid & 127; asm volatile("" : "+v"(cidx));
        unsigned char* ws = ws0; asm volatile("" : "+s"(ws));
        const GAS bf16* PROJ = (const GAS bf16*)(ws + WS_PROJ); const GAS float* BA = (const GAS float*)(ws + WS_BA);
        GAS unsigned char* DREC = (GAS unsigned char*)(ws + WS_DREC); GAS float* EGL = (GAS float*)(ws + WS_EGL);
        const GAS float* cw = (const GAS float*)(ap->in[10] + (size_t)j * 4 * CONV_DIM);
        GAS float* oconvp = (GAS float*)(ap->out + O_CONVP + (size_t)j * NB_P * 3 * CONV_DIM);
        unsigned lb0 = 0u, lb1 = 32768u, lb2 = 65536u, lb3 = 98304u; asm volatile("" : "+v"(lb0), "+v"(lb1), "+v"(lb2), "+v"(lb3));
        LAS unsigned char* kb16 = lds + lb0;
        LAS unsigned char* qb16 = lds + lb0 + 16384;
        LAS float* k32 = (LAS float*)(lds + lb1);
        LAS float* bmt = (LAS float*)(lds + lb2);
        LAS float* Gs = (LAS float*)(lds + lb3);
        LAS float* Bs = Gs + 128;
        LAS float* rowss = Bs + 128;
        __syncthreads();
        if (wave < 2) {
            const int h = 2 * hq + wave; const size_t t = (size_t)(trow0 + lane);
            const float bv = BA[t * 32 + h], av = BA[t * 32 + 16 + h];
            const float x = av + ap->in[12][j * 16 + h]; const float sp = (x > 20.f) ? x : log1pf(__expf(x));
            float g = -__expf(ap->in[11][j * 16 + h]) * sp;
#pragma unroll
            for (int off = 1; off < 64; off <<= 1) { const float o = __shfl_up(g, off); if (lane >= off) g += o; }
            Gs[wave * 64 + lane] = g; Bs[wave * 64 + lane] = 1.f / (1.f + __expf(-bv));
        }
        const int col = (role == 0) ? hq * 128 + cidx : (role == 1) ? 1024 + hq * 128 + cidx : 2048 + (2 * hq + role - 2) * 128 + cidx;
        float val[64];
        {
            const float w0 = cw[col], w1 = cw[CONV_DIM + col], w2 = cw[2 * CONV_DIM + col], w3 = cw[3 * CONV_DIM + col];
            const GAS bf16* pp = PROJ + (size_t)trow0 * PROJ_LD + col;
            float um3 = 0.f, um2 = 0.f, um1 = 0.f;
            if (n > 0) { um3 = bf2f(*(pp - 3 * PROJ_LD)); um2 = bf2f(*(pp - 2 * PROJ_LD)); um1 = bf2f(*(pp - PROJ_LD)); }
#pragma unroll
            for (int c = 0; c < 64; ++c) {
                const float uc = bf2f(pp[(size_t)c * PROJ_LD]);
                val[c] = silu_f(w3 * uc + w2 * um1 + w1 * um2 + w0 * um3);
                um3 = um2; um2 = um1; um1 = uc;
                if (c >= 61 && n == 31) oconvp[(size_t)(b * 3 + c - 61) * CONV_DIM + col] = uc;
            }
        }
        if (role < 2) {
#pragma unroll
            for (int c = 0; c < 64; ++c) { const float s = wave_sum(val[c] * val[c]); if (lane == 0) rowss[(role * 2 + (wave & 1)) * 64 + c] = s; }
        }
        __syncthreads();
        if (role == 0) {
            GAS unsigned char* r0 = DREC + (size_t)((b * 16 + 2 * hq) * 32 + n) * REC_BYTES; GAS unsigned char* r1 = r0 + (size_t)32 * REC_BYTES;
            GAS bf16* qg0 = (GAS bf16*)(r0 + REC_QG); GAS bf16* qg1 = (GAS bf16*)(r1 + REC_QG);
#pragma unroll
            for (int c = 0; c < 64; ++c) {
                const float inv = rsqrtf(rowss[c] + rowss[64 + c] + L2_EPS) * 0.08838834764831845f;
                const float q = val[c] * inv;
                *(LAS bf16*)(qb16 + swz256(c, cidx >> 3) + (cidx & 7) * 2) = (bf16)f2bf(q);
                qg0[c * 128 + cidx] = (bf16)f2bf(q * __expf(Gs[c])); qg1[c * 128 + cidx] = (bf16)f2bf(q * __expf(Gs[64 + c]));
            }
        } else if (role == 1) {
            GAS unsigned char* r0 = DREC + (size_t)((b * 16 + 2 * hq) * 32 + n) * REC_BYTES; GAS unsigned char* r1 = r0 + (size_t)32 * REC_BYTES;
            const float gl0 = Gs[63], gl1 = Gs[127];
#pragma unroll
            for (int c = 0; c < 64; ++c) {
                const float inv = rsqrtf(rowss[128 + c] + rowss[192 + c] + L2_EPS);
                val[c] *= inv;
                *(LAS bf16*)(kb16 + swz256(c, cidx >> 3) + (cidx & 7) * 2) = (bf16)f2bf(val[c]);
                k32[c * 128 + cidx] = val[c];
            }
#pragma unroll
            for (int c8 = 0; c8 < 8; ++c8) {
                v4u w0, w1;
                w0.x = pk2(val[c8 * 8 + 0] * __expf(gl0 - Gs[c8 * 8 + 0]), val[c8 * 8 + 1] * __expf(gl0 - Gs[c8 * 8 + 1]));
                w0.y = pk2(val[c8 * 8 + 2] * __expf(gl0 - Gs[c8 * 8 + 2]), val[c8 * 8 + 3] * __expf(gl0 - Gs[c8 * 8 + 3]));
                w0.z = pk2(val[c8 * 8 + 4] * __expf(gl0 - Gs[c8 * 8 + 4]), val[c8 * 8 + 5] * __expf(gl0 - Gs[c8 * 8 + 5]));
                w0.w = pk2(val[c8 * 8 + 6] * __expf(gl0 - Gs[c8 * 8 + 6]), val[c8 * 8 + 7] * __expf(gl0 - Gs[c8 * 8 + 7]));
                w1.x = pk2(val[c8 * 8 + 0] * __expf(gl1 - Gs[64 + c8 * 8 + 0]), val[c8 * 8 + 1] * __expf(gl1 - Gs[64 + c8 * 8 + 1]));
                w1.y = pk2(val[c8 * 8 + 2] * __expf(gl1 - Gs[64 + c8 * 8 + 2]), val[c8 * 8 + 3] * __expf(gl1 - Gs[64 + c8 * 8 + 3]));
                w1.z = pk2(val[c8 * 8 + 4] * __expf(gl1 - Gs[64 + c8 * 8 + 4]), val[c8 * 8 + 5] * __expf(gl1 - Gs[64 + c8 * 8 + 5]));
                w1.w = pk2(val[c8 * 8 + 6] * __expf(gl1 - Gs[64 + c8 * 8 + 6]), val[c8 * 8 + 7] * __expf(gl1 - Gs[64 + c8 * 8 + 7]));
                *(GAS v4u*)(r0 + REC_KGT + cidx * 128 + c8 * 16) = w0; *(GAS v4u*)(r1 + REC_KGT + cidx * 128 + c8 * 16) = w1;
            }
            if (cidx == 0) { EGL[(b * 16 + 2 * hq) * 32 + n] = __expf(gl0); EGL[(b * 16 + 2 * hq + 1) * 32 + n] = __expf(gl1); }
        } else {
            const int hh = role - 2;
#pragma unroll
            for (int c = 0; c < 64; ++c) val[c] *= Bs[hh * 64 + c];
        }
        __syncthreads();
        {
            const int prod = wave >> 2, tr = wave & 3, fr = lane & 15, fq = lane >> 4;
            f32x4 acc[4];
#pragma unroll
            for (int tc = 0; tc < 4; ++tc) acc[tc] = (f32x4){0.f, 0.f, 0.f, 0.f};
            LAS unsigned char* bsrc = prod ? qb16 : kb16;
#pragma unroll
            for (int ks = 0; ks < 4; ++ks) {
                const bf16x8_t af = *(LAS bf16x8_t*)(kb16 + swz256(16 * tr + fr, ks * 4 + fq));
#pragma unroll
                for (int tc = 0; tc < 4; ++tc) { const bf16x8_t bfr = *(LAS bf16x8_t*)(bsrc + swz256(16 * tc + fr, ks * 4 + fq));
                    acc[tc] = __builtin_amdgcn_mfma_f32_16x16x32_bf16(af, bfr, acc[tc], 0, 0, 0); }
            }
            const int i0 = 16 * tr + 4 * fq;
#pragma unroll
            for (int hh = 0; hh < 2; ++hh) {
                GAS unsigned char* rec = DREC + (size_t)((b * 16 + 2 * hq + hh) * 32 + n) * REC_BYTES;
#pragma unroll
                for (int tc = 0; tc < 4; ++tc) { const int jc = 16 * tc + fr; const float gj = Gs[hh * 64 + jc];
                    float o[4];
#pragma unroll
                    for (int r = 0; r < 4; ++r) { const int i = i0 + r; const float gi = Gs[hh * 64 + i];
                        if (prod == 0) o[r] = (i > jc) ? Bs[hh * 64 + i] * acc[tc][r] * __expf(gi - gj) : 0.f;
                        else o[r] = (jc >= i) ? acc[tc][r] * __expf(gj - gi) : 0.f; }
                    if (prod == 0) *(LAS f32x4*)(bmt + hh * 4096 + jc * 64 + i0) = (f32x4){o[0], o[1], o[2], o[3]};
                    else { v2u w; w.x = pk2(o[0], o[1]); w.y = pk2(o[2], o[3]); *(GAS v2u*)(rec + REC_AQK + jc * 128 + i0 * 2) = w; } }
            }
        }
        __syncthreads();
        {
            const int hh = (role >= 2) ? role - 2 : role;
            if (role == 0) {
#pragma unroll
                for (int c = 0; c < 64; ++c) val[c] = k32[c * 128 + cidx] * Bs[c] * __expf(Gs[c]);
            } else if (role == 1) {
#pragma unroll
                for (int c = 0; c < 64; ++c) val[c] = val[c] * Bs[64 + c] * __expf(Gs[64 + c]);
            }
            const LAS float* bm = bmt + hh * 4096;
#pragma unroll
            for (int s = 0; s < 63; ++s) {
                const float xs = val[s];
#pragma unroll
                for (int cg = (s + 1) / 4; cg < 16; ++cg) { const f32x4 m = *(const LAS f32x4*)(bm + s * 64 + cg * 4);
#pragma unroll
                    for (int e = 0; e < 4; ++e) { const int c = cg * 4 + e; if (c > s) val[c] -= m[e] * xs; } }
            }
            GAS unsigned char* rec = DREC + (size_t)((b * 16 + 2 * hq + hh) * 32 + n) * REC_BYTES;
            if (role >= 2) { GAS bf16* U = (GAS bf16*)(rec + REC_U);
#pragma unroll
                for (int c = 0; c < 64; ++c) U[c * 128 + cidx] = (bf16)f2bf(val[c]);
            } else { GAS bf16* W = (GAS bf16*)(rec + REC_WNEG);
#pragma unroll
                for (int c = 0; c < 64; ++c) W[c * 128 + cidx] = (bf16)f2bf(-val[c]);
            }
        }
    }
    phase_dn_post(ap, j, TP);
}

constexpr int SC_STAGE0 = 0, SC_STAGE1 = REC_STAGE, SC_SCR = 2 * REC_STAGE, SC_RED = SC_SCR + 8 * 4096;
__device__ __forceinline__ int stage_dst(int q) {
    const int off = q * 16;
    if (off < REC_KGT) { const int base = off & ~16383, local = off & 16383; return base + swz256(local >> 8, (local >> 4) & 15); }
    const int base = (off < REC_AQK) ? REC_KGT : REC_AQK, local = off - base; return base + swz128(local >> 7, (local >> 4) & 7);
}
__device__ __forceinline__ float silu_fast(float x) { return x * __builtin_amdgcn_rcpf(1.f + __expf(-x)); }
__device__ __forceinline__ void stage_dma(const unsigned char* rec, LAS unsigned char* sb, int wave, int lane) {
#pragma unroll
    for (int i = 0; i < 7; ++i) { const int kb = i * 8 + wave;
        __builtin_amdgcn_global_load_lds((const unsigned*)(rec + stage_dst(kb * 64 + lane)), (LAS unsigned*)(sb + kb * 1024), 16, 0, 0); }
}
#define SCAN_FINALIZE(nf) do { \
    _Pragma("unroll") for (int tc = 0; tc < 4; ++tc) { const int c = 16 * tc + fr; float tot = 0.f; \
        _Pragma("unroll") for (int w8 = 0; w8 < 8; ++w8) tot += red[((nf) & 1) * 512 + w8 * 64 + c]; \
        const float rs = rsqrtf(tot * (1.f / 128.f) + RMS_EPS); \
        const size_t tok = (size_t)(b * SEQ + (nf) * 64 + c); \
        v2u ow; ow.x = pk2(bflo(ogp[tc].x) * rs, bfhi(ogp[tc].x) * rs); ow.y = pk2(bflo(ogp[tc].y) * rs, bfhi(ogp[tc].y) * rs); \
        *(v2u*)(OG + tok * VAL_DIM + h * 128 + e0 + 4 * fq) = ow; } } while (0)
__device__ __forceinline__ void scan_unit(CArgs ap, int j, int unit, LAS unsigned char* lds) {
    int tid_ = threadIdx.x; asm volatile("" : "+v"(tid_)); const int tid = tid_, lane = tid & 63, wave = __builtin_amdgcn_readfirstlane(tid >> 6);
    const int fr = lane & 15, fq = lane >> 4, e0 = 16 * wave;
    const int b = unit >> 4, h = unit & 15;
    unsigned char* ws = ap->ws;
    const unsigned char* rec0 = ws + WS_DREC + (size_t)(unit * 32) * REC_BYTES;
    const float* EGL = (const float*)(ws + WS_EGL) + unit * 32;
    const bf16* PROJ = (const bf16*)(ws + WS_PROJ); bf16* OG = (bf16*)(ws + WS_OG);
    const float* nw = ap->in[13] + j * 128;
    LAS unsigned char* scr = lds + SC_SCR + wave * 4096;
    LAS float* red = (LAS float*)(lds + SC_RED);
    f32x4 Sacc[8];
#pragma unroll
    for (int dt = 0; dt < 8; ++dt) Sacc[dt] = (f32x4){0.f, 0.f, 0.f, 0.f};
    const f32x4 nwv = *(const f32x4*)(nw + e0 + 4 * fq);
    const size_t uoff = (size_t)fr * 256 + (e0 + 4 * fq) * 2;
    const bf16* zbase = PROJ + (size_t)(b * SEQ + fr) * PROJ_LD + 4096 + h * 128 + e0 + 4 * fq;
    __syncthreads();
    stage_dma(rec0, lds + SC_STAGE0, wave, lane);
    v2u un[4], zn[4]; float egln = EGL[0];
#pragma unroll
    for (int tc = 0; tc < 4; ++tc) { un[tc] = *(const v2u*)(rec0 + REC_U + uoff + tc * 4096); zn[tc] = *(const v2u*)(zbase + (size_t)(16 * tc) * PROJ_LD); }
    v2u ogp[4];
#pragma unroll
    for (int tc = 0; tc < 4; ++tc) ogp[tc] = (v2u){0u, 0u};
#pragma unroll 1
    for (int n = 0; n < 32; ++n) {
        LAS unsigned char* sb = lds + ((n & 1) ? SC_STAGE1 : SC_STAGE0);
        LAS unsigned char* sbn = lds + ((n & 1) ? SC_STAGE0 : SC_STAGE1);
        const int nn = (n + 1 < 32) ? n + 1 : 31;
        const unsigned char* recn = rec0 + (size_t)nn * REC_BYTES;
        asm volatile("s_waitcnt vmcnt(0) lgkmcnt(0)" ::: "memory");
        __syncthreads();
        f32x4 accu[4]; v2u zc[4]; float egl = egln;
#pragma unroll
        for (int tc = 0; tc < 4; ++tc) { accu[tc] = (f32x4){bflo(un[tc].x), bfhi(un[tc].x), bflo(un[tc].y), bfhi(un[tc].y)}; zc[tc] = zn[tc];
            asm volatile("" : "+v"(zc[tc].x), "+v"(zc[tc].y)); }
        asm volatile("" : "+v"(egl));
        if (n > 0) SCAN_FINALIZE(n - 1);
        stage_dma(recn, sbn, wave, lane);
#pragma unroll
        for (int tc = 0; tc < 4; ++tc) { un[tc] = *(const v2u*)(recn + REC_U + uoff + tc * 4096); zn[tc] = *(const v2u*)(zbase + (size_t)(nn * 64 + 16 * tc) * PROJ_LD); }
        egln = EGL[nn];
#pragma unroll
        for (int dt = 0; dt < 8; ++dt)
#pragma unroll
            for (int r = 0; r < 4; ++r) { const int el = 4 * fq + r, d = 16 * dt + fr;
                *(LAS bf16*)(scr + swz256(el, d >> 3) + (d & 7) * 2) = (bf16)f2bf(Sacc[dt][r]); }
#define CB() asm volatile("" ::: "memory")
#define LD256(dst, region, row0) do { _Pragma("unroll") for (int ks = 0; ks < 4; ++ks) dst[ks] = *(LAS bf16x8_t*)(sb + (region) + swz256((row0) + fr, ks * 4 + fq)); } while (0)
#define LD128x2(dst, region, row0) do { _Pragma("unroll") for (int k4 = 0; k4 < 4; ++k4) dst[k4] = *(LAS bf16x8_t*)(sb + (region) + swz128((row0) + 16 * (k4 >> 1) + fr, (k4 & 1) * 4 + fq)); } while (0)
#define MM4(acc, A, B) do { _Pragma("unroll") for (int ks = 0; ks < 4; ++ks) acc = __builtin_amdgcn_mfma_f32_16x16x32_bf16(A[ks], B[ks], acc, 0, 0, 0); } while (0)
#define MM2x2(acc0, acc1, A, B) do { acc0 = __builtin_amdgcn_mfma_f32_16x16x32_bf16(A[0], B[0], acc0, 0, 0, 0); acc0 = __builtin_amdgcn_mfma_f32_16x16x32_bf16(A[1], B[1], acc0, 0, 0, 0); \
        acc1 = __builtin_amdgcn_mfma_f32_16x16x32_bf16(A[0], B[2], acc1, 0, 0, 0); acc1 = __builtin_amdgcn_mfma_f32_16x16x32_bf16(A[1], B[3], acc1, 0, 0, 0); } while (0)
        bf16x8_t Sa[4], Ua[2], fA[4], fB[4], fC[4];
        f32x4 acco[4];
#pragma unroll
        for (int tc = 0; tc < 4; ++tc) acco[tc] = (f32x4){0.f, 0.f, 0.f, 0.f};
        LD256(fA, REC_WNEG, 0);
#pragma unroll
        for (int ks = 0; ks < 4; ++ks) Sa[ks] = *(LAS bf16x8_t*)(scr + swz256(fr, ks * 4 + fq));
        LD256(fB, REC_WNEG, 16); CB();
        MM4(accu[0], Sa, fA); LD256(fC, REC_WNEG, 32); CB();
        MM4(accu[1], Sa, fB); LD256(fA, REC_WNEG, 48); CB();
        MM4(accu[2], Sa, fC); LD256(fB, REC_QG, 0); CB();
        MM4(accu[3], Sa, fA); LD256(fC, REC_QG, 16); CB();
#pragma unroll
        for (int tc = 0; tc < 4; ++tc)
#pragma unroll
            for (int r = 0; r < 4; ++r) { const int el = 4 * fq + r, c = 16 * tc + fr;
                *(LAS bf16*)(scr + swz128(el, c >> 3) + (c & 7) * 2) = (bf16)f2bf(accu[tc][r]); }
        MM4(acco[0], Sa, fB); LD256(fA, REC_QG, 32); CB();
#pragma unroll
        for (int k2 = 0; k2 < 2; ++k2) Ua[k2] = *(LAS bf16x8_t*)(scr + swz128(fr, k2 * 4 + fq));
        MM4(acco[1], Sa, fC); LD256(fB, REC_QG, 48); CB();
        MM4(acco[2], Sa, fA); LD128x2(fC, REC_AQK, 0); CB();
        MM4(acco[3], Sa, fB); LD128x2(fA, REC_AQK, 32); CB();
        MM2x2(acco[0], acco[1], Ua, fC); LD128x2(fB, REC_KGT, 0); CB();
        MM2x2(acco[2], acco[3], Ua, fA); LD128x2(fC, REC_KGT, 32); CB();
#pragma unroll
        for (int dt = 0; dt < 8; ++dt) Sacc[dt] = Sacc[dt] * egl;
        MM2x2(Sacc[0], Sacc[1], Ua, fB); LD128x2(fA, REC_KGT, 64); CB();
        MM2x2(Sacc[2], Sacc[3], Ua, fC); LD128x2(fB, REC_KGT, 96); CB();
        MM2x2(Sacc[4], Sacc[5], Ua, fA);
        MM2x2(Sacc[6], Sacc[7], Ua, fB);
#undef CB
#undef LD256
#undef LD128x2
#undef MM4
#undef MM2x2
#pragma unroll
        for (int tc = 0; tc < 4; ++tc) { float p = (acco[tc][0] * acco[tc][0] + acco[tc][1] * acco[tc][1]) + (acco[tc][2] * acco[tc][2] + acco[tc][3] * acco[tc][3]);
            p += __shfl_xor(p, 16); p += __shfl_xor(p, 32);
            if (fq == 0) red[(n & 1) * 512 + wave * 64 + 16 * tc + fr] = p; }
#pragma unroll
        for (int tc = 0; tc < 4; ++tc) { const float z0 = bflo(zc[tc].x), z1 = bfhi(zc[tc].x), z2 = bflo(zc[tc].y), z3 = bfhi(zc[tc].y);
            ogp[tc].x = pk2(acco[tc][0] * nwv[0] * silu_fast(z0), acco[tc][1] * nwv[1] * silu_fast(z1)); ogp[tc].y = pk2(acco[tc][2] * nwv[2] * silu_fast(z2), acco[tc][3] * nwv[3] * silu_fast(z3)); }
    }
    asm volatile("s_waitcnt vmcnt(0) lgkmcnt(0)" ::: "memory");
    __syncthreads();
    SCAN_FINALIZE(31);
    asm volatile("s_waitcnt vmcnt(0)" ::: "memory");
    float* sout = ap->out + O_DELTAP + ((size_t)(j * NB_P + b) * 16 + h) * 16384;
#pragma unroll
    for (int dt = 0; dt < 8; ++dt) *(f32x4*)(sout + (size_t)(16 * dt + fr) * 128 + e0 + 4 * fq) = Sacc[dt];
    __syncthreads();
}
__device__ __forceinline__ void phase_dn_scan(CArgs ap, int j, LAS unsigned char* lds) {
    const int G = gridDim.x, half = G >> 1; int bid_ = blockIdx.x; asm volatile("" : "+s"(bid_));
#ifndef REP_SCANU
#define REP_SCANU 1
#endif
#ifndef REP_SREC
#define REP_SREC 1
#endif
    if (bid_ < half) { for (int rep = 0; rep < REP_SCANU; ++rep) for (int unit = bid_; unit < 128; unit += half) scan_unit(ap, j, unit, lds); }
    phase_delta_rec(ap, j, lds, (unsigned*)(ap->ws + WS_CTL) + CW_TICKET + 64 * j);
}

constexpr int AT_K = 0, AT_V = 32768, AT_VROW = 528;
__device__ __forceinline__ void attn_qtile(LAS unsigned char* Kl, LAS unsigned char* Vl, int kt0, const bf16* qptr, bf16* optr, int lo, int hi, float slope, float sink, int fr, int fq) {
    const bf16x8_t qb0 = *(const bf16x8_t*)qptr, qb1 = *(const bf16x8_t*)(qptr + 32);
    f32x4 acc[9];
#pragma unroll
    for (int i = 0; i < 9; ++i) {
        const bf16x8_t k0 = *(LAS bf16x8_t*)(Kl + swz128(16 * (kt0 + i) + fr, fq)), k1 = *(LAS bf16x8_t*)(Kl + swz128(16 * (kt0 + i) + fr, 4 + fq));
        acc[i] = __builtin_amdgcn_mfma_f32_16x16x32_bf16(k0, qb0, (f32x4){0.f, 0.f, 0.f, 0.f}, 0, 0, 0);
        acc[i] = __builtin_amdgcn_mfma_f32_16x16x32_bf16(k1, qb1, acc[i], 0, 0, 0);
    }
    float m = sink;
#pragma unroll
    for (int i = 0; i < 9; ++i)
#pragma unroll
        for (int r = 0; r < 4; ++r) { const int kc = 16 * (kt0 + i) + 4 * fq + r; const bool valid = (kc >= lo) && (kc <= hi);
            const float s = valid ? acc[i][r] - slope * (float)(hi - kc) : -INFINITY; acc[i][r] = s; m = fmaxf(m, s); }
    m = fmaxf(m, __shfl_xor(m, 16)); m = fmaxf(m, __shfl_xor(m, 32));
    float sum = 0.f;
#pragma unroll
    for (int i = 0; i < 9; ++i)
#pragma unroll
        for (int r = 0; r < 4; ++r) { const float p = __expf(acc[i][r] - m); acc[i][r] = p; sum += p; }
    sum += __shfl_xor(sum, 16); sum += __shfl_xor(sum, 32);
    const float inv = 1.f / (sum + __expf(sink - m));
    f32x4 o[4];
#pragma unroll
    for (int dt = 0; dt < 4; ++dt) o[dt] = (f32x4){0.f, 0.f, 0.f, 0.f};
#pragma unroll
    for (int i2 = 0; i2 < 5; ++i2) {
        const int ia = 2 * i2, ib = 2 * i2 + 1;
        v4u pw; pw.x = pk2(acc[ia][0], acc[ia][1]); pw.y = pk2(acc[ia][2], acc[ia][3]);
        if (ib < 9) { pw.z = pk2(acc[ib < 9 ? ib : 8][0], acc[ib < 9 ? ib : 8][1]); pw.w = pk2(acc[ib < 9 ? ib : 8][2], acc[ib < 9 ? ib : 8][3]); } else { pw.z = 0u; pw.w = 0u; }
        const bf16x8_t pf = __builtin_bit_cast(bf16x8_t, pw);
        const int kta = kt0 + ia; int ktb = kt0 + ib; ktb = ktb > 15 ? 15 : ktb;
#pragma unroll
        for (int dt = 0; dt < 4; ++dt) {
            const v2u va = *(LAS v2u*)(Vl + (16 * dt + fr) * AT_VROW + (16 * kta + 4 * fq) * 2), vb = *(LAS v2u*)(Vl + (16 * dt + fr) * AT_VROW + (16 * ktb + 4 * fq) * 2);
            const v4u vw = (v4u){va.x, va.y, vb.x, vb.y};
            o[dt] = __builtin_amdgcn_mfma_f32_16x16x32_bf16(__builtin_bit_cast(bf16x8_t, vw), pf, o[dt], 0, 0, 0);
        }
    }
#pragma unroll
    for (int dt = 0; dt < 4; ++dt) { v2u w; w.x = pk2(o[dt][0] * inv, o[dt][1] * inv); w.y = pk2(o[dt][2] * inv, o[dt][3] * inv); *(v2u*)(optr + 16 * dt) = w; }
}

__device__ __forceinline__ void phase_swa_attn_mfma(CArgs ap, int j, LAS unsigned char* lds) {
    int tid_ = threadIdx.x; asm volatile("" : "+v"(tid_)); const int tid = tid_, lane = tid & 63, wave = __builtin_amdgcn_readfirstlane(tid >> 6);
    const int fr = lane & 15, fq = lane >> 4;
    unsigned char* ws = ap->ws;
    const bf16* Q = (const bf16*)(ws + WS_Q); const bf16* KB = (const bf16*)(ws + WS_KB); const bf16* VB = (const bf16*)(ws + WS_VB);
    bf16* ATT = (bf16*)(ws + WS_ATT);
    const float* ck = ap->in[4] + (size_t)j * NB_S * 128 * 256; const float* cv = ap->in[5] + (size_t)j * NB_S * 128 * 256;
    const float* sinks = ap->in[17] + j * 16;
    LAS unsigned char* Kl = lds + AT_K; LAS unsigned char* Vl = lds + AT_V;
    int bid_ = blockIdx.x; asm volatile("" : "+s"(bid_));
    for (int unit = bid_; unit < 1024; unit += gridDim.x) {
        __syncthreads();
        if (unit < 512) {
            const int b = unit >> 6, nb = (unit >> 2) & 15, kh = unit & 3;
            const int trow0 = b * SEQ + nb * 128 - 128;
#pragma unroll
            for (int it = 0; it < 4; ++it) { const int q = tid + 512 * it;
                { const int key = q >> 3, ch = q & 7; v4u w = (v4u){0u, 0u, 0u, 0u};
                  if (nb > 0 || key >= 128) w = *(const v4u*)(KB + (size_t)(trow0 + key) * 256 + kh * 64 + ch * 8);
                  *(LAS v4u*)(Kl + swz128(key, ch)) = w; }
                { const int key = q & 255, dc = q >> 8; v4u w = (v4u){0u, 0u, 0u, 0u};
                  if (nb > 0 || key >= 128) w = *(const v4u*)(VB + (size_t)(trow0 + key) * 256 + kh * 64 + dc * 8);
                  LAS bf16* vp = (LAS bf16*)(Vl + (8 * dc) * AT_VROW + key * 2);
                  vp[0 * (AT_VROW / 2)] = (bf16)(w.x & 0xffff); vp[1 * (AT_VROW / 2)] = (bf16)(w.x >> 16); vp[2 * (AT_VROW / 2)] = (bf16)(w.y & 0xffff); vp[3 * (AT_VROW / 2)] = (bf16)(w.y >> 16);
                  vp[4 * (AT_VROW / 2)] = (bf16)(w.z & 0xffff); vp[5 * (AT_VROW / 2)] = (bf16)(w.z >> 16); vp[6 * (AT_VROW / 2)] = (bf16)(w.w & 0xffff); vp[7 * (AT_VROW / 2)] = (bf16)(w.w >> 16); }
            }
            __syncthreads();
            const int g = wave >> 1, qh = wave & 1, head = kh * 4 + g;
            const float slope = exp2f(-0.5f * (float)(head + 1)), sink = sinks[head];
#pragma unroll 1
            for (int qt = 0; qt < 4; ++qt) {
                const int o = 64 * qh + 16 * qt, qi = o + fr;
                const size_t tq = (size_t)(b * SEQ + nb * 128 + qi);
                attn_qtile(Kl, Vl, 4 * qh + qt, Q + tq * DM + head * 64 + 8 * fq, ATT + tq * DM + head * 64 + 4 * fq, (nb == 0 && qi < 128) ? 128 : qi, 128 + qi, slope, sink, fr, fq);
            }
        } else {
            const int su = unit - 512, b = su >> 2, kh = su & 3;
            for (int q = tid; q < 1280; q += 512) {
                { const int key = q >> 3, ch = q & 7; v4u w = (v4u){0u, 0u, 0u, 0u};
                  if (key < 128) { const float* p = ck + (size_t)(b * 128 + key) * 256 + kh * 64 + ch * 8; const f32x4 x0 = *(const f32x4*)p, x1 = *(const f32x4*)(p + 4);
                      w.x = pk2(x0[0], x0[1]); w.y = pk2(x0[2], x0[3]); w.z = pk2(x1[0], x1[1]); w.w = pk2(x1[2], x1[3]); }
                  else if (key < 132) w = *(const v4u*)(KB + (size_t)(TP + b * 4 + key - 128) * 256 + kh * 64 + ch * 8);
                  *(LAS v4u*)(Kl + swz128(key, ch)) = w; }
                { const int key = q % 160, dc = q / 160; v4u w = (v4u){0u, 0u, 0u, 0u};
                  if (key < 128) { const float* p = cv + (size_t)(b * 128 + key) * 256 + kh * 64 + dc * 8; const f32x4 x0 = *(const f32x4*)p, x1 = *(const f32x4*)(p + 4);
                      w.x = pk2(x0[0], x0[1]); w.y = pk2(x0[2], x0[3]); w.z = pk2(x1[0], x1[1]); w.w = pk2(x1[2], x1[3]); }
                  else if (key < 132) w = *(const v4u*)(VB + (size_t)(TP + b * 4 + key - 128) * 256 + kh * 64 + dc * 8);
                  LAS bf16* vp = (LAS bf16*)(Vl + (8 * dc) * AT_VROW + key * 2);
                  vp[0 * (AT_VROW / 2)] = (bf16)(w.x & 0xffff); vp[1 * (AT_VROW / 2)] = (bf16)(w.x >> 16); vp[2 * (AT_VROW / 2)] = (bf16)(w.y & 0xffff); vp[3 * (AT_VROW / 2)] = (bf16)(w.y >> 16);
                  vp[4 * (AT_VROW / 2)] = (bf16)(w.z & 0xffff); vp[5 * (AT_VROW / 2)] = (bf16)(w.z >> 16); vp[6 * (AT_VROW / 2)] = (bf16)(w.w & 0xffff); vp[7 * (AT_VROW / 2)] = (bf16)(w.w >> 16); }
            }
            __syncthreads();
            if (wave == 0) {
                const int tok = fr & 3, g = fr >> 2, head = kh * 4 + g;
                const float slope = exp2f(-0.5f * (float)(head + 1)), sink = sinks[head];
                const size_t tq = (size_t)(TP + b * 4 + tok);
                attn_qtile(Kl, Vl, 0, Q + tq * DM + head * 64 + 8 * fq, ATT + tq * DM + head * 64 + 4 * fq, tok, 128 + tok, slope, sink, fr, fq);
            }
        }
    }
}

#define XB_TMO      128
#define XB_XCNT(j)  (256  + 64 * (j))
#define XB_XSUB(j)  (1280 + 64 * (j))
#define XB_XGEN(j)  (2304 + 64 * (j))
#define XB_TOP      3328
#define XB_TOPGEN   3392
#define XCD_BAR_WORDS 3456
#define XB_SPIN_CAP (1u << 18)

__device__ __forceinline__ unsigned xb_ld(unsigned* p)              { return __hip_atomic_load(p, __ATOMIC_RELAXED, __HIP_MEMORY_SCOPE_AGENT); }
__device__ __forceinline__ unsigned xb_add(unsigned* p, unsigned v) { return __hip_atomic_fetch_add(p, v, __ATOMIC_RELAXED, __HIP_MEMORY_SCOPE_AGENT); }
__device__ __forceinline__ unsigned xb_xcc_id() { return (unsigned)__builtin_amdgcn_s_getreg((3 << 11) | 20) & 0xFu; }
#define XB_SPIN(cond, bar) do { unsigned _sp = 0; while (cond) { __builtin_amdgcn_s_sleep(1); \
    if ((++_sp & 255u) == 0u) { if (xb_ld(&(bar)[XB_TMO])) break; if (_sp > XB_SPIN_CAP) { atomicAdd(&(bar)[XB_TMO], 1u); break; } } } } while (0)

struct XcdBarrier {
    unsigned* bar; unsigned x;
    volatile LAS unsigned* st;
};

__device__ __forceinline__ XcdBarrier xcd_barrier_post(unsigned* bar, volatile LAS unsigned* st) {
    XcdBarrier b; b.bar = bar; b.x = xb_xcc_id(); b.st = st;
    if (threadIdx.x == 0) (void)xb_add(&bar[XB_XCNT(b.x)], 1u);
    return b;
}
__device__ __forceinline__ void xcd_barrier_complete(unsigned* bar, unsigned x, unsigned& nloc, unsigned& nx) {
    const unsigned G = gridDim.x * gridDim.y * gridDim.z;
    unsigned sum, cnt, mine, sp = 0u;
    for (;;) {
        sum = 0u; cnt = 0u; mine = 0u;
#pragma unroll
        for (unsigned j = 0; j < 16; ++j) { const unsigned c = xb_ld(&bar[XB_XCNT(j)]); sum += c; cnt += (c > 0u) ? 1u : 0u; mine = (j == x) ? c : mine; }
        if (sum == G) break;
        __builtin_amdgcn_s_sleep(1);
        if ((++sp & 255u) == 0u) { if (xb_ld(&bar[XB_TMO])) break; if (sp > XB_SPIN_CAP) { atomicAdd(&bar[XB_TMO], 1u); break; } }
    }
    nloc = mine > 0u ? mine : 1u; nx = cnt > 0u ? cnt : 1u;
}

__device__ __forceinline__ void xcd_barrier(const XcdBarrier& b) {
    asm volatile("s_waitcnt vmcnt(0)" ::: "memory");
    __syncthreads();
    if (threadIdx.x == 0) {
        unsigned* bar = b.bar;
        __builtin_amdgcn_s_waitcnt(0);
        unsigned nloc = b.st[0], nx = b.st[1];
        if (nloc == 0u) { xcd_barrier_complete(bar, b.x, nloc, nx); b.st[0] = nloc; b.st[1] = nx; }
        const unsigned old = xb_add(&bar[XB_XSUB(b.x)], 1u);
        const unsigned gen = old / nloc;
        if (old + 1u == (gen + 1u) * nloc) {
            __builtin_amdgcn_fence(__ATOMIC_RELEASE, "agent");
            asm volatile("s_waitcnt vmcnt(0)" ::: "memory");
            const unsigned og = xb_add(&bar[XB_TOP], 1u);
            const unsigned tg = og / nx;
            if (og + 1u == (tg + 1u) * nx) xb_add(&bar[XB_TOPGEN], 1u);
            else XB_SPIN(xb_ld(&bar[XB_TOPGEN]) == tg, bar);
            __builtin_amdgcn_fence(__ATOMIC_ACQUIRE, "agent");
            xb_add(&bar[XB_XGEN(b.x)], 1u);
            asm volatile("s_waitcnt vmcnt(0)" ::: "memory");
        } else {
            XB_SPIN(xb_ld(&bar[XB_XGEN(b.x)]) == gen, bar);
            __builtin_amdgcn_fence(__ATOMIC_ACQUIRE, "agent");
            asm volatile("s_waitcnt vmcnt(0)" ::: "memory");
        }
    }
    __syncthreads();
}

constexpr int CW_BAR = 4096;
constexpr int MISC_OFF = 151552;

#ifndef REP_PREP
#define REP_PREP 1
#endif
#ifndef REP_SCAN
#define REP_SCAN 1
#endif
#ifndef REP_ATTN
#define REP_ATTN 1
#endif
#ifndef REP_GIN
#define REP_GIN 1
#endif
#ifndef REP_GGU
#define REP_GGU 1
#endif
#ifndef REP_GQKV
#define REP_GQKV 1
#endif

__device__ __forceinline__ void small_res(const bf16* A, const bf16* Wt, int K, const float* bias, bf16* XBp, float* SSQp, LAS unsigned char* lds) {
    int tid_ = threadIdx.x; asm volatile("" : "+v"(tid_)); const int tid = tid_, lane = tid & 63, wave = __builtin_amdgcn_readfirstlane(tid >> 6);
    const int fr = lane & 15, fq = lane >> 4, rt = wave >> 2, ct = wave & 3;
    int bid_ = blockIdx.x; asm volatile("" : "+s"(bid_));
    LAS float* red = (LAS float*)lds;
    for (int piece = bid_; piece < 256; piece += gridDim.x) {
        const int rb = piece >> 4, cc = piece & 15, m0 = TP + rb * 32 + rt * 16, n0 = cc * 64 + ct * 16;
        const bf16* apx = A + (size_t)(m0 + fr) * K + 8 * fq; const bf16* wpx = Wt + (size_t)(n0 + fr) * K + 8 * fq;
        f32x4 acc = (f32x4){0.f, 0.f, 0.f, 0.f};
#pragma unroll 1
        for (int k = 0; k < K; k += 256) {
            bf16x8_t av[8], wv[8];
#pragma unroll
            for (int i = 0; i < 8; ++i) { av[i] = *(const bf16x8_t*)(apx + k + 32 * i); wv[i] = *(const bf16x8_t*)(wpx + k + 32 * i); }
#pragma unroll
            for (int i = 0; i < 8; ++i) acc = __builtin_amdgcn_mfma_f32_16x16x32_bf16(wv[i], av[i], acc, 0, 0, 0);
        }
        const int row = m0 + fr, col = n0 + 4 * fq;
        bf16* xp = XBp + (size_t)row * DM + col;
        const v2u xo = *(const v2u*)xp;
        f32x4 x = (f32x4){bflo(xo.x), bfhi(xo.x), bflo(xo.y), bfhi(xo.y)} + acc;
        if (bias) x = x + *(const f32x4*)(bias + col);
        v2u w; w.x = pk2(x[0], x[1]); w.y = pk2(x[2], x[3]);
        *(v2u*)xp = w;
        const float r0 = bflo(w.x), r1 = bfhi(w.x), r2 = bflo(w.y), r3 = bfhi(w.y);
        float s = (r0 * r0 + r1 * r1) + (r2 * r2 + r3 * r3);
        s += __shfl_xor(s, 16); s += __shfl_xor(s, 32);
        __syncthreads();
        if (fq == 0) red[wave * 16 + fr] = s;
        __syncthreads();
        if (ct == 0 && fq == 0) SSQp[(size_t)row * 16 + cc] = (red[(rt * 4) * 16 + fr] + red[(rt * 4 + 1) * 16 + fr]) + (red[(rt * 4 + 2) * 16 + fr] + red[(rt * 4 + 3) * 16 + fr]);
    }
}
template <class Epi>
__device__ __forceinline__ void run_gemm(LAS unsigned char* lds, const bf16* A, const bf16* Bt, int M, int N, int K, const Epi& E) {
    int c_ = blockIdx.x; asm volatile("" : "+s"(c_));
    pg8::Gemm g{A, Bt, M, N, K}; pg8::StaticOrder S; S.init(M, N, (int)gridDim.x, c_);
    pg8::gemm_phase<Epi, pg8::StaticOrder, true, true>(lds, g, S, E);
}

__global__ void __launch_bounds__(NTHREADS, 2) mk_fwd(Args a) {
    extern __shared__ __attribute__((aligned(16))) unsigned char lds_raw[];
    LAS unsigned char* lds = (LAS unsigned char*)lds_raw;
    unsigned char* ws0_ = kargs()->ws;
    for (int u = threadIdx.x; u < (LDS_BYTES - MISC_OFF) / 4; u += NTHREADS) ((LAS unsigned*)(lds + MISC_OFF))[u] = 0u;
    __syncthreads();
    (void)xcd_barrier_post((unsigned*)(ws0_ + WS_CTL) + CW_BAR, (volatile LAS unsigned*)(lds + MISC_OFF));
#define GRID_BAR() do { XcdBarrier b_; b_.bar = (unsigned*)(kargs()->ws + WS_CTL) + CW_BAR; b_.x = xb_xcc_id(); b_.st = (volatile LAS unsigned*)(lds + MISC_OFF); xcd_barrier(b_); } while (0)

    phase_prologue(kargs(), lds);
    GRID_BAR();
#pragma unroll 1
    for (int li = 0; li < 4; ++li) {
        const int j = li >> 1;
#define WSP (kargs()->ws)
#define XB ((bf16*)(WSP + WS_XB))
#define SSQ ((float*)(WSP + WS_SSQ))
        if ((li & 1) == 0) {
            for (int rep = 0; rep < REP_GIN; ++rep) { EpiDnIn E{(bf16*)(WSP + WS_PROJ), (float*)(WSP + WS_BA), SSQ};
              run_gemm(lds, XB, (const bf16*)(WSP + WS_WIN) + (size_t)j * DN_INP * DM, T, DN_INP, DM, E);
            GRID_BAR(); }
            for (int rep = 0; rep < REP_PREP; ++rep) { phase_dn_prep(kargs(), j, lds);
            GRID_BAR(); }
            for (int rep = 0; rep < REP_SCAN; ++rep) { phase_dn_scan(kargs(), j, lds);
            GRID_BAR(); }
            { EpiRes E{XB, SSQ, nullptr};
              run_gemm(lds, (const bf16*)(WSP + WS_OG), (const bf16*)(WSP + WS_WOUT) + (size_t)j * DM * VAL_DIM, TP, DM, VAL_DIM, E); }
            small_res((const bf16*)(WSP + WS_OG), (const bf16*)(WSP + WS_WOUT) + (size_t)j * DM * VAL_DIM, VAL_DIM, nullptr, XB, SSQ, lds);
            GRID_BAR();
        } else {
            { EpiQkv E{(bf16*)(WSP + WS_Q), (bf16*)(WSP + WS_KB), SSQ, kargs()->in[16] + j * QKV_N,
                       kargs()->out + O_KP + (size_t)j * NB_P * 128 * 256, kargs()->out + O_KS + (size_t)j * NB_S * 4 * 256};
              run_gemm(lds, XB, (const bf16*)(WSP + WS_WQKV) + (size_t)j * QKV_N * DM, T, QKV_N, DM, E); }
            GRID_BAR();
            for (int rep = 0; rep < REP_ATTN; ++rep) { phase_swa_attn_mfma(kargs(), j, lds);
            GRID_BAR(); }
            { EpiRes E{XB, SSQ, kargs()->in[19] + j * DM};
              run_gemm(lds, (const bf16*)(WSP + WS_ATT), (const bf16*)(WSP + WS_WO) + (size_t)j * DM * DM, TP, DM, DM, E); }
            small_res((const bf16*)(WSP + WS_ATT), (const bf16*)(WSP + WS_WO) + (size_t)j * DM * DM, DM, kargs()->in[19] + j * DM, XB, SSQ, lds);
            GRID_BAR();
        }
        for (int rep = 0; rep < REP_GGU; ++rep) { EpiGu E{(bf16*)(WSP + WS_ACT), SSQ};
          run_gemm(lds, XB, (const bf16*)(WSP + WS_WGU) + (size_t)li * GU_N * DM, T, GU_N, DM, E);
        GRID_BAR(); }
        { EpiRes E{XB, SSQ, nullptr};
          run_gemm(lds, (const bf16*)(WSP + WS_ACT), (const bf16*)(WSP + WS_WDOWN) + (size_t)li * DM * DFF, TP, DM, DFF, E); }
        small_res((const bf16*)(WSP + WS_ACT), (const bf16*)(WSP + WS_WDOWN) + (size_t)li * DM * DFF, DFF, nullptr, XB, SSQ, lds);
        GRID_BAR();
    }
#undef WSP
#undef XB
#undef SSQ
    phase_final(kargs());
}

extern "C" void kernel_launch(void* const* d_in, const int* in_sizes, int n_in, void* d_out, int out_size, void* d_ws, size_t ws_size, hipStream_t stream) {
    static int grid = 0;
    if (grid == 0) {
        if (n_in != 22 || (size_t)out_size != O_END || ws_size < WS_END) { fprintf(stderr, "kernel_launch: unexpected shapes: n_in %d out %d ws %zu\n", n_in, out_size, ws_size); grid = -1; return; }
        int dev = 0, cus = 0, per_cu = 0;
        if (hipGetDevice(&dev) != hipSuccess || hipDeviceGetAttribute(&cus, hipDeviceAttributeMultiprocessorCount, dev) != hipSuccess) { grid = -1; return; }
        if (hipFuncSetAttribute((const void*)mk_fwd, hipFuncAttributeMaxDynamicSharedMemorySize, LDS_BYTES) != hipSuccess) { fprintf(stderr, "kernel_launch: hipFuncSetAttribute failed\n"); grid = -1; return; }
        if (hipOccupancyMaxActiveBlocksPerMultiprocessor(&per_cu, (const void*)mk_fwd, NTHREADS, LDS_BYTES) != hipSuccess || per_cu < 1) { fprintf(stderr, "kernel_launch: occupancy query reports %d blocks per CU\n", per_cu); (void)hipGetLastError(); }
        grid = cus;
    }
    if (grid < 0) return;
    (void)hipMemsetAsync((char*)d_ws + WS_CTL, 0, CTL_ZERO_BYTES, stream);
    Args a{};
    for (int i = 0; i < 22; ++i) a.in[i] = (const float*)d_in[i];
    a.out = (float*)d_out; a.ws = (unsigned char*)d_ws;
    hipLaunchKernelGGL(mk_fwd, dim3(grid), dim3(NTHREADS), LDS_BYTES, stream, a);
}
```

```cpp
#include <hip/hip_runtime.h>
#include <cstdio>
#include <cstdint>
namespace pg8 {
#define PG8_LAS __attribute__((address_space(3)))
typedef unsigned short bf16_t;
typedef short bf16x8 __attribute__((ext_vector_type(8)));
typedef float f32x4 __attribute__((ext_vector_type(4)));
typedef unsigned u32x4 __attribute__((ext_vector_type(4)));
constexpr int BM = 256, BK = 64, HALF = 128, HTB = HALF * BK * 2  , STAGE_BYTES = 8 * HTB, NXCD = 8, WGM = 8;

__host__ __device__ __forceinline__ int lds_byte(int r, int c) { const int st = (r >> 4) * 2 + (c >> 5), rr = r & 15, cc = c & 31, ob = rr * 64 + cc * 2; return st * 1024 + (ob ^ (((ob >> 9) & 1) << 5)); }
__host__ __device__ __forceinline__ void stage_rc(int b, int& R, int& C) { const int st = b / 1024, sb = b % 1024, swz = sb ^ (((sb >> 9) & 1) << 5); R = (st >> 1) * 16 + swz / 64; C = (st & 1) * 32 + (swz % 64) / 2; }
__host__ __device__ __forceinline__ int perm32(int rho) { const int n = rho >> 4, i = rho & 15; return 8 * (i >> 2) + 4 * n + (i & 3); }

struct Unit { int pm, pn; };
struct Gemm { const bf16_t* A; const bf16_t* Bt; int M, N, K; };

struct StaticOrder {
    int nM, nN, nwg, G, c;
    __host__ __device__ void init(int M, int N, int G_, int c_) { nM = M / BM; nN = N / BM; nwg = nM * nN; G = G_; c = c_; }
    __host__ __device__ bool next(int i, Unit& u) const {
        const long L = (long)i * G + c; if (L >= nwg) return false;
        int wgid = (int)L; { const int q = nwg / NXCD, r = nwg % NXCD, xcd = wgid % NXCD, off = wgid / NXCD; wgid = (xcd < r ? xcd * (q + 1) : r * (q + 1) + (xcd - r) * q) + off; }
        const int nig = WGM * nN, gid = wgid / nig, fm = gid * WGM, gsz = (nM - fm) < WGM ? (nM - fm) : WGM;
        u.pm = fm + ((wgid % nig) % gsz); u.pn = (wgid % nig) / gsz; return true;
    }
    __device__ __forceinline__ void a_ready(const Unit&) const {}
    __device__ __forceinline__ void done(const Unit&) const {}
};
__device__ __forceinline__ unsigned cvt_pk_bf16(float lo, float hi) { unsigned r; asm volatile("v_cvt_pk_bf16_f32 %0, %1, %2" : "=v"(r) : "v"(lo), "v"(hi)); return r; }
typedef float f32x2 __attribute__((ext_vector_type(2)));
template <class Epi, class Sched, bool ALIGN_EPI = false, bool SP2 = false>
__device__ __forceinline__ void gemm_phase(PG8_LAS unsigned char* lds, const Gemm g, const Sched& S, const Epi& E) {
    int tid_ = threadIdx.x; asm volatile("" : "+v"(tid_)); const int tid = tid_, wid = __builtin_amdgcn_readfirstlane(tid >> 6), lane = tid & 63, wr = wid >> 2, wc = wid & 3, fr = lane & 15, fq = lane >> 4;
    const int K = g.K, nt = K / BK;
    unsigned voffA[2], voffB[2];
#pragma unroll
    for (int i = 0; i < 2; ++i) { int R, C; stage_rc(tid * 16 + i * 8192, R, C); const int Rb = Epi::PERM ? ((R & ~31) + perm32(R & 31)) : R;
        voffA[i] = (unsigned)(R * K + C) * 2u; voffB[i] = (unsigned)(Rb * K + C) * 2u; }
    const size_t kstep = (size_t)(BK * 2);
    const size_t hstep = (size_t)HALF * K * 2;
    const size_t tstep = 2 * hstep;
    const unsigned ldsw = (unsigned)wid * 1024u;
    const int aoff = lds_byte(wr * 64 + fr, fq * 8), boff = lds_byte(wc * 32 + fr, fq * 8);
#define PG8_SA(b, h) (((b) * 2 + (h)) * HTB)
#define PG8_SB(b, h) ((4 + (b) * 2 + (h)) * HTB)
#define PG8_STAGE(bufoff, gbase, voff) do { _Pragma("unroll") for (int _i = 0; _i < 2; ++_i) \
        __builtin_amdgcn_global_load_lds((const unsigned*)((const char*)(gbase) + (voff)[_i]), (PG8_LAS unsigned*)(lds + (bufoff) + ldsw + _i * 8192), 16, 0, 0); } while (0)
#define PG8_LDA(dst, b, h) do { _Pragma("unroll") for (int m = 0; m < 4; ++m) _Pragma("unroll") for (int k = 0; k < 2; ++k) dst[m][k] = *(const PG8_LAS bf16x8*)(lds + PG8_SA(b, h) + aoff + m * 2048 + k * 1024); } while (0)
#define PG8_LDB(dst, b, h) do { _Pragma("unroll") for (int n = 0; n < 2; ++n) _Pragma("unroll") for (int k = 0; k < 2; ++k) dst[n][k] = *(const PG8_LAS bf16x8*)(lds + PG8_SB(b, h) + boff + n * 2048 + k * 1024); } while (0)
#define PG8_MMA(ai, bj, At, Bt) do { __builtin_amdgcn_s_setprio(1); _Pragma("unroll") for (int m = 0; m < 4; ++m) _Pragma("unroll") for (int n = 0; n < 2; ++n) _Pragma("unroll") for (int k = 0; k < 2; ++k) \
        acc[ai][bj][m][n] = __builtin_amdgcn_mfma_f32_16x16x32_bf16(Bt[n][k], At[m][k], acc[ai][bj][m][n], 0, 0, 0); __builtin_amdgcn_s_setprio(0); } while (0)
#define PG8_WAIT_V(n) asm volatile("s_waitcnt vmcnt(" #n ")" ::: "memory")
#define PG8_WAIT_L(n) asm volatile("s_waitcnt lgkmcnt(" #n ")" ::: "memory")
#define PG8_BAR __builtin_amdgcn_s_barrier()
#define PG8_SCHED __builtin_amdgcn_sched_barrier(0)
    Unit cur, nxt; int ui = 0;
    if (!S.next(0, cur)) return;
    f32x4 acc[2][2][4][2];
#pragma unroll
    for (int a = 0; a < 2; ++a)
#pragma unroll
        for (int b = 0; b < 2; ++b)
#pragma unroll
            for (int m = 0; m < 4; ++m)
#pragma unroll
                for (int n = 0; n < 2; ++n) acc[a][b][m][n] = (f32x4){0.f, 0.f, 0.f, 0.f};
    bf16x8 At[4][2], B0[2][2], B1[2][2];
    const char* cA = (const char*)g.A + (size_t)cur.pm * tstep; const char* cB = (const char*)g.Bt + (size_t)cur.pn * tstep;
    S.a_ready(cur);
    if constexpr (SP2) {
        PG8_STAGE(PG8_SB(0, 0), cB, voffB); PG8_STAGE(PG8_SB(0, 1), cB + hstep, voffB); PG8_STAGE(PG8_SA(0, 0), cA, voffA); PG8_STAGE(PG8_SA(0, 1), cA + hstep, voffA);
        if (wr == 1) PG8_BAR;
        PG8_WAIT_V(2); PG8_BAR;
        PG8_STAGE(PG8_SB(1, 0), cB + kstep, voffB); PG8_STAGE(PG8_SA(1, 0), cA + kstep, voffA); PG8_STAGE(PG8_SB(1, 1), cB + hstep + kstep, voffB);
        PG8_WAIT_V(6); PG8_BAR;
    } else {
        PG8_STAGE(PG8_SB(0, 0), cB, voffB); PG8_STAGE(PG8_SA(0, 0), cA, voffA); PG8_STAGE(PG8_SB(0, 1), cB + hstep, voffB); PG8_STAGE(PG8_SA(0, 1), cA + hstep, voffA);
        if (wr == 1) PG8_BAR;
        PG8_WAIT_V(4); PG8_BAR;
        PG8_STAGE(PG8_SB(1, 0), cB + kstep, voffB); PG8_STAGE(PG8_SA(1, 0), cA + kstep, voffA); PG8_STAGE(PG8_SB(1, 1), cB + hstep + kstep, voffB);
        PG8_WAIT_V(6); PG8_BAR;
    }
    for (;;) {
        const bool has_next = S.next(ui + 1, nxt);
        const char* nA = has_next ? (const char*)g.A + (size_t)nxt.pm * tstep : cA; const char* nB = has_next ? (const char*)g.Bt + (size_t)nxt.pn * tstep : cB;
        for (int t = 0; t < nt; t += 2) {
            const bool last = (t == nt - 2);
            const char* a1 = cA + (size_t)(t + 1) * kstep;
            const char* a2 = last ? nA : cA + (size_t)(t + 2) * kstep; const char* b2 = last ? nB : cB + (size_t)(t + 2) * kstep;
            const char* a3 = a2 + kstep; const char* b3 = b2 + kstep;
            if (last && has_next) S.a_ready(nxt);
            if constexpr (SP2) {
            PG8_LDB(B0, 0, 0); PG8_LDB(B1, 0, 1); PG8_SCHED; PG8_LDA(At, 0, 0); PG8_STAGE(PG8_SA(1, 1), a1 + hstep, voffA);
            PG8_WAIT_V(8); PG8_WAIT_L(0); PG8_BAR; PG8_MMA(0, 0, At, B0); PG8_MMA(0, 1, At, B1); PG8_BAR; PG8_SCHED;
            PG8_LDA(At, 0, 1); PG8_STAGE(PG8_SB(0, 0), b2, voffB); PG8_STAGE(PG8_SB(0, 1), b2 + hstep, voffB); PG8_STAGE(PG8_SA(0, 0), a2, voffA);
            PG8_WAIT_V(8); PG8_WAIT_L(0); PG8_BAR; PG8_MMA(1, 0, At, B0); PG8_MMA(1, 1, At, B1); PG8_BAR; PG8_SCHED;
            PG8_LDB(B0, 1, 0); PG8_LDB(B1, 1, 1); PG8_SCHED; PG8_LDA(At, 1, 0); PG8_STAGE(PG8_SA(0, 1), a2 + hstep, voffA);
            PG8_WAIT_V(8); PG8_WAIT_L(0); PG8_BAR; PG8_MMA(0, 0, At, B0); PG8_MMA(0, 1, At, B1); PG8_BAR; PG8_SCHED;
            PG8_LDA(At, 1, 1); PG8_STAGE(PG8_SB(1, 0), b3, voffB); PG8_STAGE(PG8_SB(1, 1), b3 + hstep, voffB); PG8_STAGE(PG8_SA(1, 0), a3, voffA);
            PG8_WAIT_V(8); PG8_WAIT_L(0); PG8_BAR; PG8_MMA(1, 0, At, B0); PG8_MMA(1, 1, At, B1); PG8_BAR; PG8_SCHED;
            } else {
            PG8_LDB(B0, 0, 0); PG8_SCHED; PG8_LDA(At, 0, 0); PG8_STAGE(PG8_SA(1, 1), a1 + hstep, voffA);
            PG8_WAIT_L(8); PG8_BAR; PG8_WAIT_L(0); PG8_MMA(0, 0, At, B0); PG8_BAR; PG8_SCHED;
            PG8_LDB(B1, 0, 1); PG8_STAGE(PG8_SB(0, 0), b2, voffB);
            PG8_BAR; PG8_WAIT_L(0); PG8_MMA(0, 1, At, B1); PG8_BAR;
            PG8_LDA(At, 0, 1); PG8_STAGE(PG8_SA(0, 0), a2, voffA);
            PG8_BAR; PG8_WAIT_L(0); PG8_MMA(1, 0, At, B0); PG8_BAR; PG8_SCHED;
            PG8_STAGE(PG8_SB(0, 1), b2 + hstep, voffB);
            PG8_WAIT_V(6); PG8_BAR; PG8_MMA(1, 1, At, B1); PG8_BAR;
            PG8_LDB(B0, 1, 0); PG8_SCHED; PG8_LDA(At, 1, 0); PG8_STAGE(PG8_SA(0, 1), a2 + hstep, voffA);
            PG8_WAIT_L(8); PG8_BAR; PG8_WAIT_L(0); PG8_MMA(0, 0, At, B0); PG8_BAR; PG8_SCHED;
            PG8_LDB(B1, 1, 1); PG8_STAGE(PG8_SB(1, 0), b3, voffB);
            PG8_BAR; PG8_WAIT_L(0); PG8_MMA(0, 1, At, B1); PG8_BAR;
            PG8_LDA(At, 1, 1); PG8_STAGE(PG8_SA(1, 0), a3, voffA);
            PG8_BAR; PG8_WAIT_L(0); PG8_MMA(1, 0, At, B0); PG8_BAR; PG8_SCHED;
            PG8_STAGE(PG8_SB(1, 1), b3 + hstep, voffB);
            PG8_WAIT_V(6); PG8_BAR; PG8_MMA(1, 1, At, B1); PG8_BAR;
            }
        }
        if constexpr (ALIGN_EPI) { if (wr == 0) PG8_BAR; }
        if constexpr (!Epi::AFTER_DRAIN) { E(acc, cur, wr, wc, fr, fq); S.done(cur); }
        if (!has_next) break;
#pragma unroll
        for (int a = 0; a < 2; ++a)
#pragma unroll
            for (int b = 0; b < 2; ++b)
#pragma unroll
                for (int m = 0; m < 4; ++m)
#pragma unroll
                    for (int n = 0; n < 2; ++n) acc[a][b][m][n] = (f32x4){0.f, 0.f, 0.f, 0.f};
        cur = nxt; cA = nA; cB = nB; ++ui;
        if constexpr (ALIGN_EPI) { if (wr == 1) PG8_BAR; }
    }
    PG8_WAIT_V(0);
    if constexpr (!ALIGN_EPI) { if (wr == 0) PG8_BAR; }
    PG8_BAR;
    if constexpr (Epi::AFTER_DRAIN) { E.fused(acc, cur, wr, wc, fr, fq, lds, wid, lane); S.done(cur); }
#undef PG8_SA
#undef PG8_SB
#undef PG8_STAGE
#undef PG8_LDA
#undef PG8_LDB
#undef PG8_MMA
#undef PG8_WAIT_V
#undef PG8_WAIT_L
#undef PG8_BAR
#undef PG8_SCHED
}
}

#define GAS __attribute__((address_space(1)))
#define LAS __attribute__((address_space(3)))
typedef unsigned short bf16;
typedef unsigned v4u __attribute__((ext_vector_type(4)));
typedef unsigned v2u __attribute__((ext_vector_type(2)));
typedef float f32x4 __attribute__((ext_vector_type(4)));
typedef float f32x2v __attribute__((ext_vector_type(2)));

constexpr int DM = 1024, NB_P = 8, SEQ = 2048, NB_S = 128, DSEQ = 4;
constexpr int TP = NB_P * SEQ, TS = NB_S * DSEQ, T = TP + TS;
constexpr int DN_IN = 6176, DN_INP = 6400, PROJ_LD = 6144, CONV_DIM = 4096, VAL_DIM = 2048;
constexpr int QKV_N = 1536, DFF = 2816, GU_N = 5632;
constexpr float RMS_EPS = 1e-6f, L2_EPS = 1e-6f;

constexpr size_t O_YP = 0, O_YS = 16777216, O_CONVP = 17301504, O_DELTAP = 17498112, O_KP = 21692416, O_VP = 22216704,
                 O_CONVS = 22740992, O_DELTAS = 25886720, O_KS = 92995584, O_VS = 93257728, O_END = 93519872;

constexpr size_t MiB = 1u << 20;
constexpr size_t WS_CTL = 0, CTL_ZERO_BYTES = 1 * MiB;
constexpr size_t WS_WIN = 2 * MiB;
constexpr size_t WS_WOUT = 27 * MiB;
constexpr size_t WS_WQKV = 35 * MiB;
constexpr size_t WS_WO = 41 * MiB;
constexpr size_t WS_WGU = 45 * MiB;
constexpr size_t WS_WDOWN = 89 * MiB;
constexpr size_t WS_X = 112 * MiB;
constexpr size_t WS_XB = 178 * MiB;
constexpr size_t WS_SSQ = 211 * MiB;
constexpr size_t WS_BA = 213 * MiB;
constexpr size_t WS_BG = 216 * MiB;
constexpr size_t WS_PROJ = 220 * MiB;
constexpr size_t WS_Q = 220 * MiB;
constexpr size_t WS_KB = 253 * MiB;
constexpr size_t WS_VB = 262 * MiB;
constexpr size_t WS_ATT = 271 * MiB;
constexpr size_t WS_QKV = 418 * MiB;
constexpr size_t WS_DREC = 428 * MiB;
constexpr size_t WS_OG = 716 * MiB;
constexpr size_t WS_ACT = 782 * MiB;
constexpr size_t WS_EGL = 874 * MiB;
constexpr size_t WS_END = 876 * MiB;
constexpr size_t KV_DELTA = (WS_VB - WS_KB) / 2;

constexpr int CW_TICKET = 65536;
constexpr int NWAVES = 8, NTHREADS = 512;
constexpr int LDS_BYTES = 163840;

#define LDS_WAIT() asm volatile("s_waitcnt lgkmcnt(0)" ::: "memory")
__device__ __forceinline__ unsigned f2bf(float f) { unsigned u = __builtin_bit_cast(unsigned, f); return (u + 0x7fffu + ((u >> 16) & 1u)) >> 16; }
__device__ __forceinline__ unsigned pk2(float lo, float hi) { return f2bf(lo) | (f2bf(hi) << 16); }
__device__ __forceinline__ float bf2f(unsigned short b) { return __builtin_bit_cast(float, (unsigned)b << 16); }
__device__ __forceinline__ float bflo(unsigned w) { return __builtin_bit_cast(float, w << 16); }
__device__ __forceinline__ float bfhi(unsigned w) { return __builtin_bit_cast(float, w & 0xffff0000u); }
__device__ __forceinline__ float wave_sum(float v) {
#pragma unroll
    for (int o = 1; o < 64; o <<= 1) v += __shfl_xor(v, o);
    return v;
}
__device__ __forceinline__ float wave_max(float v) {
#pragma unroll
    for (int o = 1; o < 64; o <<= 1) v = fmaxf(v, __shfl_xor(v, o));
    return v;
}
__device__ __forceinline__ float silu_f(float x) { return x / (1.f + __expf(-x)); }
__device__ __forceinline__ float row_rstd(const float* ssq, int row) {
    const f32x4* p = (const f32x4*)(ssq + (size_t)row * 16);
    const f32x4 a = p[0], b = p[1], c = p[2], d = p[3];
    const float s = ((a[0] + a[1]) + (a[2] + a[3])) + ((b[0] + b[1]) + (b[2] + b[3])) + ((c[0] + c[1]) + (c[2] + c[3])) + ((d[0] + d[1]) + (d[2] + d[3]));
    return rsqrtf(s * (1.f / 1024.f) + RMS_EPS);
}

using pg8::Unit; using pg8::cvt_pk_bf16;
struct EpiDnIn {
    static constexpr bool PERM = true, AFTER_DRAIN = false;
    bf16* proj; float* ba; const float* ssq;
    __device__ __forceinline__ void operator()(const f32x4 (&acc)[2][2][4][2], const Unit& u, int wr, int wc, int fr, int fq) const {
        const int row0 = u.pm * 256 + wr * 64 + fr;
        if (u.pn < 24) {
            const int col0 = u.pn * 256 + wc * 32 + 8 * fq;
#pragma unroll
            for (int ai = 0; ai < 2; ++ai)
#pragma unroll
                for (int m = 0; m < 4; ++m) { const int row = row0 + ai * 128 + m * 16; const float rs = row_rstd(ssq, row);
                    bf16* rowp = proj + (size_t)row * PROJ_LD + col0;
#pragma unroll
                    for (int bj = 0; bj < 2; ++bj) { const f32x4 v0 = acc[ai][bj][m][0] * rs, v1 = acc[ai][bj][m][1] * rs;
                        v4u w; w.x = cvt_pk_bf16(v0[0], v0[1]); w.y = cvt_pk_bf16(v0[2], v0[3]); w.z = cvt_pk_bf16(v1[0], v1[1]); w.w = cvt_pk_bf16(v1[2], v1[3]);
                        *(v4u*)(rowp + bj * 128) = w; } }
        } else if (wc == 0) {
#pragma unroll
            for (int ai = 0; ai < 2; ++ai)
#pragma unroll
                for (int m = 0; m < 4; ++m) { const int row = row0 + ai * 128 + m * 16; const float rs = row_rstd(ssq, row);
                    float* o = ba + (size_t)row * 32 + 8 * fq;
                    *(f32x4*)o = acc[ai][0][m][0] * rs; *(f32x4*)(o + 4) = acc[ai][0][m][1] * rs; }
        }
    }
};
struct EpiRes {
    static constexpr bool PERM = false, AFTER_DRAIN = false;
    bf16* XB; float* ssq; const float* bias;
    __device__ __forceinline__ void operator()(const f32x4 (&acc)[2][2][4][2], const Unit& u, int wr, int wc, int fr, int fq) const {
        const int row0 = u.pm * 256 + wr * 64 + fr, col0 = u.pn * 256 + wc * 32 + 4 * fq;
#pragma unroll
        for (int ai = 0; ai < 2; ++ai)
#pragma unroll
            for (int m = 0; m < 4; ++m) { const int row = row0 + ai * 128 + m * 16; float s = 0.f;
#pragma unroll
                for (int bj = 0; bj < 2; ++bj)
#pragma unroll
                    for (int n = 0; n < 2; ++n) { const int c = col0 + bj * 128 + n * 16; bf16* xp = XB + (size_t)row * DM + c;
                        const v2u xo = *(const v2u*)xp;
                        f32x4 x = (f32x4){bflo(xo.x), bfhi(xo.x), bflo(xo.y), bfhi(xo.y)} + acc[ai][bj][m][n];
                        if (bias) x = x + *(const f32x4*)(bias + c);
                        v2u w; w.x = cvt_pk_bf16(x[0], x[1]); w.y = cvt_pk_bf16(x[2], x[3]);
                        *(v2u*)xp = w;
                        const float r0 = bflo(w.x), r1 = bfhi(w.x), r2 = bflo(w.y), r3 = bfhi(w.y);
                        s += (r0 * r0 + r1 * r1) + (r2 * r2 + r3 * r3); }
                s += __shfl_xor(s, 16); s += __shfl_xor(s, 32);
                if (fq == 0) ssq[(size_t)row * 16 + u.pn * 4 + wc] = s; }
    }
};
struct EpiQkv {
    static constexpr bool PERM = true, AFTER_DRAIN = false;
    bf16 *Q, *KB; const float* ssq; const float* bias; float *okp, *oks;
    __device__ __forceinline__ void operator()(const f32x4 (&acc)[2][2][4][2], const Unit& u, int wr, int wc, int fr, int fq) const {
        const int row0 = u.pm * 256 + wr * 64 + fr, cw = wc * 32 + 8 * fq;
        const bool isq = u.pn < 4; const size_t kvsel = (u.pn == 5) ? 1 : 0;
        const float qs = isq ? 0.125f : 1.f;
#pragma unroll
        for (int ai = 0; ai < 2; ++ai)
#pragma unroll
            for (int m = 0; m < 4; ++m) { const int row = row0 + ai * 128 + m * 16; const float rs = row_rstd(ssq, row);
#pragma unroll
                for (int bj = 0; bj < 2; ++bj) { const int colk = bj * 128 + cw, gcol = u.pn * 256 + colk;
                    const f32x4 v0 = (acc[ai][bj][m][0] * rs + *(const f32x4*)(bias + gcol)) * qs, v1 = (acc[ai][bj][m][1] * rs + *(const f32x4*)(bias + gcol + 4)) * qs;
                    v4u w; w.x = cvt_pk_bf16(v0[0], v0[1]); w.y = cvt_pk_bf16(v0[2], v0[3]); w.z = cvt_pk_bf16(v1[0], v1[1]); w.w = cvt_pk_bf16(v1[2], v1[3]);
                    if (isq) *(v4u*)(Q + (size_t)row * DM + gcol) = w;
                    else {
                        *(v4u*)(KB + kvsel * KV_DELTA + (size_t)row * 256 + colk) = w;
                        if (row < TP) { const int b = row >> 11, pos = row & 2047;
                            if (pos >= 1920) { float* o = okp + kvsel * (O_VP - O_KP) + (size_t)(b * 128 + pos - 1920) * 256 + colk; *(f32x4*)o = v0; *(f32x4*)(o + 4) = v1; } }
                        else { float* o = oks + kvsel * (O_VS - O_KS) + (size_t)(row - TP) * 256 + colk; *(f32x4*)o = v0; *(f32x4*)(o + 4) = v1; } } } }
    }
};
struct EpiGu {
    static constexpr bool PERM = true, AFTER_DRAIN = false;
    bf16* act; const float* ssq;
    __device__ __forceinline__ void operator()(const f32x4 (&acc)[2][2][4][2], const Unit& u, int wr, int wc, int fr, int fq) const {
        const int row0 = u.pm * 256 + wr * 64 + fr, col0 = u.pn * 128 + wc * 32 + 8 * fq;
#pragma unroll
        for (int ai = 0; ai < 2; ++ai)
#pragma unroll
            for (int m = 0; m < 4; ++m) { const int row = row0 + ai * 128 + m * 16; const float rs = row_rstd(ssq, row);
                float r[8];
#pragma unroll
                for (int n = 0; n < 2; ++n)
#pragma unroll
                    for (int e = 0; e < 4; ++e) { const float g = acc[ai][0][m][n][e] * rs, uu = acc[ai][1][m][n][e] * rs; r[n * 4 + e] = silu_f(g) * uu; }
                v4u w; w.x = cvt_pk_bf16(r[0], r[1]); w.y = cvt_pk_bf16(r[2], r[3]); w.z = cvt_pk_bf16(r[4], r[5]); w.w = cvt_pk_bf16(r[6], r[7]);
                *(v4u*)(act + (size_t)row * DFF + col0) = w; }
    }
};

struct Args { const float* in[22]; float* out; unsigned char* ws; int ph_lo, ph_hi; };
typedef const __attribute__((address_space(4))) Args* CArgs;
__device__ __forceinline__ CArgs kargs() { CArgs p = (CArgs)__builtin_amdgcn_kernarg_segment_ptr(); asm volatile("" : "+s"(p)); return p; }

__device__ __forceinline__ void tr_item(const float* W, int K, int N, const float* nw, bf16* WT, int dst_row0, LAS float* scr, int k0, int n0, int lane) {
#pragma unroll 8
    for (int i = 0; i < 32; ++i) { const int kk = 2 * i + (lane >> 5); const float s = nw ? nw[k0 + kk] : 1.f;
        scr[kk * 33 + (lane & 31)] = W[(size_t)(k0 + kk) * N + n0 + (lane & 31)] * s; }
    LDS_WAIT(); asm volatile("" ::: "memory");
    const int c = lane & 7;
#pragma unroll
    for (int j = 0; j < 4; ++j) { const int n = (lane >> 3) + 8 * j; const LAS float* s = scr + (8 * c) * 33 + n;
        v4u o; o.x = pk2(s[0 * 33], s[1 * 33]); o.y = pk2(s[2 * 33], s[3 * 33]); o.z = pk2(s[4 * 33], s[5 * 33]); o.w = pk2(s[6 * 33], s[7 * 33]);
        *(v4u*)(WT + (size_t)(dst_row0 + n) * K + k0 + 8 * c) = o; }
    LDS_WAIT(); asm volatile("" ::: "memory");
}
__device__ __forceinline__ void tr_matrix_item(const float* W, int K, int N, const float* nw, bf16* WT, int gu, LAS float* scr, int r, int lane) {
    const int nblk = N / 32, kb = r / nblk, nb = r % nblk, k0 = 64 * kb, n0 = 32 * nb;
    int dr = n0;
    if (gu) dr = (n0 < DFF) ? (n0 / 128) * 256 + (n0 % 128) : ((n0 - DFF) / 128) * 256 + 128 + ((n0 - DFF) % 128);
    tr_item(W, K, N, nw, WT, dr, scr, k0, n0, lane);
}
__device__ __forceinline__ void phase_prologue(CArgs ap, LAS unsigned char* lds) {
    int tid_ = threadIdx.x; asm volatile("" : "+v"(tid_)); const int tid = tid_, lane = tid & 63, wave = __builtin_amdgcn_readfirstlane(tid >> 6);
    LAS float* scr = (LAS float*)(lds + wave * 16384);
    const int gw = blockIdx.x * NWAVES + wave, NGW = gridDim.x * NWAVES;
    unsigned char* ws = ap->ws;
    constexpr int I_IN = 16 * 193, I_OUT = 32 * 32, I_QKV = 16 * 48, I_O = 16 * 32, I_GU = 16 * 176, I_DN = 44 * 32;
    constexpr int NITEMS = 2 * I_IN + 2 * I_OUT + 2 * I_QKV + 2 * I_O + 4 * I_GU + 4 * I_DN;
    for (int it = gw; it < NITEMS; it += NGW) {
        int r = it;
        if (r < 2 * I_IN) { const int j = r / I_IN; r -= j * I_IN;
            tr_matrix_item(ap->in[9] + (size_t)j * DM * DN_IN, DM, DN_IN, ap->in[6] + (2 * j) * DM, (bf16*)(ws + WS_WIN) + (size_t)j * DN_INP * DM, 0, scr, r, lane); continue; }
        r -= 2 * I_IN;
        if (r < 2 * I_OUT) { const int j = r / I_OUT; r -= j * I_OUT;
            tr_matrix_item(ap->in[14] + (size_t)j * VAL_DIM * DM, VAL_DIM, DM, nullptr, (bf16*)(ws + WS_WOUT) + (size_t)j * DM * VAL_DIM, 0, scr, r, lane); continue; }
        r -= 2 * I_OUT;
        if (r < 2 * I_QKV) { const int j = r / I_QKV; r -= j * I_QKV;
            tr_matrix_item(ap->in[15] + (size_t)j * DM * QKV_N, DM, QKV_N, ap->in[6] + (2 * j + 1) * DM, (bf16*)(ws + WS_WQKV) + (size_t)j * QKV_N * DM, 0, scr, r, lane); continue; }
        r -= 2 * I_QKV;
        if (r < 2 * I_O) { const int j = r / I_O; r -= j * I_O;
            tr_matrix_item(ap->in[18] + (size_t)j * DM * DM, DM, DM, nullptr, (bf16*)(ws + WS_WO) + (size_t)j * DM * DM, 0, scr, r, lane); continue; }
        r -= 2 * I_O;
        if (r < 4 * I_GU) { const int i = r / I_GU; r -= i * I_GU;
            tr_matrix_item(ap->in[20] + (size_t)i * DM * GU_N, DM, GU_N, ap->in[7] + i * DM, (bf16*)(ws + WS_WGU) + (size_t)i * GU_N * DM, 1, scr, r, lane); continue; }
        r -= 4 * I_GU;
        { const int i = r / I_DN; r -= i * I_DN;
            tr_matrix_item(ap->in[21] + (size_t)i * DFF * DM, DFF, DM, nullptr, (bf16*)(ws + WS_WDOWN) + (size_t)i * DM * DFF, 0, scr, r, lane); }
    }
    for (int i = blockIdx.x * NTHREADS + tid; i < 2 * 28672; i += gridDim.x * NTHREADS) { const int j = i / 28672, o = i % 28672;
        *(v4u*)((bf16*)(ws + WS_WIN) + (size_t)j * DN_INP * DM + (size_t)DN_IN * DM + (size_t)o * 8) = (v4u){0u, 0u, 0u, 0u}; }
    bf16* XB = (bf16*)(ws + WS_XB); float* SSQ = (float*)(ws + WS_SSQ);
    for (int m = gw; m < T; m += NGW) {
        const float* src = (m < TP) ? ap->in[0] + (size_t)m * DM : ap->in[1] + (size_t)(m - TP) * DM;
        float s = 0.f;
#pragma unroll
        for (int j = 0; j < 4; ++j) { const f32x4 v = *((const f32x4*)src + lane + 64 * j);
            v2u w; w.x = pk2(v[0], v[1]); w.y = pk2(v[2], v[3]); *((v2u*)(XB + (size_t)m * DM) + lane + 64 * j) = w;
            const float r0 = bflo(w.x), r1 = bfhi(w.x), r2 = bflo(w.y), r3 = bfhi(w.y);
            s += (r0 * r0 + r1 * r1) + (r2 * r2 + r3 * r3); }
        s = wave_sum(s);
        if (lane < 16) SSQ[(size_t)m * 16 + lane] = (lane == 0) ? s : 0.f;
    }
}

__device__ __forceinline__ void phase_dn_post(CArgs ap, int j, int tstart) {
    int tid_ = threadIdx.x; asm volatile("" : "+v"(tid_)); const int tid = tid_, lane = tid & 63, wave = __builtin_amdgcn_readfirstlane(tid >> 6);
    const int gw = blockIdx.x * NWAVES + wave, NGW = gridDim.x * NWAVES;
    unsigned char* ws = ap->ws;
    const bf16* PROJ = (const bf16*)(ws + WS_PROJ); const float* BA = (const float*)(ws + WS_BA);
    float* QKV = (float*)(ws + WS_QKV) - (size_t)TP * CONV_DIM; float* BG = (float*)(ws + WS_BG);
    const float* cw = ap->in[10] + (size_t)j * 4 * CONV_DIM;
    const float* sconv = ap->in[2] + (size_t)j * NB_S * 3 * CONV_DIM;
    float* oconvp = ap->out + O_CONVP + (size_t)j * NB_P * 3 * CONV_DIM;
    float* oconvs = ap->out + O_CONVS + (size_t)j * NB_S * 3 * CONV_DIM;
    for (int task = tstart * 32 + gw; task < T * 32; task += NGW) {
        const int t = task >> 5, hc = task & 31, col0 = hc * 128 + 2 * lane;
        const bool prompt = t < TP; const int pos = prompt ? (t & 2047) : ((t - TP) & 3); const int b = prompt ? (t >> 11) : ((t - TP) >> 2);
        float y0 = 0.f, y1 = 0.f, u00 = 0.f, u01 = 0.f;
#pragma unroll
        for (int k = 0; k < 4; ++k) {
            float u0 = 0.f, u1 = 0.f;
            if (pos - k >= 0) { const unsigned w = *(const unsigned*)(PROJ + (size_t)(t - k) * PROJ_LD + col0); u0 = bflo(w); u1 = bfhi(w); }
            else if (!prompt) { const f32x2v v = *(const f32x2v*)(sconv + (size_t)(b * 3 + (3 + pos - k)) * CONV_DIM + col0); u0 = v[0]; u1 = v[1]; }
            const f32x2v wv = *(const f32x2v*)(cw + (size_t)(3 - k) * CONV_DIM + col0);
            y0 += u0 * wv[0]; y1 += u1 * wv[1];
            if (k == 0) { u00 = u0; u01 = u1; }
        }
        y0 = silu_f(y0); y1 = silu_f(y1);
        if (hc < 16) {
            const float ss = wave_sum(y0 * y0 + y1 * y1);
            float inv = rsqrtf(ss + L2_EPS); if (hc < 8) inv *= 0.08838834764831845f;
            y0 *= inv; y1 *= inv;
        }
        *(f32x2v*)(QKV + (size_t)t * CONV_DIM + col0) = (f32x2v){y0, y1};
        if (prompt) { if (pos >= SEQ - 3) *(f32x2v*)(oconvp + (size_t)(b * 3 + pos - (SEQ - 3)) * CONV_DIM + col0) = (f32x2v){u00, u01}; }
        else if (pos >= 1) *(f32x2v*)(oconvs + (size_t)(b * 3 + pos - 1) * CONV_DIM + col0) = (f32x2v){u00, u01};
        if (hc == 0 && lane < 32) {
            const int h = lane & 15; const float v = BA[(size_t)t * 32 + lane];
            float r;
            if (lane < 16) r = 1.f / (1.f + __expf(-v));
            else { const float x = v + ap->in[12][j * 16 + h]; const float sp = (x > 20.f) ? x : log1pf(__expf(x)); r = -__expf(ap->in[11][j * 16 + h]) * sp; }
            BG[(size_t)t * 32 + lane] = r;
        }
    }
}

__device__ __forceinline__ void phase_delta_rec(CArgs ap, int j, LAS unsigned char* lds, unsigned* ticket) {
    int tid_ = threadIdx.x; asm volatile("" : "+v"(tid_)); const int tid = tid_, lane = tid & 63, wave = __builtin_amdgcn_readfirstlane(tid >> 6);
    const int e = tid & 127, dq = tid >> 7;
    unsigned char* ws = ap->ws;
    const float* QKV = (const float*)(ws + WS_QKV) - (size_t)TP * CONV_DIM; const float* BG = (const float*)(ws + WS_BG); const bf16* PROJ = (const bf16*)(ws + WS_PROJ);
    bf16* OG = (bf16*)(ws + WS_OG);
    const float* nw = ap->in[13] + j * 128;
    constexpr int NTB = 16;
    LAS float* qs = (LAS float*)lds;
    LAS float* ks = qs + NTB * 128;
    LAS float* vs = ks + NTB * 128;
    LAS float* ob = vs + NTB * 128;
    LAS float* red = ob + NTB * 128;
    LAS float* red2 = red + 512;
    LAS float* ab = red2 + 512;
    LAS int* tk = (LAS int*)(ab + 32);
    for (;;) {
        if (tid == 0) *tk = (int)__hip_atomic_fetch_add(ticket, 1u, __ATOMIC_RELAXED, __HIP_MEMORY_SCOPE_AGENT);
        __syncthreads();
        const int unit = 128 + *tk;
        if (unit >= 128 + 2048) break;
        int b, h, L, t0; const float* s0 = nullptr; float* sout;
        if (unit < 128) { b = unit >> 4; h = unit & 15; L = SEQ; t0 = b * SEQ; sout = ap->out + O_DELTAP + ((size_t)(j * NB_P + b) * 16 + h) * 16384; }
        else { const int su = unit - 128; b = su >> 4; h = su & 15; L = DSEQ; t0 = TP + b * DSEQ;
            s0 = ap->in[3] + ((size_t)(j * NB_S + b) * 16 + h) * 16384; sout = ap->out + O_DELTAS + ((size_t)(j * NB_S + b) * 16 + h) * 16384; }
        const int hq = h >> 1;
        float S[32];
#pragma unroll
        for (int i = 0; i < 32; ++i) S[i] = s0 ? s0[(size_t)(32 * dq + i) * 128 + e] : 0.f;
        for (int tb = 0; tb < L; tb += NTB) {
            const int nb = (L - tb) < NTB ? (L - tb) : NTB;
            __syncthreads();
            for (int i = tid; i < nb * 384; i += NTHREADS) { const int tt = i / 384, rem = i % 384, which = rem >> 7, ee = rem & 127;
                const int col = (which == 0) ? hq * 128 + ee : (which == 1) ? 1024 + hq * 128 + ee : 2048 + h * 128 + ee;
                qs[which * (NTB * 128) + tt * 128 + ee] = QKV[(size_t)(t0 + tb + tt) * CONV_DIM + col]; }
            if (tid < nb) { ab[tid * 2] = __expf(BG[(size_t)(t0 + tb + tid) * 32 + 16 + h]); ab[tid * 2 + 1] = BG[(size_t)(t0 + tb + tid) * 32 + h]; }
            __syncthreads();
            for (int tt = 0; tt < nb; ++tt) {
                const float av = ab[tt * 2], bt = ab[tt * 2 + 1];
                float part = 0.f;
#pragma unroll
                for (int i = 0; i < 32; ++i) part += ks[tt * 128 + 32 * dq + i] * S[i];
                red[dq * 128 + e] = part;
                __syncthreads();
                const float kS = (red[e] + red[128 + e]) + (red[256 + e] + red[384 + e]);
                const float vv = bt * (vs[tt * 128 + e] - av * kS);
                float po = 0.f;
#pragma unroll
                for (int i = 0; i < 32; ++i) { S[i] = av * S[i] + ks[tt * 128 + 32 * dq + i] * vv; po += S[i] * qs[tt * 128 + 32 * dq + i]; }
                red2[dq * 128 + e] = po;
                __syncthreads();
                if (dq == 0) ob[tt * 128 + e] = (red2[e] + red2[128 + e]) + (red2[256 + e] + red2[384 + e]);
            }
            __syncthreads();
            for (int tt = wave; tt < nb; tt += NWAVES) {
                const float o0 = ob[tt * 128 + lane], o1 = ob[tt * 128 + 64 + lane];
                const float ss = wave_sum(o0 * o0 + o1 * o1);
                const float rs = rsqrtf(ss * (1.f / 128.f) + RMS_EPS);
                const size_t tok = (size_t)(t0 + tb + tt);
                const float z0 = bf2f(PROJ[tok * PROJ_LD + 4096 + h * 128 + lane]), z1 = bf2f(PROJ[tok * PROJ_LD + 4096 + h * 128 + 64 + lane]);
                OG[tok * VAL_DIM + h * 128 + lane] = (bf16)f2bf(o0 * rs * nw[lane] * silu_f(z0));
                OG[tok * VAL_DIM + h * 128 + 64 + lane] = (bf16)f2bf(o1 * rs * nw[64 + lane] * silu_f(z1));
            }
        }
#pragma unroll
        for (int i = 0; i < 32; ++i) sout[(size_t)(32 * dq + i) * 128 + e] = S[i];
        __syncthreads();
    }
}

__device__ __forceinline__ void phase_swa_attn(CArgs ap, int j, LAS unsigned char* lds) {
    int tid_ = threadIdx.x; asm volatile("" : "+v"(tid_)); const int tid = tid_, lane = tid & 63, wave = __builtin_amdgcn_readfirstlane(tid >> 6);
    const int gw = blockIdx.x * NWAVES + wave, NGW = gridDim.x * NWAVES;
    unsigned char* ws = ap->ws;
    const bf16* Q = (const bf16*)(ws + WS_Q); const bf16* KB = (const bf16*)(ws + WS_KB); const bf16* VB = (const bf16*)(ws + WS_VB);
    bf16* ATT = (bf16*)(ws + WS_ATT);
    const float* ck = ap->in[4] + (size_t)j * NB_S * 128 * 256; const float* cv = ap->in[5] + (size_t)j * NB_S * 128 * 256;
    const float* sinks = ap->in[17] + j * 16;
    LAS float* qs = (LAS float*)(lds + wave * 4096);
    LAS float* ps = qs + 256;
    for (int task = gw; task < T * 4; task += NGW) {
        const int t = task >> 2, kh = task & 3;
#pragma unroll
        for (int g = 0; g < 4; ++g) qs[g * 64 + lane] = bf2f(Q[(size_t)t * DM + (kh * 4 + g) * 64 + lane]);
        LDS_WAIT(); asm volatile("" ::: "memory");
        const bool prompt = t < TP; int nk, b = 0, l = 0;
        if (prompt) { const int pos = t & 2047; nk = (pos < 128 ? pos : 128) + 1; } else { const int r = t - TP; b = r >> 2; l = r & 3; nk = 129; }
        const float sl0 = exp2f(-0.5f * (float)(kh * 4 + 1)), sl1 = exp2f(-0.5f * (float)(kh * 4 + 2)), sl2 = exp2f(-0.5f * (float)(kh * 4 + 3)), sl3 = exp2f(-0.5f * (float)(kh * 4 + 4));
#pragma unroll 1
        for (int kb = 0; kb < 3; ++kb) {
            const int jj = kb * 64 + lane; const bool valid = jj < nk;
            float d0 = 0.f, d1 = 0.f, d2 = 0.f, d3 = 0.f;
            if (valid) {
                const int cj = l + jj;
                if (prompt || cj >= 128) {
                    const bf16* kp = prompt ? KB + (size_t)(t - (nk - 1) + jj) * 256 + kh * 64 : KB + (size_t)(TP + b * 4 + (cj - 128)) * 256 + kh * 64;
#pragma unroll 1
                    for (int d = 0; d < 64; d += 8) {
                        const v4u w = *(const v4u*)(kp + d);
                        const float kv[8] = {bflo(w.x), bfhi(w.x), bflo(w.y), bfhi(w.y), bflo(w.z), bfhi(w.z), bflo(w.w), bfhi(w.w)};
#pragma unroll
                        for (int i = 0; i < 8; ++i) { d0 += kv[i] * qs[d + i]; d1 += kv[i] * qs[64 + d + i]; d2 += kv[i] * qs[128 + d + i]; d3 += kv[i] * qs[192 + d + i]; }
                    }
                } else {
                    const float* kf = ck + (size_t)(b * 128 + cj) * 256 + kh * 64;
#pragma unroll 1
                    for (int d = 0; d < 64; d += 4) {
                        const f32x4 x = *(const f32x4*)(kf + d);
#pragma unroll
                        for (int i = 0; i < 4; ++i) { d0 += x[i] * qs[d + i]; d1 += x[i] * qs[64 + d + i]; d2 += x[i] * qs[128 + d + i]; d3 += x[i] * qs[192 + d + i]; }
                    }
                }
            }
            const float rel = (float)((nk - 1) - jj);
            const float NEG = -INFINITY;
            ps[jj] = valid ? d0 - sl0 * rel : NEG; ps[192 + jj] = valid ? d1 - sl1 * rel : NEG; ps[384 + jj] = valid ? d2 - sl2 * rel : NEG; ps[576 + jj] = valid ? d3 - sl3 * rel : NEG;
        }
        LDS_WAIT(); asm volatile("" ::: "memory");
#pragma unroll 1
        for (int g = 0; g < 4; ++g) {
            const float sk = sinks[kh * 4 + g];
            const float s0 = ps[g * 192 + lane], s1 = ps[g * 192 + 64 + lane], s2 = ps[g * 192 + 128 + lane];
            float m = wave_max(fmaxf(fmaxf(s0, s1), s2)); m = fmaxf(m, sk);
            const float p0 = __expf(s0 - m), p1 = __expf(s1 - m), p2 = __expf(s2 - m);
            const float den = wave_sum(p0 + p1 + p2) + __expf(sk - m); const float inv = 1.f / den;
            ps[g * 192 + lane] = p0 * inv; ps[g * 192 + 64 + lane] = p1 * inv; ps[g * 192 + 128 + lane] = p2 * inv;
        }
        LDS_WAIT(); asm volatile("" ::: "memory");
        float o0 = 0.f, o1 = 0.f, o2 = 0.f, o3 = 0.f;
        if (prompt) {
            const bf16* vp = VB + (size_t)(t - (nk - 1)) * 256 + kh * 64 + lane;
#pragma unroll 4
            for (int jj = 0; jj < nk; ++jj) { const float vv = bf2f(vp[(size_t)jj * 256]);
                o0 += ps[jj] * vv; o1 += ps[192 + jj] * vv; o2 += ps[384 + jj] * vv; o3 += ps[576 + jj] * vv; }
        } else {
#pragma unroll 4
            for (int jj = 0; jj < 129; ++jj) { const int cj = l + jj;
                const float vv = (cj < 128) ? cv[(size_t)(b * 128 + cj) * 256 + kh * 64 + lane] : bf2f(VB[(size_t)(TP + b * 4 + (cj - 128)) * 256 + kh * 64 + lane]);
                o0 += ps[jj] * vv; o1 += ps[192 + jj] * vv; o2 += ps[384 + jj] * vv; o3 += ps[576 + jj] * vv; }
        }
        bf16* op = ATT + (size_t)t * DM + kh * 256 + lane;
        op[0] = (bf16)f2bf(o0); op[64] = (bf16)f2bf(o1); op[128] = (bf16)f2bf(o2); op[192] = (bf16)f2bf(o3);
        LDS_WAIT(); asm volatile("" ::: "memory");
    }
}

__device__ __forceinline__ void phase_final(CArgs ap) {
    int tid_ = threadIdx.x; asm volatile("" : "+v"(tid_)); const int tid = tid_, lane = tid & 63, wave = __builtin_amdgcn_readfirstlane(tid >> 6);
    const int gw = blockIdx.x * NWAVES + wave, NGW = gridDim.x * NWAVES;
    const bf16* XB = (const bf16*)(ap->ws + WS_XB); const float* nw = ap->in[8];
    for (int m = gw; m < T; m += NGW) {
        f32x4 v[4]; float s = 0.f;
#pragma unroll
        for (int j = 0; j < 4; ++j) { const v2u w = *((const v2u*)(XB + (size_t)m * DM) + lane + 64 * j); v[j] = (f32x4){bflo(w.x), bfhi(w.x), bflo(w.y), bfhi(w.y)};
            s += (v[j][0] * v[j][0] + v[j][1] * v[j][1]) + (v[j][2] * v[j][2] + v[j][3] * v[j][3]); }
        const float rs = rsqrtf(wave_sum(s) * (1.f / 1024.f) + RMS_EPS);
        float* o = ap->out + (size_t)m * DM;
#pragma unroll
        for (int j = 0; j < 4; ++j) { const f32x4 w = *((const f32x4*)nw + lane + 64 * j); *((f32x4*)o + lane + 64 * j) = v[j] * rs * w; }
    }
}

constexpr int REC_WNEG = 0, REC_QG = 16384, REC_KGT = 32768, REC_AQK = 49152, REC_U = 57344, REC_BYTES = 73728, REC_STAGE = 57344;
typedef short bf16x8_t __attribute__((ext_vector_type(8)));

__device__ __forceinline__ int swz256(int row, int ch) { return row * 256 + ((ch ^ (row & 15)) << 4); }
__device__ __forceinline__ int swz128(int row, int ch) { return row * 128 + ((ch ^ (row & 7)) << 4); }

__device__ __forceinline__ void phase_dn_prep(CArgs ap, int j, LAS unsigned char* lds) {
    int tid_ = threadIdx.x; asm volatile("" : "+v"(tid_)); const int tid = tid_, lane = tid & 63, wave = __builtin_amdgcn_readfirstlane(tid >> 6);
    const int role = wave >> 1;
    unsigned char* ws0 = ap->ws;
    int bid_ = blockIdx.x; asm volatile("" : "+s"(bid_));
    for (int unit = bid_; unit < 2048; unit += gridDim.x) {
        const int b = unit >> 8, hq = (unit >> 5) & 7, n = unit & 31, trow0 = b * SEQ + n * 64;
        int cidx = tid & 127; asm volatile("" : "+v"(cidx));
        unsigned char* ws = ws0; asm volatile("" : "+s"(ws));
        const GAS bf16* PROJ = (const GAS bf16*)(ws + WS_PROJ); const GAS float* BA = (const GAS float*)(ws + WS_BA);
        GAS unsigned char* DREC = (GAS unsigned char*)(ws + WS_DREC); GAS float* EGL = (GAS float*)(ws + WS_EGL);
        const GAS float* cw = (const GAS float*)(ap->in[10] + (size_t)j * 4 * CONV_DIM);
        GAS float* oconvp = (GAS float*)(ap->out + O_CONVP + (size_t)j * NB_P * 3 * CONV_DIM);
        unsigned lb0 = 0u, lb1 = 32768u, lb2 = 65536u, lb3 = 98304u; asm volatile("" : "+v"(lb0), "+v"(lb1), "+v"(lb2), "+v"(lb3));
        LAS unsigned char* kb16 = lds + lb0;
        LAS unsigned char* qb16 = lds + lb0 + 16384;
        LAS float* k32 = (LAS float*)(lds + lb1);
        LAS float* bmt = (LAS float*)(lds + lb2);
        LAS float* Gs = (LAS float*)(lds + lb3);
        LAS float* Bs = Gs + 128;
        LAS float* rowss = Bs + 128;
        __syncthreads();
        if (wave < 2) {
            const int h = 2 * hq + wave; const size_t t = (size_t)(trow0 + lane);
            const float bv = BA[t * 32 + h], av = BA[t * 32 + 16 + h];
            const float x = av + ap->in[12][j * 16 + h]; const float sp = (x > 20.f) ? x : log1pf(__expf(x));
            float g = -__expf(ap->in[11][j * 16 + h]) * sp;
#pragma unroll
            for (int off = 1; off < 64; off <<= 1) { const float o = __shfl_up(g, off); if (lane >= off) g += o; }
            Gs[wave * 64 + lane] = g; Bs[wave * 64 + lane] = 1.f / (1.f + __expf(-bv));
        }
        const int col = (role == 0) ? hq * 128 + cidx : (role == 1) ? 1024 + hq * 128 + cidx : 2048 + (2 * hq + role - 2) * 128 + cidx;
        float val[64];
        {
            const float w0 = cw[col], w1 = cw[CONV_DIM + col], w2 = cw[2 * CONV_DIM + col], w3 = cw[3 * CONV_DIM + col];
            const GAS bf16* pp = PROJ + (size_t)trow0 * PROJ_LD + col;
            float um3 = 0.f, um2 = 0.f, um1 = 0.f;
            if (n > 0) { um3 = bf2f(*(pp - 3 * PROJ_LD)); um2 = bf2f(*(pp - 2 * PROJ_LD)); um1 = bf2f(*(pp - PROJ_LD)); }
#pragma unroll
            for (int c = 0; c < 64; ++c) {
                const float uc = bf2f(pp[(size_t)c * PROJ_LD]);
                val[c] = silu_f(w3 * uc + w2 * um1 + w1 * um2 + w0 * um3);
                um3 = um2; um2 = um1; um1 = uc;
                if (c >= 61 && n == 31) oconvp[(size_t)(b * 3 + c - 61) * CONV_DIM + col] = uc;
            }
        }
        if (role < 2) {
#pragma unroll
            for (int c = 0; c < 64; ++c) { const float s = wave_sum(val[c] * val[c]); if (lane == 0) rowss[(role * 2 + (wave & 1)) * 64 + c] = s; }
        }
        __syncthreads();
        if (role == 0) {
            GAS unsigned char* r0 = DREC + (size_t)((b * 16 + 2 * hq) * 32 + n) * REC_BYTES; GAS unsigned char* r1 = r0 + (size_t)32 * REC_BYTES;
            GAS bf16* qg0 = (GAS bf16*)(r0 + REC_QG); GAS bf16* qg1 = (GAS bf16*)(r1 + REC_QG);
#pragma unroll
            for (int c = 0; c < 64; ++c) {
                const float inv = rsqrtf(rowss[c] + rowss[64 + c] + L2_EPS) * 0.08838834764831845f;
                const float q = val[c] * inv;
                *(LAS bf16*)(qb16 + swz256(c, cidx >> 3) + (cidx & 7) * 2) = (bf16)f2bf(q);
                qg0[c * 128 + cidx] = (bf16)f2bf(q * __expf(Gs[c])); qg1[c * 128 + cidx] = (bf16)f2bf(q * __expf(Gs[64 + c]));
            }
        } else if (role == 1) {
            GAS unsigned char* r0 = DREC + (size_t)((b * 16 + 2 * hq) * 32 + n) * REC_BYTES; GAS unsigned char* r1 = r0 + (size_t)32 * REC_BYTES;
            const float gl0 = Gs[63], gl1 = Gs[127];
#pragma unroll
            for (int c = 0; c < 64; ++c) {
                const float inv = rsqrtf(rowss[128 + c] + rowss[192 + c] + L2_EPS);
                val[c] *= inv;
                *(LAS bf16*)(kb16 + swz256(c, cidx >> 3) + (cidx & 7) * 2) = (bf16)f2bf(val[c]);
                k32[c * 128 + cidx] = val[c];
            }
#pragma unroll
            for (int c8 = 0; c8 < 8; ++c8) {
                v4u w0, w1;
                w0.x = pk2(val[c8 * 8 + 0] * __expf(gl0 - Gs[c8 * 8 + 0]), val[c8 * 8 + 1] * __expf(gl0 - Gs[c8 * 8 + 1]));
                w0.y = pk2(val[c8 * 8 + 2] * __expf(gl0 - Gs[c8 * 8 + 2]), val[c8 * 8 + 3] * __expf(gl0 - Gs[c8 * 8 + 3]));
                w0.z = pk2(val[c8 * 8 + 4] * __expf(gl0 - Gs[c8 * 8 + 4]), val[c8 * 8 + 5] * __expf(gl0 - Gs[c8 * 8 + 5]));
                w0.w = pk2(val[c8 * 8 + 6] * __expf(gl0 - Gs[c8 * 8 + 6]), val[c8 * 8 + 7] * __expf(gl0 - Gs[c8 * 8 + 7]));
                w1.x = pk2(val[c8 * 8 + 0] * __expf(gl1 - Gs[64 + c8 * 8 + 0]), val[c8 * 8 + 1] * __expf(gl1 - Gs[64 + c8 * 8 + 1]));
                w1.y = pk2(val[c8 * 8 + 2] * __expf(gl1 - Gs[64 + c8 * 8 + 2]), val[c8 * 8 + 3] * __expf(gl1 - Gs[64 + c8 * 8 + 3]));
                w1.z = pk2(val[c8 * 8 + 4] * __expf(gl1 - Gs[64 + c8 * 8 + 4]), val[c8 * 8 + 5] * __expf(gl1 - Gs[64 + c8 * 8 + 5]));
                w1.w = pk2(val[c8 * 8 + 6] * __expf(gl1 - Gs[64 + c8 * 8 + 6]), val[c8 * 8 + 7] * __expf(gl1 - Gs[64 + c8 * 8 + 7]));
                *(GAS v4u*)(r0 + REC_KGT + cidx * 128 + c8 * 16) = w0; *(GAS v4u*)(r1 + REC_KGT + cidx * 128 + c8 * 16) = w1;
            }
            if (cidx == 0) { EGL[(b * 16 + 2 * hq) * 32 + n] = __expf(gl0); EGL[(b * 16 + 2 * hq + 1) * 32 + n] = __expf(gl1); }
        } else {
            const int hh = role - 2;
#pragma unroll
            for (int c = 0; c < 64; ++c) val[c] *= Bs[hh * 64 + c];
        }
        __syncthreads();
        {
            const int prod = wave >> 2, tr = wave & 3, fr = lane & 15, fq = lane >> 4;
            f32x4 acc[4];
#pragma unroll
            for (int tc = 0; tc < 4; ++tc) acc[tc] = (f32x4){0.f, 0.f, 0.f, 0.f};
            LAS unsigned char* bsrc = prod ? qb16 : kb16;
#pragma unroll
            for (int ks = 0; ks < 4; ++ks) {
                const bf16x8_t af = *(LAS bf16x8_t*)(kb16 + swz256(16 * tr + fr, ks * 4 + fq));
#pragma unroll
                for (int tc = 0; tc < 4; ++tc) { const bf16x8_t bfr = *(LAS bf16x8_t*)(bsrc + swz256(16 * tc + fr, ks * 4 + fq));
                    acc[tc] = __builtin_amdgcn_mfma_f32_16x16x32_bf16(af, bfr, acc[tc], 0, 0, 0); }
            }
            const int i0 = 16 * tr + 4 * fq;
#pragma unroll
            for (int hh = 0; hh < 2; ++hh) {
                GAS unsigned char* rec = DREC + (size_t)((b * 16 + 2 * hq + hh) * 32 + n) * REC_BYTES;
#pragma unroll
                for (int tc = 0; tc < 4; ++tc) { const int jc = 16 * tc + fr; const float gj = Gs[hh * 64 + jc];
                    float o[4];
#pragma unroll
                    for (int r = 0; r < 4; ++r) { const int i = i0 + r; const float gi = Gs[hh * 64 + i];
                        if (prod == 0) o[r] = (i > jc) ? Bs[hh * 64 + i] * acc[tc][r] * __expf(gi - gj) : 0.f;
                        else o[r] = (jc >= i) ? acc[tc][r] * __expf(gj - gi) : 0.f; }
                    if (prod == 0) *(LAS f32x4*)(bmt + hh * 4096 + jc * 64 + i0) = (f32x4){o[0], o[1], o[2], o[3]};
                    else { v2u w; w.x = pk2(o[0], o[1]); w.y = pk2(o[2], o[3]); *(GAS v2u*)(rec + REC_AQK + jc * 128 + i0 * 2) = w; } }
            }
        }
        __syncthreads();
        {
            const int hh = (role >= 2) ? role - 2 : role;
            if (role == 0) {
#pragma unroll
                for (int c = 0; c < 64; ++c) val[c] = k32[c * 128 + cidx] * Bs[c] * __expf(Gs[c]);
            } else if (role == 1) {
#pragma unroll
                for (int c = 0; c < 64; ++c) val[c] = val[c] * Bs[64 + c] * __expf(Gs[64 + c]);
            }
            const LAS float* bm = bmt + hh * 4096;
#pragma unroll
            for (int s = 0; s < 63; ++s) {
                const float xs = val[s];
#pragma unroll
                for (int cg = (s + 1) / 4; cg < 16; ++cg) { const f32x4 m = *(const LAS f32x4*)(bm + s * 64 + cg * 4);
#pragma unroll
                    for (int e = 0; e < 4; ++e) { const int c = cg * 4 + e; if (c > s) val[c] -= m[e] * xs; } }
            }
            GAS unsigned char* rec = DREC + (size_t)((b * 16 + 2 * hq + hh) * 32 + n) * REC_BYTES;
            if (role >= 2) { GAS bf16* U = (GAS bf16*)(rec + REC_U);
#pragma unroll
                for (int c = 0; c < 64; ++c) U[c * 128 + cidx] = (bf16)f2bf(val[c]);
            } else { GAS bf16* W = (GAS bf16*)(rec + REC_WNEG);
#pragma unroll
                for (int c = 0; c < 64; ++c) W[c * 128 + cidx] = (bf16)f2bf(-val[c]);
            }
        }
    }
    phase_dn_post(ap, j, TP);
}

constexpr int SC_STAGE0 = 0, SC_STAGE1 = REC_STAGE, SC_SCR = 2 * REC_STAGE, SC_RED = SC_SCR + 8 * 4096;
__device__ __forceinline__ int stage_dst(int q) {
    const int off = q * 16;
    if (off < REC_KGT) { const int base = off & ~16383, local = off & 16383; return base + swz256(local >> 8, (local >> 4) & 15); }
    const int base = (off < REC_AQK) ? REC_KGT : REC_AQK, local = off - base; return base + swz128(local >> 7, (local >> 4) & 7);
}
__device__ __forceinline__ float silu_fast(float x) { return x * __builtin_amdgcn_rcpf(1.f + __expf(-x)); }
__device__ __forceinline__ void stage_dma(const unsigned char* rec, LAS unsigned char* sb, int wave, int lane) {
#pragma unroll
    for (int i = 0; i < 7; ++i) { const int kb = i * 8 + wave;
        __builtin_amdgcn_global_load_lds((const unsigned*)(rec + stage_dst(kb * 64 + lane)), (LAS unsigned*)(sb + kb * 1024), 16, 0, 0); }
}
#define SCAN_FINALIZE(nf) do { \
    _Pragma("unroll") for (int tc = 0; tc < 4; ++tc) { const int c = 16 * tc + fr; float tot = 0.f; \
        _Pragma("unroll") for (int w8 = 0; w8 < 8; ++w8) tot += red[((nf) & 1) * 512 + w8 * 64 + c]; \
        const float rs = rsqrtf(tot * (1.f / 128.f) + RMS_EPS); \
        const size_t tok = (size_t)(b * SEQ + (nf) * 64 + c); \
        v2u ow; ow.x = pk2(bflo(ogp[tc].x) * rs, bfhi(ogp[tc].x) * rs); ow.y = pk2(bflo(ogp[tc].y) * rs, bfhi(ogp[tc].y) * rs); \
        *(v2u*)(OG + tok * VAL_DIM + h * 128 + e0 + 4 * fq) = ow; } } while (0)
__device__ __forceinline__ void scan_unit(CArgs ap, int j, int unit, LAS unsigned char* lds) {
    int tid_ = threadIdx.x; asm volatile("" : "+v"(tid_)); const int tid = tid_, lane = tid & 63, wave = __builtin_amdgcn_readfirstlane(tid >> 6);
    const int fr = lane & 15, fq = lane >> 4, e0 = 16 * wave;
    const int b = unit >> 4, h = unit & 15;
    unsigned char* ws = ap->ws;
    const unsigned char* rec0 = ws + WS_DREC + (size_t)(unit * 32) * REC_BYTES;
    const float* EGL = (const float*)(ws + WS_EGL) + unit * 32;
    const bf16* PROJ = (const bf16*)(ws + WS_PROJ); bf16* OG = (bf16*)(ws + WS_OG);
    const float* nw = ap->in[13] + j * 128;
    LAS unsigned char* scr = lds + SC_SCR + wave * 4096;
    LAS float* red = (LAS float*)(lds + SC_RED);
    f32x4 Sacc[8];
#pragma unroll
    for (int dt = 0; dt < 8; ++dt) Sacc[dt] = (f32x4){0.f, 0.f, 0.f, 0.f};
    const f32x4 nwv = *(const f32x4*)(nw + e0 + 4 * fq);
    const size_t uoff = (size_t)fr * 256 + (e0 + 4 * fq) * 2;
    const bf16* zbase = PROJ + (size_t)(b * SEQ + fr) * PROJ_LD + 4096 + h * 128 + e0 + 4 * fq;
    __syncthreads();
    stage_dma(rec0, lds + SC_STAGE0, wave, lane);
    v2u un[4], zn[4]; float egln = EGL[0];
#pragma unroll
    for (int tc = 0; tc < 4; ++tc) { un[tc] = *(const v2u*)(rec0 + REC_U + uoff + tc * 4096); zn[tc] = *(const v2u*)(zbase + (size_t)(16 * tc) * PROJ_LD); }
    v2u ogp[4];
#pragma unroll
    for (int tc = 0; tc < 4; ++tc) ogp[tc] = (v2u){0u, 0u};
#pragma unroll 1
    for (int n = 0; n < 32; ++n) {
        LAS unsigned char* sb = lds + ((n & 1) ? SC_STAGE1 : SC_STAGE0);
        LAS unsigned char* sbn = lds + ((n & 1) ? SC_STAGE0 : SC_STAGE1);
        const int nn = (n + 1 < 32) ? n + 1 : 31;
        const unsigned char* recn = rec0 + (size_t)nn * REC_BYTES;
        asm volatile("s_waitcnt vmcnt(0) lgkmcnt(0)" ::: "memory");
        __syncthreads();
        f32x4 accu[4]; v2u zc[4]; float egl = egln;
#pragma unroll
        for (int tc = 0; tc < 4; ++tc) { accu[tc] = (f32x4){bflo(un[tc].x), bfhi(un[tc].x), bflo(un[tc].y), bfhi(un[tc].y)}; zc[tc] = zn[tc];
            asm volatile("" : "+v"(zc[tc].x), "+v"(zc[tc].y)); }
        asm volatile("" : "+v"(egl));
        if (n > 0) SCAN_FINALIZE(n - 1);
        stage_dma(recn, sbn, wave, lane);
#pragma unroll
        for (int tc = 0; tc < 4; ++tc) { un[tc] = *(const v2u*)(recn + REC_U + uoff + tc * 4096); zn[tc] = *(const v2u*)(zbase + (size_t)(nn * 64 + 16 * tc) * PROJ_LD); }
        egln = EGL[nn];
#pragma unroll
        for (int dt = 0; dt < 8; ++dt)
#pragma unroll
            for (int r = 0; r < 4; ++r) { const int el = 4 * fq + r, d = 16 * dt + fr;
                *(LAS bf16*)(scr + swz256(el, d >> 3) + (d & 7) * 2) = (bf16)f2bf(Sacc[dt][r]); }
#define CB() asm volatile("" ::: "memory")
#define LD256(dst, region, row0) do { _Pragma("unroll") for (int ks = 0; ks < 4; ++ks) dst[ks] = *(LAS bf16x8_t*)(sb + (region) + swz256((row0) + fr, ks * 4 + fq)); } while (0)
#define LD128x2(dst, region, row0) do { _Pragma("unroll") for (int k4 = 0; k4 < 4; ++k4) dst[k4] = *(LAS bf16x8_t*)(sb + (region) + swz128((row0) + 16 * (k4 >> 1) + fr, (k4 & 1) * 4 + fq)); } while (0)
#define MM4(acc, A, B) do { _Pragma("unroll") for (int ks = 0; ks < 4; ++ks) acc = __builtin_amdgcn_mfma_f32_16x16x32_bf16(A[ks], B[ks], acc, 0, 0, 0); } while (0)
#define MM2x2(acc0, acc1, A, B) do { acc0 = __builtin_amdgcn_mfma_f32_16x16x32_bf16(A[0], B[0], acc0, 0, 0, 0); acc0 = __builtin_amdgcn_mfma_f32_16x16x32_bf16(A[1], B[1], acc0, 0, 0, 0); \
        acc1 = __builtin_amdgcn_mfma_f32_16x16x32_bf16(A[0], B[2], acc1, 0, 0, 0); acc1 = __builtin_amdgcn_mfma_f32_16x16x32_bf16(A[1], B[3], acc1, 0, 0, 0); } while (0)
        bf16x8_t Sa[4], Ua[2], fA[4], fB[4], fC[4];
        f32x4 acco[4];
#pragma unroll
        for (int tc = 0; tc < 4; ++tc) acco[tc] = (f32x4){0.f, 0.f, 0.f, 0.f};
        LD256(fA, REC_WNEG, 0);
#pragma unroll
        for (int ks = 0; ks < 4; ++ks) Sa[ks] = *(LAS bf16x8_t*)(scr + swz256(fr, ks * 4 + fq));
        LD256(fB, REC_WNEG, 16); CB();
        MM4(accu[0], Sa, fA); LD256(fC, REC_WNEG, 32); CB();
        MM4(accu[1], Sa, fB); LD256(fA, REC_WNEG, 48); CB();
        MM4(accu[2], Sa, fC); LD256(fB, REC_QG, 0); CB();
        MM4(accu[3], Sa, fA); LD256(fC, REC_QG, 16); CB();
#pragma unroll
        for (int tc = 0; tc < 4; ++tc)
#pragma unroll
            for (int r = 0; r < 4; ++r) { const int el = 4 * fq + r, c = 16 * tc + fr;
                *(LAS bf16*)(scr + swz128(el, c >> 3) + (c & 7) * 2) = (bf16)f2bf(accu[tc][r]); }
        MM4(acco[0], Sa, fB); LD256(fA, REC_QG, 32); CB();
#pragma unroll
        for (int k2 = 0; k2 < 2; ++k2) Ua[k2] = *(LAS bf16x8_t*)(scr + swz128(fr, k2 * 4 + fq));
        MM4(acco[1], Sa, fC); LD256(fB, REC_QG, 48); CB();
        MM4(acco[2], Sa, fA); LD128x2(fC, REC_AQK, 0); CB();
        MM4(acco[3], Sa, fB); LD128x2(fA, REC_AQK, 32); CB();
        MM2x2(acco[0], acco[1], Ua, fC); LD128x2(fB, REC_KGT, 0); CB();
        MM2x2(acco[2], acco[3], Ua, fA); LD128x2(fC, REC_KGT, 32); CB();
#pragma unroll
        for (int dt = 0; dt < 8; ++dt) Sacc[dt] = Sacc[dt] * egl;
        MM2x2(Sacc[0], Sacc[1], Ua, fB); LD128x2(fA, REC_KGT, 64); CB();
        MM2x2(Sacc[2], Sacc[3], Ua, fC); LD128x2(fB, REC_KGT, 96); CB();
        MM2x2(Sacc[4], Sacc[5], Ua, fA);
        MM2x2(Sacc[6], Sacc[7], Ua, fB);
#undef CB
#undef LD256
#undef LD128x2
#undef MM4
#undef MM2x2
#pragma unroll
        for (int tc = 0; tc < 4; ++tc) { float p = (acco[tc][0] * acco[tc][0] + acco[tc][1] * acco[tc][1]) + (acco[tc][2] * acco[tc][2] + acco[tc][3] * acco[tc][3]);
            p += __shfl_xor(p, 16); p += __shfl_xor(p, 32);
            if (fq == 0) red[(n & 1) * 512 + wave * 64 + 16 * tc + fr] = p; }
#pragma unroll
        for (int tc = 0; tc < 4; ++tc) { const float z0 = bflo(zc[tc].x), z1 = bfhi(zc[tc].x), z2 = bflo(zc[tc].y), z3 = bfhi(zc[tc].y);
            ogp[tc].x = pk2(acco[tc][0] * nwv[0] * silu_fast(z0), acco[tc][1] * nwv[1] * silu_fast(z1)); ogp[tc].y = pk2(acco[tc][2] * nwv[2] * silu_fast(z2), acco[tc][3] * nwv[3] * silu_fast(z3)); }
    }
    asm volatile("s_waitcnt vmcnt(0) lgkmcnt(0)" ::: "memory");
    __syncthreads();
    SCAN_FINALIZE(31);
    asm volatile("s_waitcnt vmcnt(0)" ::: "memory");
    float* sout = ap->out + O_DELTAP + ((size_t)(j * NB_P + b) * 16 + h) * 16384;
#pragma unroll
    for (int dt = 0; dt < 8; ++dt) *(f32x4*)(sout + (size_t)(16 * dt + fr) * 128 + e0 + 4 * fq) = Sacc[dt];
    __syncthreads();
}
__device__ __forceinline__ void phase_dn_scan(CArgs ap, int j, LAS unsigned char* lds) {
    const int G = gridDim.x, half = G >> 1; int bid_ = blockIdx.x; asm volatile("" : "+s"(bid_));
#ifndef REP_SCANU
#define REP_SCANU 1
#endif
#ifndef REP_SREC
#define REP_SREC 1
#endif
    if (bid_ < half) { for (int rep = 0; rep < REP_SCANU; ++rep) for (int unit = bid_; unit < 128; unit += half) scan_unit(ap, j, unit, lds); }
    phase_delta_rec(ap, j, lds, (unsigned*)(ap->ws + WS_CTL) + CW_TICKET + 64 * j);
}

constexpr int P2_KIMG = 0, P2_QIMG = 16384, P2_KT = 32768, P2_VT = 49152, P2_LROW = 81920, P2_TB = 98304, P2_TR = 114688, P2_SM = 131072, P2_LDIAG = 135168, P2_PS = 143360;
__device__ __forceinline__ void phase_dn_prep2(CArgs ap, int j, LAS unsigned char* lds) {
    int tid_ = threadIdx.x; asm volatile("" : "+v"(tid_)); const int tid0 = tid_, wave = __builtin_amdgcn_readfirstlane(tid0 >> 6);
    const int role = wave >> 1;
    unsigned char* ws0 = ap->ws;
    int bid_ = blockIdx.x; asm volatile("" : "+s"(bid_));
    for (int unit = bid_; unit < 2048; unit += gridDim.x) {
        const int b = unit >> 8, hq = (unit >> 5) & 7, n = unit & 31, trow0 = b * SEQ + n * 64;
        int tid = tid0; asm volatile("" : "+v"(tid));
        const int lane = tid & 63, fr = lane & 15, fq = lane >> 4, cidx = tid & 127;
        unsigned char* ws = ws0; asm volatile("" : "+s"(ws));
        const GAS bf16* PROJ = (const GAS bf16*)(ws + WS_PROJ); const GAS float* BA = (const GAS float*)(ws + WS_BA);
        GAS unsigned char* DREC = (GAS unsigned char*)(ws + WS_DREC); GAS float* EGL = (GAS float*)(ws + WS_EGL);
        const GAS float* cw = (const GAS float*)(ap->in[10] + (size_t)j * 4 * CONV_DIM);
        GAS float* oconvp = (GAS float*)(ap->out + O_CONVP + (size_t)j * NB_P * 3 * CONV_DIM);
        GAS unsigned char* rec0 = DREC + (size_t)((b * 16 + 2 * hq) * 32 + n) * REC_BYTES;
        unsigned lb0 = 0u, lb1 = 32768u, lb2 = 81920u, lb3 = 131072u; asm volatile("" : "+v"(lb0), "+v"(lb1), "+v"(lb2), "+v"(lb3));
        LAS unsigned char* L0 = lds + lb0;
        LAS unsigned char* L1 = lds + lb1;
        LAS unsigned char* L2 = lds + lb2;
        LAS unsigned char* L3 = lds + lb3;
        LAS float* SM = (LAS float*)L3;
        __syncthreads();
        if (wave < 2) {
            const int h = 2 * hq + wave; const size_t t = (size_t)(trow0 + lane);
            const float bv = BA[t * 32 + h], av = BA[t * 32 + 16 + h];
            const float x = av + ap->in[12][j * 16 + h]; const float sp = (x > 20.f) ? x : log1pf(__expf(x));
            float g = -__expf(ap->in[11][j * 16 + h]) * sp;
#pragma unroll
            for (int off = 1; off < 64; off <<= 1) { const float o = __shfl_up(g, off); if (lane >= off) g += o; }
            SM[wave * 64 + lane] = g; SM[128 + wave * 64 + lane] = 1.f / (1.f + __expf(-bv));
        }
        *(LAS v4u*)(L3 + (P2_PS - P2_SM) + wave * 2048 + lane * 32) = (v4u){0u, 0u, 0u, 0u};
        *(LAS v4u*)(L3 + (P2_PS - P2_SM) + wave * 2048 + lane * 32 + 16) = (v4u){0u, 0u, 0u, 0u};
        {
            const int col = (role == 0) ? hq * 128 + cidx : (role == 1) ? 1024 + hq * 128 + cidx : 2048 + (2 * hq + role - 2) * 128 + cidx;
            float val[64];
            const float w0 = cw[col], w1 = cw[CONV_DIM + col], w2 = cw[2 * CONV_DIM + col], w3 = cw[3 * CONV_DIM + col];
            const GAS bf16* pp = PROJ + (size_t)trow0 * PROJ_LD + col;
            float um3 = 0.f, um2 = 0.f, um1 = 0.f;
            if (n > 0) { um3 = bf2f(*(pp - 3 * PROJ_LD)); um2 = bf2f(*(pp - 2 * PROJ_LD)); um1 = bf2f(*(pp - PROJ_LD)); }
#pragma unroll
            for (int c = 0; c < 64; ++c) {
                const float uc = bf2f(pp[(size_t)c * PROJ_LD]);
                val[c] = silu_fast(w3 * uc + w2 * um1 + w1 * um2 + w0 * um3);
                um3 = um2; um2 = um1; um1 = uc;
                if (c >= 61 && n == 31) oconvp[(size_t)(b * 3 + c - 61) * CONV_DIM + col] = uc;
            }
            if (role < 2) {
                LAS unsigned char* img = L0 + (role == 0 ? 16384 : 0);
#pragma unroll
                for (int c = 0; c < 64; ++c) *(LAS bf16*)(img + swz256(c, cidx >> 3) + (cidx & 7) * 2) = (bf16)f2bf(val[c]);
            }
            if (role >= 1) {
                LAS unsigned char* img = L1 + (role - 1) * 16384;
#pragma unroll
                for (int ch = 0; ch < 8; ++ch) { v4u w; w.x = pk2(val[8 * ch], val[8 * ch + 1]); w.y = pk2(val[8 * ch + 2], val[8 * ch + 3]); w.z = pk2(val[8 * ch + 4], val[8 * ch + 5]); w.w = pk2(val[8 * ch + 6], val[8 * ch + 7]);
                    *(LAS v4u*)(img + swz128(cidx, ch)) = w; }
            }
        }
        __syncthreads();
        f32x4 acc[4];
        {
            const int tr = wave & 3; const bool kq = wave >= 4;
            f32x4 accq = (f32x4){0.f, 0.f, 0.f, 0.f};
#pragma unroll
            for (int tc = 0; tc < 4; ++tc) acc[tc] = (f32x4){0.f, 0.f, 0.f, 0.f};
#pragma unroll
            for (int ks = 0; ks < 4; ++ks) {
                const bf16x8_t af = *(LAS bf16x8_t*)(L0 + swz256(16 * tr + fr, ks * 4 + fq));
                if (kq) { const bf16x8_t qf = *(LAS bf16x8_t*)(L0 + 16384 + swz256(16 * tr + fr, ks * 4 + fq)); accq = __builtin_amdgcn_mfma_f32_16x16x32_bf16(qf, qf, accq, 0, 0, 0); }
#pragma unroll
                for (int tc = 0; tc < 4; ++tc) { const bf16x8_t bfr = *(LAS bf16x8_t*)(L0 + (kq ? 16384 : 0) + swz256(16 * tc + fr, ks * 4 + fq));
                    acc[tc] = __builtin_amdgcn_mfma_f32_16x16x32_bf16(af, bfr, acc[tc], 0, 0, 0); }
            }
            const f32x4 dsrc = kq ? accq : (tr == 0 ? acc[0] : tr == 1 ? acc[1] : tr == 2 ? acc[2] : acc[3]);
            const int rsel = fr & 3; const float dv = rsel == 0 ? dsrc[0] : rsel == 1 ? dsrc[1] : rsel == 2 ? dsrc[2] : dsrc[3];
            if (fq == (fr >> 2)) SM[(kq ? 320 : 256) + 16 * tr + fr] = dv;
        }
        __syncthreads();
        if (tid < 128) { const int hh = tid >> 6, c = tid & 63;
            const float rk = rsqrtf(SM[256 + c] + L2_EPS), rq = rsqrtf(SM[320 + c] + L2_EPS) * 0.08838834764831845f;
            const float G = SM[hh * 64 + c], Gl = SM[hh * 64 + 63], be = SM[128 + hh * 64 + c];
            SM[384 + hh * 64 + c] = rk * be * __expf(G); SM[512 + hh * 64 + c] = rk * __expf(Gl - G); SM[640 + hh * 64 + c] = rq * __expf(G);
            if (c == 63) EGL[(b * 16 + 2 * hq + hh) * 32 + n] = __expf(Gl);
        }
        {
            const int tr = wave & 3; const bool kq = wave >= 4; const int i0 = 16 * tr + 4 * fq;
#pragma unroll
            for (int hh = 0; hh < 2; ++hh) {
#pragma unroll
                for (int tc = 0; tc < 4; ++tc) { const int jc = 16 * tc + fr; const float gj = SM[hh * 64 + jc];
                    float o[4];
                    if (!kq) { const float rkj = rsqrtf(SM[256 + jc] + L2_EPS);
#pragma unroll
                        for (int r = 0; r < 4; ++r) { const int i = i0 + r; o[r] = (i > jc) ? SM[128 + hh * 64 + i] * rsqrtf(SM[256 + i] + L2_EPS) * rkj * acc[tc][r] * __expf(SM[hh * 64 + i] - gj) : 0.f;
                            *(LAS bf16*)(L2 + hh * 8192 + swz128(i, jc >> 3) + (jc & 7) * 2) = (bf16)f2bf(o[r]); }
                        if (tc == tr) *(LAS f32x4*)(L3 + (P2_LDIAG - P2_SM) + ((hh * 4 + tr) * 256 + fr * 16 + 4 * fq) * 4) = (f32x4){o[0], o[1], o[2], o[3]};
                    } else { const float rqj = rsqrtf(SM[320 + jc] + L2_EPS) * 0.08838834764831845f;
#pragma unroll
                        for (int r = 0; r < 4; ++r) { const int i = i0 + r; o[r] = (jc >= i) ? rqj * rsqrtf(SM[256 + i] + L2_EPS) * acc[tc][r] * __expf(gj - SM[hh * 64 + i]) : 0.f; }
                        v2u w; w.x = pk2(o[0], o[1]); w.y = pk2(o[2], o[3]); *(GAS v2u*)(rec0 + (size_t)hh * 32 * REC_BYTES + REC_AQK + jc * 128 + i0 * 2) = w; }
                }
            }
        }
        __syncthreads();
#pragma unroll
        for (int it = 0; it < 2; ++it) { const int q = tid + 512 * it, c = q >> 4, ch = q & 15;
            const v4u w = *(LAS v4u*)(L0 + 16384 + swz256(c, ch));
#pragma unroll
            for (int hh = 0; hh < 2; ++hh) { const float f = SM[640 + hh * 64 + c];
                v4u o; o.x = pk2(bflo(w.x) * f, bfhi(w.x) * f); o.y = pk2(bflo(w.y) * f, bfhi(w.y) * f); o.z = pk2(bflo(w.z) * f, bfhi(w.z) * f); o.w = pk2(bflo(w.w) * f, bfhi(w.w) * f);
                *(GAS v4u*)(rec0 + (size_t)hh * 32 * REC_BYTES + REC_QG + c * 256 + ch * 16) = o; } }
#pragma unroll
        for (int it = 0; it < 2; ++it) { const int q = tid + 512 * it, d = q >> 3, ch = q & 7;
            const v4u w = *(LAS v4u*)(L1 + swz128(d, ch));
#pragma unroll
            for (int hh = 0; hh < 2; ++hh) { const LAS float* kp = SM + 512 + hh * 64 + 8 * ch;
                v4u o; o.x = pk2(bflo(w.x) * kp[0], bfhi(w.x) * kp[1]); o.y = pk2(bflo(w.y) * kp[2], bfhi(w.y) * kp[3]); o.z = pk2(bflo(w.z) * kp[4], bfhi(w.z) * kp[5]); o.w = pk2(bflo(w.w) * kp[6], bfhi(w.w) * kp[7]);
                *(GAS v4u*)(rec0 + (size_t)hh * 32 * REC_BYTES + REC_KGT + d * 128 + ch * 16) = o; } }
        __syncthreads();
        {
            const int hh = wave >> 2, i = wave & 3;
            LAS unsigned char* Trow = L0 + hh * 8192; LAS unsigned char* TT = L0 + 16384 + hh * 8192;
            LAS unsigned char* Tb = L2 + 16384 + hh * 8192; LAS unsigned char* Tr = L2 + 32768 + hh * 8192;
            const v4u z4 = (v4u){0u, 0u, 0u, 0u};
            { const int row = 16 * i + (lane >> 2), c0 = (lane & 3) * 2;
              *(LAS v4u*)(Trow + swz128(row, c0)) = z4; *(LAS v4u*)(Trow + swz128(row, c0 + 1)) = z4;
              *(LAS v4u*)(Tb + swz128(row, c0)) = z4; *(LAS v4u*)(Tb + swz128(row, c0 + 1)) = z4;
              *(LAS v4u*)(Tr + swz128(row, c0)) = z4; *(LAS v4u*)(Tr + swz128(row, c0 + 1)) = z4;
              *(LAS v4u*)(TT + swz128(lane, 2 * i)) = z4; *(LAS v4u*)(TT + swz128(lane, 2 * i + 1)) = z4; }
            if (lane < 16) {
                const int jcol = lane; const LAS float* Ld = (const LAS float*)(L3 + (P2_LDIAG - P2_SM)) + (hh * 4 + i) * 256;
                float x[16];
#pragma unroll
                for (int r = 0; r < 16; ++r) x[r] = (r == jcol) ? 1.f : 0.f;
#pragma unroll
                for (int s = 0; s < 15; ++s) {
                    const float xs = x[s];
#pragma unroll
                    for (int cg = (s + 1) / 4; cg < 4; ++cg) { const f32x4 m = *(const LAS f32x4*)(Ld + s * 16 + cg * 4);
#pragma unroll
                        for (int e = 0; e < 4; ++e) { const int c = cg * 4 + e; if (c > s) x[c] -= m[e] * xs; } }
                }
                const int gc = 16 * i + jcol; const float be = SM[128 + hh * 64 + gc], rho = SM[384 + hh * 64 + gc];
#pragma unroll
                for (int r = 0; r < 16; ++r) { const int grow = 16 * i + r; const int off = swz128(grow, gc >> 3) + (gc & 7) * 2;
                    *(LAS bf16*)(Trow + off) = (bf16)f2bf(x[r]); *(LAS bf16*)(Tb + off) = (bf16)f2bf(x[r] * be); *(LAS bf16*)(Tr + off) = (bf16)f2bf(x[r] * rho); }
                v4u t0, t1; t0.x = pk2(x[0], x[1]); t0.y = pk2(x[2], x[3]); t0.z = pk2(x[4], x[5]); t0.w = pk2(x[6], x[7]); t1.x = pk2(x[8], x[9]); t1.y = pk2(x[10], x[11]); t1.z = pk2(x[12], x[13]); t1.w = pk2(x[14], x[15]);
                *(LAS v4u*)(TT + swz128(gc, 2 * i)) = t0; *(LAS v4u*)(TT + swz128(gc, 2 * i + 1)) = t1;
            }
        }
        __syncthreads();
#pragma unroll 1
        for (int lev = 1; lev < 4; ++lev) {
            const int nb = 4 - lev;
            if (wave < 2 * nb) {
                const int hh = wave / nb, i = lev + wave % nb, jb = i - lev;
                LAS unsigned char* Trow = L0 + hh * 8192; LAS unsigned char* TT = L0 + 16384 + hh * 8192;
                LAS unsigned char* Lrow = L2 + hh * 8192; LAS unsigned char* Tb = L2 + 16384 + hh * 8192; LAS unsigned char* Tr = L2 + 32768 + hh * 8192;
                LAS unsigned char* PS = L3 + (P2_PS - P2_SM) + wave * 2048 + (i & 1) * 1024;
                f32x4 p = (f32x4){0.f, 0.f, 0.f, 0.f};
#pragma unroll
                for (int ks = 0; ks < 2; ++ks) { const bf16x8_t la = *(LAS bf16x8_t*)(Lrow + swz128(16 * i + fr, ks * 4 + fq)), tb = *(LAS bf16x8_t*)(TT + swz128(16 * jb + fr, ks * 4 + fq));
                    p = __builtin_amdgcn_mfma_f32_16x16x32_bf16(la, tb, p, 0, 0, 0); }
                { v2u w; w.x = pk2(p[0], p[1]); w.y = pk2(p[2], p[3]); *(LAS v2u*)(PS + fr * 64 + (16 * (i & 1) + 4 * fq) * 2) = w; }
                const bf16x8_t ta = *(LAS bf16x8_t*)(Trow + swz128(16 * i + fr, (i >> 1) * 4 + fq)), pb = *(LAS bf16x8_t*)(PS + fr * 64 + fq * 16);
                const f32x4 t = __builtin_amdgcn_mfma_f32_16x16x32_bf16(ta, pb, (f32x4){0.f, 0.f, 0.f, 0.f}, 0, 0, 0);
                const int gc = 16 * jb + fr; const float be = SM[128 + hh * 64 + gc], rho = SM[384 + hh * 64 + gc];
#pragma unroll
                for (int r = 0; r < 4; ++r) { const int grow = 16 * i + 4 * fq + r; const int off = swz128(grow, gc >> 3) + (gc & 7) * 2; const float v = -t[r];
                    *(LAS bf16*)(Trow + off) = (bf16)f2bf(v); *(LAS bf16*)(Tb + off) = (bf16)f2bf(v * be); *(LAS bf16*)(Tr + off) = (bf16)f2bf(v * rho); }
                { v2u w; w.x = pk2(-t[0], -t[1]); w.y = pk2(-t[2], -t[3]); const int s0 = 16 * i + 4 * fq; *(LAS v2u*)(TT + swz128(gc, s0 >> 3) + (s0 & 7) * 2) = w; }
            }
            __syncthreads();
        }
        {
            const int hh = wave >> 2, X = (wave >> 1) & 1;
            LAS unsigned char* RT = X ? L1 : L1 + 16384 + hh * 16384;
            LAS unsigned char* TX = L2 + (X ? 32768 : 16384) + hh * 8192;
            GAS unsigned char* outp = rec0 + (size_t)hh * 32 * REC_BYTES + (X ? REC_WNEG : REC_U);
            const float sgn = X ? -1.f : 1.f;
            bf16x8_t tb[4][2];
#pragma unroll
            for (int tc = 0; tc < 4; ++tc)
#pragma unroll
                for (int ks = 0; ks < 2; ++ks) tb[tc][ks] = *(LAS bf16x8_t*)(TX + swz128(16 * tc + fr, ks * 4 + fq));
#pragma unroll
            for (int c8 = 0; c8 < 4; ++c8) { const int ct8 = 4 * (wave & 1) + c8;
                const bf16x8_t a0 = *(LAS bf16x8_t*)(RT + swz128(16 * ct8 + fr, fq)), a1 = *(LAS bf16x8_t*)(RT + swz128(16 * ct8 + fr, 4 + fq));
#pragma unroll
                for (int tc = 0; tc < 4; ++tc) { f32x4 d = __builtin_amdgcn_mfma_f32_16x16x32_bf16(a0, tb[tc][0], (f32x4){0.f, 0.f, 0.f, 0.f}, 0, 0, 0);
                    d = __builtin_amdgcn_mfma_f32_16x16x32_bf16(a1, tb[tc][1], d, 0, 0, 0);
                    v2u w; w.x = pk2(d[0] * sgn, d[1] * sgn); w.y = pk2(d[2] * sgn, d[3] * sgn);
                    *(GAS v2u*)(outp + (16 * tc + fr) * 256 + (16 * ct8 + 4 * fq) * 2) = w; } }
        }
    }
    phase_dn_post(ap, j, TP);
}

constexpr int AT_K = 0, AT_V = 32768, AT_VROW = 528;
__device__ __forceinline__ void attn_qtile(LAS unsigned char* Kl, LAS unsigned char* Vl, int kt0, const bf16* qptr, bf16* optr, int lo, int hi, float slope, float sink, int fr, int fq) {
    const bf16x8_t qb0 = *(const bf16x8_t*)qptr, qb1 = *(const bf16x8_t*)(qptr + 32);
    f32x4 acc[9];
#pragma unroll
    for (int i = 0; i < 9; ++i) {
        const bf16x8_t k0 = *(LAS bf16x8_t*)(Kl + swz128(16 * (kt0 + i) + fr, fq)), k1 = *(LAS bf16x8_t*)(Kl + swz128(16 * (kt0 + i) + fr, 4 + fq));
        acc[i] = __builtin_amdgcn_mfma_f32_16x16x32_bf16(k0, qb0, (f32x4){0.f, 0.f, 0.f, 0.f}, 0, 0, 0);
        acc[i] = __builtin_amdgcn_mfma_f32_16x16x32_bf16(k1, qb1, acc[i], 0, 0, 0);
    }
    float m = sink;
#pragma unroll
    for (int i = 0; i < 9; ++i)
#pragma unroll
        for (int r = 0; r < 4; ++r) { const int kc = 16 * (kt0 + i) + 4 * fq + r; const bool valid = (kc >= lo) && (kc <= hi);
            const float s = valid ? acc[i][r] - slope * (float)(hi - kc) : -INFINITY; acc[i][r] = s; m = fmaxf(m, s); }
    m = fmaxf(m, __shfl_xor(m, 16)); m = fmaxf(m, __shfl_xor(m, 32));
    float sum = 0.f;
#pragma unroll
    for (int i = 0; i < 9; ++i)
#pragma unroll
        for (int r = 0; r < 4; ++r) { const float p = __expf(acc[i][r] - m); acc[i][r] = p; sum += p; }
    sum += __shfl_xor(sum, 16); sum += __shfl_xor(sum, 32);
    const float inv = 1.f / (sum + __expf(sink - m));
    f32x4 o[4];
#pragma unroll
    for (int dt = 0; dt < 4; ++dt) o[dt] = (f32x4){0.f, 0.f, 0.f, 0.f};
#pragma unroll
    for (int i2 = 0; i2 < 5; ++i2) {
        const int ia = 2 * i2, ib = 2 * i2 + 1;
        v4u pw; pw.x = pk2(acc[ia][0], acc[ia][1]); pw.y = pk2(acc[ia][2], acc[ia][3]);
        if (ib < 9) { pw.z = pk2(acc[ib < 9 ? ib : 8][0], acc[ib < 9 ? ib : 8][1]); pw.w = pk2(acc[ib < 9 ? ib : 8][2], acc[ib < 9 ? ib : 8][3]); } else { pw.z = 0u; pw.w = 0u; }
        const bf16x8_t pf = __builtin_bit_cast(bf16x8_t, pw);
        const int kta = kt0 + ia; int ktb = kt0 + ib; ktb = ktb > 15 ? 15 : ktb;
#pragma unroll
        for (int dt = 0; dt < 4; ++dt) {
            const v2u va = *(LAS v2u*)(Vl + (16 * dt + fr) * AT_VROW + (16 * kta + 4 * fq) * 2), vb = *(LAS v2u*)(Vl + (16 * dt + fr) * AT_VROW + (16 * ktb + 4 * fq) * 2);
            const v4u vw = (v4u){va.x, va.y, vb.x, vb.y};
            o[dt] = __builtin_amdgcn_mfma_f32_16x16x32_bf16(__builtin_bit_cast(bf16x8_t, vw), pf, o[dt], 0, 0, 0);
        }
    }
#pragma unroll
    for (int dt = 0; dt < 4; ++dt) { v2u w; w.x = pk2(o[dt][0] * inv, o[dt][1] * inv); w.y = pk2(o[dt][2] * inv, o[dt][3] * inv); *(v2u*)(optr + 16 * dt) = w; }
}

__device__ __forceinline__ void phase_swa_attn_mfma(CArgs ap, int j, LAS unsigned char* lds) {
    int tid_ = threadIdx.x; asm volatile("" : "+v"(tid_)); const int tid = tid_, lane = tid & 63, wave = __builtin_amdgcn_readfirstlane(tid >> 6);
    const int fr = lane & 15, fq = lane >> 4;
    unsigned char* ws = ap->ws;
    const bf16* Q = (const bf16*)(ws + WS_Q); const bf16* KB = (const bf16*)(ws + WS_KB); const bf16* VB = (const bf16*)(ws + WS_VB);
    bf16* ATT = (bf16*)(ws + WS_ATT);
    const float* ck = ap->in[4] + (size_t)j * NB_S * 128 * 256; const float* cv = ap->in[5] + (size_t)j * NB_S * 128 * 256;
    const float* sinks = ap->in[17] + j * 16;
    LAS unsigned char* Kl = lds + AT_K; LAS unsigned char* Vl = lds + AT_V;
    int bid_ = blockIdx.x; asm volatile("" : "+s"(bid_));
    for (int unit = bid_; unit < 1024; unit += gridDim.x) {
        __syncthreads();
        if (unit < 512) {
            const int b = unit >> 6, nb = (unit >> 2) & 15, kh = unit & 3;
            const int trow0 = b * SEQ + nb * 128 - 128;
#pragma unroll
            for (int it = 0; it < 4; ++it) { const int q = tid + 512 * it;
                { const int key = q >> 3, ch = q & 7; v4u w = (v4u){0u, 0u, 0u, 0u};
                  if (nb > 0 || key >= 128) w = *(const v4u*)(KB + (size_t)(trow0 + key) * 256 + kh * 64 + ch * 8);
                  *(LAS v4u*)(Kl + swz128(key, ch)) = w; }
                { const int key = q & 255, dc = q >> 8; v4u w = (v4u){0u, 0u, 0u, 0u};
                  if (nb > 0 || key >= 128) w = *(const v4u*)(VB + (size_t)(trow0 + key) * 256 + kh * 64 + dc * 8);
                  LAS bf16* vp = (LAS bf16*)(Vl + (8 * dc) * AT_VROW + key * 2);
                  vp[0 * (AT_VROW / 2)] = (bf16)(w.x & 0xffff); vp[1 * (AT_VROW / 2)] = (bf16)(w.x >> 16); vp[2 * (AT_VROW / 2)] = (bf16)(w.y & 0xffff); vp[3 * (AT_VROW / 2)] = (bf16)(w.y >> 16);
                  vp[4 * (AT_VROW / 2)] = (bf16)(w.z & 0xffff); vp[5 * (AT_VROW / 2)] = (bf16)(w.z >> 16); vp[6 * (AT_VROW / 2)] = (bf16)(w.w & 0xffff); vp[7 * (AT_VROW / 2)] = (bf16)(w.w >> 16); }
            }
            __syncthreads();
            const int g = wave >> 1, qh = wave & 1, head = kh * 4 + g;
            const float slope = exp2f(-0.5f * (float)(head + 1)), sink = sinks[head];
#pragma unroll 1
            for (int qt = 0; qt < 4; ++qt) {
                const int o = 64 * qh + 16 * qt, qi = o + fr;
                const size_t tq = (size_t)(b * SEQ + nb * 128 + qi);
                attn_qtile(Kl, Vl, 4 * qh + qt, Q + tq * DM + head * 64 + 8 * fq, ATT + tq * DM + head * 64 + 4 * fq, (nb == 0 && qi < 128) ? 128 : qi, 128 + qi, slope, sink, fr, fq);
            }
        } else {
            const int su = unit - 512, b = su >> 2, kh = su & 3;
            for (int q = tid; q < 1280; q += 512) {
                { const int key = q >> 3, ch = q & 7; v4u w = (v4u){0u, 0u, 0u, 0u};
                  if (key < 128) { const float* p = ck + (size_t)(b * 128 + key) * 256 + kh * 64 + ch * 8; const f32x4 x0 = *(const f32x4*)p, x1 = *(const f32x4*)(p + 4);
                      w.x = pk2(x0[0], x0[1]); w.y = pk2(x0[2], x0[3]); w.z = pk2(x1[0], x1[1]); w.w = pk2(x1[2], x1[3]); }
                  else if (key < 132) w = *(const v4u*)(KB + (size_t)(TP + b * 4 + key - 128) * 256 + kh * 64 + ch * 8);
                  *(LAS v4u*)(Kl + swz128(key, ch)) = w; }
                { const int key = q % 160, dc = q / 160; v4u w = (v4u){0u, 0u, 0u, 0u};
                  if (key < 128) { const float* p = cv + (size_t)(b * 128 + key) * 256 + kh * 64 + dc * 8; const f32x4 x0 = *(const f32x4*)p, x1 = *(const f32x4*)(p + 4);
                      w.x = pk2(x0[0], x0[1]); w.y = pk2(x0[2], x0[3]); w.z = pk2(x1[0], x1[1]); w.w = pk2(x1[2], x1[3]); }
                  else if (key < 132) w = *(const v4u*)(VB + (size_t)(TP + b * 4 + key - 128) * 256 + kh * 64 + dc * 8);
                  LAS bf16* vp = (LAS bf16*)(Vl + (8 * dc) * AT_VROW + key * 2);
                  vp[0 * (AT_VROW / 2)] = (bf16)(w.x & 0xffff); vp[1 * (AT_VROW / 2)] = (bf16)(w.x >> 16); vp[2 * (AT_VROW / 2)] = (bf16)(w.y & 0xffff); vp[3 * (AT_VROW / 2)] = (bf16)(w.y >> 16);
                  vp[4 * (AT_VROW / 2)] = (bf16)(w.z & 0xffff); vp[5 * (AT_VROW / 2)] = (bf16)(w.z >> 16); vp[6 * (AT_VROW / 2)] = (bf16)(w.w & 0xffff); vp[7 * (AT_VROW / 2)] = (bf16)(w.w >> 16); }
            }
            __syncthreads();
            if (wave == 0) {
                const int tok = fr & 3, g = fr >> 2, head = kh * 4 + g;
                const float slope = exp2f(-0.5f * (float)(head + 1)), sink = sinks[head];
                const size_t tq = (size_t)(TP + b * 4 + tok);
                attn_qtile(Kl, Vl, 0, Q + tq * DM + head * 64 + 8 * fq, ATT + tq * DM + head * 64 + 4 * fq, tok, 128 + tok, slope, sink, fr, fq);
            }
        }
    }
}

#define XB_TMO      128
#define XB_XCNT(j)  (256  + 64 * (j))
#define XB_XSUB(j)  (1280 + 64 * (j))
#define XB_XGEN(j)  (2304 + 64 * (j))
#define XB_TOP      3328
#define XB_TOPGEN   3392
#define XCD_BAR_WORDS 3456
#define XB_SPIN_CAP (1u << 18)

__device__ __forceinline__ unsigned xb_ld(unsigned* p)              { return __hip_atomic_load(p, __ATOMIC_RELAXED, __HIP_MEMORY_SCOPE_AGENT); }
__device__ __forceinline__ unsigned xb_add(unsigned* p, unsigned v) { return __hip_atomic_fetch_add(p, v, __ATOMIC_RELAXED, __HIP_MEMORY_SCOPE_AGENT); }
__device__ __forceinline__ unsigned xb_xcc_id() { return (unsigned)__builtin_amdgcn_s_getreg((3 << 11) | 20) & 0xFu; }
#define XB_SPIN(cond, bar) do { unsigned _sp = 0; while (cond) { __builtin_amdgcn_s_sleep(1); \
    if ((++_sp & 255u) == 0u) { if (xb_ld(&(bar)[XB_TMO])) break; if (_sp > XB_SPIN_CAP) { atomicAdd(&(bar)[XB_TMO], 1u); break; } } } } while (0)

struct XcdBarrier {
    unsigned* bar; unsigned x;
    volatile LAS unsigned* st;
};

__device__ __forceinline__ XcdBarrier xcd_barrier_post(unsigned* bar, volatile LAS unsigned* st) {
    XcdBarrier b; b.bar = bar; b.x = xb_xcc_id(); b.st = st;
    if (threadIdx.x == 0) (void)xb_add(&bar[XB_XCNT(b.x)], 1u);
    return b;
}
__device__ __forceinline__ void xcd_barrier_complete(unsigned* bar, unsigned x, unsigned& nloc, unsigned& nx) {
    const unsigned G = gridDim.x * gridDim.y * gridDim.z;
    unsigned sum, cnt, mine, sp = 0u;
    for (;;) {
        sum = 0u; cnt = 0u; mine = 0u;
#pragma unroll
        for (unsigned j = 0; j < 16; ++j) { const unsigned c = xb_ld(&bar[XB_XCNT(j)]); sum += c; cnt += (c > 0u) ? 1u : 0u; mine = (j == x) ? c : mine; }
        if (sum == G) break;
        __builtin_amdgcn_s_sleep(1);
        if ((++sp & 255u) == 0u) { if (xb_ld(&bar[XB_TMO])) break; if (sp > XB_SPIN_CAP) { atomicAdd(&bar[XB_TMO], 1u); break; } }
    }
    nloc = mine > 0u ? mine : 1u; nx = cnt > 0u ? cnt : 1u;
}

__device__ __forceinline__ void xcd_barrier(const XcdBarrier& b) {
    asm volatile("s_waitcnt vmcnt(0)" ::: "memory");
    __syncthreads();
    if (threadIdx.x == 0) {
        unsigned* bar = b.bar;
        __builtin_amdgcn_s_waitcnt(0);
        unsigned nloc = b.st[0], nx = b.st[1];
        if (nloc == 0u) { xcd_barrier_complete(bar, b.x, nloc, nx); b.st[0] = nloc; b.st[1] = nx; }
        const unsigned old = xb_add(&bar[XB_XSUB(b.x)], 1u);
        const unsigned gen = old / nloc;
        if (old + 1u == (gen + 1u) * nloc) {
            __builtin_amdgcn_fence(__ATOMIC_RELEASE, "agent");
            asm volatile("s_waitcnt vmcnt(0)" ::: "memory");
            const unsigned og = xb_add(&bar[XB_TOP], 1u);
            const unsigned tg = og / nx;
            if (og + 1u == (tg + 1u) * nx) xb_add(&bar[XB_TOPGEN], 1u);
            else XB_SPIN(xb_ld(&bar[XB_TOPGEN]) == tg, bar);
            __builtin_amdgcn_fence(__ATOMIC_ACQUIRE, "agent");
            xb_add(&bar[XB_XGEN(b.x)], 1u);
            asm volatile("s_waitcnt vmcnt(0)" ::: "memory");
        } else {
            XB_SPIN(xb_ld(&bar[XB_XGEN(b.x)]) == gen, bar);
            __builtin_amdgcn_fence(__ATOMIC_ACQUIRE, "agent");
            asm volatile("s_waitcnt vmcnt(0)" ::: "memory");
        }
    }
    __syncthreads();
}

constexpr int CW_BAR = 4096;
constexpr int MISC_OFF = 163584;

#ifndef REP_PREP
#define REP_PREP 1
#endif
#ifndef REP_SCAN
#define REP_SCAN 1
#endif
#ifndef REP_ATTN
#define REP_ATTN 1
#endif
#ifndef REP_GIN
#define REP_GIN 1
#endif
#ifndef REP_GGU
#define REP_GGU 1
#endif
#ifndef REP_GQKV
#define REP_GQKV 1
#endif

__device__ __forceinline__ void small_res(const bf16* A, const bf16* Wt, int K, const float* bias, bf16* XBp, float* SSQp, LAS unsigned char* lds) {
    int tid_ = threadIdx.x; asm volatile("" : "+v"(tid_)); const int tid = tid_, lane = tid & 63, wave = __builtin_amdgcn_readfirstlane(tid >> 6);
    const int fr = lane & 15, fq = lane >> 4, rt = wave >> 2, ct = wave & 3;
    int bid_ = blockIdx.x; asm volatile("" : "+s"(bid_));
    LAS float* red = (LAS float*)lds;
    for (int piece = bid_; piece < 256; piece += gridDim.x) {
        const int rb = piece >> 4, cc = piece & 15, m0 = TP + rb * 32 + rt * 16, n0 = cc * 64 + ct * 16;
        const bf16* apx = A + (size_t)(m0 + fr) * K + 8 * fq; const bf16* wpx = Wt + (size_t)(n0 + fr) * K + 8 * fq;
        f32x4 acc = (f32x4){0.f, 0.f, 0.f, 0.f};
#pragma unroll 1
        for (int k = 0; k < K; k += 256) {
            bf16x8_t av[8], wv[8];
#pragma unroll
            for (int i = 0; i < 8; ++i) { av[i] = *(const bf16x8_t*)(apx + k + 32 * i); wv[i] = *(const bf16x8_t*)(wpx + k + 32 * i); }
#pragma unroll
            for (int i = 0; i < 8; ++i) acc = __builtin_amdgcn_mfma_f32_16x16x32_bf16(wv[i], av[i], acc, 0, 0, 0);
        }
        const int row = m0 + fr, col = n0 + 4 * fq;
        bf16* xp = XBp + (size_t)row * DM + col;
        const v2u xo = *(const v2u*)xp;
        f32x4 x = (f32x4){bflo(xo.x), bfhi(xo.x), bflo(xo.y), bfhi(xo.y)} + acc;
        if (bias) x = x + *(const f32x4*)(bias + col);
        v2u w; w.x = pk2(x[0], x[1]); w.y = pk2(x[2], x[3]);
        *(v2u*)xp = w;
        const float r0 = bflo(w.x), r1 = bfhi(w.x), r2 = bflo(w.y), r3 = bfhi(w.y);
        float s = (r0 * r0 + r1 * r1) + (r2 * r2 + r3 * r3);
        s += __shfl_xor(s, 16); s += __shfl_xor(s, 32);
        __syncthreads();
        if (fq == 0) red[wave * 16 + fr] = s;
        __syncthreads();
        if (ct == 0 && fq == 0) SSQp[(size_t)row * 16 + cc] = (red[(rt * 4) * 16 + fr] + red[(rt * 4 + 1) * 16 + fr]) + (red[(rt * 4 + 2) * 16 + fr] + red[(rt * 4 + 3) * 16 + fr]);
    }
}
template <class Epi>
__device__ __forceinline__ void run_gemm(LAS unsigned char* lds, const bf16* A, const bf16* Bt, int M, int N, int K, const Epi& E) {
    int c_ = blockIdx.x; asm volatile("" : "+s"(c_));
    pg8::Gemm g{A, Bt, M, N, K}; pg8::StaticOrder S; S.init(M, N, (int)gridDim.x, c_);
    pg8::gemm_phase<Epi, pg8::StaticOrder, true, true>(lds, g, S, E);
}

__global__ void __launch_bounds__(NTHREADS, 2) mk_fwd(Args a) {
    extern __shared__ __attribute__((aligned(16))) unsigned char lds_raw[];
    LAS unsigned char* lds = (LAS unsigned char*)lds_raw;
    unsigned char* ws0_ = kargs()->ws;
    for (int u = threadIdx.x; u < (LDS_BYTES - MISC_OFF) / 4; u += NTHREADS) ((LAS unsigned*)(lds + MISC_OFF))[u] = 0u;
    __syncthreads();
    (void)xcd_barrier_post((unsigned*)(ws0_ + WS_CTL) + CW_BAR, (volatile LAS unsigned*)(lds + MISC_OFF));
#define GRID_BAR() do { XcdBarrier b_; b_.bar = (unsigned*)(kargs()->ws + WS_CTL) + CW_BAR; b_.x = xb_xcc_id(); b_.st = (volatile LAS unsigned*)(lds + MISC_OFF); xcd_barrier(b_); } while (0)

    phase_prologue(kargs(), lds);
    GRID_BAR();
#pragma unroll 1
    for (int li = 0; li < 4; ++li) {
        const int j = li >> 1;
#define WSP (kargs()->ws)
#define XB ((bf16*)(WSP + WS_XB))
#define SSQ ((float*)(WSP + WS_SSQ))
        if ((li & 1) == 0) {
            for (int rep = 0; rep < REP_GIN; ++rep) { EpiDnIn E{(bf16*)(WSP + WS_PROJ), (float*)(WSP + WS_BA), SSQ};
              run_gemm(lds, XB, (const bf16*)(WSP + WS_WIN) + (size_t)j * DN_INP * DM, T, DN_INP, DM, E);
            GRID_BAR(); }
            for (int rep = 0; rep < REP_PREP; ++rep) { phase_dn_prep2(kargs(), j, lds);
            GRID_BAR(); }
            for (int rep = 0; rep < REP_SCAN; ++rep) { phase_dn_scan(kargs(), j, lds);
            GRID_BAR(); }
            { EpiRes E{XB, SSQ, nullptr};
              run_gemm(lds, (const bf16*)(WSP + WS_OG), (const bf16*)(WSP + WS_WOUT) + (size_t)j * DM * VAL_DIM, TP, DM, VAL_DIM, E); }
            small_res((const bf16*)(WSP + WS_OG), (const bf16*)(WSP + WS_WOUT) + (size_t)j * DM * VAL_DIM, VAL_DIM, nullptr, XB, SSQ, lds);
            GRID_BAR();
        } else {
            { EpiQkv E{(bf16*)(WSP + WS_Q), (bf16*)(WSP + WS_KB), SSQ, kargs()->in[16] + j * QKV_N,
                       kargs()->out + O_KP + (size_t)j * NB_P * 128 * 256, kargs()->out + O_KS + (size_t)j * NB_S * 4 * 256};
              run_gemm(lds, XB, (const bf16*)(WSP + WS_WQKV) + (size_t)j * QKV_N * DM, T, QKV_N, DM, E); }
            GRID_BAR();
            for (int rep = 0; rep < REP_ATTN; ++rep) { phase_swa_attn_mfma(kargs(), j, lds);
            GRID_BAR(); }
            { EpiRes E{XB, SSQ, kargs()->in[19] + j * DM};
              run_gemm(lds, (const bf16*)(WSP + WS_ATT), (const bf16*)(WSP + WS_WO) + (size_t)j * DM * DM, TP, DM, DM, E); }
            small_res((const bf16*)(WSP + WS_ATT), (const bf16*)(WSP + WS_WO) + (size_t)j * DM * DM, DM, kargs()->in[19] + j * DM, XB, SSQ, lds);
            GRID_BAR();
        }
        for (int rep = 0; rep < REP_GGU; ++rep) { EpiGu E{(bf16*)(WSP + WS_ACT), SSQ};
          run_gemm(lds, XB, (const bf16*)(WSP + WS_WGU) + (size_t)li * GU_N * DM, T, GU_N, DM, E);
        GRID_BAR(); }
        { EpiRes E{XB, SSQ, nullptr};
          run_gemm(lds, (const bf16*)(WSP + WS_ACT), (const bf16*)(WSP + WS_WDOWN) + (size_t)li * DM * DFF, TP, DM, DFF, E); }
        small_res((const bf16*)(WSP + WS_ACT), (const bf16*)(WSP + WS_WDOWN) + (size_t)li * DM * DFF, DFF, nullptr, XB, SSQ, lds);
        GRID_BAR();
    }
#undef WSP
#undef XB
#undef SSQ
    phase_final(kargs());
}

extern "C" void kernel_launch(void* const* d_in, const int* in_sizes, int n_in, void* d_out, int out_size, void* d_ws, size_t ws_size, hipStream_t stream) {
    static int grid = 0;
    if (grid == 0) {
        if (n_in != 22 || (size_t)out_size != O_END || ws_size < WS_END) { fprintf(stderr, "kernel_launch: unexpected shapes: n_in %d out %d ws %zu\n", n_in, out_size, ws_size); grid = -1; return; }
        int dev = 0, cus = 0, per_cu = 0;
        if (hipGetDevice(&dev) != hipSuccess || hipDeviceGetAttribute(&cus, hipDeviceAttributeMultiprocessorCount, dev) != hipSuccess) { grid = -1; return; }
        if (hipFuncSetAttribute((const void*)mk_fwd, hipFuncAttributeMaxDynamicSharedMemorySize, LDS_BYTES) != hipSuccess) { fprintf(stderr, "kernel_launch: hipFuncSetAttribute failed\n"); grid = -1; return; }
        if (hipOccupancyMaxActiveBlocksPerMultiprocessor(&per_cu, (const void*)mk_fwd, NTHREADS, LDS_BYTES) != hipSuccess || per_cu < 1) { fprintf(stderr, "kernel_launch: occupancy query reports %d blocks per CU\n", per_cu); (void)hipGetLastError(); }
        grid = cus;
    }
    if (grid < 0) return;
    (void)hipMemsetAsync((char*)d_ws + WS_CTL, 0, CTL_ZERO_BYTES, stream);
    Args a{};
    for (int i = 0; i < 22; ++i) a.in[i] = (const float*)d_in[i];
    a.out = (float*)d_out; a.ws = (unsigned char*)d_ws;
    hipLaunchKernelGGL(mk_fwd, dim3(grid), dim3(NTHREADS), LDS_BYTES, stream, a);
}
```

```cpp
#include <hip/hip_runtime.h>
#include <cstdio>
#include <cstdint>
namespace pg8 {
#define PG8_LAS __attribute__((address_space(3)))
typedef unsigned short bf16_t;
typedef short bf16x8 __attribute__((ext_vector_type(8)));
typedef float f32x4 __attribute__((ext_vector_type(4)));
typedef unsigned u32x4 __attribute__((ext_vector_type(4)));
constexpr int BM = 256, BK = 64, HALF = 128, HTB = HALF * BK * 2  , STAGE_BYTES = 8 * HTB, NXCD = 8, WGM = 8;

__host__ __device__ __forceinline__ int lds_byte(int r, int c) { const int st = (r >> 4) * 2 + (c >> 5), rr = r & 15, cc = c & 31, ob = rr * 64 + cc * 2; return st * 1024 + (ob ^ (((ob >> 9) & 1) << 5)); }
__host__ __device__ __forceinline__ void stage_rc(int b, int& R, int& C) { const int st = b / 1024, sb = b % 1024, swz = sb ^ (((sb >> 9) & 1) << 5); R = (st >> 1) * 16 + swz / 64; C = (st & 1) * 32 + (swz % 64) / 2; }
__host__ __device__ __forceinline__ int perm32(int rho) { const int n = rho >> 4, i = rho & 15; return 8 * (i >> 2) + 4 * n + (i & 3); }

struct Unit { int pm, pn; };
struct Gemm { const bf16_t* A; const bf16_t* Bt; int M, N, K; };

struct StaticOrder {
    int nM, nN, nwg, G, c;
    __host__ __device__ void init(int M, int N, int G_, int c_) { nM = M / BM; nN = N / BM; nwg = nM * nN; G = G_; c = c_; }
    __host__ __device__ bool next(int i, Unit& u) const {
        const long L = (long)i * G + c; if (L >= nwg) return false;
        int wgid = (int)L; { const int q = nwg / NXCD, r = nwg % NXCD, xcd = wgid % NXCD, off = wgid / NXCD; wgid = (xcd < r ? xcd * (q + 1) : r * (q + 1) + (xcd - r) * q) + off; }
        const int nig = WGM * nN, gid = wgid / nig, fm = gid * WGM, gsz = (nM - fm) < WGM ? (nM - fm) : WGM;
        u.pm = fm + ((wgid % nig) % gsz); u.pn = (wgid % nig) / gsz; return true;
    }
    __device__ __forceinline__ void a_ready(const Unit&) const {}
    __device__ __forceinline__ void done(const Unit&) const {}
};
__device__ __forceinline__ unsigned cvt_pk_bf16(float lo, float hi) { unsigned r; asm volatile("v_cvt_pk_bf16_f32 %0, %1, %2" : "=v"(r) : "v"(lo), "v"(hi)); return r; }
typedef float f32x2 __attribute__((ext_vector_type(2)));
template <class Epi, class Sched, bool ALIGN_EPI = false, bool SP2 = false, int KPAD = -1>
__device__ __forceinline__ void gemm_phase(PG8_LAS unsigned char* lds, const Gemm g, const Sched& S, const Epi& E) {
    int tid_ = threadIdx.x; asm volatile("" : "+v"(tid_)); const int tid = tid_, wid = __builtin_amdgcn_readfirstlane(tid >> 6), lane = tid & 63, wr = wid >> 2, wc = wid & 3, fr = lane & 15, fq = lane >> 4;
    const int K = g.K, nt = K / BK;
    unsigned voffA[2], voffB[2];
#pragma unroll
    for (int i = 0; i < 2; ++i) { int R, C; stage_rc(tid * 16 + i * 8192, R, C); const int Rb = Epi::PERM ? ((R & ~31) + perm32(R & 31)) : R;
        voffA[i] = (unsigned)(R * K + C) * 2u; voffB[i] = (unsigned)(Rb * K + C) * 2u; }
    const size_t kstep = (size_t)(BK * 2);
    const size_t hstep = (size_t)HALF * K * 2;
    const size_t tstep = 2 * hstep;
    const unsigned ldsw = (unsigned)wid * 1024u;
    const int aoff = lds_byte(wr * 64 + fr, fq * 8), boff = lds_byte(wc * 32 + fr, fq * 8);
#define PG8_SA(b, h) (((b) * 2 + (h)) * HTB)
#define PG8_SB(b, h) ((4 + (b) * 2 + (h)) * HTB)
#define PG8_STAGE(bufoff, gbase, voff) do { _Pragma("unroll") for (int _i = 0; _i < 2; ++_i) \
        __builtin_amdgcn_global_load_lds((const unsigned*)((const char*)(gbase) + (voff)[_i]), (PG8_LAS unsigned*)(lds + (bufoff) + ldsw + _i * 8192), 16, 0, 0); } while (0)
#define PG8_LDA(dst, b, h) do { _Pragma("unroll") for (int m = 0; m < 4; ++m) _Pragma("unroll") for (int k = 0; k < 2; ++k) dst[m][k] = *(const PG8_LAS bf16x8*)(lds + PG8_SA(b, h) + aoff + m * 2048 + k * 1024); } while (0)
#define PG8_LDB(dst, b, h) do { _Pragma("unroll") for (int n = 0; n < 2; ++n) _Pragma("unroll") for (int k = 0; k < 2; ++k) dst[n][k] = *(const PG8_LAS bf16x8*)(lds + PG8_SB(b, h) + boff + n * 2048 + k * 1024); } while (0)
#define PG8_MMA(ai, bj, At, Bt) do { __builtin_amdgcn_s_setprio(1); _Pragma("unroll") for (int m = 0; m < 4; ++m) _Pragma("unroll") for (int n = 0; n < 2; ++n) _Pragma("unroll") for (int k = 0; k < 2; ++k) \
        acc[ai][bj][m][n] = __builtin_amdgcn_mfma_f32_16x16x32_bf16(Bt[n][k], At[m][k], acc[ai][bj][m][n], 0, 0, 0); __builtin_amdgcn_s_setprio(0); } while (0)
#define PG8_WAIT_V(n) asm volatile("s_waitcnt vmcnt(" #n ")" ::: "memory")
#define PG8_WAIT_L(n) asm volatile("s_waitcnt lgkmcnt(" #n ")" ::: "memory")
#define PG8_BAR __builtin_amdgcn_s_barrier()
#define PG8_SCHED __builtin_amdgcn_sched_barrier(0)
    Unit cur, nxt; int ui = 0;
    if (!S.next(0, cur)) return;
    f32x4 acc[2][2][4][2];
#pragma unroll
    for (int a = 0; a < 2; ++a)
#pragma unroll
        for (int b = 0; b < 2; ++b)
#pragma unroll
            for (int m = 0; m < 4; ++m)
#pragma unroll
                for (int n = 0; n < 2; ++n) acc[a][b][m][n] = (f32x4){0.f, 0.f, 0.f, 0.f};
    bf16x8 At[4][2], B0[2][2], B1[2][2];
    const char* cA = (const char*)g.A + (size_t)cur.pm * tstep; const char* cB = (const char*)g.Bt + (size_t)cur.pn * tstep;
    S.a_ready(cur);
    if constexpr (SP2) {
        PG8_STAGE(PG8_SB(0, 0), cB, voffB); PG8_STAGE(PG8_SB(0, 1), cB + hstep, voffB); PG8_STAGE(PG8_SA(0, 0), cA, voffA); PG8_STAGE(PG8_SA(0, 1), cA + hstep, voffA);
        if (wr == 1) PG8_BAR;
        PG8_WAIT_V(2); PG8_BAR;
        PG8_STAGE(PG8_SB(1, 0), cB + kstep, voffB); PG8_STAGE(PG8_SA(1, 0), cA + kstep, voffA); PG8_STAGE(PG8_SB(1, 1), cB + hstep + kstep, voffB);
        PG8_WAIT_V(6); PG8_BAR;
    } else {
        PG8_STAGE(PG8_SB(0, 0), cB, voffB); PG8_STAGE(PG8_SA(0, 0), cA, voffA); PG8_STAGE(PG8_SB(0, 1), cB + hstep, voffB); PG8_STAGE(PG8_SA(0, 1), cA + hstep, voffA);
        if (wr == 1) PG8_BAR;
        PG8_WAIT_V(4); PG8_BAR;
        PG8_STAGE(PG8_SB(1, 0), cB + kstep, voffB); PG8_STAGE(PG8_SA(1, 0), cA + kstep, voffA); PG8_STAGE(PG8_SB(1, 1), cB + hstep + kstep, voffB);
        PG8_WAIT_V(6); PG8_BAR;
    }
    for (;;) {
        const bool has_next = S.next(ui + 1, nxt);
        const char* nA = has_next ? (const char*)g.A + (size_t)nxt.pm * tstep : cA; const char* nB = has_next ? (const char*)g.Bt + (size_t)nxt.pn * tstep : cB;
        for (int t = 0; t < nt; t += 2) {
            if constexpr (KPAD == 0) asm volatile(".p2align 6" ::: "memory");
            if constexpr (KPAD == 1) asm volatile(".p2align 6\n s_nop 0" ::: "memory");
            if constexpr (KPAD == 2) asm volatile(".p2align 6\n s_nop 0\n s_nop 0" ::: "memory");
            if constexpr (KPAD == 3) asm volatile(".p2align 6\n s_nop 0\n s_nop 0\n s_nop 0" ::: "memory");
            if constexpr (KPAD == 4) asm volatile(".p2align 6\n s_nop 0\n s_nop 0\n s_nop 0\n s_nop 0" ::: "memory");
            if constexpr (KPAD == 5) asm volatile(".p2align 6\n s_nop 0\n s_nop 0\n s_nop 0\n s_nop 0\n s_nop 0" ::: "memory");
            if constexpr (KPAD == 6) asm volatile(".p2align 6\n s_nop 0\n s_nop 0\n s_nop 0\n s_nop 0\n s_nop 0\n s_nop 0" ::: "memory");
            if constexpr (KPAD == 7) asm volatile(".p2align 6\n s_nop 0\n s_nop 0\n s_nop 0\n s_nop 0\n s_nop 0\n s_nop 0\n s_nop 0" ::: "memory");
            if constexpr (KPAD == 8) asm volatile(".p2align 6\n s_nop 0\n s_nop 0\n s_nop 0\n s_nop 0\n s_nop 0\n s_nop 0\n s_nop 0\n s_nop 0" ::: "memory");
            if constexpr (KPAD == 9) asm volatile(".p2align 6\n s_nop 0\n s_nop 0\n s_nop 0\n s_nop 0\n s_nop 0\n s_nop 0\n s_nop 0\n s_nop 0\n s_nop 0" ::: "memory");
            if constexpr (KPAD == 10) asm volatile(".p2align 6\n s_nop 0\n s_nop 0\n s_nop 0\n s_nop 0\n s_nop 0\n s_nop 0\n s_nop 0\n s_nop 0\n s_nop 0\n s_nop 0" ::: "memory");
            if constexpr (KPAD == 11) asm volatile(".p2align 6\n s_nop 0\n s_nop 0\n s_nop 0\n s_nop 0\n s_nop 0\n s_nop 0\n s_nop 0\n s_nop 0\n s_nop 0\n s_nop 0\n s_nop 0" ::: "memory");
            if constexpr (KPAD == 12) asm volatile(".p2align 6\n s_nop 0\n s_nop 0\n s_nop 0\n s_nop 0\n s_nop 0\n s_nop 0\n s_nop 0\n s_nop 0\n s_nop 0\n s_nop 0\n s_nop 0\n s_nop 0" ::: "memory");
            if constexpr (KPAD == 13) asm volatile(".p2align 6\n s_nop 0\n s_nop 0\n s_nop 0\n s_nop 0\n s_nop 0\n s_nop 0\n s_nop 0\n s_nop 0\n s_nop 0\n s_nop 0\n s_nop 0\n s_nop 0\n s_nop 0" ::: "memory");
            if constexpr (KPAD == 14) asm volatile(".p2align 6\n s_nop 0\n s_nop 0\n s_nop 0\n s_nop 0\n s_nop 0\n s_nop 0\n s_nop 0\n s_nop 0\n s_nop 0\n s_nop 0\n s_nop 0\n s_nop 0\n s_nop 0\n s_nop 0" ::: "memory");
            if constexpr (KPAD == 15) asm volatile(".p2align 6\n s_nop 0\n s_nop 0\n s_nop 0\n s_nop 0\n s_nop 0\n s_nop 0\n s_nop 0\n s_nop 0\n s_nop 0\n s_nop 0\n s_nop 0\n s_nop 0\n s_nop 0\n s_nop 0\n s_nop 0" ::: "memory");
            const bool last = (t == nt - 2);
            const char* a1 = cA + (size_t)(t + 1) * kstep;
            const char* a2 = last ? nA : cA + (size_t)(t + 2) * kstep; const char* b2 = last ? nB : cB + (size_t)(t + 2) * kstep;
            const char* a3 = a2 + kstep; const char* b3 = b2 + kstep;
            if (last && has_next) S.a_ready(nxt);
            if constexpr (SP2) {
            PG8_LDB(B0, 0, 0); PG8_LDB(B1, 0, 1); PG8_SCHED; PG8_LDA(At, 0, 0); PG8_STAGE(PG8_SA(1, 1), a1 + hstep, voffA);
            PG8_WAIT_V(8); PG8_WAIT_L(0); PG8_BAR; PG8_MMA(0, 0, At, B0); PG8_MMA(0, 1, At, B1); PG8_BAR; PG8_SCHED;
            PG8_LDA(At, 0, 1); PG8_STAGE(PG8_SB(0, 0), b2, voffB); PG8_STAGE(PG8_SB(0, 1), b2 + hstep, voffB); PG8_STAGE(PG8_SA(0, 0), a2, voffA);
            PG8_WAIT_V(8); PG8_WAIT_L(0); PG8_BAR; PG8_MMA(1, 0, At, B0); PG8_MMA(1, 1, At, B1); PG8_BAR; PG8_SCHED;
            PG8_LDB(B0, 1, 0); PG8_LDB(B1, 1, 1); PG8_SCHED; PG8_LDA(At, 1, 0); PG8_STAGE(PG8_SA(0, 1), a2 + hstep, voffA);
            PG8_WAIT_V(8); PG8_WAIT_L(0); PG8_BAR; PG8_MMA(0, 0, At, B0); PG8_MMA(0, 1, At, B1); PG8_BAR; PG8_SCHED;
            PG8_LDA(At, 1, 1); PG8_STAGE(PG8_SB(1, 0), b3, voffB); PG8_STAGE(PG8_SB(1, 1), b3 + hstep, voffB); PG8_STAGE(PG8_SA(1, 0), a3, voffA);
            PG8_WAIT_V(8); PG8_WAIT_L(0); PG8_BAR; PG8_MMA(1, 0, At, B0); PG8_MMA(1, 1, At, B1); PG8_BAR; PG8_SCHED;
            } else {
            PG8_LDB(B0, 0, 0); PG8_SCHED; PG8_LDA(At, 0, 0); PG8_STAGE(PG8_SA(1, 1), a1 + hstep, voffA);
            PG8_WAIT_L(8); PG8_BAR; PG8_WAIT_L(0); PG8_MMA(0, 0, At, B0); PG8_BAR; PG8_SCHED;
            PG8_LDB(B1, 0, 1); PG8_STAGE(PG8_SB(0, 0), b2, voffB);
            PG8_BAR; PG8_WAIT_L(0); PG8_MMA(0, 1, At, B1); PG8_BAR;
            PG8_LDA(At, 0, 1); PG8_STAGE(PG8_SA(0, 0), a2, voffA);
            PG8_BAR; PG8_WAIT_L(0); PG8_MMA(1, 0, At, B0); PG8_BAR; PG8_SCHED;
            PG8_STAGE(PG8_SB(0, 1), b2 + hstep, voffB);
            PG8_WAIT_V(6); PG8_BAR; PG8_MMA(1, 1, At, B1); PG8_BAR;
            PG8_LDB(B0, 1, 0); PG8_SCHED; PG8_LDA(At, 1, 0); PG8_STAGE(PG8_SA(0, 1), a2 + hstep, voffA);
            PG8_WAIT_L(8); PG8_BAR; PG8_WAIT_L(0); PG8_MMA(0, 0, At, B0); PG8_BAR; PG8_SCHED;
            PG8_LDB(B1, 1, 1); PG8_STAGE(PG8_SB(1, 0), b3, voffB);
            PG8_BAR; PG8_WAIT_L(0); PG8_MMA(0, 1, At, B1); PG8_BAR;
            PG8_LDA(At, 1, 1); PG8_STAGE(PG8_SA(1, 0), a3, voffA);
            PG8_BAR; PG8_WAIT_L(0); PG8_MMA(1, 0, At, B0); PG8_BAR; PG8_SCHED;
            PG8_STAGE(PG8_SB(1, 1), b3 + hstep, voffB);
            PG8_WAIT_V(6); PG8_BAR; PG8_MMA(1, 1, At, B1); PG8_BAR;
            }
        }
        if constexpr (ALIGN_EPI) { if (wr == 0) PG8_BAR; }
        if constexpr (!Epi::AFTER_DRAIN) { E(acc, cur, wr, wc, fr, fq); S.done(cur); }
        if (!has_next) break;
#pragma unroll
        for (int a = 0; a < 2; ++a)
#pragma unroll
            for (int b = 0; b < 2; ++b)
#pragma unroll
                for (int m = 0; m < 4; ++m)
#pragma unroll
                    for (int n = 0; n < 2; ++n) acc[a][b][m][n] = (f32x4){0.f, 0.f, 0.f, 0.f};
        cur = nxt; cA = nA; cB = nB; ++ui;
        if constexpr (ALIGN_EPI) { if (wr == 1) PG8_BAR; }
    }
    PG8_WAIT_V(0);
    if constexpr (!ALIGN_EPI) { if (wr == 0) PG8_BAR; }
    PG8_BAR;
    if constexpr (Epi::AFTER_DRAIN) { E.fused(acc, cur, wr, wc, fr, fq, lds, wid, lane); S.done(cur); }
#undef PG8_SA
#undef PG8_SB
#undef PG8_STAGE
#undef PG8_LDA
#undef PG8_LDB
#undef PG8_MMA
#undef PG8_WAIT_V
#undef PG8_WAIT_L
#undef PG8_BAR
#undef PG8_SCHED
}
}
 constexpr int KP_WIN = 1; constexpr int KP_WOUT = 2; constexpr int KP_QKV = 8; constexpr int KP_WO = 8; constexpr int KP_GU = 2; constexpr int KP_DOWN = 2;

#define GAS __attribute__((address_space(1)))
#define LAS __attribute__((address_space(3)))
typedef unsigned short bf16;
typedef unsigned v4u __attribute__((ext_vector_type(4)));
typedef unsigned v2u __attribute__((ext_vector_type(2)));
typedef float f32x4 __attribute__((ext_vector_type(4)));
typedef float f32x2v __attribute__((ext_vector_type(2)));

constexpr int DM = 1024, NB_P = 8, SEQ = 2048, NB_S = 128, DSEQ = 4;
constexpr int TP = NB_P * SEQ, TS = NB_S * DSEQ, T = TP + TS;
constexpr int DN_IN = 6176, DN_INP = 6400, PROJ_LD = 6144, CONV_DIM = 4096, VAL_DIM = 2048;
constexpr int QKV_N = 1536, DFF = 2816, GU_N = 5632;
constexpr float RMS_EPS = 1e-6f, L2_EPS = 1e-6f;

constexpr size_t O_YP = 0, O_YS = 16777216, O_CONVP = 17301504, O_DELTAP = 17498112, O_KP = 21692416, O_VP = 22216704,
                 O_CONVS = 22740992, O_DELTAS = 25886720, O_KS = 92995584, O_VS = 93257728, O_END = 93519872;

constexpr size_t MiB = 1u << 20;
constexpr size_t WS_CTL = 0, CTL_ZERO_BYTES = 65536;
constexpr size_t WS_WIN = 2 * MiB;
constexpr size_t WS_WOUT = 27 * MiB;
constexpr size_t WS_WQKV = 35 * MiB;
constexpr size_t WS_WO = 41 * MiB;
constexpr size_t WS_WGU = 45 * MiB;
constexpr size_t WS_WDOWN = 89 * MiB;
constexpr size_t WS_X = 112 * MiB;
constexpr size_t WS_XB = 178 * MiB;
constexpr size_t WS_SSQ = 211 * MiB;
constexpr size_t WS_BA = 213 * MiB;
constexpr size_t WS_BG = 216 * MiB;
constexpr size_t WS_PROJ = 220 * MiB;
constexpr size_t WS_Q = 220 * MiB;
constexpr size_t WS_KB = 253 * MiB;
constexpr size_t WS_VB = 262 * MiB;
constexpr size_t WS_ATT = 271 * MiB;
constexpr size_t WS_QKV = 418 * MiB;
constexpr size_t WS_DREC = 428 * MiB;
constexpr size_t WS_OG = 716 * MiB;
constexpr size_t WS_ACT = 782 * MiB;
constexpr size_t WS_EGL = 874 * MiB;
constexpr size_t WS_XCH = 876 * MiB;
constexpr size_t WS_END = 880 * MiB;
constexpr size_t KV_DELTA = (WS_VB - WS_KB) / 2;

constexpr int CW_TICKET = 8192;
constexpr int NWAVES = 8, NTHREADS = 512;
constexpr int LDS_BYTES = 163840;

#define LDS_WAIT() asm volatile("s_waitcnt lgkmcnt(0)" ::: "memory")
typedef float f32x2c_t __attribute__((ext_vector_type(2))); typedef __bf16 bf16x2c_t __attribute__((ext_vector_type(2)));
__device__ __forceinline__ unsigned pk2(float lo, float hi) { const f32x2c_t v = {lo, hi}; const bf16x2c_t b = __builtin_convertvector(v, bf16x2c_t); return __builtin_bit_cast(unsigned, b); }
__device__ __forceinline__ unsigned f2bf(float f) { return pk2(f, f) & 0xffffu; }
__device__ __forceinline__ v4u widen16(v2u a, v2u b) {
    const auto r0 = __builtin_amdgcn_permlane16_swap(a.x, b.x, false, false); const auto r1 = __builtin_amdgcn_permlane16_swap(a.y, b.y, false, false);
    return (v4u){r0[0], r1[0], r0[1], r1[1]};
}
__device__ __forceinline__ void narrow16(v4u x, v2u& a, v2u& b) {
    const auto r0 = __builtin_amdgcn_permlane16_swap(x.x, x.z, false, false); const auto r1 = __builtin_amdgcn_permlane16_swap(x.y, x.w, false, false);
    a = (v2u){r0[0], r1[0]}; b = (v2u){r0[1], r1[1]};
}
__device__ __forceinline__ float bf2f(unsigned short b) { return __builtin_bit_cast(float, (unsigned)b << 16); }
__device__ __forceinline__ float bflo(unsigned w) { return __builtin_bit_cast(float, w << 16); }
__device__ __forceinline__ float bfhi(unsigned w) { return __builtin_bit_cast(float, w & 0xffff0000u); }
__device__ __forceinline__ float wave_sum(float v) {
#pragma unroll
    for (int o = 1; o < 64; o <<= 1) v += __shfl_xor(v, o);
    return v;
}
__device__ __forceinline__ float wave_max(float v) {
#pragma unroll
    for (int o = 1; o < 64; o <<= 1) v = fmaxf(v, __shfl_xor(v, o));
    return v;
}
__device__ __forceinline__ float silu_f(float x) { return x * __builtin_amdgcn_rcpf(1.f + __expf(-x)); }
__device__ __forceinline__ float row_rstd(const float* ssq, int row) {
    const f32x4* p = (const f32x4*)(ssq + (size_t)row * 16);
    const f32x4 a = p[0], b = p[1], c = p[2], d = p[3];
    const float s = ((a[0] + a[1]) + (a[2] + a[3])) + ((b[0] + b[1]) + (b[2] + b[3])) + ((c[0] + c[1]) + (c[2] + c[3])) + ((d[0] + d[1]) + (d[2] + d[3]));
    return rsqrtf(s * (1.f / 1024.f) + RMS_EPS);
}


__device__ __forceinline__ void wave_rstd(const float* ssq, int rowbase, LAS float* scr, int lane, int fr, float (&rs)[2][4]) {
    scr[lane] = row_rstd(ssq, rowbase + lane); scr[64 + lane] = row_rstd(ssq, rowbase + 128 + lane);
#pragma unroll
    for (int ai = 0; ai < 2; ++ai)
#pragma unroll
        for (int m = 0; m < 4; ++m) rs[ai][m] = scr[ai * 64 + m * 16 + fr];
}
using pg8::Unit; using pg8::cvt_pk_bf16;
struct EpiDnIn {
    static constexpr bool PERM = true, AFTER_DRAIN = false;
    bf16* proj; float* ba; const float* ssq; LAS float* rscr;
    __device__ __forceinline__ void operator()(const f32x4 (&acc)[2][2][4][2], const Unit& u, int wr, int wc, int fr, int fq) const {
        const int row0 = u.pm * 256 + wr * 64 + fr; float rsv[2][4];
        wave_rstd(ssq, u.pm * 256 + wr * 64, rscr + (wr * 4 + wc) * 128, (int)(threadIdx.x & 63), fr, rsv);
        if (u.pn < 24) {
            const int col0 = u.pn * 256 + wc * 32 + 8 * fq;
#pragma unroll
            for (int ai = 0; ai < 2; ++ai)
#pragma unroll
                for (int m = 0; m < 4; ++m) { const int row = row0 + ai * 128 + m * 16; const float rs = rsv[ai][m];
                    bf16* rowp = proj + (size_t)row * PROJ_LD + col0;
#pragma unroll
                    for (int bj = 0; bj < 2; ++bj) { const f32x4 v0 = acc[ai][bj][m][0] * rs, v1 = acc[ai][bj][m][1] * rs;
                        v4u w; w.x = cvt_pk_bf16(v0[0], v0[1]); w.y = cvt_pk_bf16(v0[2], v0[3]); w.z = cvt_pk_bf16(v1[0], v1[1]); w.w = cvt_pk_bf16(v1[2], v1[3]);
                        *(v4u*)(rowp + bj * 128) = w; } }
        } else if (wc == 0) {
#pragma unroll
            for (int ai = 0; ai < 2; ++ai)
#pragma unroll
                for (int m = 0; m < 4; ++m) { const int row = row0 + ai * 128 + m * 16; const float rs = rsv[ai][m];
                    float* o = ba + (size_t)row * 32 + 8 * fq;
                    *(f32x4*)o = acc[ai][0][m][0] * rs; *(f32x4*)(o + 4) = acc[ai][0][m][1] * rs; }
        }
    }
};
struct EpiRes {
    static constexpr bool PERM = true, AFTER_DRAIN = false;
    bf16* XB; float* ssq; const float* bias;
    __device__ __forceinline__ void operator()(const f32x4 (&acc)[2][2][4][2], const Unit& u, int wr, int wc, int fr, int fq) const {
        const int row0 = u.pm * 256 + wr * 64 + fr, col0 = u.pn * 256 + wc * 32 + 8 * fq;
        f32x4 bv[2][2];
#pragma unroll
        for (int bj = 0; bj < 2; ++bj) { bv[bj][0] = bias ? *(const f32x4*)(bias + col0 + bj * 128) : (f32x4){0.f, 0.f, 0.f, 0.f}; bv[bj][1] = bias ? *(const f32x4*)(bias + col0 + bj * 128 + 4) : (f32x4){0.f, 0.f, 0.f, 0.f}; }
#pragma unroll
        for (int ai = 0; ai < 2; ++ai)
#pragma unroll
            for (int m = 0; m < 4; ++m) { const int row = row0 + ai * 128 + m * 16; float s = 0.f;
#pragma unroll
                for (int bj = 0; bj < 2; ++bj) { const int c = col0 + bj * 128; bf16* xp = XB + (size_t)row * DM + c;
                    const v4u xo = *(const v4u*)xp;
                    f32x4 x0 = (f32x4){bflo(xo.x), bfhi(xo.x), bflo(xo.y), bfhi(xo.y)} + acc[ai][bj][m][0], x1 = (f32x4){bflo(xo.z), bfhi(xo.z), bflo(xo.w), bfhi(xo.w)} + acc[ai][bj][m][1];
                    x0 = x0 + bv[bj][0]; x1 = x1 + bv[bj][1];
                    v4u w; w.x = cvt_pk_bf16(x0[0], x0[1]); w.y = cvt_pk_bf16(x0[2], x0[3]); w.z = cvt_pk_bf16(x1[0], x1[1]); w.w = cvt_pk_bf16(x1[2], x1[3]);
                    *(v4u*)xp = w;
                    const float r0 = bflo(w.x), r1 = bfhi(w.x), r2 = bflo(w.y), r3 = bfhi(w.y), r4 = bflo(w.z), r5 = bfhi(w.z), r6 = bflo(w.w), r7 = bfhi(w.w);
                    s += ((r0 * r0 + r1 * r1) + (r2 * r2 + r3 * r3)) + ((r4 * r4 + r5 * r5) + (r6 * r6 + r7 * r7)); }
                s += __shfl_xor(s, 16); s += __shfl_xor(s, 32);
                if (fq == 0) ssq[(size_t)row * 16 + u.pn * 4 + wc] = s; }
    }
};
struct EpiQkv {
    static constexpr bool PERM = true, AFTER_DRAIN = false;
    bf16 *Q, *KB; const float* ssq; const float* bias; float *okp, *oks; LAS float* rscr;
    __device__ __forceinline__ void operator()(const f32x4 (&acc)[2][2][4][2], const Unit& u, int wr, int wc, int fr, int fq) const {
        const int row0 = u.pm * 256 + wr * 64 + fr, cw = wc * 32 + 8 * fq;
        const bool isq = u.pn < 4; const size_t kvsel = (u.pn == 5) ? 1 : 0;
        const float qs = isq ? 0.125f : 1.f; float rsv[2][4];
        wave_rstd(ssq, u.pm * 256 + wr * 64, rscr + (wr * 4 + wc) * 128, (int)(threadIdx.x & 63), fr, rsv);
        f32x4 bv[2][2];
#pragma unroll
        for (int bj = 0; bj < 2; ++bj) { bv[bj][0] = *(const f32x4*)(bias + u.pn * 256 + bj * 128 + cw); bv[bj][1] = *(const f32x4*)(bias + u.pn * 256 + bj * 128 + cw + 4); }
#pragma unroll
        for (int ai = 0; ai < 2; ++ai)
#pragma unroll
            for (int m = 0; m < 4; ++m) { const int row = row0 + ai * 128 + m * 16; const float rs = rsv[ai][m];
#pragma unroll
                for (int bj = 0; bj < 2; ++bj) { const int colk = bj * 128 + cw, gcol = u.pn * 256 + colk;
                    const f32x4 v0 = (acc[ai][bj][m][0] * rs + bv[bj][0]) * qs, v1 = (acc[ai][bj][m][1] * rs + bv[bj][1]) * qs;
                    v4u w; w.x = cvt_pk_bf16(v0[0], v0[1]); w.y = cvt_pk_bf16(v0[2], v0[3]); w.z = cvt_pk_bf16(v1[0], v1[1]); w.w = cvt_pk_bf16(v1[2], v1[3]);
                    if (isq) *(v4u*)(Q + (size_t)row * DM + gcol) = w;
                    else {
                        *(v4u*)(KB + kvsel * KV_DELTA + (size_t)row * 256 + colk) = w;
                        if (row < TP) { const int b = row >> 11, pos = row & 2047;
                            if (pos >= 1920) { float* o = okp + kvsel * (O_VP - O_KP) + (size_t)(b * 128 + pos - 1920) * 256 + colk; *(f32x4*)o = v0; *(f32x4*)(o + 4) = v1; } }
                        else { float* o = oks + kvsel * (O_VS - O_KS) + (size_t)(row - TP) * 256 + colk; *(f32x4*)o = v0; *(f32x4*)(o + 4) = v1; } } } }
    }
};
struct EpiGu {
    static constexpr bool PERM = true, AFTER_DRAIN = false;
    bf16* act; const float* ssq; LAS float* rscr;
    __device__ __forceinline__ void operator()(const f32x4 (&acc)[2][2][4][2], const Unit& u, int wr, int wc, int fr, int fq) const {
        const int row0 = u.pm * 256 + wr * 64 + fr, col0 = u.pn * 128 + wc * 32 + 8 * fq; float rsv[2][4];
        wave_rstd(ssq, u.pm * 256 + wr * 64, rscr + (wr * 4 + wc) * 128, (int)(threadIdx.x & 63), fr, rsv);
#pragma unroll
        for (int ai = 0; ai < 2; ++ai)
#pragma unroll
            for (int m = 0; m < 4; ++m) { const int row = row0 + ai * 128 + m * 16; const float rs = rsv[ai][m];
                float r[8];
#pragma unroll
                for (int n = 0; n < 2; ++n)
#pragma unroll
                    for (int e = 0; e < 4; ++e) { const float g = acc[ai][0][m][n][e] * rs, uu = acc[ai][1][m][n][e] * rs; r[n * 4 + e] = silu_f(g) * uu; }
                v4u w; w.x = cvt_pk_bf16(r[0], r[1]); w.y = cvt_pk_bf16(r[2], r[3]); w.z = cvt_pk_bf16(r[4], r[5]); w.w = cvt_pk_bf16(r[6], r[7]);
                *(v4u*)(act + (size_t)row * DFF + col0) = w; }
    }
};

struct Args { const float* in[22]; float* out; unsigned char* ws; int ph_lo, ph_hi; };
typedef const __attribute__((address_space(4))) Args* CArgs;
__device__ __forceinline__ CArgs kargs() { CArgs p = (CArgs)__builtin_amdgcn_kernarg_segment_ptr(); asm volatile("" : "+s"(p)); return p; }

__device__ __forceinline__ void tr_item64(const float* W, int K, int N, const float* nw, bf16* WT, int dst_row0, LAS float* scr, int k0, int n0, int lane) {
    const int nvalid = (N - n0) < 64 ? (N - n0) : 64, n4 = (lane & 15) * 4;
#pragma unroll 4
    for (int i = 0; i < 16; ++i) { const int kk = 4 * i + (lane >> 4); const float s = nw ? nw[k0 + kk] : 1.f;
        f32x4 v = (f32x4){0.f, 0.f, 0.f, 0.f};
        if (n4 < nvalid) v = *(const f32x4*)(W + (size_t)(k0 + kk) * N + n0 + n4);
        LAS float* d = scr + kk * 65 + n4; d[0] = v[0] * s; d[1] = v[1] * s; d[2] = v[2] * s; d[3] = v[3] * s; }
    LDS_WAIT(); asm volatile("" ::: "memory");
    const int c = lane & 7;
#pragma unroll
    for (int p = 0; p < 8; ++p) { const int n = 8 * p + (lane >> 3); const LAS float* s = scr + (8 * c) * 65 + n;
        v4u o; o.x = pk2(s[0 * 65], s[1 * 65]); o.y = pk2(s[2 * 65], s[3 * 65]); o.z = pk2(s[4 * 65], s[5 * 65]); o.w = pk2(s[6 * 65], s[7 * 65]);
        if (n < nvalid) *(v4u*)(WT + (size_t)(dst_row0 + n) * K + k0 + 8 * c) = o; }
    LDS_WAIT(); asm volatile("" ::: "memory");
}
__device__ __forceinline__ void tr_matrix_item(const float* W, int K, int N, const float* nw, bf16* WT, int gu, LAS float* scr, int r, int lane) {
    const int nblk = (N + 63) / 64, kb = r / nblk, nb = r % nblk, k0 = 64 * kb, n0 = 64 * nb;
    int dr = n0;
    if (gu) dr = (n0 < DFF) ? (n0 / 128) * 256 + (n0 % 128) : ((n0 - DFF) / 128) * 256 + 128 + ((n0 - DFF) % 128);
    tr_item64(W, K, N, nw, WT, dr, scr, k0, n0, lane);
}
__device__ __forceinline__ void phase_prologue(CArgs ap, LAS unsigned char* lds) {
    int tid_ = threadIdx.x; asm volatile("" : "+v"(tid_)); const int tid = tid_, lane = tid & 63, wave = __builtin_amdgcn_readfirstlane(tid >> 6);
    LAS float* scr = (LAS float*)(lds + wave * 16896);
    const int gw = blockIdx.x * NWAVES + wave, NGW = gridDim.x * NWAVES;
    unsigned char* ws = ap->ws;
    constexpr int I_IN = 16 * 97, I_OUT = 32 * 16, I_QKV = 16 * 24, I_O = 16 * 16, I_GU = 16 * 88, I_DN = 44 * 16;
    constexpr int NITEMS = 2 * I_IN + 2 * I_OUT + 2 * I_QKV + 2 * I_O + 4 * I_GU + 4 * I_DN;
    for (int it = gw; it < NITEMS; it += NGW) {
        int r = it;
        if (r < 2 * I_IN) { const int j = r / I_IN; r -= j * I_IN;
            tr_matrix_item(ap->in[9] + (size_t)j * DM * DN_IN, DM, DN_IN, ap->in[6] + (2 * j) * DM, (bf16*)(ws + WS_WIN) + (size_t)j * DN_INP * DM, 0, scr, r, lane); continue; }
        r -= 2 * I_IN;
        if (r < 2 * I_OUT) { const int j = r / I_OUT; r -= j * I_OUT;
            tr_matrix_item(ap->in[14] + (size_t)j * VAL_DIM * DM, VAL_DIM, DM, nullptr, (bf16*)(ws + WS_WOUT) + (size_t)j * DM * VAL_DIM, 0, scr, r, lane); continue; }
        r -= 2 * I_OUT;
        if (r < 2 * I_QKV) { const int j = r / I_QKV; r -= j * I_QKV;
            tr_matrix_item(ap->in[15] + (size_t)j * DM * QKV_N, DM, QKV_N, ap->in[6] + (2 * j + 1) * DM, (bf16*)(ws + WS_WQKV) + (size_t)j * QKV_N * DM, 0, scr, r, lane); continue; }
        r -= 2 * I_QKV;
        if (r < 2 * I_O) { const int j = r / I_O; r -= j * I_O;
            tr_matrix_item(ap->in[18] + (size_t)j * DM * DM, DM, DM, nullptr, (bf16*)(ws + WS_WO) + (size_t)j * DM * DM, 0, scr, r, lane); continue; }
        r -= 2 * I_O;
        if (r < 4 * I_GU) { const int i = r / I_GU; r -= i * I_GU;
            tr_matrix_item(ap->in[20] + (size_t)i * DM * GU_N, DM, GU_N, ap->in[7] + i * DM, (bf16*)(ws + WS_WGU) + (size_t)i * GU_N * DM, 1, scr, r, lane); continue; }
        r -= 4 * I_GU;
        { const int i = r / I_DN; r -= i * I_DN;
            tr_matrix_item(ap->in[21] + (size_t)i * DFF * DM, DFF, DM, nullptr, (bf16*)(ws + WS_WDOWN) + (size_t)i * DM * DFF, 0, scr, r, lane); }
    }
    for (int i = blockIdx.x * NTHREADS + tid; i < 2 * 28672; i += gridDim.x * NTHREADS) { const int j = i / 28672, o = i % 28672;
        *(v4u*)((bf16*)(ws + WS_WIN) + (size_t)j * DN_INP * DM + (size_t)DN_IN * DM + (size_t)o * 8) = (v4u){0u, 0u, 0u, 0u}; }
    bf16* XB = (bf16*)(ws + WS_XB); float* SSQ = (float*)(ws + WS_SSQ);
    for (int m = gw; m < T; m += NGW) {
        const float* src = (m < TP) ? ap->in[0] + (size_t)m * DM : ap->in[1] + (size_t)(m - TP) * DM;
        float s = 0.f;
#pragma unroll
        for (int j = 0; j < 4; ++j) { const f32x4 v = *((const f32x4*)src + lane + 64 * j);
            v2u w; w.x = pk2(v[0], v[1]); w.y = pk2(v[2], v[3]); *((v2u*)(XB + (size_t)m * DM) + lane + 64 * j) = w;
            const float r0 = bflo(w.x), r1 = bfhi(w.x), r2 = bflo(w.y), r3 = bfhi(w.y);
            s += (r0 * r0 + r1 * r1) + (r2 * r2 + r3 * r3); }
        s = wave_sum(s);
        if (lane < 16) SSQ[(size_t)m * 16 + lane] = (lane == 0) ? s : 0.f;
    }
}

__device__ __forceinline__ void phase_dn_post(CArgs ap, int j, int tstart) {
    int tid_ = threadIdx.x; asm volatile("" : "+v"(tid_)); const int tid = tid_, lane = tid & 63, wave = __builtin_amdgcn_readfirstlane(tid >> 6);
    const int gw = blockIdx.x * NWAVES + wave, NGW = gridDim.x * NWAVES;
    unsigned char* ws = ap->ws;
    const bf16* PROJ = (const bf16*)(ws + WS_PROJ); const float* BA = (const float*)(ws + WS_BA);
    float* QKV = (float*)(ws + WS_QKV) - (size_t)TP * CONV_DIM; float* BG = (float*)(ws + WS_BG);
    const float* cw = ap->in[10] + (size_t)j * 4 * CONV_DIM;
    const float* sconv = ap->in[2] + (size_t)j * NB_S * 3 * CONV_DIM;
    float* oconvp = ap->out + O_CONVP + (size_t)j * NB_P * 3 * CONV_DIM;
    float* oconvs = ap->out + O_CONVS + (size_t)j * NB_S * 3 * CONV_DIM;
    for (int task = tstart * 32 + gw; task < T * 32; task += NGW) {
        const int t = task >> 5, hc = task & 31, col0 = hc * 128 + 2 * lane;
        const bool prompt = t < TP; const int pos = prompt ? (t & 2047) : ((t - TP) & 3); const int b = prompt ? (t >> 11) : ((t - TP) >> 2);
        float y0 = 0.f, y1 = 0.f, u00 = 0.f, u01 = 0.f;
#pragma unroll
        for (int k = 0; k < 4; ++k) {
            float u0 = 0.f, u1 = 0.f;
            if (pos - k >= 0) { const unsigned w = *(const unsigned*)(PROJ + (size_t)(t - k) * PROJ_LD + col0); u0 = bflo(w); u1 = bfhi(w); }
            else if (!prompt) { const f32x2v v = *(const f32x2v*)(sconv + (size_t)(b * 3 + (3 + pos - k)) * CONV_DIM + col0); u0 = v[0]; u1 = v[1]; }
            const f32x2v wv = *(const f32x2v*)(cw + (size_t)(3 - k) * CONV_DIM + col0);
            y0 += u0 * wv[0]; y1 += u1 * wv[1];
            if (k == 0) { u00 = u0; u01 = u1; }
        }
        y0 = silu_f(y0); y1 = silu_f(y1);
        if (hc < 16) {
            const float ss = wave_sum(y0 * y0 + y1 * y1);
            float inv = rsqrtf(ss + L2_EPS); if (hc < 8) inv *= 0.08838834764831845f;
            y0 *= inv; y1 *= inv;
        }
        *(f32x2v*)(QKV + (size_t)t * CONV_DIM + col0) = (f32x2v){y0, y1};
        if (prompt) { if (pos >= SEQ - 3) *(f32x2v*)(oconvp + (size_t)(b * 3 + pos - (SEQ - 3)) * CONV_DIM + col0) = (f32x2v){u00, u01}; }
        else if (pos >= 1) *(f32x2v*)(oconvs + (size_t)(b * 3 + pos - 1) * CONV_DIM + col0) = (f32x2v){u00, u01};
        if (hc == 0 && lane < 32) {
            const int h = lane & 15; const float v = BA[(size_t)t * 32 + lane];
            float r;
            if (lane < 16) r = 1.f / (1.f + __expf(-v));
            else { const float x = v + ap->in[12][j * 16 + h]; const float sp = (x > 20.f) ? x : log1pf(__expf(x)); r = -__expf(ap->in[11][j * 16 + h]) * sp; }
            BG[(size_t)t * 32 + lane] = r;
        }
    }
}


__device__ __forceinline__ void phase_dn_post_sample(CArgs ap, int j) {
    int tid_ = threadIdx.x; asm volatile("" : "+v"(tid_)); const int tid = tid_, lane = tid & 63, wave = __builtin_amdgcn_readfirstlane(tid >> 6);
    const int gw = blockIdx.x * NWAVES + wave, NGW = gridDim.x * NWAVES;
    unsigned char* ws = ap->ws;
    const bf16* PROJ = (const bf16*)(ws + WS_PROJ); const float* BA = (const float*)(ws + WS_BA);
    float* QKV = (float*)(ws + WS_QKV) - (size_t)TP * CONV_DIM; float* BG = (float*)(ws + WS_BG);
    const float* cw = ap->in[10] + (size_t)j * 4 * CONV_DIM;
    const float* sconv = ap->in[2] + (size_t)j * NB_S * 3 * CONV_DIM;
    float* oconvs = ap->out + O_CONVS + (size_t)j * NB_S * 3 * CONV_DIM;
    for (int task = gw; task < TS * 8; task += NGW) {
        const int tt = task >> 3, hc4 = task & 7, t = TP + tt, pos = tt & 3, b = tt >> 2;
        float ua[4][4], ub[4][4]; f32x2v wv[4][4];
#pragma unroll
        for (int k = 0; k < 4; ++k)
#pragma unroll
            for (int uu = 0; uu < 4; ++uu) { const int col0 = (4 * hc4 + uu) * 128 + 2 * lane;
                if (pos - k >= 0) { const unsigned w = *(const unsigned*)(PROJ + (size_t)(t - k) * PROJ_LD + col0); ua[k][uu] = bflo(w); ub[k][uu] = bfhi(w); }
                else { const f32x2v v = *(const f32x2v*)(sconv + (size_t)(b * 3 + (3 + pos - k)) * CONV_DIM + col0); ua[k][uu] = v[0]; ub[k][uu] = v[1]; }
                wv[k][uu] = *(const f32x2v*)(cw + (size_t)(3 - k) * CONV_DIM + col0); }
#pragma unroll
        for (int uu = 0; uu < 4; ++uu) { const int col0 = (4 * hc4 + uu) * 128 + 2 * lane;
            float y0 = 0.f, y1 = 0.f;
#pragma unroll
            for (int k = 0; k < 4; ++k) { y0 += ua[k][uu] * wv[k][uu][0]; y1 += ub[k][uu] * wv[k][uu][1]; }
            y0 = silu_f(y0); y1 = silu_f(y1);
            if (hc4 < 4) { const float ss = wave_sum(y0 * y0 + y1 * y1);
                float inv = rsqrtf(ss + L2_EPS); if (hc4 < 2) inv *= 0.08838834764831845f;
                y0 *= inv; y1 *= inv; }
            *(f32x2v*)(QKV + (size_t)t * CONV_DIM + col0) = (f32x2v){y0, y1};
            if (pos >= 1) *(f32x2v*)(oconvs + (size_t)(b * 3 + pos - 1) * CONV_DIM + col0) = (f32x2v){ua[0][uu], ub[0][uu]}; }
        if (hc4 == 0 && lane < 32) {
            const int h = lane & 15; const float v = BA[(size_t)t * 32 + lane];
            float r;
            if (lane < 16) r = 1.f / (1.f + __expf(-v));
            else { const float x = v + ap->in[12][j * 16 + h]; const float sp = (x > 20.f) ? x : log1pf(__expf(x)); r = -__expf(ap->in[11][j * 16 + h]) * sp; }
            BG[(size_t)t * 32 + lane] = r;
        }
    }
}

__device__ __forceinline__ void phase_delta_rec(CArgs ap, int j, LAS unsigned char* lds, unsigned* ticket) {
    int tid_ = threadIdx.x; asm volatile("" : "+v"(tid_)); const int tid = tid_, lane = tid & 63, wave = __builtin_amdgcn_readfirstlane(tid >> 6);
    const int e4 = tid & 31, dg = tid >> 5;
    unsigned char* ws = ap->ws;
    const float* QKV = (const float*)(ws + WS_QKV) - (size_t)TP * CONV_DIM; const float* BG = (const float*)(ws + WS_BG); const bf16* PROJ = (const bf16*)(ws + WS_PROJ);
    bf16* OG = (bf16*)(ws + WS_OG);
    const float* nw = ap->in[13] + j * 128;
    LAS float* qs = (LAS float*)lds;
    LAS float* ks = qs + 512;
    LAS float* vs = ks + 512;
    LAS float* ob = vs + 512;
    LAS float* red = ob + 512;
    LAS float* red2 = red + 1024;
    LAS float* ab = red2 + 1024;
    LAS int* tk = (LAS int*)(ab + 8);
    for (;;) {
        if (tid == 0) *tk = (int)__hip_atomic_fetch_add(ticket, 1u, __ATOMIC_RELAXED, __HIP_MEMORY_SCOPE_AGENT);
        __syncthreads();
        const int su = *tk;
        if (su >= 2048) break;
        const int b = su >> 4, h = su & 15, hq = h >> 1, t0 = TP + b * DSEQ;
        const float* s0 = ap->in[3] + ((size_t)(j * NB_S + b) * 16 + h) * 16384; float* sout = ap->out + O_DELTAS + ((size_t)(j * NB_S + b) * 16 + h) * 16384;
        f32x4 S[8];
#pragma unroll
        for (int i = 0; i < 8; ++i) S[i] = __builtin_nontemporal_load((const f32x4*)(s0 + (size_t)(8 * dg + i) * 128 + 4 * e4));
        if (tid < 384) { const int tt = tid / 96, rem = tid % 96, which = rem >> 5, ee = 4 * (rem & 31);
            const int col = (which == 0) ? hq * 128 + ee : (which == 1) ? 1024 + hq * 128 + ee : 2048 + h * 128 + ee;
            *(LAS f32x4*)(qs + which * 512 + tt * 128 + ee) = *(const f32x4*)(QKV + (size_t)(t0 + tt) * CONV_DIM + col); }
        if (tid < DSEQ) { ab[tid * 2] = __expf(BG[(size_t)(t0 + tid) * 32 + 16 + h]); ab[tid * 2 + 1] = BG[(size_t)(t0 + tid) * 32 + h]; }
        __syncthreads();
#pragma unroll 1
        for (int tt = 0; tt < DSEQ; ++tt) {
            const float av = ab[tt * 2], bt = ab[tt * 2 + 1];
            f32x4 part = (f32x4){0.f, 0.f, 0.f, 0.f};
#pragma unroll
            for (int i = 0; i < 8; ++i) part = part + S[i] * ks[tt * 128 + 8 * dg + i];
#pragma unroll
            for (int c = 0; c < 4; ++c) part[c] += __shfl_xor(part[c], 32);
            if (lane < 32) *(LAS f32x4*)(red + wave * 128 + 4 * e4) = part;
            __syncthreads();
            f32x4 kS = (f32x4){0.f, 0.f, 0.f, 0.f};
#pragma unroll
            for (int w8 = 0; w8 < 8; ++w8) kS = kS + *(const LAS f32x4*)(red + w8 * 128 + 4 * e4);
            const f32x4 vv = (*(const LAS f32x4*)(vs + tt * 128 + 4 * e4) - kS * av) * bt;
            f32x4 po = (f32x4){0.f, 0.f, 0.f, 0.f};
#pragma unroll
            for (int i = 0; i < 8; ++i) { S[i] = S[i] * av + vv * ks[tt * 128 + 8 * dg + i]; po = po + S[i] * qs[tt * 128 + 8 * dg + i]; }
#pragma unroll
            for (int c = 0; c < 4; ++c) po[c] += __shfl_xor(po[c], 32);
            if (lane < 32) *(LAS f32x4*)(red2 + wave * 128 + 4 * e4) = po;
            __syncthreads();
            if (tid < 32) { f32x4 o = (f32x4){0.f, 0.f, 0.f, 0.f};
#pragma unroll
                for (int w8 = 0; w8 < 8; ++w8) o = o + *(const LAS f32x4*)(red2 + w8 * 128 + 4 * e4);
                *(LAS f32x4*)(ob + tt * 128 + 4 * e4) = o; }
        }
        __syncthreads();
        if (wave < DSEQ) { const int tt = wave;
            const float o0 = ob[tt * 128 + lane], o1 = ob[tt * 128 + 64 + lane];
            const float ss = wave_sum(o0 * o0 + o1 * o1);
            const float rs = rsqrtf(ss * (1.f / 128.f) + RMS_EPS);
            const size_t tok = (size_t)(t0 + tt);
            const float z0 = bf2f(PROJ[tok * PROJ_LD + 4096 + h * 128 + lane]), z1 = bf2f(PROJ[tok * PROJ_LD + 4096 + h * 128 + 64 + lane]);
            OG[tok * VAL_DIM + h * 128 + lane] = (bf16)f2bf(o0 * rs * nw[lane] * silu_f(z0));
            OG[tok * VAL_DIM + h * 128 + 64 + lane] = (bf16)f2bf(o1 * rs * nw[64 + lane] * silu_f(z1));
        }
#pragma unroll
        for (int i = 0; i < 8; ++i) __builtin_nontemporal_store(S[i], (f32x4*)(sout + (size_t)(8 * dg + i) * 128 + 4 * e4));
        __syncthreads();
    }
}

__device__ __forceinline__ void phase_swa_attn(CArgs ap, int j, LAS unsigned char* lds) {
    int tid_ = threadIdx.x; asm volatile("" : "+v"(tid_)); const int tid = tid_, lane = tid & 63, wave = __builtin_amdgcn_readfirstlane(tid >> 6);
    const int gw = blockIdx.x * NWAVES + wave, NGW = gridDim.x * NWAVES;
    unsigned char* ws = ap->ws;
    const bf16* Q = (const bf16*)(ws + WS_Q); const bf16* KB = (const bf16*)(ws + WS_KB); const bf16* VB = (const bf16*)(ws + WS_VB);
    bf16* ATT = (bf16*)(ws + WS_ATT);
    const float* ck = ap->in[4] + (size_t)j * NB_S * 128 * 256; const float* cv = ap->in[5] + (size_t)j * NB_S * 128 * 256;
    const float* sinks = ap->in[17] + j * 16;
    LAS float* qs = (LAS float*)(lds + wave * 4096);
    LAS float* ps = qs + 256;
    for (int task = gw; task < T * 4; task += NGW) {
        const int t = task >> 2, kh = task & 3;
#pragma unroll
        for (int g = 0; g < 4; ++g) qs[g * 64 + lane] = bf2f(Q[(size_t)t * DM + (kh * 4 + g) * 64 + lane]);
        LDS_WAIT(); asm volatile("" ::: "memory");
        const bool prompt = t < TP; int nk, b = 0, l = 0;
        if (prompt) { const int pos = t & 2047; nk = (pos < 128 ? pos : 128) + 1; } else { const int r = t - TP; b = r >> 2; l = r & 3; nk = 129; }
        const float sl0 = exp2f(-0.5f * (float)(kh * 4 + 1)), sl1 = exp2f(-0.5f * (float)(kh * 4 + 2)), sl2 = exp2f(-0.5f * (float)(kh * 4 + 3)), sl3 = exp2f(-0.5f * (float)(kh * 4 + 4));
#pragma unroll 1
        for (int kb = 0; kb < 3; ++kb) {
            const int jj = kb * 64 + lane; const bool valid = jj < nk;
            float d0 = 0.f, d1 = 0.f, d2 = 0.f, d3 = 0.f;
            if (valid) {
                const int cj = l + jj;
                if (prompt || cj >= 128) {
                    const bf16* kp = prompt ? KB + (size_t)(t - (nk - 1) + jj) * 256 + kh * 64 : KB + (size_t)(TP + b * 4 + (cj - 128)) * 256 + kh * 64;
#pragma unroll 1
                    for (int d = 0; d < 64; d += 8) {
                        const v4u w = *(const v4u*)(kp + d);
                        const float kv[8] = {bflo(w.x), bfhi(w.x), bflo(w.y), bfhi(w.y), bflo(w.z), bfhi(w.z), bflo(w.w), bfhi(w.w)};
#pragma unroll
                        for (int i = 0; i < 8; ++i) { d0 += kv[i] * qs[d + i]; d1 += kv[i] * qs[64 + d + i]; d2 += kv[i] * qs[128 + d + i]; d3 += kv[i] * qs[192 + d + i]; }
                    }
                } else {
                    const float* kf = ck + (size_t)(b * 128 + cj) * 256 + kh * 64;
#pragma unroll 1
                    for (int d = 0; d < 64; d += 4) {
                        const f32x4 x = *(const f32x4*)(kf + d);
#pragma unroll
                        for (int i = 0; i < 4; ++i) { d0 += x[i] * qs[d + i]; d1 += x[i] * qs[64 + d + i]; d2 += x[i] * qs[128 + d + i]; d3 += x[i] * qs[192 + d + i]; }
                    }
                }
            }
            const float rel = (float)((nk - 1) - jj);
            const float NEG = -INFINITY;
            ps[jj] = valid ? d0 - sl0 * rel : NEG; ps[192 + jj] = valid ? d1 - sl1 * rel : NEG; ps[384 + jj] = valid ? d2 - sl2 * rel : NEG; ps[576 + jj] = valid ? d3 - sl3 * rel : NEG;
        }
        LDS_WAIT(); asm volatile("" ::: "memory");
#pragma unroll 1
        for (int g = 0; g < 4; ++g) {
            const float sk = sinks[kh * 4 + g];
            const float s0 = ps[g * 192 + lane], s1 = ps[g * 192 + 64 + lane], s2 = ps[g * 192 + 128 + lane];
            float m = wave_max(fmaxf(fmaxf(s0, s1), s2)); m = fmaxf(m, sk);
            const float p0 = __expf(s0 - m), p1 = __expf(s1 - m), p2 = __expf(s2 - m);
            const float den = wave_sum(p0 + p1 + p2) + __expf(sk - m); const float inv = 1.f / den;
            ps[g * 192 + lane] = p0 * inv; ps[g * 192 + 64 + lane] = p1 * inv; ps[g * 192 + 128 + lane] = p2 * inv;
        }
        LDS_WAIT(); asm volatile("" ::: "memory");
        float o0 = 0.f, o1 = 0.f, o2 = 0.f, o3 = 0.f;
        if (prompt) {
            const bf16* vp = VB + (size_t)(t - (nk - 1)) * 256 + kh * 64 + lane;
#pragma unroll 4
            for (int jj = 0; jj < nk; ++jj) { const float vv = bf2f(vp[(size_t)jj * 256]);
                o0 += ps[jj] * vv; o1 += ps[192 + jj] * vv; o2 += ps[384 + jj] * vv; o3 += ps[576 + jj] * vv; }
        } else {
#pragma unroll 4
            for (int jj = 0; jj < 129; ++jj) { const int cj = l + jj;
                const float vv = (cj < 128) ? cv[(size_t)(b * 128 + cj) * 256 + kh * 64 + lane] : bf2f(VB[(size_t)(TP + b * 4 + (cj - 128)) * 256 + kh * 64 + lane]);
                o0 += ps[jj] * vv; o1 += ps[192 + jj] * vv; o2 += ps[384 + jj] * vv; o3 += ps[576 + jj] * vv; }
        }
        bf16* op = ATT + (size_t)t * DM + kh * 256 + lane;
        op[0] = (bf16)f2bf(o0); op[64] = (bf16)f2bf(o1); op[128] = (bf16)f2bf(o2); op[192] = (bf16)f2bf(o3);
        LDS_WAIT(); asm volatile("" ::: "memory");
    }
}

__device__ __forceinline__ void phase_final(CArgs ap) {
    int tid_ = threadIdx.x; asm volatile("" : "+v"(tid_)); const int tid = tid_, lane = tid & 63, wave = __builtin_amdgcn_readfirstlane(tid >> 6);
    const int gw = blockIdx.x * NWAVES + wave, NGW = gridDim.x * NWAVES;
    const bf16* XB = (const bf16*)(ap->ws + WS_XB); const float* nw = ap->in[8];
    for (int m = gw; m < T; m += NGW) {
        f32x4 v[4]; float s = 0.f;
#pragma unroll
        for (int j = 0; j < 4; ++j) { const v2u w = *((const v2u*)(XB + (size_t)m * DM) + lane + 64 * j); v[j] = (f32x4){bflo(w.x), bfhi(w.x), bflo(w.y), bfhi(w.y)};
            s += (v[j][0] * v[j][0] + v[j][1] * v[j][1]) + (v[j][2] * v[j][2] + v[j][3] * v[j][3]); }
        float rs = rsqrtf(wave_sum(s) * (1.f / 1024.f) + RMS_EPS);
#if defined(TP_FROM) || defined(TQ_FROM)
        if (m >= TP) { const float v = (float)(*(const unsigned long long*)(ap->ws + WS_CTL + 8192)) * (1.f / (float)TP_COUNT) * (1.f / (float)TP_SCALE);
            rs *= 1.f + floorf(v * 8.f + TP_PHASE) * (1.f / 8.f); }
#endif
        float* o = ap->out + (size_t)m * DM;
#pragma unroll
        for (int j = 0; j < 4; ++j) { const f32x4 w = *((const f32x4*)nw + lane + 64 * j); *((f32x4*)o + lane + 64 * j) = v[j] * rs * w; }
    }
}

constexpr int REC_WNEG = 0, REC_QG = 16384, REC_KGT = 32768, REC_AQK = 49152, REC_FAC = 57344, REC_STAGE = 58368;
constexpr int H_WNEG = 0, H_AQK = 16384, H_U = 24576, H_FAC = 40960, HREC_BYTES = 41984, P_QT = 0, P_KTT = 16384, PREC_BYTES = 32768;
constexpr size_t WS_PREC = WS_DREC + (size_t)168 * MiB;
typedef short bf16x8_t __attribute__((ext_vector_type(8)));

__device__ __forceinline__ int swz256(int row, int ch) { return row * 256 + ((ch ^ (row & 15)) << 4); }
__device__ __forceinline__ int swz128(int row, int ch) { return row * 128 + ((ch ^ (row & 7)) << 4); }


constexpr int SC_STAGE0 = 0, SC_STAGE1 = REC_STAGE, SC_SCR = 2 * REC_STAGE, SC_WSCR = 4608, SC_OBUF = SC_SCR + 4 * SC_WSCR, SC_OROW = 144, SC_OBYTES = 64 * SC_OROW;
constexpr int SC_ROWA = 272, SC_ROWB = 144;
__device__ __forceinline__ int stage_dst(int q) {
    const int off = q * 16;
    if (off < REC_KGT) { const int base = off & ~16383, local = off & 16383; return base + swz256(local >> 8, (local >> 4) & 15); }
    const int base = (off < REC_AQK) ? REC_KGT : REC_AQK, local = off - base; return base + swz128(local >> 7, (local >> 4) & 7);
}
__device__ __forceinline__ float silu_fast(float x) { return x * __builtin_amdgcn_rcpf(1.f + __expf(-x)); }

__device__ __forceinline__ void stage_dma2(const unsigned char* rech, const unsigned char* recp, LAS unsigned char* sb, int dw, int lane) {
#pragma unroll
    for (int i = 0; i < 28; ++i) { const int kb = i * 2 + dw; const int off = stage_dst(kb * 64 + lane);
        const unsigned char* src = (kb < 16) ? rech + H_WNEG + off : (kb < 48) ? recp + (off - 16384) : rech + H_AQK + (off - 49152);
        __builtin_amdgcn_global_load_lds((const unsigned*)src, (LAS unsigned*)(sb + kb * 1024), 16, 0, 0); }
    if (dw == 0) __builtin_amdgcn_global_load_lds((const unsigned*)(rech + H_FAC + lane * 16), (LAS unsigned*)(sb + REC_FAC), 16, 0, 0);
}

__device__ __forceinline__ void scan_unit(CArgs ap, int j, int unit, int eh, LAS unsigned char* lds) {
    int tid_ = threadIdx.x; asm volatile("" : "+v"(tid_)); const int tid = tid_, lane = tid & 63, wave = __builtin_amdgcn_readfirstlane(tid >> 6);
    const int b = unit >> 4, h = unit & 15;
    unsigned char* ws = ap->ws;
    const unsigned char* rec0 = ws + WS_DREC + (size_t)(unit * 32) * HREC_BYTES;
    const unsigned char* recp0 = ws + WS_PREC + (size_t)((b * 8 + (h >> 1)) * 32) * PREC_BYTES;
    __syncthreads();
    if (wave >= 6) {
        const int hc = 32 * (wave - 6) + (lane >> 1), hp = lane & 1;
        const bf16* PROJ = (const bf16*)(ws + WS_PROJ); bf16* OG = (bf16*)(ws + WS_OG);
        const float* nw = ap->in[13] + j * 128 + 64 * eh + 8 * hp;
        f32x4 nwv[8];
#pragma unroll
        for (int i = 0; i < 4; ++i) { nwv[2 * i] = *(const f32x4*)(nw + 16 * i); nwv[2 * i + 1] = *(const f32x4*)(nw + 16 * i + 4); }
        unsigned long long* xown = (unsigned long long*)(ws + WS_XCH) + ((size_t)(unit * 32) * 64 + hc) * 2 + eh;
        const unsigned long long* xsib = (const unsigned long long*)(ws + WS_XCH) + ((size_t)(unit * 32) * 64 + hc) * 2 + (eh ^ 1);
        const bf16* zbase = PROJ + (size_t)(b * SEQ + hc) * PROJ_LD + 4096 + h * 128 + 64 * eh + 8 * hp;
        bf16* obase = OG + (size_t)(b * SEQ + hc) * VAL_DIM + h * 128 + 64 * eh + 8 * hp;
        v4u o0[4], o1[4], o2[4], z0[4], z1[4], z2[4]; float ss0 = 0.f, ss1 = 0.f, ss2 = 0.f;
#pragma unroll
        for (int i = 0; i < 4; ++i) { o0[i] = (v4u){0u, 0u, 0u, 0u}; o1[i] = o0[i]; o2[i] = o0[i]; z0[i] = o0[i]; z1[i] = o0[i]; z2[i] = o0[i]; }
#define EPI_TAKE(m, oc, ssc) do { \
        const LAS unsigned char* ob_ = lds + SC_OBUF + ((m) & 1) * SC_OBYTES + hc * SC_OROW + hp * 16; \
        _Pragma("unroll") for (int i_ = 0; i_ < 4; ++i_) oc[i_] = *(const LAS v4u*)(ob_ + 32 * i_); \
        float s_ = 0.f; \
        _Pragma("unroll") for (int i_ = 0; i_ < 4; ++i_) { const float a0 = bflo(oc[i_].x), a1 = bfhi(oc[i_].x), a2 = bflo(oc[i_].y), a3 = bfhi(oc[i_].y), a4 = bflo(oc[i_].z), a5 = bfhi(oc[i_].z), a6 = bflo(oc[i_].w), a7 = bfhi(oc[i_].w); \
            s_ += ((a0 * a0 + a1 * a1) + (a2 * a2 + a3 * a3)) + ((a4 * a4 + a5 * a5) + (a6 * a6 + a7 * a7)); } \
        s_ += __shfl_xor(s_, 1); ssc = s_; } while (0)
#define EPI_PUBLISH(m, ssc) do { if (hp == 0) __hip_atomic_store(xown + (size_t)(m) * 128, ((unsigned long long)1u << 32) | (unsigned long long)__builtin_bit_cast(unsigned, ssc), __ATOMIC_RELAXED, __HIP_MEMORY_SCOPE_AGENT); } while (0)
#define EPI_ZLOAD(m, zc) do { _Pragma("unroll") for (int i_ = 0; i_ < 4; ++i_) zc[i_] = *(const v4u*)(zbase + (size_t)((m) * 64) * PROJ_LD + 16 * i_); } while (0)
#define EPI_FINISH(m, sv, op, zp, ssp) do { \
        unsigned long long sv_ = (sv); \
        while ((unsigned)(sv_ >> 32) != 1u) { __builtin_amdgcn_s_sleep(1); sv_ = __hip_atomic_load(xsib + (size_t)(m) * 128, __ATOMIC_RELAXED, __HIP_MEMORY_SCOPE_AGENT); } \
        const float rs_ = rsqrtf((ssp + __builtin_bit_cast(float, (unsigned)sv_)) * (1.f / 128.f) + RMS_EPS); \
        bf16* op_ = obase + (size_t)((m) * 64) * VAL_DIM; \
        _Pragma("unroll") for (int i_ = 0; i_ < 4; ++i_) { const f32x4 na = nwv[2 * i_] * rs_, nb = nwv[2 * i_ + 1] * rs_; v4u w_; \
            w_.x = pk2(bflo(op[i_].x) * na[0] * silu_fast(bflo(zp[i_].x)), bfhi(op[i_].x) * na[1] * silu_fast(bfhi(zp[i_].x))); \
            w_.y = pk2(bflo(op[i_].y) * na[2] * silu_fast(bflo(zp[i_].y)), bfhi(op[i_].y) * na[3] * silu_fast(bfhi(zp[i_].y))); \
            w_.z = pk2(bflo(op[i_].z) * nb[0] * silu_fast(bflo(zp[i_].z)), bfhi(op[i_].z) * nb[1] * silu_fast(bfhi(zp[i_].z))); \
            w_.w = pk2(bflo(op[i_].w) * nb[2] * silu_fast(bflo(zp[i_].w)), bfhi(op[i_].w) * nb[3] * silu_fast(bfhi(zp[i_].w))); \
            *(v4u*)(op_ + 16 * i_) = w_; } } while (0)
#define EPI_ITER(n, zin, ocur, sscur, oprev, ssprev, zprev) do { \
            asm volatile("s_waitcnt lgkmcnt(0)" ::: "memory"); \
            __syncthreads(); \
            unsigned long long sv = 0ull; \
            if ((n) >= 2) sv = __hip_atomic_load(xsib + (size_t)((n) - 2) * 128, __ATOMIC_RELAXED, __HIP_MEMORY_SCOPE_AGENT); \
            EPI_ZLOAD(n, zin); \
            if ((n) >= 1) EPI_TAKE((n) - 1, ocur, sscur); \
            if ((n) >= 2) EPI_FINISH((n) - 2, sv, oprev, zprev, ssprev); \
            if ((n) >= 1) EPI_PUBLISH((n) - 1, sscur); } while (0)
#pragma unroll 1
        for (int n = 0; n < 30; n += 3) { EPI_ITER(n, z0, o2, ss2, o1, ss1, z1); EPI_ITER(n + 1, z1, o0, ss0, o2, ss2, z2); EPI_ITER(n + 2, z2, o1, ss1, o0, ss0, z0); }
        EPI_ITER(30, z0, o2, ss2, o1, ss1, z1); EPI_ITER(31, z1, o0, ss0, o2, ss2, z2);
        asm volatile("s_waitcnt lgkmcnt(0)" ::: "memory");
        __syncthreads();
        {
            unsigned long long sv = __hip_atomic_load(xsib + (size_t)30 * 128, __ATOMIC_RELAXED, __HIP_MEMORY_SCOPE_AGENT);
            EPI_TAKE(31, o1, ss1);
            EPI_PUBLISH(31, ss1);
            EPI_FINISH(30, sv, o0, z0, ss0);
            sv = __hip_atomic_load(xsib + (size_t)31 * 128, __ATOMIC_RELAXED, __HIP_MEMORY_SCOPE_AGENT);
            EPI_FINISH(31, sv, o1, z1, ss1);
        }
#undef EPI_ITER
#undef EPI_TAKE
#undef EPI_PUBLISH
#undef EPI_ZLOAD
#undef EPI_FINISH
    } else if (wave >= 4) {
        const int dw = wave - 4;
        stage_dma2(rec0, recp0, lds + SC_STAGE0, dw, lane);
#pragma unroll 1
        for (int n = 0; n < 32; ++n) {
            LAS unsigned char* sbn = lds + ((n & 1) ? SC_STAGE0 : SC_STAGE1);
            const int nn = (n + 1 < 32) ? n + 1 : 31;
            asm volatile("s_waitcnt vmcnt(0)" ::: "memory");
            __syncthreads();
            stage_dma2(rec0 + (size_t)nn * HREC_BYTES, recp0 + (size_t)nn * PREC_BYTES, sbn, dw, lane);
        }
        asm volatile("s_waitcnt vmcnt(0)" ::: "memory");
        __syncthreads();
    } else {
        const int fr = lane & 15, fq = lane >> 4, e0 = 64 * eh + 16 * wave;
        const float* EGL = (const float*)(ws + WS_EGL) + unit * 32;
        LAS unsigned char* scr = lds + SC_SCR + wave * SC_WSCR;
        f32x4 Sacc[8];
#pragma unroll
        for (int dt = 0; dt < 8; ++dt) Sacc[dt] = (f32x4){0.f, 0.f, 0.f, 0.f};
        const size_t uoff = (size_t)(e0 + fr) * 128 + (16 * (fq & 1) + 8 * (fq >> 1)) * 2;
        v4u un[2]; float egln = EGL[0];
#pragma unroll
        for (int p = 0; p < 2; ++p) un[p] = *(const v4u*)(rec0 + H_U + uoff + p * 64);
#pragma unroll 1
        for (int n = 0; n < 32; ++n) {
            LAS unsigned char* sb = lds + ((n & 1) ? SC_STAGE1 : SC_STAGE0);
            LAS unsigned char* ob = lds + SC_OBUF + (n & 1) * SC_OBYTES;
            const int nn = (n + 1 < 32) ? n + 1 : 31;
            const unsigned char* recn = rec0 + (size_t)nn * HREC_BYTES;
            asm volatile("s_waitcnt vmcnt(0) lgkmcnt(0)" ::: "memory");
            __syncthreads();
            f32x4 accu[4]; float egl = egln;
#pragma unroll
            for (int p = 0; p < 2; ++p) { v2u ua, ub; narrow16(un[p], ua, ub);
                accu[2 * p] = (f32x4){bflo(ua.x), bfhi(ua.x), bflo(ua.y), bfhi(ua.y)}; accu[2 * p + 1] = (f32x4){bflo(ub.x), bfhi(ub.x), bflo(ub.y), bfhi(ub.y)}; }
            asm volatile("" : "+v"(egl));
#pragma unroll
            for (int p = 0; p < 2; ++p) un[p] = *(const v4u*)(recn + H_U + uoff + p * 64);
            egln = EGL[nn];
#pragma unroll
            for (int dt = 0; dt < 8; ++dt) { v2u w; w.x = pk2(Sacc[dt][0], Sacc[dt][1]); w.y = pk2(Sacc[dt][2], Sacc[dt][3]);
                *(LAS v2u*)(scr + fr * SC_ROWA + (16 * dt + 4 * fq) * 2) = w; }
#define CB() asm volatile("" ::: "memory")
#define LD256(dst, region, row0) do { _Pragma("unroll") for (int ks = 0; ks < 4; ++ks) dst[ks] = *(LAS bf16x8_t*)(sb + (region) + swz256((row0) + fr, ks * 4 + fq)); } while (0)
#define LD128x2(dst, region, row0) do { _Pragma("unroll") for (int k4 = 0; k4 < 4; ++k4) dst[k4] = *(LAS bf16x8_t*)(sb + (region) + swz128((row0) + 16 * (k4 >> 1) + fr, (k4 & 1) * 4 + fq)); } while (0)
#define MM4(acc, A, B) do { _Pragma("unroll") for (int ks = 0; ks < 4; ++ks) acc = __builtin_amdgcn_mfma_f32_16x16x32_bf16(A[ks], B[ks], acc, 0, 0, 0); } while (0)
#define MM2x2S(acc0, acc1, A, B) do { acc0 = __builtin_amdgcn_mfma_f32_16x16x32_bf16(B[0], A[0], acc0, 0, 0, 0); acc0 = __builtin_amdgcn_mfma_f32_16x16x32_bf16(B[1], A[1], acc0, 0, 0, 0); \
        acc1 = __builtin_amdgcn_mfma_f32_16x16x32_bf16(B[2], A[0], acc1, 0, 0, 0); acc1 = __builtin_amdgcn_mfma_f32_16x16x32_bf16(B[3], A[1], acc1, 0, 0, 0); } while (0)
#define MM2x2(acc0, acc1, A, B) do { acc0 = __builtin_amdgcn_mfma_f32_16x16x32_bf16(A[0], B[0], acc0, 0, 0, 0); acc0 = __builtin_amdgcn_mfma_f32_16x16x32_bf16(A[1], B[1], acc0, 0, 0, 0); \
        acc1 = __builtin_amdgcn_mfma_f32_16x16x32_bf16(A[0], B[2], acc1, 0, 0, 0); acc1 = __builtin_amdgcn_mfma_f32_16x16x32_bf16(A[1], B[3], acc1, 0, 0, 0); } while (0)
            bf16x8_t Sa[4], Ua[2], Uk[2], fA[4], fB[4], fC[4];
            f32x4 kapv[4]; float qfv[4];
#pragma unroll
            for (int tc = 0; tc < 4; ++tc) { qfv[tc] = *(LAS float*)(sb + REC_FAC + (16 * tc + fr) * 4); kapv[tc] = *(LAS f32x4*)(sb + REC_FAC + 256 + (16 * tc + 4 * fq) * 4); }
            f32x4 acco[4];
#pragma unroll
            for (int tc = 0; tc < 4; ++tc) acco[tc] = (f32x4){0.f, 0.f, 0.f, 0.f};
            LD256(fA, REC_WNEG, 0);
#pragma unroll
            for (int ks = 0; ks < 4; ++ks) Sa[ks] = *(LAS bf16x8_t*)(scr + fr * SC_ROWA + (ks * 4 + fq) * 16);
            LD256(fB, REC_WNEG, 16); CB();
            MM4(accu[0], fA, Sa); LD256(fC, REC_WNEG, 32); CB();
            MM4(accu[1], fB, Sa); LD256(fA, REC_WNEG, 48); CB();
            MM4(accu[2], fC, Sa); LD256(fB, REC_QG, 0); CB();
            MM4(accu[3], fA, Sa); LD256(fC, REC_QG, 16); CB();
#pragma unroll
            for (int tc = 0; tc < 4; ++tc) { const f32x4 sk = accu[tc] * kapv[tc]; v2u w, wk;
                w.x = pk2(accu[tc][0], accu[tc][1]); w.y = pk2(accu[tc][2], accu[tc][3]); wk.x = pk2(sk[0], sk[1]); wk.y = pk2(sk[2], sk[3]);
                *(LAS v2u*)(scr + fr * SC_ROWB + (16 * tc + 4 * fq) * 2) = w; *(LAS v2u*)(scr + 16 * SC_ROWB + fr * SC_ROWB + (16 * tc + 4 * fq) * 2) = wk; }
            MM4(acco[0], Sa, fB); LD256(fA, REC_QG, 32); CB();
#pragma unroll
            for (int k2 = 0; k2 < 2; ++k2) { Ua[k2] = *(LAS bf16x8_t*)(scr + fr * SC_ROWB + (k2 * 4 + fq) * 16); Uk[k2] = *(LAS bf16x8_t*)(scr + 16 * SC_ROWB + fr * SC_ROWB + (k2 * 4 + fq) * 16); }
            MM4(acco[1], Sa, fC); LD256(fB, REC_QG, 48); CB();
            MM4(acco[2], Sa, fA); LD128x2(fC, REC_AQK, 0); CB();
            MM4(acco[3], Sa, fB); LD128x2(fA, REC_AQK, 32); CB();
#pragma unroll
            for (int tc = 0; tc < 4; ++tc) acco[tc] = acco[tc] * qfv[tc];
            MM2x2(acco[0], acco[1], Ua, fC); LD128x2(fB, REC_KGT, 0); CB();
            MM2x2(acco[2], acco[3], Ua, fA); LD128x2(fC, REC_KGT, 32); CB();
#pragma unroll
            for (int dt = 0; dt < 8; ++dt) Sacc[dt] = Sacc[dt] * egl;
            MM2x2S(Sacc[0], Sacc[1], Uk, fB); LD128x2(fA, REC_KGT, 64); CB();
            MM2x2S(Sacc[2], Sacc[3], Uk, fC); LD128x2(fB, REC_KGT, 96); CB();
            MM2x2S(Sacc[4], Sacc[5], Uk, fA);
            MM2x2S(Sacc[6], Sacc[7], Uk, fB);
#undef CB
#undef LD256
#undef LD128x2
#undef MM4
#undef MM2x2
#undef MM2x2S
#pragma unroll
            for (int tc = 0; tc < 4; ++tc) { v2u w; w.x = pk2(acco[tc][0], acco[tc][1]); w.y = pk2(acco[tc][2], acco[tc][3]);
                *(LAS v2u*)(ob + (16 * tc + fr) * SC_OROW + (16 * wave + 4 * fq) * 2) = w; }
        }
        asm volatile("s_waitcnt vmcnt(0) lgkmcnt(0)" ::: "memory");
        __syncthreads();
        float* sout = ap->out + O_DELTAP + ((size_t)(j * NB_P + b) * 16 + h) * 16384;
#pragma unroll
        for (int dt = 0; dt < 8; ++dt)
#pragma unroll
            for (int r = 0; r < 4; ++r) sout[(size_t)(16 * dt + 4 * fq + r) * 128 + e0 + fr] = Sacc[dt][r];
    }
    __syncthreads();
}
__device__ __forceinline__ void phase_dn_scan(CArgs ap, int j, LAS unsigned char* lds) {
    const int G = gridDim.x; int bid_ = blockIdx.x; asm volatile("" : "+s"(bid_));
    for (int t = bid_; t < 256; t += G) { const int x = t & 7, idx = t >> 3; scan_unit(ap, j, (idx >> 1) * 8 + x, idx & 1, lds); }
    phase_delta_rec(ap, j, lds, (unsigned*)(ap->ws + WS_CTL) + CW_TICKET + 64 * j);
}

constexpr int P2_KIMG = 0, P2_QIMG = 16384, P2_KT = 32768, P2_VT = 49152, P2_LROW = 81920, P2_TB = 98304, P2_TR = 114688, P2_SM = 131072, P2_LDIAG = 135168, P2_PS = 143360;

#ifdef TQ_FROM
#define TQ(k) do { if ((k) == TQ_FROM && tq_on) { asm volatile("" ::: "memory"); tq_t0 = __builtin_amdgcn_s_memtime(); asm volatile("" ::: "memory"); } \
                   if ((k) == TQ_TO && tq_on) { asm volatile("" ::: "memory"); tq_acc += __builtin_amdgcn_s_memtime() - tq_t0; asm volatile("" ::: "memory"); } } while (0)
#else
#define TQ(k) do { } while (0)
#endif
__device__ __forceinline__ void phase_dn_prep2(CArgs ap, int j, LAS unsigned char* lds) {
    int tid_ = threadIdx.x; asm volatile("" : "+v"(tid_)); const int tid0 = tid_, wave = __builtin_amdgcn_readfirstlane(tid0 >> 6);
    const int role = wave >> 1;
    unsigned char* ws0 = ap->ws;
    int bid_ = blockIdx.x; asm volatile("" : "+s"(bid_));
#ifdef TQ_FROM
    unsigned long long tq_t0 = 0, tq_acc = 0; const bool tq_on = (bid_ == 0 && j == 0 && wave == TQ_WAVE);
#endif
    unsigned raw[35];
    for (int zi = bid_; zi < 256; zi += gridDim.x) { GAS v4u* xz = (GAS v4u*)(ws0 + WS_XCH) + ((size_t)zi * 512 + tid0) * 2; xz[0] = (v4u){0u, 0u, 0u, 0u}; xz[1] = (v4u){0u, 0u, 0u, 0u}; }
    for (int unit = bid_; unit < 2048; unit += gridDim.x) {
        const int b = unit >> 8, hq = (unit >> 5) & 7, n = unit & 31, trow0 = b * SEQ + n * 64;
        int tid = tid0; asm volatile("" : "+v"(tid));
        const int lane = tid & 63, fr = lane & 15, fq = lane >> 4, cidx = tid & 127;
        unsigned char* ws = ws0; asm volatile("" : "+s"(ws));
        const GAS bf16* PROJ = (const GAS bf16*)(ws + WS_PROJ); const GAS float* BA = (const GAS float*)(ws + WS_BA);
        GAS unsigned char* DREC = (GAS unsigned char*)(ws + WS_DREC); GAS float* EGL = (GAS float*)(ws + WS_EGL);
        const GAS float* cw = (const GAS float*)(ap->in[10] + (size_t)j * 4 * CONV_DIM);
        GAS float* oconvp = (GAS float*)(ap->out + O_CONVP + (size_t)j * NB_P * 3 * CONV_DIM);
        GAS unsigned char* rec0 = DREC + (size_t)((b * 16 + 2 * hq) * 32 + n) * HREC_BYTES;
        GAS unsigned char* prec = (GAS unsigned char*)(ws + WS_PREC) + (size_t)((b * 8 + hq) * 32 + n) * PREC_BYTES;
        unsigned lb0 = 0u, lb1 = 32768u, lb2 = 81920u, lb3 = 131072u; asm volatile("" : "+v"(lb0), "+v"(lb1), "+v"(lb2), "+v"(lb3));
        LAS unsigned char* L0 = lds + lb0;
        LAS unsigned char* L1 = lds + lb1;
        LAS unsigned char* L2 = lds + lb2;
        LAS unsigned char* L3 = lds + lb3;
        LAS float* SM = (LAS float*)L3;
        __syncthreads();
        TQ(0);
        if (wave < 2) {
            const int h = 2 * hq + wave; const size_t t = (size_t)(trow0 + lane);
            const float bv = BA[t * 32 + h], av = BA[t * 32 + 16 + h];
            const float x = av + ap->in[12][j * 16 + h]; const float sp = (x > 20.f) ? x : log1pf(__expf(x));
            float g = -__expf(ap->in[11][j * 16 + h]) * sp;
#pragma unroll
            for (int off = 1; off < 64; off <<= 1) { const float o = __shfl_up(g, off); if (lane >= off) g += o; }
            SM[wave * 64 + lane] = g; SM[128 + wave * 64 + lane] = 1.f / (1.f + __expf(-bv));
        }
        *(LAS v4u*)(L3 + (P2_PS - P2_SM) + wave * 2048 + lane * 32) = (v4u){0u, 0u, 0u, 0u};
        *(LAS v4u*)(L3 + (P2_PS - P2_SM) + wave * 2048 + lane * 32 + 16) = (v4u){0u, 0u, 0u, 0u};
#ifndef REPS_S3
#define REPS_S3 1
#endif
#ifndef REPS_S5
#define REPS_S5 1
#endif
#ifndef REPS_S2B
#define REPS_S2B 1
#endif
        {
            const int rh = wave & 1, cp = lane, r0 = 32 * rh;
            const int col = ((role == 0) ? hq * 128 : (role == 1) ? 1024 + hq * 128 : 2048 + (2 * hq + role - 2) * 128) + 2 * cp;
            const f32x2v w0 = *(const GAS f32x2v*)(cw + col), w1 = *(const GAS f32x2v*)(cw + CONV_DIM + col), w2 = *(const GAS f32x2v*)(cw + 2 * CONV_DIM + col), w3 = *(const GAS f32x2v*)(cw + 3 * CONV_DIM + col);
            { const GAS bf16* pn = PROJ + (size_t)(trow0 + r0) * PROJ_LD + col; const bool nh = (n == 0 && rh == 0);
#pragma unroll
              for (int i = 0; i < 35; ++i) raw[i] = (nh && i < 3) ? 0u : *(const GAS unsigned*)(pn + (ptrdiff_t)(i - 3) * PROJ_LD); }
            float va[32], vb[32];
            const bool nohalo = (n == 0 && rh == 0);
            float a3 = nohalo ? 0.f : bflo(raw[0]), a2 = nohalo ? 0.f : bflo(raw[1]), a1 = nohalo ? 0.f : bflo(raw[2]);
            float b3 = nohalo ? 0.f : bfhi(raw[0]), b2 = nohalo ? 0.f : bfhi(raw[1]), b1 = nohalo ? 0.f : bfhi(raw[2]);
#pragma unroll
            for (int c = 0; c < 32; ++c) {
                const float ua = bflo(raw[3 + c]), ub = bfhi(raw[3 + c]);
                va[c] = silu_fast(w3[0] * ua + w2[0] * a1 + w1[0] * a2 + w0[0] * a3);
                vb[c] = silu_fast(w3[1] * ub + w2[1] * b1 + w1[1] * b2 + w0[1] * b3);
                a3 = a2; a2 = a1; a1 = ua; b3 = b2; b2 = b1; b1 = ub;
                if (c >= 29 && n == 31 && rh == 1) *(GAS f32x2v*)(oconvp + (size_t)(b * 3 + c - 29) * CONV_DIM + col) = (f32x2v){ua, ub};
            }
            if (role < 2) {
                LAS unsigned char* img = L0 + (role == 0 ? 16384 : 0);
#pragma unroll
                for (int c = 0; c < 32; ++c) *(LAS unsigned*)(img + swz256(r0 + c, cp >> 2) + (cp & 3) * 4) = pk2(va[c], vb[c]);
            }
            if (role >= 1) {
                LAS unsigned char* img = L1 + (role - 1) * 16384;
#pragma unroll
                for (int ch = 0; ch < 4; ++ch) { v4u wa, wb;
                    wa.x = pk2(va[8 * ch], va[8 * ch + 1]); wa.y = pk2(va[8 * ch + 2], va[8 * ch + 3]); wa.z = pk2(va[8 * ch + 4], va[8 * ch + 5]); wa.w = pk2(va[8 * ch + 6], va[8 * ch + 7]);
                    wb.x = pk2(vb[8 * ch], vb[8 * ch + 1]); wb.y = pk2(vb[8 * ch + 2], vb[8 * ch + 3]); wb.z = pk2(vb[8 * ch + 4], vb[8 * ch + 5]); wb.w = pk2(vb[8 * ch + 6], vb[8 * ch + 7]);
                    *(LAS v4u*)(img + swz128(2 * cp, 4 * rh + ch)) = wa; *(LAS v4u*)(img + swz128(2 * cp + 1, 4 * rh + ch)) = wb; }
            }
        }
        __syncthreads();
        TQ(1);
        f32x4 acc[4];
        {
            const int tr = wave & 3; const bool kq = wave >= 4;
            f32x4 accq = (f32x4){0.f, 0.f, 0.f, 0.f};
#pragma unroll
            for (int tc = 0; tc < 4; ++tc) acc[tc] = (f32x4){0.f, 0.f, 0.f, 0.f};
#pragma unroll
            for (int ks = 0; ks < 4; ++ks) {
                const bf16x8_t af = *(LAS bf16x8_t*)(L0 + swz256(16 * tr + fr, ks * 4 + fq));
                if (kq) { const bf16x8_t qf = *(LAS bf16x8_t*)(L0 + 16384 + swz256(16 * tr + fr, ks * 4 + fq)); accq = __builtin_amdgcn_mfma_f32_16x16x32_bf16(qf, qf, accq, 0, 0, 0); }
#pragma unroll
                for (int tc = 0; tc < 4; ++tc) { const bf16x8_t bfr = *(LAS bf16x8_t*)(L0 + (kq ? 16384 : 0) + swz256(16 * tc + fr, ks * 4 + fq));
                    acc[tc] = __builtin_amdgcn_mfma_f32_16x16x32_bf16(af, bfr, acc[tc], 0, 0, 0); }
            }
            const f32x4 dsrc = kq ? accq : (tr == 0 ? acc[0] : tr == 1 ? acc[1] : tr == 2 ? acc[2] : acc[3]);
            const int rsel = fr & 3; const float dv = rsel == 0 ? dsrc[0] : rsel == 1 ? dsrc[1] : rsel == 2 ? dsrc[2] : dsrc[3];
            if (fq == (fr >> 2)) SM[(kq ? 320 : 256) + 16 * tr + fr] = dv;
#pragma unroll
            for (int it = 0; it < 2; ++it) { const int q = tid + 512 * it;
                { const int c = q >> 4, ch = q & 15; *(GAS v4u*)(prec + P_QT + c * 256 + ch * 16) = *(LAS v4u*)(L0 + 16384 + swz256(c, ch)); }
                { const int d = q >> 3, ch = q & 7; *(GAS v4u*)(prec + P_KTT + d * 128 + ch * 16) = *(LAS v4u*)(L1 + swz128(d, ch)); } }
        }
        __syncthreads();
        TQ(2);
        if (tid < 128) { const int hh = tid >> 6, c = tid & 63;
            const float rk = rsqrtf(SM[256 + c] + L2_EPS), rq = rsqrtf(SM[320 + c] + L2_EPS) * 0.08838834764831845f;
            const float G = SM[hh * 64 + c], Gl = SM[hh * 64 + 63], be = SM[128 + hh * 64 + c];
            SM[384 + hh * 64 + c] = rk * be * __expf(G); SM[512 + hh * 64 + c] = rk * __expf(Gl - G); SM[640 + hh * 64 + c] = rq * __expf(G);
            { GAS float* fac = (GAS float*)(rec0 + (size_t)hh * 32 * HREC_BYTES + H_FAC); fac[c] = rq * __expf(G); fac[64 + c] = rk * __expf(Gl - G); }
            if (c == 63) EGL[(b * 16 + 2 * hq + hh) * 32 + n] = __expf(Gl);
        }
        TQ(3);
        for (int rs_ = 0; rs_ < REPS_S2B; ++rs_) {
            const int tr = wave & 3; const bool kq = wave >= 4; const int i0 = 16 * tr + 4 * fq;
#pragma unroll
            for (int hh = 0; hh < 2; ++hh) {
                float gi[4], fi[4];
#pragma unroll
                for (int r = 0; r < 4; ++r) { gi[r] = SM[hh * 64 + i0 + r]; const float rki = rsqrtf(SM[256 + i0 + r] + L2_EPS); fi[r] = kq ? rki : rki * SM[128 + hh * 64 + i0 + r]; }
                v2u aq[4];
#pragma unroll
                for (int tc = 0; tc < 4; ++tc) { const int jc = 16 * tc + fr; const float gj = SM[hh * 64 + jc]; const float fj = kq ? rsqrtf(SM[320 + jc] + L2_EPS) * 0.08838834764831845f : rsqrtf(SM[256 + jc] + L2_EPS);
                    float o[4];
                    if (!kq) {
#pragma unroll
                        for (int r = 0; r < 4; ++r) { const int i = i0 + r; o[r] = (i > jc) ? fi[r] * fj * acc[tc][r] * __expf(gi[r] - gj) : 0.f;
                            *(LAS bf16*)(L2 + hh * 8192 + swz128(i, jc >> 3) + (jc & 7) * 2) = (bf16)f2bf(o[r]); }
                        if (tc == tr) *(LAS f32x4*)(L3 + (P2_LDIAG - P2_SM) + ((hh * 4 + tr) * 256 + fr * 16 + 4 * fq) * 4) = (f32x4){o[0], o[1], o[2], o[3]};
                    } else {
#pragma unroll
                        for (int r = 0; r < 4; ++r) { const int i = i0 + r; o[r] = (jc >= i) ? fj * fi[r] * acc[tc][r] * __expf(gj - gi[r]) : 0.f; }
                        aq[tc].x = pk2(o[0], o[1]); aq[tc].y = pk2(o[2], o[3]); }
                }
                if (kq) {
#pragma unroll
                    for (int tp = 0; tp < 2; ++tp)
                        *(GAS v4u*)(rec0 + (size_t)hh * 32 * HREC_BYTES + H_AQK + (16 * (2 * tp + (fq & 1)) + fr) * 128 + (16 * tr + 8 * (fq >> 1)) * 2) = widen16(aq[2 * tp], aq[2 * tp + 1]);
                }
            }
        }
        __syncthreads();
        TQ(4);
        for (int rs_ = 0; rs_ < REPS_S3; ++rs_) {
            const int hh = wave >> 2, i = wave & 3;
            LAS unsigned char* Trow = L0 + hh * 8192; LAS unsigned char* TT = L0 + 16384 + hh * 8192;
            LAS unsigned char* Tb = L2 + 16384 + hh * 8192; LAS unsigned char* Tr = L2 + 32768 + hh * 8192;
            const v4u z4 = (v4u){0u, 0u, 0u, 0u};
            { const int row = 16 * i + (lane >> 2), c0 = (lane & 3) * 2;
              *(LAS v4u*)(Trow + swz128(row, c0)) = z4; *(LAS v4u*)(Trow + swz128(row, c0 + 1)) = z4;
              *(LAS v4u*)(Tb + swz128(row, c0)) = z4; *(LAS v4u*)(Tb + swz128(row, c0 + 1)) = z4;
              *(LAS v4u*)(Tr + swz128(row, c0)) = z4; *(LAS v4u*)(Tr + swz128(row, c0 + 1)) = z4;
              *(LAS v4u*)(TT + swz128(lane, 2 * i)) = z4; *(LAS v4u*)(TT + swz128(lane, 2 * i + 1)) = z4; }
            if (lane < 16) {
                const int jcol = lane; const LAS float* Ld = (const LAS float*)(L3 + (P2_LDIAG - P2_SM)) + (hh * 4 + i) * 256;
                float x[16];
#pragma unroll
                for (int r = 0; r < 16; ++r) x[r] = (r == jcol) ? 1.f : 0.f;
#pragma unroll
                for (int s = 0; s < 15; ++s) {
                    const float xs = x[s];
#pragma unroll
                    for (int cg = (s + 1) / 4; cg < 4; ++cg) { const f32x4 m = *(const LAS f32x4*)(Ld + s * 16 + cg * 4);
#pragma unroll
                        for (int e = 0; e < 4; ++e) { const int c = cg * 4 + e; if (c > s) x[c] -= m[e] * xs; } }
                }
                const int gc = 16 * i + jcol; const float be = SM[128 + hh * 64 + gc], rho = SM[384 + hh * 64 + gc];
#pragma unroll
                for (int r = 0; r < 16; ++r) { const int grow = 16 * i + r; const int off = swz128(grow, gc >> 3) + (gc & 7) * 2;
                    *(LAS bf16*)(Trow + off) = (bf16)f2bf(x[r]); *(LAS bf16*)(Tb + off) = (bf16)f2bf(x[r] * be); *(LAS bf16*)(Tr + off) = (bf16)f2bf(x[r] * rho); }
                v4u t0, t1; t0.x = pk2(x[0], x[1]); t0.y = pk2(x[2], x[3]); t0.z = pk2(x[4], x[5]); t0.w = pk2(x[6], x[7]); t1.x = pk2(x[8], x[9]); t1.y = pk2(x[10], x[11]); t1.z = pk2(x[12], x[13]); t1.w = pk2(x[14], x[15]);
                *(LAS v4u*)(TT + swz128(gc, 2 * i)) = t0; *(LAS v4u*)(TT + swz128(gc, 2 * i + 1)) = t1;
            }
        }
        __syncthreads();
        TQ(5);
        if (wave < 4) {
            const int hh = wave >> 1, i = 1 + 2 * (wave & 1), jb = i - 1;
            LAS unsigned char* Trow = L0 + hh * 8192; LAS unsigned char* TT = L0 + 16384 + hh * 8192;
            LAS unsigned char* Lrow = L2 + hh * 8192; LAS unsigned char* Tb = L2 + 16384 + hh * 8192; LAS unsigned char* Tr = L2 + 32768 + hh * 8192;
            LAS unsigned char* PS = L3 + (P2_PS - P2_SM) + wave * 2048 + 1024;
            f32x4 p = (f32x4){0.f, 0.f, 0.f, 0.f};
#pragma unroll
            for (int ks = 0; ks < 2; ++ks) { const bf16x8_t la = *(LAS bf16x8_t*)(Lrow + swz128(16 * i + fr, ks * 4 + fq)), tb = *(LAS bf16x8_t*)(TT + swz128(16 * jb + fr, ks * 4 + fq));
                p = __builtin_amdgcn_mfma_f32_16x16x32_bf16(la, tb, p, 0, 0, 0); }
            { v2u w; w.x = pk2(p[0], p[1]); w.y = pk2(p[2], p[3]); *(LAS v2u*)(PS + fr * 64 + (16 + 4 * fq) * 2) = w; }
            const bf16x8_t ta = *(LAS bf16x8_t*)(Trow + swz128(16 * i + fr, (i >> 1) * 4 + fq)), pb = *(LAS bf16x8_t*)(PS + fr * 64 + fq * 16);
            const f32x4 t = __builtin_amdgcn_mfma_f32_16x16x32_bf16(ta, pb, (f32x4){0.f, 0.f, 0.f, 0.f}, 0, 0, 0);
            const int gc = 16 * jb + fr; const float be = SM[128 + hh * 64 + gc], rho = SM[384 + hh * 64 + gc];
#pragma unroll
            for (int r = 0; r < 4; ++r) { const int grow = 16 * i + 4 * fq + r; const int off = swz128(grow, gc >> 3) + (gc & 7) * 2; const float v = -t[r];
                *(LAS bf16*)(Trow + off) = (bf16)f2bf(v); *(LAS bf16*)(Tb + off) = (bf16)f2bf(v * be); *(LAS bf16*)(Tr + off) = (bf16)f2bf(v * rho); }
            { v2u w; w.x = pk2(-t[0], -t[1]); w.y = pk2(-t[2], -t[3]); const int s0 = 16 * i + 4 * fq; *(LAS v2u*)(TT + swz128(gc, s0 >> 3) + (s0 & 7) * 2) = w; }
        }
        __syncthreads();
        TQ(6);
        {
            const int hh = wave >> 2, i2 = (wave >> 1) & 1, j2 = wave & 1, i = 2 + i2, jb = j2;
            LAS unsigned char* Trow = L0 + hh * 8192; LAS unsigned char* TT = L0 + 16384 + hh * 8192;
            LAS unsigned char* Lrow = L2 + hh * 8192; LAS unsigned char* Tb = L2 + 16384 + hh * 8192; LAS unsigned char* Tr = L2 + 32768 + hh * 8192;
            LAS unsigned char* PS = L3 + (P2_PS - P2_SM) + wave * 2048;
            const bf16x8_t tb = *(LAS bf16x8_t*)(TT + swz128(16 * jb + fr, fq));
#pragma unroll
            for (int k = 0; k < 2; ++k) { const bf16x8_t la = *(LAS bf16x8_t*)(Lrow + swz128(32 + 16 * k + fr, fq));
                const f32x4 p = __builtin_amdgcn_mfma_f32_16x16x32_bf16(la, tb, (f32x4){0.f, 0.f, 0.f, 0.f}, 0, 0, 0);
                v2u w; w.x = pk2(p[0], p[1]); w.y = pk2(p[2], p[3]); *(LAS v2u*)(PS + fr * 64 + (16 * k + 4 * fq) * 2) = w; }
            const bf16x8_t ta = *(LAS bf16x8_t*)(Trow + swz128(16 * i + fr, 4 + fq)), pb = *(LAS bf16x8_t*)(PS + fr * 64 + fq * 16);
            const f32x4 t = __builtin_amdgcn_mfma_f32_16x16x32_bf16(ta, pb, (f32x4){0.f, 0.f, 0.f, 0.f}, 0, 0, 0);
            const int gc = 16 * jb + fr; const float be = SM[128 + hh * 64 + gc], rho = SM[384 + hh * 64 + gc];
#pragma unroll
            for (int r = 0; r < 4; ++r) { const int grow = 16 * i + 4 * fq + r; const int off = swz128(grow, gc >> 3) + (gc & 7) * 2; const float v = -t[r];
                *(LAS bf16*)(Trow + off) = (bf16)f2bf(v); *(LAS bf16*)(Tb + off) = (bf16)f2bf(v * be); *(LAS bf16*)(Tr + off) = (bf16)f2bf(v * rho); }
            { v2u w; w.x = pk2(-t[0], -t[1]); w.y = pk2(-t[2], -t[3]); const int s0 = 16 * i + 4 * fq; *(LAS v2u*)(TT + swz128(gc, s0 >> 3) + (s0 & 7) * 2) = w; }
        }
        __syncthreads();
        for (int rs_ = 0; rs_ < REPS_S5; ++rs_) {
            const int hh = wave >> 2, X = (wave >> 1) & 1;
            LAS unsigned char* RT = X ? L1 : L1 + 16384 + hh * 16384;
            LAS unsigned char* TX = L2 + (X ? 32768 : 16384) + hh * 8192;
            GAS unsigned char* outp = rec0 + (size_t)hh * 32 * HREC_BYTES + (X ? H_WNEG : H_U);
            const float sgn = X ? -1.f : 1.f;
            bf16x8_t tb[4][2];
#pragma unroll
            for (int tc = 0; tc < 4; ++tc)
#pragma unroll
                for (int ks = 0; ks < 2; ++ks) tb[tc][ks] = *(LAS bf16x8_t*)(TX + swz128(16 * tc + fr, ks * 4 + fq));
            if (X) {
#pragma unroll
                for (int c8p = 0; c8p < 2; ++c8p) { const int ctA = 4 * (wave & 1) + 2 * c8p;
                    const bf16x8_t a0 = *(LAS bf16x8_t*)(RT + swz128(16 * ctA + fr, fq)), a1 = *(LAS bf16x8_t*)(RT + swz128(16 * ctA + fr, 4 + fq));
                    const bf16x8_t b0 = *(LAS bf16x8_t*)(RT + swz128(16 * ctA + 16 + fr, fq)), b1 = *(LAS bf16x8_t*)(RT + swz128(16 * ctA + 16 + fr, 4 + fq));
#pragma unroll
                    for (int tc = 0; tc < 4; ++tc) {
                        f32x4 dA = __builtin_amdgcn_mfma_f32_16x16x32_bf16(a0, tb[tc][0], (f32x4){0.f, 0.f, 0.f, 0.f}, 0, 0, 0); dA = __builtin_amdgcn_mfma_f32_16x16x32_bf16(a1, tb[tc][1], dA, 0, 0, 0);
                        f32x4 dB = __builtin_amdgcn_mfma_f32_16x16x32_bf16(b0, tb[tc][0], (f32x4){0.f, 0.f, 0.f, 0.f}, 0, 0, 0); dB = __builtin_amdgcn_mfma_f32_16x16x32_bf16(b1, tb[tc][1], dB, 0, 0, 0);
                        const v4u w = widen16((v2u){pk2(-dA[0], -dA[1]), pk2(-dA[2], -dA[3])}, (v2u){pk2(-dB[0], -dB[1]), pk2(-dB[2], -dB[3])});
                        *(GAS v4u*)(outp + (16 * tc + fr) * 256 + (16 * (ctA + (fq & 1)) + 8 * (fq >> 1)) * 2) = w; } }
            } else {
#pragma unroll
                for (int c8 = 0; c8 < 4; ++c8) { const int ct8 = 4 * (wave & 1) + c8;
                    const bf16x8_t a0 = *(LAS bf16x8_t*)(RT + swz128(16 * ct8 + fr, fq)), a1 = *(LAS bf16x8_t*)(RT + swz128(16 * ct8 + fr, 4 + fq));
#pragma unroll
                    for (int tcp = 0; tcp < 2; ++tcp) {
                        f32x4 dA = __builtin_amdgcn_mfma_f32_16x16x32_bf16(tb[2 * tcp][0], a0, (f32x4){0.f, 0.f, 0.f, 0.f}, 0, 0, 0); dA = __builtin_amdgcn_mfma_f32_16x16x32_bf16(tb[2 * tcp][1], a1, dA, 0, 0, 0);
                        f32x4 dB = __builtin_amdgcn_mfma_f32_16x16x32_bf16(tb[2 * tcp + 1][0], a0, (f32x4){0.f, 0.f, 0.f, 0.f}, 0, 0, 0); dB = __builtin_amdgcn_mfma_f32_16x16x32_bf16(tb[2 * tcp + 1][1], a1, dB, 0, 0, 0);
                        const v4u w = widen16((v2u){pk2(dA[0], dA[1]), pk2(dA[2], dA[3])}, (v2u){pk2(dB[0], dB[1]), pk2(dB[2], dB[3])});
                        *(GAS v4u*)(outp + (16 * ct8 + fr) * 128 + (16 * (2 * tcp + (fq & 1)) + 8 * (fq >> 1)) * 2) = w; } }
            }
        }
        TQ(99);
    }
#ifdef TQ_FROM
    if (tq_on && (threadIdx.x & 63) == 0) *(unsigned long long*)(ap->ws + WS_CTL + 8192) = tq_acc;
#endif
    phase_dn_post_sample(ap, j);
}

constexpr int AT_K = 0, AT_V = 32768, AT_VROW = 528;
__device__ __forceinline__ void attn_qtile(LAS unsigned char* Kl, LAS unsigned char* Vl, int kt0, const bf16* qptr, bf16* optr, int lo, int hi, float slope, float sink, int fr, int fq) {
    const bf16x8_t qb0 = *(const bf16x8_t*)qptr, qb1 = *(const bf16x8_t*)(qptr + 32);
    f32x4 acc[9];
#pragma unroll
    for (int i = 0; i < 9; ++i) {
        const bf16x8_t k0 = *(LAS bf16x8_t*)(Kl + swz128(16 * (kt0 + i) + fr, fq)), k1 = *(LAS bf16x8_t*)(Kl + swz128(16 * (kt0 + i) + fr, 4 + fq));
        acc[i] = __builtin_amdgcn_mfma_f32_16x16x32_bf16(k0, qb0, (f32x4){0.f, 0.f, 0.f, 0.f}, 0, 0, 0);
        acc[i] = __builtin_amdgcn_mfma_f32_16x16x32_bf16(k1, qb1, acc[i], 0, 0, 0);
    }
    float m = sink;
#pragma unroll
    for (int i = 0; i < 9; ++i)
#pragma unroll
        for (int r = 0; r < 4; ++r) { const int kc = 16 * (kt0 + i) + 4 * fq + r; const bool valid = (kc >= lo) && (kc <= hi);
            const float s = valid ? acc[i][r] - slope * (float)(hi - kc) : -INFINITY; acc[i][r] = s; m = fmaxf(m, s); }
    m = fmaxf(m, __shfl_xor(m, 16)); m = fmaxf(m, __shfl_xor(m, 32));
    float sum = 0.f;
#pragma unroll
    for (int i = 0; i < 9; ++i)
#pragma unroll
        for (int r = 0; r < 4; ++r) { const float p = __expf(acc[i][r] - m); acc[i][r] = p; sum += p; }
    sum += __shfl_xor(sum, 16); sum += __shfl_xor(sum, 32);
    const float inv = 1.f / (sum + __expf(sink - m));
    f32x4 o[4];
#pragma unroll
    for (int dt = 0; dt < 4; ++dt) o[dt] = (f32x4){0.f, 0.f, 0.f, 0.f};
#pragma unroll
    for (int i2 = 0; i2 < 5; ++i2) {
        const int ia = 2 * i2, ib = 2 * i2 + 1;
        v4u pw; pw.x = pk2(acc[ia][0], acc[ia][1]); pw.y = pk2(acc[ia][2], acc[ia][3]);
        if (ib < 9) { pw.z = pk2(acc[ib < 9 ? ib : 8][0], acc[ib < 9 ? ib : 8][1]); pw.w = pk2(acc[ib < 9 ? ib : 8][2], acc[ib < 9 ? ib : 8][3]); } else { pw.z = 0u; pw.w = 0u; }
        const bf16x8_t pf = __builtin_bit_cast(bf16x8_t, pw);
        const int kta = kt0 + ia; int ktb = kt0 + ib; ktb = ktb > 15 ? 15 : ktb;
#pragma unroll
        for (int dt = 0; dt < 4; ++dt) {
            const v2u va = *(LAS v2u*)(Vl + (16 * dt + fr) * AT_VROW + (16 * kta + 4 * fq) * 2), vb = *(LAS v2u*)(Vl + (16 * dt + fr) * AT_VROW + (16 * ktb + 4 * fq) * 2);
            const v4u vw = (v4u){va.x, va.y, vb.x, vb.y};
            o[dt] = __builtin_amdgcn_mfma_f32_16x16x32_bf16(__builtin_bit_cast(bf16x8_t, vw), pf, o[dt], 0, 0, 0);
        }
    }
#pragma unroll
    for (int dp = 0; dp < 2; ++dp) { v2u wa, wb; wa.x = pk2(o[2 * dp][0] * inv, o[2 * dp][1] * inv); wa.y = pk2(o[2 * dp][2] * inv, o[2 * dp][3] * inv);
        wb.x = pk2(o[2 * dp + 1][0] * inv, o[2 * dp + 1][1] * inv); wb.y = pk2(o[2 * dp + 1][2] * inv, o[2 * dp + 1][3] * inv);
        *(v4u*)(optr + 16 * (2 * dp + (fq & 1)) + 8 * (fq >> 1)) = widen16(wa, wb); }
}

__device__ __forceinline__ void phase_swa_attn_mfma(CArgs ap, int j, LAS unsigned char* lds) {
    int tid_ = threadIdx.x; asm volatile("" : "+v"(tid_)); const int tid = tid_, lane = tid & 63, wave = __builtin_amdgcn_readfirstlane(tid >> 6);
    const int fr = lane & 15, fq = lane >> 4;
    unsigned char* ws = ap->ws;
    const bf16* Q = (const bf16*)(ws + WS_Q); const bf16* KB = (const bf16*)(ws + WS_KB); const bf16* VB = (const bf16*)(ws + WS_VB);
    bf16* ATT = (bf16*)(ws + WS_ATT);
    const float* ck = ap->in[4] + (size_t)j * NB_S * 128 * 256; const float* cv = ap->in[5] + (size_t)j * NB_S * 128 * 256;
    const float* sinks = ap->in[17] + j * 16;
    LAS unsigned char* Kl = lds + AT_K; LAS unsigned char* Vl = lds + AT_V;
    int bid_ = blockIdx.x; asm volatile("" : "+s"(bid_));
    for (int unit = bid_; unit < 1024; unit += gridDim.x) {
        __syncthreads();
        if (unit < 512) {
            const int b = unit >> 6, nb = (unit >> 2) & 15, kh = unit & 3;
            const int trow0 = b * SEQ + nb * 128 - 128;
#pragma unroll
            for (int it = 0; it < 4; ++it) { const int q = tid + 512 * it;
                { const int key = q >> 3, ch = q & 7; v4u w = (v4u){0u, 0u, 0u, 0u};
                  if (nb > 0 || key >= 128) w = *(const v4u*)(KB + (size_t)(trow0 + key) * 256 + kh * 64 + ch * 8);
                  *(LAS v4u*)(Kl + swz128(key, ch)) = w; }
                { const int key = q & 255, dc = q >> 8; v4u w = (v4u){0u, 0u, 0u, 0u};
                  if (nb > 0 || key >= 128) w = *(const v4u*)(VB + (size_t)(trow0 + key) * 256 + kh * 64 + dc * 8);
                  LAS bf16* vp = (LAS bf16*)(Vl + (8 * dc) * AT_VROW + key * 2);
                  vp[0 * (AT_VROW / 2)] = (bf16)(w.x & 0xffff); vp[1 * (AT_VROW / 2)] = (bf16)(w.x >> 16); vp[2 * (AT_VROW / 2)] = (bf16)(w.y & 0xffff); vp[3 * (AT_VROW / 2)] = (bf16)(w.y >> 16);
                  vp[4 * (AT_VROW / 2)] = (bf16)(w.z & 0xffff); vp[5 * (AT_VROW / 2)] = (bf16)(w.z >> 16); vp[6 * (AT_VROW / 2)] = (bf16)(w.w & 0xffff); vp[7 * (AT_VROW / 2)] = (bf16)(w.w >> 16); }
            }
            __syncthreads();
            const int g = wave >> 1, qh = wave & 1, head = kh * 4 + g;
            const float slope = exp2f(-0.5f * (float)(head + 1)), sink = sinks[head];
#pragma unroll 1
            for (int qt = 0; qt < 4; ++qt) {
                const int o = 64 * qh + 16 * qt, qi = o + fr;
                const size_t tq = (size_t)(b * SEQ + nb * 128 + qi);
                attn_qtile(Kl, Vl, 4 * qh + qt, Q + tq * DM + head * 64 + 8 * fq, ATT + tq * DM + head * 64, (nb == 0 && qi < 128) ? 128 : qi, 128 + qi, slope, sink, fr, fq);
            }
        } else {
            const int su = unit - 512, b = su >> 2, kh = su & 3;
            for (int q = tid; q < 1280; q += 512) {
                { const int key = q >> 3, ch = q & 7; v4u w = (v4u){0u, 0u, 0u, 0u};
                  if (key < 128) { const float* p = ck + (size_t)(b * 128 + key) * 256 + kh * 64 + ch * 8; const f32x4 x0 = *(const f32x4*)p, x1 = *(const f32x4*)(p + 4);
                      w.x = pk2(x0[0], x0[1]); w.y = pk2(x0[2], x0[3]); w.z = pk2(x1[0], x1[1]); w.w = pk2(x1[2], x1[3]); }
                  else if (key < 132) w = *(const v4u*)(KB + (size_t)(TP + b * 4 + key - 128) * 256 + kh * 64 + ch * 8);
                  *(LAS v4u*)(Kl + swz128(key, ch)) = w; }
                { const int key = q % 160, dc = q / 160; v4u w = (v4u){0u, 0u, 0u, 0u};
                  if (key < 128) { const float* p = cv + (size_t)(b * 128 + key) * 256 + kh * 64 + dc * 8; const f32x4 x0 = *(const f32x4*)p, x1 = *(const f32x4*)(p + 4);
                      w.x = pk2(x0[0], x0[1]); w.y = pk2(x0[2], x0[3]); w.z = pk2(x1[0], x1[1]); w.w = pk2(x1[2], x1[3]); }
                  else if (key < 132) w = *(const v4u*)(VB + (size_t)(TP + b * 4 + key - 128) * 256 + kh * 64 + dc * 8);
                  LAS bf16* vp = (LAS bf16*)(Vl + (8 * dc) * AT_VROW + key * 2);
                  vp[0 * (AT_VROW / 2)] = (bf16)(w.x & 0xffff); vp[1 * (AT_VROW / 2)] = (bf16)(w.x >> 16); vp[2 * (AT_VROW / 2)] = (bf16)(w.y & 0xffff); vp[3 * (AT_VROW / 2)] = (bf16)(w.y >> 16);
                  vp[4 * (AT_VROW / 2)] = (bf16)(w.z & 0xffff); vp[5 * (AT_VROW / 2)] = (bf16)(w.z >> 16); vp[6 * (AT_VROW / 2)] = (bf16)(w.w & 0xffff); vp[7 * (AT_VROW / 2)] = (bf16)(w.w >> 16); }
            }
            __syncthreads();
            if (wave == 0) {
                const int tok = fr & 3, g = fr >> 2, head = kh * 4 + g;
                const float slope = exp2f(-0.5f * (float)(head + 1)), sink = sinks[head];
                const size_t tq = (size_t)(TP + b * 4 + tok);
                attn_qtile(Kl, Vl, 0, Q + tq * DM + head * 64 + 8 * fq, ATT + tq * DM + head * 64, tok, 128 + tok, slope, sink, fr, fq);
            }
        }
    }
}

#define XB_TMO      128
#define XB_XCNT(j)  (256  + 64 * (j))
#define XB_XSUB(j)  (1280 + 64 * (j))
#define XB_XGEN(j)  (2304 + 64 * (j))
#define XB_TOP      3328
#define XB_TOPGEN   3392
#define XCD_BAR_WORDS 3456
#define XB_SPIN_CAP (1u << 18)

__device__ __forceinline__ unsigned xb_ld(unsigned* p)              { return __hip_atomic_load(p, __ATOMIC_RELAXED, __HIP_MEMORY_SCOPE_AGENT); }
__device__ __forceinline__ unsigned xb_add(unsigned* p, unsigned v) { return __hip_atomic_fetch_add(p, v, __ATOMIC_RELAXED, __HIP_MEMORY_SCOPE_AGENT); }
__device__ __forceinline__ unsigned xb_xcc_id() { return (unsigned)__builtin_amdgcn_s_getreg((3 << 11) | 20) & 0xFu; }
#define XB_SPIN(cond, bar) do { unsigned _sp = 0; while (cond) { __builtin_amdgcn_s_sleep(1); \
    if ((++_sp & 255u) == 0u) { if (xb_ld(&(bar)[XB_TMO])) break; if (_sp > XB_SPIN_CAP) { atomicAdd(&(bar)[XB_TMO], 1u); break; } } } } while (0)

struct XcdBarrier {
    unsigned* bar; unsigned x;
    volatile LAS unsigned* st;
};

__device__ __forceinline__ XcdBarrier xcd_barrier_post(unsigned* bar, volatile LAS unsigned* st) {
    XcdBarrier b; b.bar = bar; b.x = xb_xcc_id(); b.st = st;
    if (threadIdx.x == 0) (void)xb_add(&bar[XB_XCNT(b.x)], 1u);
    return b;
}
__device__ __forceinline__ void xcd_barrier_complete(unsigned* bar, unsigned x, unsigned& nloc, unsigned& nx) {
    const unsigned G = gridDim.x * gridDim.y * gridDim.z;
    unsigned sum, cnt, mine, sp = 0u;
    for (;;) {
        sum = 0u; cnt = 0u; mine = 0u;
#pragma unroll
        for (unsigned j = 0; j < 16; ++j) { const unsigned c = xb_ld(&bar[XB_XCNT(j)]); sum += c; cnt += (c > 0u) ? 1u : 0u; mine = (j == x) ? c : mine; }
        if (sum == G) break;
        __builtin_amdgcn_s_sleep(1);
        if ((++sp & 255u) == 0u) { if (xb_ld(&bar[XB_TMO])) break; if (sp > XB_SPIN_CAP) { atomicAdd(&bar[XB_TMO], 1u); break; } }
    }
    nloc = mine > 0u ? mine : 1u; nx = cnt > 0u ? cnt : 1u;
}

__device__ __forceinline__ void xcd_barrier(const XcdBarrier& b) {
    asm volatile("s_waitcnt vmcnt(0)" ::: "memory");
    __syncthreads();
    if (threadIdx.x == 0) {
        unsigned* bar = b.bar;
        __builtin_amdgcn_s_waitcnt(0);
        unsigned nloc = b.st[0], nx = b.st[1];
        if (nloc == 0u) { xcd_barrier_complete(bar, b.x, nloc, nx); b.st[0] = nloc; b.st[1] = nx; }
        const unsigned old = xb_add(&bar[XB_XSUB(b.x)], 1u);
        const unsigned gen = old / nloc;
        if (old + 1u == (gen + 1u) * nloc) {
            __builtin_amdgcn_fence(__ATOMIC_RELEASE, "agent");
            asm volatile("s_waitcnt vmcnt(0)" ::: "memory");
            const unsigned og = xb_add(&bar[XB_TOP], 1u);
            const unsigned tg = og / nx;
            if (og + 1u == (tg + 1u) * nx) xb_add(&bar[XB_TOPGEN], 1u);
            else XB_SPIN(xb_ld(&bar[XB_TOPGEN]) == tg, bar);
            __builtin_amdgcn_fence(__ATOMIC_ACQUIRE, "agent");
            xb_add(&bar[XB_XGEN(b.x)], 1u);
            asm volatile("s_waitcnt vmcnt(0)" ::: "memory");
        } else {
            XB_SPIN(xb_ld(&bar[XB_XGEN(b.x)]) == gen, bar);
            __builtin_amdgcn_fence(__ATOMIC_ACQUIRE, "agent");
            asm volatile("s_waitcnt vmcnt(0)" ::: "memory");
        }
    }
    __syncthreads();
}

constexpr int CW_BAR = 4096;
constexpr int MISC_OFF = 163584;

#ifndef REP_PREP
#define REP_PREP 1
#endif
#ifndef REP_SCAN
#define REP_SCAN 1
#endif
#ifndef REP_ATTN
#define REP_ATTN 1
#endif
#ifndef REP_GIN
#define REP_GIN 1
#endif
#ifndef REP_GGU
#define REP_GGU 1
#endif
#ifndef REP_GQKV
#define REP_GQKV 1
#endif

__device__ __forceinline__ void small_res(const bf16* A, const bf16* Wt, int K, const float* bias, bf16* XBp, float* SSQp, LAS unsigned char* lds) {
    int tid_ = threadIdx.x; asm volatile("" : "+v"(tid_)); const int tid = tid_, lane = tid & 63, wave = __builtin_amdgcn_readfirstlane(tid >> 6);
    const int fr = lane & 15, fq = lane >> 4, rt = wave >> 2, ct = wave & 3;
    int bid_ = blockIdx.x; asm volatile("" : "+s"(bid_));
    LAS float* red = (LAS float*)lds;
    for (int piece = bid_; piece < 256; piece += gridDim.x) {
        const int rb = piece >> 4, cc = piece & 15, m0 = TP + rb * 32 + rt * 16, n0 = cc * 64 + ct * 16;
        const bf16* apx = A + (size_t)(m0 + fr) * K + 8 * fq; const bf16* wpx = Wt + (size_t)(n0 + fr) * K + 8 * fq;
        f32x4 acc = (f32x4){0.f, 0.f, 0.f, 0.f};
        bf16x8_t a0[4], w0[4], a1[4], w1[4];
#pragma unroll
        for (int i = 0; i < 4; ++i) { a0[i] = *(const bf16x8_t*)(apx + 32 * i); w0[i] = *(const bf16x8_t*)(wpx + 32 * i); }
#pragma unroll 1
        for (int k = 0; k < K; k += 256) {
#pragma unroll
            for (int i = 0; i < 4; ++i) { a1[i] = *(const bf16x8_t*)(apx + k + 128 + 32 * i); w1[i] = *(const bf16x8_t*)(wpx + k + 128 + 32 * i); }
#pragma unroll
            for (int i = 0; i < 4; ++i) acc = __builtin_amdgcn_mfma_f32_16x16x32_bf16(w0[i], a0[i], acc, 0, 0, 0);
            const int kn = (k + 256 < K) ? k + 256 : k;
#pragma unroll
            for (int i = 0; i < 4; ++i) { a0[i] = *(const bf16x8_t*)(apx + kn + 32 * i); w0[i] = *(const bf16x8_t*)(wpx + kn + 32 * i); }
#pragma unroll
            for (int i = 0; i < 4; ++i) acc = __builtin_amdgcn_mfma_f32_16x16x32_bf16(w1[i], a1[i], acc, 0, 0, 0);
        }
        const int row = m0 + fr, col = n0 + 4 * fq;
        bf16* xp = XBp + (size_t)row * DM + col;
        const v2u xo = *(const v2u*)xp;
        f32x4 x = (f32x4){bflo(xo.x), bfhi(xo.x), bflo(xo.y), bfhi(xo.y)} + acc;
        if (bias) x = x + *(const f32x4*)(bias + col);
        v2u w; w.x = pk2(x[0], x[1]); w.y = pk2(x[2], x[3]);
        *(v2u*)xp = w;
        const float r0 = bflo(w.x), r1 = bfhi(w.x), r2 = bflo(w.y), r3 = bfhi(w.y);
        float s = (r0 * r0 + r1 * r1) + (r2 * r2 + r3 * r3);
        s += __shfl_xor(s, 16); s += __shfl_xor(s, 32);
        __syncthreads();
        if (fq == 0) red[wave * 16 + fr] = s;
        __syncthreads();
        if (ct == 0 && fq == 0) SSQp[(size_t)row * 16 + cc] = (red[(rt * 4) * 16 + fr] + red[(rt * 4 + 1) * 16 + fr]) + (red[(rt * 4 + 2) * 16 + fr] + red[(rt * 4 + 3) * 16 + fr]);
    }
}

__device__ __forceinline__ void small_in(const bf16* XBp, const bf16* Wt, const float* SSQp, bf16* proj, float* ba) {
    int tid_ = threadIdx.x; asm volatile("" : "+v"(tid_)); const int tid = tid_, lane = tid & 63, wave = __builtin_amdgcn_readfirstlane(tid >> 6);
    const int fr = lane & 15, fq = lane >> 4;
    int bid_ = blockIdx.x; asm volatile("" : "+s"(bid_));
    const int gw = bid_ * NWAVES + wave, NGW = gridDim.x * NWAVES;
    for (int task = gw; task < 2048; task += NGW) {
        const int rt = task >> 6, cg = task & 63, m0 = TP + 16 * rt, n0 = 96 * cg;
        const bf16* apx = XBp + (size_t)(m0 + fr) * DM + 8 * fq; const bf16* wpx = Wt + (size_t)(n0 + fr) * DM + 8 * fq;
        f32x4 acc[6];
#pragma unroll
        for (int t = 0; t < 6; ++t) acc[t] = (f32x4){0.f, 0.f, 0.f, 0.f};
#pragma unroll 1
        for (int k = 0; k < DM; k += 128) {
            bf16x8_t av[4], wv[4][6];
#pragma unroll
            for (int i = 0; i < 4; ++i) { av[i] = *(const bf16x8_t*)(apx + k + 32 * i);
#pragma unroll
                for (int t = 0; t < 6; ++t) wv[i][t] = *(const bf16x8_t*)(wpx + (size_t)(16 * t) * DM + k + 32 * i); }
#pragma unroll
            for (int i = 0; i < 4; ++i)
#pragma unroll
                for (int t = 0; t < 6; ++t) acc[t] = __builtin_amdgcn_mfma_f32_16x16x32_bf16(wv[i][t], av[i], acc[t], 0, 0, 0);
        }
        const int row = m0 + fr; const float rs = row_rstd(SSQp, row);
#pragma unroll
        for (int t = 0; t < 6; ++t) { v2u w; w.x = pk2(acc[t][0] * rs, acc[t][1] * rs); w.y = pk2(acc[t][2] * rs, acc[t][3] * rs);
            *(v2u*)(proj + (size_t)row * PROJ_LD + n0 + 16 * t + 4 * fq) = w; }
    }
    for (int task = gw; task < T / 16; task += NGW) {
        const int m0 = 16 * task;
        const bf16* apx = XBp + (size_t)(m0 + fr) * DM + 8 * fq; const bf16* wpx = Wt + (size_t)(6144 + fr) * DM + 8 * fq;
        f32x4 acc0 = (f32x4){0.f, 0.f, 0.f, 0.f}, acc1 = (f32x4){0.f, 0.f, 0.f, 0.f};
#pragma unroll 1
        for (int k = 0; k < DM; k += 256) {
            bf16x8_t av[8], w0[8], w1[8];
#pragma unroll
            for (int i = 0; i < 8; ++i) { av[i] = *(const bf16x8_t*)(apx + k + 32 * i); w0[i] = *(const bf16x8_t*)(wpx + k + 32 * i); w1[i] = *(const bf16x8_t*)(wpx + (size_t)16 * DM + k + 32 * i); }
#pragma unroll
            for (int i = 0; i < 8; ++i) { acc0 = __builtin_amdgcn_mfma_f32_16x16x32_bf16(w0[i], av[i], acc0, 0, 0, 0); acc1 = __builtin_amdgcn_mfma_f32_16x16x32_bf16(w1[i], av[i], acc1, 0, 0, 0); }
        }
        const int row = m0 + fr; const float rs = row_rstd(SSQp, row);
        *(f32x4*)(ba + (size_t)row * 32 + 4 * fq) = acc0 * rs; *(f32x4*)(ba + (size_t)row * 32 + 16 + 4 * fq) = acc1 * rs;
    }
}
template <int KPAD, class Epi>
__device__ __forceinline__ void run_gemm(LAS unsigned char* lds, const bf16* A, const bf16* Bt, int M, int N, int K, const Epi& E) {
    int c_ = blockIdx.x; asm volatile("" : "+s"(c_));
    pg8::Gemm g{A, Bt, M, N, K}; pg8::StaticOrder S; S.init(M, N, (int)gridDim.x, c_);
    pg8::gemm_phase<Epi, pg8::StaticOrder, true, true, KPAD>(lds, g, S, E);
}

__global__ void __launch_bounds__(NTHREADS, 2) mk_fwd(Args a) {
    extern __shared__ __attribute__((aligned(16))) unsigned char lds_raw[];
    LAS unsigned char* lds = (LAS unsigned char*)lds_raw;
    unsigned char* ws0_ = kargs()->ws;
    for (int u = threadIdx.x; u < (LDS_BYTES - MISC_OFF) / 4; u += NTHREADS) ((LAS unsigned*)(lds + MISC_OFF))[u] = 0u;
    __syncthreads();
    (void)xcd_barrier_post((unsigned*)(ws0_ + WS_CTL) + CW_BAR, (volatile LAS unsigned*)(lds + MISC_OFF));
#ifndef BAR_REP
#define BAR_REP 1
#endif
#define GRID_BAR() do { for (int br_ = 0; br_ < BAR_REP; ++br_) { XcdBarrier b_; b_.bar = (unsigned*)(kargs()->ws + WS_CTL) + CW_BAR; b_.x = xb_xcc_id(); b_.st = (volatile LAS unsigned*)(lds + MISC_OFF); xcd_barrier(b_); } } while (0)

#ifndef REP_PROLOGUE
#define REP_PROLOGUE 1
#endif
    for (int rep = 0; rep < REP_PROLOGUE; ++rep) { if (rep) GRID_BAR(); phase_prologue(kargs(), lds); }
    GRID_BAR();
#pragma unroll 1
    for (int li = 0; li < 4; ++li) {
        const int j = li >> 1;
#define WSP (kargs()->ws)
#define XB ((bf16*)(WSP + WS_XB))
#define SSQ ((float*)(WSP + WS_SSQ))
        if ((li & 1) == 0) {
            for (int rep = 0; rep < REP_GIN; ++rep) { EpiDnIn E{(bf16*)(WSP + WS_PROJ), (float*)(WSP + WS_BA), SSQ, (LAS float*)(lds + 131072)};
              run_gemm<KP_WIN>(lds, XB, (const bf16*)(WSP + WS_WIN) + (size_t)j * DN_INP * DM, T, DN_INP, DM, E);
            GRID_BAR(); }
            for (int rep = 0; rep < REP_PREP; ++rep) { phase_dn_prep2(kargs(), j, lds);
            GRID_BAR(); }
            for (int rep = 0; rep < REP_SCAN; ++rep) { phase_dn_scan(kargs(), j, lds);
            GRID_BAR(); }
            { EpiRes E{XB, SSQ, nullptr};
              run_gemm<KP_WOUT>(lds, (const bf16*)(WSP + WS_OG), (const bf16*)(WSP + WS_WOUT) + (size_t)j * DM * VAL_DIM, TP, DM, VAL_DIM, E); }
            small_res((const bf16*)(WSP + WS_OG), (const bf16*)(WSP + WS_WOUT) + (size_t)j * DM * VAL_DIM, VAL_DIM, nullptr, XB, SSQ, lds);
            GRID_BAR();
        } else {
            { EpiQkv E{(bf16*)(WSP + WS_Q), (bf16*)(WSP + WS_KB), SSQ, kargs()->in[16] + j * QKV_N,
                       kargs()->out + O_KP + (size_t)j * NB_P * 128 * 256, kargs()->out + O_KS + (size_t)j * NB_S * 4 * 256, (LAS float*)(lds + 131072)};
              run_gemm<KP_QKV>(lds, XB, (const bf16*)(WSP + WS_WQKV) + (size_t)j * QKV_N * DM, T, QKV_N, DM, E); }
            GRID_BAR();
            for (int rep = 0; rep < REP_ATTN; ++rep) { phase_swa_attn_mfma(kargs(), j, lds);
            GRID_BAR(); }
            { EpiRes E{XB, SSQ, kargs()->in[19] + j * DM};
              run_gemm<KP_WO>(lds, (const bf16*)(WSP + WS_ATT), (const bf16*)(WSP + WS_WO) + (size_t)j * DM * DM, TP, DM, DM, E); }
            small_res((const bf16*)(WSP + WS_ATT), (const bf16*)(WSP + WS_WO) + (size_t)j * DM * DM, DM, kargs()->in[19] + j * DM, XB, SSQ, lds);
            GRID_BAR();
        }
        for (int rep = 0; rep < REP_GGU; ++rep) { EpiGu E{(bf16*)(WSP + WS_ACT), SSQ, (LAS float*)(lds + 131072)};
          run_gemm<KP_GU>(lds, XB, (const bf16*)(WSP + WS_WGU) + (size_t)li * GU_N * DM, T, GU_N, DM, E);
        GRID_BAR(); }
        { EpiRes E{XB, SSQ, nullptr};
          run_gemm<KP_DOWN>(lds, (const bf16*)(WSP + WS_ACT), (const bf16*)(WSP + WS_WDOWN) + (size_t)li * DM * DFF, TP, DM, DFF, E); }
        small_res((const bf16*)(WSP + WS_ACT), (const bf16*)(WSP + WS_WDOWN) + (size_t)li * DM * DFF, DFF, nullptr, XB, SSQ, lds);
        GRID_BAR();
    }
#undef WSP
#undef XB
#undef SSQ
    phase_final(kargs());
}

extern "C" void kernel_launch(void* const* d_in, const int* in_sizes, int n_in, void* d_out, int out_size, void* d_ws, size_t ws_size, hipStream_t stream) {
    static int grid = 0;
    if (grid == 0) {
        if (n_in != 22 || (size_t)out_size != O_END || ws_size < WS_END) { fprintf(stderr, "kernel_launch: unexpected shapes: n_in %d out %d ws %zu\n", n_in, out_size, ws_size); grid = -1; return; }
        int dev = 0, cus = 0, per_cu = 0;
        if (hipGetDevice(&dev) != hipSuccess || hipDeviceGetAttribute(&cus, hipDeviceAttributeMultiprocessorCount, dev) != hipSuccess) { grid = -1; return; }
        if (hipFuncSetAttribute((const void*)mk_fwd, hipFuncAttributeMaxDynamicSharedMemorySize, LDS_BYTES) != hipSuccess) { fprintf(stderr, "kernel_launch: hipFuncSetAttribute failed\n"); grid = -1; return; }
        if (hipOccupancyMaxActiveBlocksPerMultiprocessor(&per_cu, (const void*)mk_fwd, NTHREADS, LDS_BYTES) != hipSuccess || per_cu < 1) { fprintf(stderr, "kernel_launch: occupancy query reports %d blocks per CU\n", per_cu); (void)hipGetLastError(); }
        grid = cus;
    }
    if (grid < 0) return;
    (void)hipMemsetAsync((char*)d_ws + WS_CTL, 0, CTL_ZERO_BYTES, stream);
    Args a{};
    for (int i = 0; i < 22; ++i) a.in[i] = (const float*)d_in[i];
    a.out = (float*)d_out; a.ws = (unsigned char*)d_ws;
    hipLaunchKernelGGL(mk_fwd, dim3(grid), dim3(NTHREADS), LDS_BYTES, stream, a);
}
```

```cpp
#include <hip/hip_runtime.h>
#include <cstdio>
#include <cstdint>
namespace pg8 {
#define PG8_LAS __attribute__((address_space(3)))
typedef unsigned short bf16_t;
typedef short bf16x8 __attribute__((ext_vector_type(8)));
typedef float f32x4 __attribute__((ext_vector_type(4)));
typedef unsigned u32x4 __attribute__((ext_vector_type(4)));
constexpr int BM = 256, BK = 64, HALF = 128, HTB = HALF * BK * 2  , STAGE_BYTES = 8 * HTB, NXCD = 8, WGM = 8;

__host__ __device__ __forceinline__ int lds_byte(int r, int c) { const int st = (r >> 4) * 2 + (c >> 5), rr = r & 15, cc = c & 31, ob = rr * 64 + cc * 2; return st * 1024 + (ob ^ (((ob >> 9) & 1) << 5)); }
__host__ __device__ __forceinline__ void stage_rc(int b, int& R, int& C) { const int st = b / 1024, sb = b % 1024, swz = sb ^ (((sb >> 9) & 1) << 5); R = (st >> 1) * 16 + swz / 64; C = (st & 1) * 32 + (swz % 64) / 2; }
__host__ __device__ __forceinline__ int perm32(int rho) { const int n = rho >> 4, i = rho & 15; return 8 * (i >> 2) + 4 * n + (i & 3); }

struct Unit { int pm, pn; };
struct Gemm { const bf16_t* A; const bf16_t* Bt; int M, N, K; };

struct StaticOrder {
    int nM, nN, nwg, G, c;
    __host__ __device__ void init(int M, int N, int G_, int c_) { nM = M / BM; nN = N / BM; nwg = nM * nN; G = G_; c = c_; }
    __host__ __device__ bool next(int i, Unit& u) const {
        const long L = (long)i * G + c; if (L >= nwg) return false;
        int wgid = (int)L; { const int q = nwg / NXCD, r = nwg % NXCD, xcd = wgid % NXCD, off = wgid / NXCD; wgid = (xcd < r ? xcd * (q + 1) : r * (q + 1) + (xcd - r) * q) + off; }
        const int nig = WGM * nN, gid = wgid / nig, fm = gid * WGM, gsz = (nM - fm) < WGM ? (nM - fm) : WGM;
        u.pm = fm + ((wgid % nig) % gsz); u.pn = (wgid % nig) / gsz; return true;
    }
    __device__ __forceinline__ void a_ready(const Unit&) const {}
    __device__ __forceinline__ void done(const Unit&) const {}
};
__device__ __forceinline__ unsigned cvt_pk_bf16(float lo, float hi) { unsigned r; asm volatile("v_cvt_pk_bf16_f32 %0, %1, %2" : "=v"(r) : "v"(lo), "v"(hi)); return r; }
typedef float f32x2 __attribute__((ext_vector_type(2)));
template <class Epi, class Sched, bool ALIGN_EPI = false, bool SP2 = false>
__device__ __forceinline__ void gemm_phase(PG8_LAS unsigned char* lds, const Gemm g, const Sched& S, const Epi& E) {
    int tid_ = threadIdx.x; asm volatile("" : "+v"(tid_)); const int tid = tid_, wid = __builtin_amdgcn_readfirstlane(tid >> 6), lane = tid & 63, wr = wid >> 2, wc = wid & 3, fr = lane & 15, fq = lane >> 4;
    const int K = g.K, nt = K / BK;
    unsigned voffA[2], voffB[2];
#pragma unroll
    for (int i = 0; i < 2; ++i) { int R, C; stage_rc(tid * 16 + i * 8192, R, C); const int Rb = Epi::PERM ? ((R & ~31) + perm32(R & 31)) : R;
        voffA[i] = (unsigned)(R * K + C) * 2u; voffB[i] = (unsigned)(Rb * K + C) * 2u; }
    const size_t kstep = (size_t)(BK * 2);
    const size_t hstep = (size_t)HALF * K * 2;
    const size_t tstep = 2 * hstep;
    const unsigned ldsw = (unsigned)wid * 1024u;
    const int aoff = lds_byte(wr * 64 + fr, fq * 8), boff = lds_byte(wc * 32 + fr, fq * 8);
#define PG8_SA(b, h) (((b) * 2 + (h)) * HTB)
#define PG8_SB(b, h) ((4 + (b) * 2 + (h)) * HTB)
#define PG8_STAGE(bufoff, gbase, voff) do { _Pragma("unroll") for (int _i = 0; _i < 2; ++_i) \
        __builtin_amdgcn_global_load_lds((const unsigned*)((const char*)(gbase) + (voff)[_i]), (PG8_LAS unsigned*)(lds + (bufoff) + ldsw + _i * 8192), 16, 0, 0); } while (0)
#define PG8_LDA(dst, b, h) do { _Pragma("unroll") for (int m = 0; m < 4; ++m) _Pragma("unroll") for (int k = 0; k < 2; ++k) dst[m][k] = *(const PG8_LAS bf16x8*)(lds + PG8_SA(b, h) + aoff + m * 2048 + k * 1024); } while (0)
#define PG8_LDB(dst, b, h) do { _Pragma("unroll") for (int n = 0; n < 2; ++n) _Pragma("unroll") for (int k = 0; k < 2; ++k) dst[n][k] = *(const PG8_LAS bf16x8*)(lds + PG8_SB(b, h) + boff + n * 2048 + k * 1024); } while (0)
#define PG8_MMA(ai, bj, At, Bt) do { __builtin_amdgcn_s_setprio(1); _Pragma("unroll") for (int m = 0; m < 4; ++m) _Pragma("unroll") for (int n = 0; n < 2; ++n) _Pragma("unroll") for (int k = 0; k < 2; ++k) \
        acc[ai][bj][m][n] = __builtin_amdgcn_mfma_f32_16x16x32_bf16(Bt[n][k], At[m][k], acc[ai][bj][m][n], 0, 0, 0); __builtin_amdgcn_s_setprio(0); } while (0)
#define PG8_WAIT_V(n) asm volatile("s_waitcnt vmcnt(" #n ")" ::: "memory")
#define PG8_WAIT_L(n) asm volatile("s_waitcnt lgkmcnt(" #n ")" ::: "memory")
#define PG8_BAR __builtin_amdgcn_s_barrier()
#define PG8_SCHED __builtin_amdgcn_sched_barrier(0)
    Unit cur, nxt; int ui = 0;
    if (!S.next(0, cur)) return;
    f32x4 acc[2][2][4][2];
#pragma unroll
    for (int a = 0; a < 2; ++a)
#pragma unroll
        for (int b = 0; b < 2; ++b)
#pragma unroll
            for (int m = 0; m < 4; ++m)
#pragma unroll
                for (int n = 0; n < 2; ++n) acc[a][b][m][n] = (f32x4){0.f, 0.f, 0.f, 0.f};
    bf16x8 At[4][2], B0[2][2], B1[2][2];
    const char* cA = (const char*)g.A + (size_t)cur.pm * tstep; const char* cB = (const char*)g.Bt + (size_t)cur.pn * tstep;
    S.a_ready(cur);
    if constexpr (SP2) {
        PG8_STAGE(PG8_SB(0, 0), cB, voffB); PG8_STAGE(PG8_SB(0, 1), cB + hstep, voffB); PG8_STAGE(PG8_SA(0, 0), cA, voffA); PG8_STAGE(PG8_SA(0, 1), cA + hstep, voffA);
        if (wr == 1) PG8_BAR;
        PG8_WAIT_V(2); PG8_BAR;
        PG8_STAGE(PG8_SB(1, 0), cB + kstep, voffB); PG8_STAGE(PG8_SA(1, 0), cA + kstep, voffA); PG8_STAGE(PG8_SB(1, 1), cB + hstep + kstep, voffB);
        PG8_WAIT_V(6); PG8_BAR;
    } else {
        PG8_STAGE(PG8_SB(0, 0), cB, voffB); PG8_STAGE(PG8_SA(0, 0), cA, voffA); PG8_STAGE(PG8_SB(0, 1), cB + hstep, voffB); PG8_STAGE(PG8_SA(0, 1), cA + hstep, voffA);
        if (wr == 1) PG8_BAR;
        PG8_WAIT_V(4); PG8_BAR;
        PG8_STAGE(PG8_SB(1, 0), cB + kstep, voffB); PG8_STAGE(PG8_SA(1, 0), cA + kstep, voffA); PG8_STAGE(PG8_SB(1, 1), cB + hstep + kstep, voffB);
        PG8_WAIT_V(6); PG8_BAR;
    }
    for (;;) {
        const bool has_next = S.next(ui + 1, nxt);
        const char* nA = has_next ? (const char*)g.A + (size_t)nxt.pm * tstep : cA; const char* nB = has_next ? (const char*)g.Bt + (size_t)nxt.pn * tstep : cB;
        for (int t = 0; t < nt; t += 2) {
            const bool last = (t == nt - 2);
            const char* a1 = cA + (size_t)(t + 1) * kstep;
            const char* a2 = last ? nA : cA + (size_t)(t + 2) * kstep; const char* b2 = last ? nB : cB + (size_t)(t + 2) * kstep;
            const char* a3 = a2 + kstep; const char* b3 = b2 + kstep;
            if (last && has_next) S.a_ready(nxt);
            if constexpr (SP2) {
            PG8_LDB(B0, 0, 0); PG8_LDB(B1, 0, 1); PG8_SCHED; PG8_LDA(At, 0, 0); PG8_STAGE(PG8_SA(1, 1), a1 + hstep, voffA);
            PG8_WAIT_V(8); PG8_WAIT_L(0); PG8_BAR; PG8_MMA(0, 0, At, B0); PG8_MMA(0, 1, At, B1); PG8_BAR; PG8_SCHED;
            PG8_LDA(At, 0, 1); PG8_STAGE(PG8_SB(0, 0), b2, voffB); PG8_STAGE(PG8_SB(0, 1), b2 + hstep, voffB); PG8_STAGE(PG8_SA(0, 0), a2, voffA);
            PG8_WAIT_V(8); PG8_WAIT_L(0); PG8_BAR; PG8_MMA(1, 0, At, B0); PG8_MMA(1, 1, At, B1); PG8_BAR; PG8_SCHED;
            PG8_LDB(B0, 1, 0); PG8_LDB(B1, 1, 1); PG8_SCHED; PG8_LDA(At, 1, 0); PG8_STAGE(PG8_SA(0, 1), a2 + hstep, voffA);
            PG8_WAIT_V(8); PG8_WAIT_L(0); PG8_BAR; PG8_MMA(0, 0, At, B0); PG8_MMA(0, 1, At, B1); PG8_BAR; PG8_SCHED;
            PG8_LDA(At, 1, 1); PG8_STAGE(PG8_SB(1, 0), b3, voffB); PG8_STAGE(PG8_SB(1, 1), b3 + hstep, voffB); PG8_STAGE(PG8_SA(1, 0), a3, voffA);
            PG8_WAIT_V(8); PG8_WAIT_L(0); PG8_BAR; PG8_MMA(1, 0, At, B0); PG8_MMA(1, 1, At, B1); PG8_BAR; PG8_SCHED;
            } else {
            PG8_LDB(B0, 0, 0); PG8_SCHED; PG8_LDA(At, 0, 0); PG8_STAGE(PG8_SA(1, 1), a1 + hstep, voffA);
            PG8_WAIT_L(8); PG8_BAR; PG8_WAIT_L(0); PG8_MMA(0, 0, At, B0); PG8_BAR; PG8_SCHED;
            PG8_LDB(B1, 0, 1); PG8_STAGE(PG8_SB(0, 0), b2, voffB);
            PG8_BAR; PG8_WAIT_L(0); PG8_MMA(0, 1, At, B1); PG8_BAR;
            PG8_LDA(At, 0, 1); PG8_STAGE(PG8_SA(0, 0), a2, voffA);
            PG8_BAR; PG8_WAIT_L(0); PG8_MMA(1, 0, At, B0); PG8_BAR; PG8_SCHED;
            PG8_STAGE(PG8_SB(0, 1), b2 + hstep, voffB);
            PG8_WAIT_V(6); PG8_BAR; PG8_MMA(1, 1, At, B1); PG8_BAR;
            PG8_LDB(B0, 1, 0); PG8_SCHED; PG8_LDA(At, 1, 0); PG8_STAGE(PG8_SA(0, 1), a2 + hstep, voffA);
            PG8_WAIT_L(8); PG8_BAR; PG8_WAIT_L(0); PG8_MMA(0, 0, At, B0); PG8_BAR; PG8_SCHED;
            PG8_LDB(B1, 1, 1); PG8_STAGE(PG8_SB(1, 0), b3, voffB);
            PG8_BAR; PG8_WAIT_L(0); PG8_MMA(0, 1, At, B1); PG8_BAR;
            PG8_LDA(At, 1, 1); PG8_STAGE(PG8_SA(1, 0), a3, voffA);
            PG8_BAR; PG8_WAIT_L(0); PG8_MMA(1, 0, At, B0); PG8_BAR; PG8_SCHED;
            PG8_STAGE(PG8_SB(1, 1), b3 + hstep, voffB);
            PG8_WAIT_V(6); PG8_BAR; PG8_MMA(1, 1, At, B1); PG8_BAR;
            }
        }
        if constexpr (ALIGN_EPI) { if (wr == 0) PG8_BAR; }
        if constexpr (!Epi::AFTER_DRAIN) { E(acc, cur, wr, wc, fr, fq); S.done(cur); }
        if (!has_next) break;
#pragma unroll
        for (int a = 0; a < 2; ++a)
#pragma unroll
            for (int b = 0; b < 2; ++b)
#pragma unroll
                for (int m = 0; m < 4; ++m)
#pragma unroll
                    for (int n = 0; n < 2; ++n) acc[a][b][m][n] = (f32x4){0.f, 0.f, 0.f, 0.f};
        cur = nxt; cA = nA; cB = nB; ++ui;
        if constexpr (ALIGN_EPI) { if (wr == 1) PG8_BAR; }
    }
    PG8_WAIT_V(0);
    if constexpr (!ALIGN_EPI) { if (wr == 0) PG8_BAR; }
    PG8_BAR;
    if constexpr (Epi::AFTER_DRAIN) { E.fused(acc, cur, wr, wc, fr, fq, lds, wid, lane); S.done(cur); }
#undef PG8_SA
#undef PG8_SB
#undef PG8_STAGE
#undef PG8_LDA
#undef PG8_LDB
#undef PG8_MMA
#undef PG8_WAIT_V
#undef PG8_WAIT_L
#undef PG8_BAR
#undef PG8_SCHED
}
}

#define GAS __attribute__((address_space(1)))
#define LAS __attribute__((address_space(3)))
typedef unsigned short bf16;
typedef unsigned v4u __attribute__((ext_vector_type(4)));
typedef unsigned v2u __attribute__((ext_vector_type(2)));
typedef float f32x4 __attribute__((ext_vector_type(4)));
typedef float f32x2v __attribute__((ext_vector_type(2)));

constexpr int DM = 1024, NB_P = 8, SEQ = 2048, NB_S = 128, DSEQ = 4;
constexpr int TP = NB_P * SEQ, TS = NB_S * DSEQ, T = TP + TS;
constexpr int DN_IN = 6176, DN_INP = 6400, PROJ_LD = 6144, CONV_DIM = 4096, VAL_DIM = 2048;
constexpr int QKV_N = 1536, DFF = 2816, GU_N = 5632;
constexpr float RMS_EPS = 1e-6f, L2_EPS = 1e-6f;

constexpr size_t O_YP = 0, O_YS = 16777216, O_CONVP = 17301504, O_DELTAP = 17498112, O_KP = 21692416, O_VP = 22216704,
                 O_CONVS = 22740992, O_DELTAS = 25886720, O_KS = 92995584, O_VS = 93257728, O_END = 93519872;

constexpr size_t MiB = 1u << 20;
constexpr size_t WS_CTL = 0, CTL_ZERO_BYTES = 65536;
constexpr size_t WS_WIN = 2 * MiB;
constexpr size_t WS_WOUT = 27 * MiB;
constexpr size_t WS_WQKV = 35 * MiB;
constexpr size_t WS_WO = 41 * MiB;
constexpr size_t WS_WGU = 45 * MiB;
constexpr size_t WS_WDOWN = 89 * MiB;
constexpr size_t WS_X = 112 * MiB;
constexpr size_t WS_XB = 178 * MiB;
constexpr size_t WS_SSQ = 211 * MiB;
constexpr size_t WS_BA = 213 * MiB;
constexpr size_t WS_BG = 216 * MiB;
constexpr size_t WS_PROJ = 220 * MiB;
constexpr size_t WS_Q = 220 * MiB;
constexpr size_t WS_KB = 253 * MiB;
constexpr size_t WS_VB = 262 * MiB;
constexpr size_t WS_ATT = 271 * MiB;
constexpr size_t WS_QKV = 418 * MiB;
constexpr size_t WS_DREC = 428 * MiB;
constexpr size_t WS_OG = 716 * MiB;
constexpr size_t WS_ACT = 782 * MiB;
constexpr size_t WS_EGL = 874 * MiB;
constexpr size_t WS_XCH = 876 * MiB;
constexpr size_t WS_END = 880 * MiB;
constexpr size_t KV_DELTA = (WS_VB - WS_KB) / 2;

constexpr int CW_TICKET = 8192;
constexpr int NWAVES = 8, NTHREADS = 512;
constexpr int LDS_BYTES = 163840;

#define LDS_WAIT() asm volatile("s_waitcnt lgkmcnt(0)" ::: "memory")
typedef float f32x2c_t __attribute__((ext_vector_type(2))); typedef __bf16 bf16x2c_t __attribute__((ext_vector_type(2)));
__device__ __forceinline__ unsigned pk2(float lo, float hi) { const f32x2c_t v = {lo, hi}; const bf16x2c_t b = __builtin_convertvector(v, bf16x2c_t); return __builtin_bit_cast(unsigned, b); }
__device__ __forceinline__ unsigned f2bf(float f) { return pk2(f, f) & 0xffffu; }
__device__ __forceinline__ v4u widen16(v2u a, v2u b) {
    const auto r0 = __builtin_amdgcn_permlane16_swap(a.x, b.x, false, false); const auto r1 = __builtin_amdgcn_permlane16_swap(a.y, b.y, false, false);
    return (v4u){r0[0], r1[0], r0[1], r1[1]};
}
__device__ __forceinline__ void narrow16(v4u x, v2u& a, v2u& b) {
    const auto r0 = __builtin_amdgcn_permlane16_swap(x.x, x.z, false, false); const auto r1 = __builtin_amdgcn_permlane16_swap(x.y, x.w, false, false);
    a = (v2u){r0[0], r1[0]}; b = (v2u){r0[1], r1[1]};
}
__device__ __forceinline__ float bf2f(unsigned short b) { return __builtin_bit_cast(float, (unsigned)b << 16); }
__device__ __forceinline__ float bflo(unsigned w) { return __builtin_bit_cast(float, w << 16); }
__device__ __forceinline__ float bfhi(unsigned w) { return __builtin_bit_cast(float, w & 0xffff0000u); }
__device__ __forceinline__ float wave_sum(float v) {
#pragma unroll
    for (int o = 1; o < 64; o <<= 1) v += __shfl_xor(v, o);
    return v;
}
__device__ __forceinline__ float wave_max(float v) {
#pragma unroll
    for (int o = 1; o < 64; o <<= 1) v = fmaxf(v, __shfl_xor(v, o));
    return v;
}
__device__ __forceinline__ float silu_f(float x) { return x * __builtin_amdgcn_rcpf(1.f + __expf(-x)); }
__device__ __forceinline__ float row_rstd(const float* ssq, int row) {
    const f32x4* p = (const f32x4*)(ssq + (size_t)row * 16);
    const f32x4 a = p[0], b = p[1], c = p[2], d = p[3];
    const float s = ((a[0] + a[1]) + (a[2] + a[3])) + ((b[0] + b[1]) + (b[2] + b[3])) + ((c[0] + c[1]) + (c[2] + c[3])) + ((d[0] + d[1]) + (d[2] + d[3]));
    return rsqrtf(s * (1.f / 1024.f) + RMS_EPS);
}


__device__ __forceinline__ void wave_rstd(const float* ssq, int rowbase, LAS float* scr, int lane, int fr, float (&rs)[2][4]) {
    scr[lane] = row_rstd(ssq, rowbase + lane); scr[64 + lane] = row_rstd(ssq, rowbase + 128 + lane);
#pragma unroll
    for (int ai = 0; ai < 2; ++ai)
#pragma unroll
        for (int m = 0; m < 4; ++m) rs[ai][m] = scr[ai * 64 + m * 16 + fr];
}
using pg8::Unit; using pg8::cvt_pk_bf16;
struct EpiDnIn {
    static constexpr bool PERM = true, AFTER_DRAIN = false;
    bf16* proj; float* ba; const float* ssq; LAS float* rscr;
    __device__ __forceinline__ void operator()(const f32x4 (&acc)[2][2][4][2], const Unit& u, int wr, int wc, int fr, int fq) const {
        const int row0 = u.pm * 256 + wr * 64 + fr; float rsv[2][4];
        wave_rstd(ssq, u.pm * 256 + wr * 64, rscr + (wr * 4 + wc) * 128, (int)(threadIdx.x & 63), fr, rsv);
        if (u.pn < 24) {
            const int col0 = u.pn * 256 + wc * 32 + 8 * fq;
#pragma unroll
            for (int ai = 0; ai < 2; ++ai)
#pragma unroll
                for (int m = 0; m < 4; ++m) { const int row = row0 + ai * 128 + m * 16; const float rs = rsv[ai][m];
                    bf16* rowp = proj + (size_t)row * PROJ_LD + col0;
#pragma unroll
                    for (int bj = 0; bj < 2; ++bj) { const f32x4 v0 = acc[ai][bj][m][0] * rs, v1 = acc[ai][bj][m][1] * rs;
                        v4u w; w.x = cvt_pk_bf16(v0[0], v0[1]); w.y = cvt_pk_bf16(v0[2], v0[3]); w.z = cvt_pk_bf16(v1[0], v1[1]); w.w = cvt_pk_bf16(v1[2], v1[3]);
                        *(v4u*)(rowp + bj * 128) = w; } }
        } else if (wc == 0) {
#pragma unroll
            for (int ai = 0; ai < 2; ++ai)
#pragma unroll
                for (int m = 0; m < 4; ++m) { const int row = row0 + ai * 128 + m * 16; const float rs = rsv[ai][m];
                    float* o = ba + (size_t)row * 32 + 8 * fq;
                    *(f32x4*)o = acc[ai][0][m][0] * rs; *(f32x4*)(o + 4) = acc[ai][0][m][1] * rs; }
        }
    }
};
struct EpiRes {
    static constexpr bool PERM = true, AFTER_DRAIN = false;
    bf16* XB; float* ssq; const float* bias;
    __device__ __forceinline__ void operator()(const f32x4 (&acc)[2][2][4][2], const Unit& u, int wr, int wc, int fr, int fq) const {
        const int row0 = u.pm * 256 + wr * 64 + fr, col0 = u.pn * 256 + wc * 32 + 8 * fq;
        f32x4 bv[2][2];
#pragma unroll
        for (int bj = 0; bj < 2; ++bj) { bv[bj][0] = bias ? *(const f32x4*)(bias + col0 + bj * 128) : (f32x4){0.f, 0.f, 0.f, 0.f}; bv[bj][1] = bias ? *(const f32x4*)(bias + col0 + bj * 128 + 4) : (f32x4){0.f, 0.f, 0.f, 0.f}; }
#pragma unroll
        for (int ai = 0; ai < 2; ++ai)
#pragma unroll
            for (int m = 0; m < 4; ++m) { const int row = row0 + ai * 128 + m * 16; float s = 0.f;
#pragma unroll
                for (int bj = 0; bj < 2; ++bj) { const int c = col0 + bj * 128; bf16* xp = XB + (size_t)row * DM + c;
                    const v4u xo = *(const v4u*)xp;
                    f32x4 x0 = (f32x4){bflo(xo.x), bfhi(xo.x), bflo(xo.y), bfhi(xo.y)} + acc[ai][bj][m][0], x1 = (f32x4){bflo(xo.z), bfhi(xo.z), bflo(xo.w), bfhi(xo.w)} + acc[ai][bj][m][1];
                    x0 = x0 + bv[bj][0]; x1 = x1 + bv[bj][1];
                    v4u w; w.x = cvt_pk_bf16(x0[0], x0[1]); w.y = cvt_pk_bf16(x0[2], x0[3]); w.z = cvt_pk_bf16(x1[0], x1[1]); w.w = cvt_pk_bf16(x1[2], x1[3]);
                    *(v4u*)xp = w;
                    const float r0 = bflo(w.x), r1 = bfhi(w.x), r2 = bflo(w.y), r3 = bfhi(w.y), r4 = bflo(w.z), r5 = bfhi(w.z), r6 = bflo(w.w), r7 = bfhi(w.w);
                    s += ((r0 * r0 + r1 * r1) + (r2 * r2 + r3 * r3)) + ((r4 * r4 + r5 * r5) + (r6 * r6 + r7 * r7)); }
                s += __shfl_xor(s, 16); s += __shfl_xor(s, 32);
                if (fq == 0) ssq[(size_t)row * 16 + u.pn * 4 + wc] = s; }
    }
};
struct EpiQkv {
    static constexpr bool PERM = true, AFTER_DRAIN = false;
    bf16 *Q, *KB; const float* ssq; const float* bias; float *okp, *oks; LAS float* rscr;
    __device__ __forceinline__ void operator()(const f32x4 (&acc)[2][2][4][2], const Unit& u, int wr, int wc, int fr, int fq) const {
        const int row0 = u.pm * 256 + wr * 64 + fr, cw = wc * 32 + 8 * fq;
        const bool isq = u.pn < 4; const size_t kvsel = (u.pn == 5) ? 1 : 0;
        const float qs = isq ? 0.125f : 1.f; float rsv[2][4];
        wave_rstd(ssq, u.pm * 256 + wr * 64, rscr + (wr * 4 + wc) * 128, (int)(threadIdx.x & 63), fr, rsv);
        f32x4 bv[2][2];
#pragma unroll
        for (int bj = 0; bj < 2; ++bj) { bv[bj][0] = *(const f32x4*)(bias + u.pn * 256 + bj * 128 + cw); bv[bj][1] = *(const f32x4*)(bias + u.pn * 256 + bj * 128 + cw + 4); }
#pragma unroll
        for (int ai = 0; ai < 2; ++ai)
#pragma unroll
            for (int m = 0; m < 4; ++m) { const int row = row0 + ai * 128 + m * 16; const float rs = rsv[ai][m];
#pragma unroll
                for (int bj = 0; bj < 2; ++bj) { const int colk = bj * 128 + cw, gcol = u.pn * 256 + colk;
                    const f32x4 v0 = (acc[ai][bj][m][0] * rs + bv[bj][0]) * qs, v1 = (acc[ai][bj][m][1] * rs + bv[bj][1]) * qs;
                    v4u w; w.x = cvt_pk_bf16(v0[0], v0[1]); w.y = cvt_pk_bf16(v0[2], v0[3]); w.z = cvt_pk_bf16(v1[0], v1[1]); w.w = cvt_pk_bf16(v1[2], v1[3]);
                    if (isq) *(v4u*)(Q + (size_t)row * DM + gcol) = w;
                    else {
                        *(v4u*)(KB + kvsel * KV_DELTA + (size_t)row * 256 + colk) = w;
                        if (row < TP) { const int b = row >> 11, pos = row & 2047;
                            if (pos >= 1920) { float* o = okp + kvsel * (O_VP - O_KP) + (size_t)(b * 128 + pos - 1920) * 256 + colk; *(f32x4*)o = v0; *(f32x4*)(o + 4) = v1; } }
                        else { float* o = oks + kvsel * (O_VS - O_KS) + (size_t)(row - TP) * 256 + colk; *(f32x4*)o = v0; *(f32x4*)(o + 4) = v1; } } } }
    }
};
struct EpiGu {
    static constexpr bool PERM = true, AFTER_DRAIN = false;
    bf16* act; const float* ssq; LAS float* rscr;
    __device__ __forceinline__ void operator()(const f32x4 (&acc)[2][2][4][2], const Unit& u, int wr, int wc, int fr, int fq) const {
        const int row0 = u.pm * 256 + wr * 64 + fr, col0 = u.pn * 128 + wc * 32 + 8 * fq; float rsv[2][4];
        wave_rstd(ssq, u.pm * 256 + wr * 64, rscr + (wr * 4 + wc) * 128, (int)(threadIdx.x & 63), fr, rsv);
#pragma unroll
        for (int ai = 0; ai < 2; ++ai)
#pragma unroll
            for (int m = 0; m < 4; ++m) { const int row = row0 + ai * 128 + m * 16; const float rs = rsv[ai][m];
                float r[8];
#pragma unroll
                for (int n = 0; n < 2; ++n)
#pragma unroll
                    for (int e = 0; e < 4; ++e) { const float g = acc[ai][0][m][n][e] * rs, uu = acc[ai][1][m][n][e] * rs; r[n * 4 + e] = silu_f(g) * uu; }
                v4u w; w.x = cvt_pk_bf16(r[0], r[1]); w.y = cvt_pk_bf16(r[2], r[3]); w.z = cvt_pk_bf16(r[4], r[5]); w.w = cvt_pk_bf16(r[6], r[7]);
                *(v4u*)(act + (size_t)row * DFF + col0) = w; }
    }
};

struct Args { const float* in[22]; float* out; unsigned char* ws; int ph_lo, ph_hi; };
typedef const __attribute__((address_space(4))) Args* CArgs;
__device__ __forceinline__ CArgs kargs() { CArgs p = (CArgs)__builtin_amdgcn_kernarg_segment_ptr(); asm volatile("" : "+s"(p)); return p; }

__device__ __forceinline__ void tr_item64(const float* W, int K, int N, const float* nw, bf16* WT, int dst_row0, LAS float* scr, int k0, int n0, int lane) {
    const int nvalid = (N - n0) < 64 ? (N - n0) : 64, n4 = (lane & 15) * 4;
#pragma unroll 4
    for (int i = 0; i < 16; ++i) { const int kk = 4 * i + (lane >> 4); const float s = nw ? nw[k0 + kk] : 1.f;
        f32x4 v = (f32x4){0.f, 0.f, 0.f, 0.f};
        if (n4 < nvalid) v = *(const f32x4*)(W + (size_t)(k0 + kk) * N + n0 + n4);
        LAS float* d = scr + kk * 65 + n4; d[0] = v[0] * s; d[1] = v[1] * s; d[2] = v[2] * s; d[3] = v[3] * s; }
    LDS_WAIT(); asm volatile("" ::: "memory");
    const int c = lane & 7;
#pragma unroll
    for (int p = 0; p < 8; ++p) { const int n = 8 * p + (lane >> 3); const LAS float* s = scr + (8 * c) * 65 + n;
        v4u o; o.x = pk2(s[0 * 65], s[1 * 65]); o.y = pk2(s[2 * 65], s[3 * 65]); o.z = pk2(s[4 * 65], s[5 * 65]); o.w = pk2(s[6 * 65], s[7 * 65]);
        if (n < nvalid) *(v4u*)(WT + (size_t)(dst_row0 + n) * K + k0 + 8 * c) = o; }
    LDS_WAIT(); asm volatile("" ::: "memory");
}
__device__ __forceinline__ void tr_matrix_item(const float* W, int K, int N, const float* nw, bf16* WT, int gu, LAS float* scr, int r, int lane) {
    const int nblk = (N + 63) / 64, kb = r / nblk, nb = r % nblk, k0 = 64 * kb, n0 = 64 * nb;
    int dr = n0;
    if (gu) dr = (n0 < DFF) ? (n0 / 128) * 256 + (n0 % 128) : ((n0 - DFF) / 128) * 256 + 128 + ((n0 - DFF) % 128);
    tr_item64(W, K, N, nw, WT, dr, scr, k0, n0, lane);
}
__device__ __forceinline__ void phase_prologue(CArgs ap, LAS unsigned char* lds) {
    int tid_ = threadIdx.x; asm volatile("" : "+v"(tid_)); const int tid = tid_, lane = tid & 63, wave = __builtin_amdgcn_readfirstlane(tid >> 6);
    LAS float* scr = (LAS float*)(lds + wave * 16896);
    const int gw = blockIdx.x * NWAVES + wave, NGW = gridDim.x * NWAVES;
    unsigned char* ws = ap->ws;
    constexpr int I_IN = 16 * 97, I_OUT = 32 * 16, I_QKV = 16 * 24, I_O = 16 * 16, I_GU = 16 * 88, I_DN = 44 * 16;
    constexpr int NITEMS = 2 * I_IN + 2 * I_OUT + 2 * I_QKV + 2 * I_O + 4 * I_GU + 4 * I_DN;
    for (int it = gw; it < NITEMS; it += NGW) {
        int r = it;
        if (r < 2 * I_IN) { const int j = r / I_IN; r -= j * I_IN;
            tr_matrix_item(ap->in[9] + (size_t)j * DM * DN_IN, DM, DN_IN, ap->in[6] + (2 * j) * DM, (bf16*)(ws + WS_WIN) + (size_t)j * DN_INP * DM, 0, scr, r, lane); continue; }
        r -= 2 * I_IN;
        if (r < 2 * I_OUT) { const int j = r / I_OUT; r -= j * I_OUT;
            tr_matrix_item(ap->in[14] + (size_t)j * VAL_DIM * DM, VAL_DIM, DM, nullptr, (bf16*)(ws + WS_WOUT) + (size_t)j * DM * VAL_DIM, 0, scr, r, lane); continue; }
        r -= 2 * I_OUT;
        if (r < 2 * I_QKV) { const int j = r / I_QKV; r -= j * I_QKV;
            tr_matrix_item(ap->in[15] + (size_t)j * DM * QKV_N, DM, QKV_N, ap->in[6] + (2 * j + 1) * DM, (bf16*)(ws + WS_WQKV) + (size_t)j * QKV_N * DM, 0, scr, r, lane); continue; }
        r -= 2 * I_QKV;
        if (r < 2 * I_O) { const int j = r / I_O; r -= j * I_O;
            tr_matrix_item(ap->in[18] + (size_t)j * DM * DM, DM, DM, nullptr, (bf16*)(ws + WS_WO) + (size_t)j * DM * DM, 0, scr, r, lane); continue; }
        r -= 2 * I_O;
        if (r < 4 * I_GU) { const int i = r / I_GU; r -= i * I_GU;
            tr_matrix_item(ap->in[20] + (size_t)i * DM * GU_N, DM, GU_N, ap->in[7] + i * DM, (bf16*)(ws + WS_WGU) + (size_t)i * GU_N * DM, 1, scr, r, lane); continue; }
        r -= 4 * I_GU;
        { const int i = r / I_DN; r -= i * I_DN;
            tr_matrix_item(ap->in[21] + (size_t)i * DFF * DM, DFF, DM, nullptr, (bf16*)(ws + WS_WDOWN) + (size_t)i * DM * DFF, 0, scr, r, lane); }
    }
    for (int i = blockIdx.x * NTHREADS + tid; i < 2 * 28672; i += gridDim.x * NTHREADS) { const int j = i / 28672, o = i % 28672;
        *(v4u*)((bf16*)(ws + WS_WIN) + (size_t)j * DN_INP * DM + (size_t)DN_IN * DM + (size_t)o * 8) = (v4u){0u, 0u, 0u, 0u}; }
    bf16* XB = (bf16*)(ws + WS_XB); float* SSQ = (float*)(ws + WS_SSQ);
    for (int m = gw; m < T; m += NGW) {
        const float* src = (m < TP) ? ap->in[0] + (size_t)m * DM : ap->in[1] + (size_t)(m - TP) * DM;
        float s = 0.f;
#pragma unroll
        for (int j = 0; j < 4; ++j) { const f32x4 v = *((const f32x4*)src + lane + 64 * j);
            v2u w; w.x = pk2(v[0], v[1]); w.y = pk2(v[2], v[3]); *((v2u*)(XB + (size_t)m * DM) + lane + 64 * j) = w;
            const float r0 = bflo(w.x), r1 = bfhi(w.x), r2 = bflo(w.y), r3 = bfhi(w.y);
            s += (r0 * r0 + r1 * r1) + (r2 * r2 + r3 * r3); }
        s = wave_sum(s);
        if (lane < 16) SSQ[(size_t)m * 16 + lane] = (lane == 0) ? s : 0.f;
    }
}

__device__ __forceinline__ void phase_dn_post(CArgs ap, int j, int tstart) {
    int tid_ = threadIdx.x; asm volatile("" : "+v"(tid_)); const int tid = tid_, lane = tid & 63, wave = __builtin_amdgcn_readfirstlane(tid >> 6);
    const int gw = blockIdx.x * NWAVES + wave, NGW = gridDim.x * NWAVES;
    unsigned char* ws = ap->ws;
    const bf16* PROJ = (const bf16*)(ws + WS_PROJ); const float* BA = (const float*)(ws + WS_BA);
    float* QKV = (float*)(ws + WS_QKV) - (size_t)TP * CONV_DIM; float* BG = (float*)(ws + WS_BG);
    const float* cw = ap->in[10] + (size_t)j * 4 * CONV_DIM;
    const float* sconv = ap->in[2] + (size_t)j * NB_S * 3 * CONV_DIM;
    float* oconvp = ap->out + O_CONVP + (size_t)j * NB_P * 3 * CONV_DIM;
    float* oconvs = ap->out + O_CONVS + (size_t)j * NB_S * 3 * CONV_DIM;
    for (int task = tstart * 32 + gw; task < T * 32; task += NGW) {
        const int t = task >> 5, hc = task & 31, col0 = hc * 128 + 2 * lane;
        const bool prompt = t < TP; const int pos = prompt ? (t & 2047) : ((t - TP) & 3); const int b = prompt ? (t >> 11) : ((t - TP) >> 2);
        float y0 = 0.f, y1 = 0.f, u00 = 0.f, u01 = 0.f;
#pragma unroll
        for (int k = 0; k < 4; ++k) {
            float u0 = 0.f, u1 = 0.f;
            if (pos - k >= 0) { const unsigned w = *(const unsigned*)(PROJ + (size_t)(t - k) * PROJ_LD + col0); u0 = bflo(w); u1 = bfhi(w); }
            else if (!prompt) { const f32x2v v = *(const f32x2v*)(sconv + (size_t)(b * 3 + (3 + pos - k)) * CONV_DIM + col0); u0 = v[0]; u1 = v[1]; }
            const f32x2v wv = *(const f32x2v*)(cw + (size_t)(3 - k) * CONV_DIM + col0);
            y0 += u0 * wv[0]; y1 += u1 * wv[1];
            if (k == 0) { u00 = u0; u01 = u1; }
        }
        y0 = silu_f(y0); y1 = silu_f(y1);
        if (hc < 16) {
            const float ss = wave_sum(y0 * y0 + y1 * y1);
            float inv = rsqrtf(ss + L2_EPS); if (hc < 8) inv *= 0.08838834764831845f;
            y0 *= inv; y1 *= inv;
        }
        *(f32x2v*)(QKV + (size_t)t * CONV_DIM + col0) = (f32x2v){y0, y1};
        if (prompt) { if (pos >= SEQ - 3) *(f32x2v*)(oconvp + (size_t)(b * 3 + pos - (SEQ - 3)) * CONV_DIM + col0) = (f32x2v){u00, u01}; }
        else if (pos >= 1) *(f32x2v*)(oconvs + (size_t)(b * 3 + pos - 1) * CONV_DIM + col0) = (f32x2v){u00, u01};
        if (hc == 0 && lane < 32) {
            const int h = lane & 15; const float v = BA[(size_t)t * 32 + lane];
            float r;
            if (lane < 16) r = 1.f / (1.f + __expf(-v));
            else { const float x = v + ap->in[12][j * 16 + h]; const float sp = (x > 20.f) ? x : log1pf(__expf(x)); r = -__expf(ap->in[11][j * 16 + h]) * sp; }
            BG[(size_t)t * 32 + lane] = r;
        }
    }
}


__device__ __forceinline__ void phase_dn_post_sample(CArgs ap, int j) {
    int tid_ = threadIdx.x; asm volatile("" : "+v"(tid_)); const int tid = tid_, lane = tid & 63, wave = __builtin_amdgcn_readfirstlane(tid >> 6);
    const int gw = blockIdx.x * NWAVES + wave, NGW = gridDim.x * NWAVES;
    unsigned char* ws = ap->ws;
    const bf16* PROJ = (const bf16*)(ws + WS_PROJ); const float* BA = (const float*)(ws + WS_BA);
    float* QKV = (float*)(ws + WS_QKV) - (size_t)TP * CONV_DIM; float* BG = (float*)(ws + WS_BG);
    const float* cw = ap->in[10] + (size_t)j * 4 * CONV_DIM;
    const float* sconv = ap->in[2] + (size_t)j * NB_S * 3 * CONV_DIM;
    float* oconvs = ap->out + O_CONVS + (size_t)j * NB_S * 3 * CONV_DIM;
    for (int task = gw; task < TS * 8; task += NGW) {
        const int tt = task >> 3, hc4 = task & 7, t = TP + tt, pos = tt & 3, b = tt >> 2;
        float ua[4][4], ub[4][4]; f32x2v wv[4][4];
#pragma unroll
        for (int k = 0; k < 4; ++k)
#pragma unroll
            for (int uu = 0; uu < 4; ++uu) { const int col0 = (4 * hc4 + uu) * 128 + 2 * lane;
                if (pos - k >= 0) { const unsigned w = *(const unsigned*)(PROJ + (size_t)(t - k) * PROJ_LD + col0); ua[k][uu] = bflo(w); ub[k][uu] = bfhi(w); }
                else { const f32x2v v = *(const f32x2v*)(sconv + (size_t)(b * 3 + (3 + pos - k)) * CONV_DIM + col0); ua[k][uu] = v[0]; ub[k][uu] = v[1]; }
                wv[k][uu] = *(const f32x2v*)(cw + (size_t)(3 - k) * CONV_DIM + col0); }
#pragma unroll
        for (int uu = 0; uu < 4; ++uu) { const int col0 = (4 * hc4 + uu) * 128 + 2 * lane;
            float y0 = 0.f, y1 = 0.f;
#pragma unroll
            for (int k = 0; k < 4; ++k) { y0 += ua[k][uu] * wv[k][uu][0]; y1 += ub[k][uu] * wv[k][uu][1]; }
            y0 = silu_f(y0); y1 = silu_f(y1);
            if (hc4 < 4) { const float ss = wave_sum(y0 * y0 + y1 * y1);
                float inv = rsqrtf(ss + L2_EPS); if (hc4 < 2) inv *= 0.08838834764831845f;
                y0 *= inv; y1 *= inv; }
            *(f32x2v*)(QKV + (size_t)t * CONV_DIM + col0) = (f32x2v){y0, y1};
            if (pos >= 1) *(f32x2v*)(oconvs + (size_t)(b * 3 + pos - 1) * CONV_DIM + col0) = (f32x2v){ua[0][uu], ub[0][uu]}; }
        if (hc4 == 0 && lane < 32) {
            const int h = lane & 15; const float v = BA[(size_t)t * 32 + lane];
            float r;
            if (lane < 16) r = 1.f / (1.f + __expf(-v));
            else { const float x = v + ap->in[12][j * 16 + h]; const float sp = (x > 20.f) ? x : log1pf(__expf(x)); r = -__expf(ap->in[11][j * 16 + h]) * sp; }
            BG[(size_t)t * 32 + lane] = r;
        }
    }
}

__device__ __forceinline__ void phase_delta_rec(CArgs ap, int j, LAS unsigned char* lds, unsigned* ticket) {
    int tid_ = threadIdx.x; asm volatile("" : "+v"(tid_)); const int tid = tid_, lane = tid & 63, wave = __builtin_amdgcn_readfirstlane(tid >> 6);
    const int e4 = tid & 31, dg = tid >> 5;
    unsigned char* ws = ap->ws;
    const float* QKV = (const float*)(ws + WS_QKV) - (size_t)TP * CONV_DIM; const float* BG = (const float*)(ws + WS_BG); const bf16* PROJ = (const bf16*)(ws + WS_PROJ);
    bf16* OG = (bf16*)(ws + WS_OG);
    const float* nw = ap->in[13] + j * 128;
    LAS float* qs = (LAS float*)lds;
    LAS float* ks = qs + 512;
    LAS float* vs = ks + 512;
    LAS float* ob = vs + 512;
    LAS float* red = ob + 512;
    LAS float* red2 = red + 1024;
    LAS float* ab = red2 + 1024;
    LAS int* tk = (LAS int*)(ab + 8);
    for (;;) {
        if (tid == 0) *tk = (int)__hip_atomic_fetch_add(ticket, 1u, __ATOMIC_RELAXED, __HIP_MEMORY_SCOPE_AGENT);
        __syncthreads();
        const int su = *tk;
        if (su >= 2048) break;
        const int b = su >> 4, h = su & 15, hq = h >> 1, t0 = TP + b * DSEQ;
        const float* s0 = ap->in[3] + ((size_t)(j * NB_S + b) * 16 + h) * 16384; float* sout = ap->out + O_DELTAS + ((size_t)(j * NB_S + b) * 16 + h) * 16384;
        f32x4 S[8];
#pragma unroll
        for (int i = 0; i < 8; ++i) S[i] = __builtin_nontemporal_load((const f32x4*)(s0 + (size_t)(8 * dg + i) * 128 + 4 * e4));
        if (tid < 384) { const int tt = tid / 96, rem = tid % 96, which = rem >> 5, ee = 4 * (rem & 31);
            const int col = (which == 0) ? hq * 128 + ee : (which == 1) ? 1024 + hq * 128 + ee : 2048 + h * 128 + ee;
            *(LAS f32x4*)(qs + which * 512 + tt * 128 + ee) = *(const f32x4*)(QKV + (size_t)(t0 + tt) * CONV_DIM + col); }
        if (tid < DSEQ) { ab[tid * 2] = __expf(BG[(size_t)(t0 + tid) * 32 + 16 + h]); ab[tid * 2 + 1] = BG[(size_t)(t0 + tid) * 32 + h]; }
        __syncthreads();
#pragma unroll 1
        for (int tt = 0; tt < DSEQ; ++tt) {
            const float av = ab[tt * 2], bt = ab[tt * 2 + 1];
            f32x4 part = (f32x4){0.f, 0.f, 0.f, 0.f};
#pragma unroll
            for (int i = 0; i < 8; ++i) part = part + S[i] * ks[tt * 128 + 8 * dg + i];
#pragma unroll
            for (int c = 0; c < 4; ++c) part[c] += __shfl_xor(part[c], 32);
            if (lane < 32) *(LAS f32x4*)(red + wave * 128 + 4 * e4) = part;
            __syncthreads();
            f32x4 kS = (f32x4){0.f, 0.f, 0.f, 0.f};
#pragma unroll
            for (int w8 = 0; w8 < 8; ++w8) kS = kS + *(const LAS f32x4*)(red + w8 * 128 + 4 * e4);
            const f32x4 vv = (*(const LAS f32x4*)(vs + tt * 128 + 4 * e4) - kS * av) * bt;
            f32x4 po = (f32x4){0.f, 0.f, 0.f, 0.f};
#pragma unroll
            for (int i = 0; i < 8; ++i) { S[i] = S[i] * av + vv * ks[tt * 128 + 8 * dg + i]; po = po + S[i] * qs[tt * 128 + 8 * dg + i]; }
#pragma unroll
            for (int c = 0; c < 4; ++c) po[c] += __shfl_xor(po[c], 32);
            if (lane < 32) *(LAS f32x4*)(red2 + wave * 128 + 4 * e4) = po;
            __syncthreads();
            if (tid < 32) { f32x4 o = (f32x4){0.f, 0.f, 0.f, 0.f};
#pragma unroll
                for (int w8 = 0; w8 < 8; ++w8) o = o + *(const LAS f32x4*)(red2 + w8 * 128 + 4 * e4);
                *(LAS f32x4*)(ob + tt * 128 + 4 * e4) = o; }
        }
        __syncthreads();
        if (wave < DSEQ) { const int tt = wave;
            const float o0 = ob[tt * 128 + lane], o1 = ob[tt * 128 + 64 + lane];
            const float ss = wave_sum(o0 * o0 + o1 * o1);
            const float rs = rsqrtf(ss * (1.f / 128.f) + RMS_EPS);
            const size_t tok = (size_t)(t0 + tt);
            const float z0 = bf2f(PROJ[tok * PROJ_LD + 4096 + h * 128 + lane]), z1 = bf2f(PROJ[tok * PROJ_LD + 4096 + h * 128 + 64 + lane]);
            OG[tok * VAL_DIM + h * 128 + lane] = (bf16)f2bf(o0 * rs * nw[lane] * silu_f(z0));
            OG[tok * VAL_DIM + h * 128 + 64 + lane] = (bf16)f2bf(o1 * rs * nw[64 + lane] * silu_f(z1));
        }
#pragma unroll
        for (int i = 0; i < 8; ++i) __builtin_nontemporal_store(S[i], (f32x4*)(sout + (size_t)(8 * dg + i) * 128 + 4 * e4));
        __syncthreads();
    }
}

__device__ __forceinline__ void phase_swa_attn(CArgs ap, int j, LAS unsigned char* lds) {
    int tid_ = threadIdx.x; asm volatile("" : "+v"(tid_)); const int tid = tid_, lane = tid & 63, wave = __builtin_amdgcn_readfirstlane(tid >> 6);
    const int gw = blockIdx.x * NWAVES + wave, NGW = gridDim.x * NWAVES;
    unsigned char* ws = ap->ws;
    const bf16* Q = (const bf16*)(ws + WS_Q); const bf16* KB = (const bf16*)(ws + WS_KB); const bf16* VB = (const bf16*)(ws + WS_VB);
    bf16* ATT = (bf16*)(ws + WS_ATT);
    const float* ck = ap->in[4] + (size_t)j * NB_S * 128 * 256; const float* cv = ap->in[5] + (size_t)j * NB_S * 128 * 256;
    const float* sinks = ap->in[17] + j * 16;
    LAS float* qs = (LAS float*)(lds + wave * 4096);
    LAS float* ps = qs + 256;
    for (int task = gw; task < T * 4; task += NGW) {
        const int t = task >> 2, kh = task & 3;
#pragma unroll
        for (int g = 0; g < 4; ++g) qs[g * 64 + lane] = bf2f(Q[(size_t)t * DM + (kh * 4 + g) * 64 + lane]);
        LDS_WAIT(); asm volatile("" ::: "memory");
        const bool prompt = t < TP; int nk, b = 0, l = 0;
        if (prompt) { const int pos = t & 2047; nk = (pos < 128 ? pos : 128) + 1; } else { const int r = t - TP; b = r >> 2; l = r & 3; nk = 129; }
        const float sl0 = exp2f(-0.5f * (float)(kh * 4 + 1)), sl1 = exp2f(-0.5f * (float)(kh * 4 + 2)), sl2 = exp2f(-0.5f * (float)(kh * 4 + 3)), sl3 = exp2f(-0.5f * (float)(kh * 4 + 4));
#pragma unroll 1
        for (int kb = 0; kb < 3; ++kb) {
            const int jj = kb * 64 + lane; const bool valid = jj < nk;
            float d0 = 0.f, d1 = 0.f, d2 = 0.f, d3 = 0.f;
            if (valid) {
                const int cj = l + jj;
                if (prompt || cj >= 128) {
                    const bf16* kp = prompt ? KB + (size_t)(t - (nk - 1) + jj) * 256 + kh * 64 : KB + (size_t)(TP + b * 4 + (cj - 128)) * 256 + kh * 64;
#pragma unroll 1
                    for (int d = 0; d < 64; d += 8) {
                        const v4u w = *(const v4u*)(kp + d);
                        const float kv[8] = {bflo(w.x), bfhi(w.x), bflo(w.y), bfhi(w.y), bflo(w.z), bfhi(w.z), bflo(w.w), bfhi(w.w)};
#pragma unroll
                        for (int i = 0; i < 8; ++i) { d0 += kv[i] * qs[d + i]; d1 += kv[i] * qs[64 + d + i]; d2 += kv[i] * qs[128 + d + i]; d3 += kv[i] * qs[192 + d + i]; }
                    }
                } else {
                    const float* kf = ck + (size_t)(b * 128 + cj) * 256 + kh * 64;
#pragma unroll 1
                    for (int d = 0; d < 64; d += 4) {
                        const f32x4 x = *(const f32x4*)(kf + d);
#pragma unroll
                        for (int i = 0; i < 4; ++i) { d0 += x[i] * qs[d + i]; d1 += x[i] * qs[64 + d + i]; d2 += x[i] * qs[128 + d + i]; d3 += x[i] * qs[192 + d + i]; }
                    }
                }
            }
            const float rel = (float)((nk - 1) - jj);
            const float NEG = -INFINITY;
            ps[jj] = valid ? d0 - sl0 * rel : NEG; ps[192 + jj] = valid ? d1 - sl1 * rel : NEG; ps[384 + jj] = valid ? d2 - sl2 * rel : NEG; ps[576 + jj] = valid ? d3 - sl3 * rel : NEG;
        }
        LDS_WAIT(); asm volatile("" ::: "memory");
#pragma unroll 1
        for (int g = 0; g < 4; ++g) {
            const float sk = sinks[kh * 4 + g];
            const float s0 = ps[g * 192 + lane], s1 = ps[g * 192 + 64 + lane], s2 = ps[g * 192 + 128 + lane];
            float m = wave_max(fmaxf(fmaxf(s0, s1), s2)); m = fmaxf(m, sk);
            const float p0 = __expf(s0 - m), p1 = __expf(s1 - m), p2 = __expf(s2 - m);
            const float den = wave_sum(p0 + p1 + p2) + __expf(sk - m); const float inv = 1.f / den;
            ps[g * 192 + lane] = p0 * inv; ps[g * 192 + 64 + lane] = p1 * inv; ps[g * 192 + 128 + lane] = p2 * inv;
        }
        LDS_WAIT(); asm volatile("" ::: "memory");
        float o0 = 0.f, o1 = 0.f, o2 = 0.f, o3 = 0.f;
        if (prompt) {
            const bf16* vp = VB + (size_t)(t - (nk - 1)) * 256 + kh * 64 + lane;
#pragma unroll 4
            for (int jj = 0; jj < nk; ++jj) { const float vv = bf2f(vp[(size_t)jj * 256]);
                o0 += ps[jj] * vv; o1 += ps[192 + jj] * vv; o2 += ps[384 + jj] * vv; o3 += ps[576 + jj] * vv; }
        } else {
#pragma unroll 4
            for (int jj = 0; jj < 129; ++jj) { const int cj = l + jj;
                const float vv = (cj < 128) ? cv[(size_t)(b * 128 + cj) * 256 + kh * 64 + lane] : bf2f(VB[(size_t)(TP + b * 4 + (cj - 128)) * 256 + kh * 64 + lane]);
                o0 += ps[jj] * vv; o1 += ps[192 + jj] * vv; o2 += ps[384 + jj] * vv; o3 += ps[576 + jj] * vv; }
        }
        bf16* op = ATT + (size_t)t * DM + kh * 256 + lane;
        op[0] = (bf16)f2bf(o0); op[64] = (bf16)f2bf(o1); op[128] = (bf16)f2bf(o2); op[192] = (bf16)f2bf(o3);
        LDS_WAIT(); asm volatile("" ::: "memory");
    }
}

__device__ __forceinline__ void phase_final(CArgs ap) {
    int tid_ = threadIdx.x; asm volatile("" : "+v"(tid_)); const int tid = tid_, lane = tid & 63, wave = __builtin_amdgcn_readfirstlane(tid >> 6);
    const int gw = blockIdx.x * NWAVES + wave, NGW = gridDim.x * NWAVES;
    const bf16* XB = (const bf16*)(ap->ws + WS_XB); const float* nw = ap->in[8];
    for (int m = gw; m < T; m += NGW) {
        f32x4 v[4]; float s = 0.f;
#pragma unroll
        for (int j = 0; j < 4; ++j) { const v2u w = *((const v2u*)(XB + (size_t)m * DM) + lane + 64 * j); v[j] = (f32x4){bflo(w.x), bfhi(w.x), bflo(w.y), bfhi(w.y)};
            s += (v[j][0] * v[j][0] + v[j][1] * v[j][1]) + (v[j][2] * v[j][2] + v[j][3] * v[j][3]); }
        float rs = rsqrtf(wave_sum(s) * (1.f / 1024.f) + RMS_EPS);
#if defined(TP_FROM) || defined(TQ_FROM)
        if (m >= TP) { const float v = (float)(*(const unsigned long long*)(ap->ws + WS_CTL + 8192)) * (1.f / (float)TP_COUNT) * (1.f / (float)TP_SCALE);
            rs *= 1.f + floorf(v * 8.f + TP_PHASE) * (1.f / 8.f); }
#endif
        float* o = ap->out + (size_t)m * DM;
#pragma unroll
        for (int j = 0; j < 4; ++j) { const f32x4 w = *((const f32x4*)nw + lane + 64 * j); *((f32x4*)o + lane + 64 * j) = v[j] * rs * w; }
    }
}

constexpr int REC_WNEG = 0, REC_QG = 16384, REC_KGT = 32768, REC_AQK = 49152, REC_FAC = 57344, REC_STAGE = 58368;
constexpr int H_WNEG = 0, H_AQK = 16384, H_U = 24576, H_FAC = 40960, HREC_BYTES = 41984, P_QT = 0, P_KTT = 16384, PREC_BYTES = 32768;
constexpr size_t WS_PREC = WS_DREC + (size_t)168 * MiB;
typedef short bf16x8_t __attribute__((ext_vector_type(8)));

__device__ __forceinline__ int swz256(int row, int ch) { return row * 256 + ((ch ^ (row & 15)) << 4); }
__device__ __forceinline__ int swz128(int row, int ch) { return row * 128 + ((ch ^ (row & 7)) << 4); }


constexpr int SC_STAGE0 = 0, SC_STAGE1 = REC_STAGE, SC_SCR = 2 * REC_STAGE, SC_WSCR = 4608, SC_OBUF = SC_SCR + 4 * SC_WSCR, SC_OROW = 144, SC_OBYTES = 64 * SC_OROW;
constexpr int SC_ROWA = 272, SC_ROWB = 144;
__device__ __forceinline__ int stage_dst(int q) {
    const int off = q * 16;
    if (off < REC_KGT) { const int base = off & ~16383, local = off & 16383; return base + swz256(local >> 8, (local >> 4) & 15); }
    const int base = (off < REC_AQK) ? REC_KGT : REC_AQK, local = off - base; return base + swz128(local >> 7, (local >> 4) & 7);
}
__device__ __forceinline__ float silu_fast(float x) { return x * __builtin_amdgcn_rcpf(1.f + __expf(-x)); }

__device__ __forceinline__ void stage_dma4(const unsigned char* rech, const unsigned char* recp, LAS unsigned char* sb, int hw, int lane) {
#pragma unroll
    for (int i = 0; i < 14; ++i) { const int kb = i * 4 + hw; const int off = stage_dst(kb * 64 + lane);
        const unsigned char* src = (kb < 16) ? rech + H_WNEG + off : (kb < 48) ? recp + (off - 16384) : rech + H_AQK + (off - 49152);
        __builtin_amdgcn_global_load_lds((const unsigned*)src, (LAS unsigned*)(sb + kb * 1024), 16, 0, 0); }
    if (hw == 0) __builtin_amdgcn_global_load_lds((const unsigned*)(rech + H_FAC + lane * 16), (LAS unsigned*)(sb + REC_FAC), 16, 0, 0);
}

__device__ __forceinline__ void scan_unit(CArgs ap, int j, int unit, int eh, LAS unsigned char* lds) {
    int tid_ = threadIdx.x; asm volatile("" : "+v"(tid_)); const int tid = tid_, lane = tid & 63, wave = __builtin_amdgcn_readfirstlane(tid >> 6);
    const int b = unit >> 4, h = unit & 15;
    unsigned char* ws = ap->ws;
    const unsigned char* rec0 = ws + WS_DREC + (size_t)(unit * 32) * HREC_BYTES;
    const unsigned char* recp0 = ws + WS_PREC + (size_t)((b * 8 + (h >> 1)) * 32) * PREC_BYTES;
    __syncthreads();
    if (wave >= 4) {
        const int hc = 16 * (wave - 4) + (lane >> 2), hp = lane & 3;
        const bf16* PROJ = (const bf16*)(ws + WS_PROJ); bf16* OG = (bf16*)(ws + WS_OG);
        const float* nw = ap->in[13] + j * 128 + 64 * eh + 8 * hp;
        f32x4 nwv[4];
#pragma unroll
        for (int i = 0; i < 2; ++i) { nwv[2 * i] = *(const f32x4*)(nw + 32 * i); nwv[2 * i + 1] = *(const f32x4*)(nw + 32 * i + 4); }
        unsigned long long* xown = (unsigned long long*)(ws + WS_XCH) + ((size_t)(unit * 32) * 64 + hc) * 2 + eh;
        const unsigned long long* xsib = (const unsigned long long*)(ws + WS_XCH) + ((size_t)(unit * 32) * 64 + hc) * 2 + (eh ^ 1);
        const bf16* zbase = PROJ + (size_t)(b * SEQ + hc) * PROJ_LD + 4096 + h * 128 + 64 * eh + 8 * hp;
        bf16* obase = OG + (size_t)(b * SEQ + hc) * VAL_DIM + h * 128 + 64 * eh + 8 * hp;
        v4u o0[2], o1[2], o2[2], o3[2], z0[2], z1[2], z2[2], z3[2]; float ss0 = 0.f, ss1 = 0.f, ss2 = 0.f, ss3 = 0.f;
        unsigned long long svA = 0ull, svB = 0ull;
#pragma unroll
        for (int i = 0; i < 2; ++i) { o0[i] = (v4u){0u, 0u, 0u, 0u}; o1[i] = o0[i]; o2[i] = o0[i]; o3[i] = o0[i]; z0[i] = o0[i]; z1[i] = o0[i]; z2[i] = o0[i]; z3[i] = o0[i]; }
#define EPI_TAKE(m, oc, ssc) do { \
        const LAS unsigned char* ob_ = lds + SC_OBUF + ((m) & 1) * SC_OBYTES + hc * SC_OROW + hp * 16; \
        _Pragma("unroll") for (int i_ = 0; i_ < 2; ++i_) oc[i_] = *(const LAS v4u*)(ob_ + 64 * i_); \
        float s_ = 0.f; \
        _Pragma("unroll") for (int i_ = 0; i_ < 2; ++i_) { const float a0 = bflo(oc[i_].x), a1 = bfhi(oc[i_].x), a2 = bflo(oc[i_].y), a3 = bfhi(oc[i_].y), a4 = bflo(oc[i_].z), a5 = bfhi(oc[i_].z), a6 = bflo(oc[i_].w), a7 = bfhi(oc[i_].w); \
            s_ += ((a0 * a0 + a1 * a1) + (a2 * a2 + a3 * a3)) + ((a4 * a4 + a5 * a5) + (a6 * a6 + a7 * a7)); } \
        s_ += __shfl_xor(s_, 1); s_ += __shfl_xor(s_, 2); ssc = s_; } while (0)
#define EPI_PUBLISH(m, ssc) do { if (hp == 0) __hip_atomic_store(xown + (size_t)(m) * 128, ((unsigned long long)1u << 32) | (unsigned long long)__builtin_bit_cast(unsigned, ssc), __ATOMIC_RELAXED, __HIP_MEMORY_SCOPE_AGENT); } while (0)
#define EPI_ZLOAD(m, zc) do { _Pragma("unroll") for (int i_ = 0; i_ < 2; ++i_) zc[i_] = *(const v4u*)(zbase + (size_t)((m) * 64) * PROJ_LD + 32 * i_); } while (0)
#define EPI_FINISH(m, sv, op, zp, ssp) do { \
        unsigned long long sv_ = (sv); \
        while ((unsigned)(sv_ >> 32) != 1u) { __builtin_amdgcn_s_sleep(1); sv_ = __hip_atomic_load(xsib + (size_t)(m) * 128, __ATOMIC_RELAXED, __HIP_MEMORY_SCOPE_AGENT); } \
        const float rs_ = rsqrtf((ssp + __builtin_bit_cast(float, (unsigned)sv_)) * (1.f / 128.f) + RMS_EPS); \
        bf16* op_ = obase + (size_t)((m) * 64) * VAL_DIM; \
        _Pragma("unroll") for (int i_ = 0; i_ < 2; ++i_) { const f32x4 na = nwv[2 * i_] * rs_, nb = nwv[2 * i_ + 1] * rs_; v4u w_; \
            w_.x = pk2(bflo(op[i_].x) * na[0] * silu_fast(bflo(zp[i_].x)), bfhi(op[i_].x) * na[1] * silu_fast(bfhi(zp[i_].x))); \
            w_.y = pk2(bflo(op[i_].y) * na[2] * silu_fast(bflo(zp[i_].y)), bfhi(op[i_].y) * na[3] * silu_fast(bfhi(zp[i_].y))); \
            w_.z = pk2(bflo(op[i_].z) * nb[0] * silu_fast(bflo(zp[i_].z)), bfhi(op[i_].z) * nb[1] * silu_fast(bfhi(zp[i_].z))); \
            w_.w = pk2(bflo(op[i_].w) * nb[2] * silu_fast(bflo(zp[i_].w)), bfhi(op[i_].w) * nb[3] * silu_fast(bfhi(zp[i_].w))); \
            *(v4u*)(op_ + 32 * i_) = w_; } } while (0)
#define EPI_ITER(n, svi, svc, zin, ocur, sscur, oprev, ssprev, zprev, DO_POLL, DO_TAKE, DO_FIN) do { \
            asm volatile("s_waitcnt lgkmcnt(0)" ::: "memory"); \
            __syncthreads(); \
            if (DO_POLL) svi = __hip_atomic_load(xsib + (size_t)((n) - 2) * 128, __ATOMIC_RELAXED, __HIP_MEMORY_SCOPE_AGENT); \
            EPI_ZLOAD(n, zin); \
            if (DO_TAKE) EPI_TAKE((n) - 1, ocur, sscur); \
            if (DO_FIN) EPI_FINISH((n) - 3, svc, oprev, zprev, ssprev); \
            if (DO_TAKE) EPI_PUBLISH((n) - 1, sscur); } while (0)
        EPI_ITER(0, svA, svB, z0, o3, ss3, o1, ss1, z1, 0, 0, 0); EPI_ITER(1, svB, svA, z1, o0, ss0, o2, ss2, z2, 0, 1, 0);
        EPI_ITER(2, svA, svB, z2, o1, ss1, o3, ss3, z3, 1, 1, 0); EPI_ITER(3, svB, svA, z3, o2, ss2, o0, ss0, z0, 1, 1, 1);
#pragma unroll 1
        for (int n = 4; n < 32; n += 4) { EPI_ITER(n, svA, svB, z0, o3, ss3, o1, ss1, z1, 1, 1, 1); EPI_ITER(n + 1, svB, svA, z1, o0, ss0, o2, ss2, z2, 1, 1, 1);
                                          EPI_ITER(n + 2, svA, svB, z2, o1, ss1, o3, ss3, z3, 1, 1, 1); EPI_ITER(n + 3, svB, svA, z3, o2, ss2, o0, ss0, z0, 1, 1, 1); }
        asm volatile("s_waitcnt lgkmcnt(0)" ::: "memory");
        __syncthreads();
        {
            svA = __hip_atomic_load(xsib + (size_t)30 * 128, __ATOMIC_RELAXED, __HIP_MEMORY_SCOPE_AGENT);
            EPI_TAKE(31, o3, ss3);
            EPI_PUBLISH(31, ss3);
            EPI_FINISH(29, svB, o1, z1, ss1);
            svB = __hip_atomic_load(xsib + (size_t)31 * 128, __ATOMIC_RELAXED, __HIP_MEMORY_SCOPE_AGENT);
            EPI_FINISH(30, svA, o2, z2, ss2);
            EPI_FINISH(31, svB, o3, z3, ss3);
        }
#undef EPI_ITER
#undef EPI_TAKE
#undef EPI_PUBLISH
#undef EPI_ZLOAD
#undef EPI_FINISH
    } else {
        const int fr = lane & 15, fq = lane >> 4, e0 = 64 * eh + 16 * wave;
        const float* EGL = (const float*)(ws + WS_EGL) + unit * 32;
        LAS unsigned char* scr = lds + SC_SCR + wave * SC_WSCR;
        f32x4 Sacc[8];
#pragma unroll
        for (int dt = 0; dt < 8; ++dt) Sacc[dt] = (f32x4){0.f, 0.f, 0.f, 0.f};
        const size_t uoff = (size_t)(e0 + fr) * 128 + (16 * (fq & 1) + 8 * (fq >> 1)) * 2;
        stage_dma4(rec0, recp0, lds + SC_STAGE0, wave, lane);
        v4u un[2]; float egln = EGL[0];
#pragma unroll
        for (int p = 0; p < 2; ++p) un[p] = *(const v4u*)(rec0 + H_U + uoff + p * 64);
#pragma unroll 1
        for (int n = 0; n < 32; ++n) {
            LAS unsigned char* sb = lds + ((n & 1) ? SC_STAGE1 : SC_STAGE0);
            LAS unsigned char* ob = lds + SC_OBUF + (n & 1) * SC_OBYTES;
            LAS unsigned char* sbn = lds + ((n & 1) ? SC_STAGE0 : SC_STAGE1);
            const unsigned char* recpn = recp0 + (size_t)((n + 1 < 32) ? n + 1 : 31) * PREC_BYTES;
            const int nn = (n + 1 < 32) ? n + 1 : 31;
            const unsigned char* recn = rec0 + (size_t)nn * HREC_BYTES;
            asm volatile("s_waitcnt vmcnt(0) lgkmcnt(0)" ::: "memory");
            __syncthreads();
            stage_dma4(recn, recpn, sbn, wave, lane);
            f32x4 accu[4]; float egl = egln;
#pragma unroll
            for (int p = 0; p < 2; ++p) { v2u ua, ub; narrow16(un[p], ua, ub);
                accu[2 * p] = (f32x4){bflo(ua.x), bfhi(ua.x), bflo(ua.y), bfhi(ua.y)}; accu[2 * p + 1] = (f32x4){bflo(ub.x), bfhi(ub.x), bflo(ub.y), bfhi(ub.y)}; }
            asm volatile("" : "+v"(egl));
#pragma unroll
            for (int p = 0; p < 2; ++p) un[p] = *(const v4u*)(recn + H_U + uoff + p * 64);
            egln = EGL[nn];
#pragma unroll
            for (int dt = 0; dt < 8; ++dt) { v2u w; w.x = pk2(Sacc[dt][0], Sacc[dt][1]); w.y = pk2(Sacc[dt][2], Sacc[dt][3]);
                *(LAS v2u*)(scr + fr * SC_ROWA + (16 * dt + 4 * fq) * 2) = w; }
#define CB() asm volatile("" ::: "memory")
#define LD256(dst, region, row0) do { _Pragma("unroll") for (int ks = 0; ks < 4; ++ks) dst[ks] = *(LAS bf16x8_t*)(sb + (region) + swz256((row0) + fr, ks * 4 + fq)); } while (0)
#define LD128x2(dst, region, row0) do { _Pragma("unroll") for (int k4 = 0; k4 < 4; ++k4) dst[k4] = *(LAS bf16x8_t*)(sb + (region) + swz128((row0) + 16 * (k4 >> 1) + fr, (k4 & 1) * 4 + fq)); } while (0)
#define MM4(acc, A, B) do { _Pragma("unroll") for (int ks = 0; ks < 4; ++ks) acc = __builtin_amdgcn_mfma_f32_16x16x32_bf16(A[ks], B[ks], acc, 0, 0, 0); } while (0)
#define MM2x2S(acc0, acc1, A, B) do { acc0 = __builtin_amdgcn_mfma_f32_16x16x32_bf16(B[0], A[0], acc0, 0, 0, 0); acc0 = __builtin_amdgcn_mfma_f32_16x16x32_bf16(B[1], A[1], acc0, 0, 0, 0); \
        acc1 = __builtin_amdgcn_mfma_f32_16x16x32_bf16(B[2], A[0], acc1, 0, 0, 0); acc1 = __builtin_amdgcn_mfma_f32_16x16x32_bf16(B[3], A[1], acc1, 0, 0, 0); } while (0)
#define MM2x2(acc0, acc1, A, B) do { acc0 = __builtin_amdgcn_mfma_f32_16x16x32_bf16(A[0], B[0], acc0, 0, 0, 0); acc0 = __builtin_amdgcn_mfma_f32_16x16x32_bf16(A[1], B[1], acc0, 0, 0, 0); \
        acc1 = __builtin_amdgcn_mfma_f32_16x16x32_bf16(A[0], B[2], acc1, 0, 0, 0); acc1 = __builtin_amdgcn_mfma_f32_16x16x32_bf16(A[1], B[3], acc1, 0, 0, 0); } while (0)
            bf16x8_t Sa[4], Ua[2], Uk[2], fA[4], fB[4], fC[4];
            f32x4 kapv[4]; float qfv[4];
#pragma unroll
            for (int tc = 0; tc < 4; ++tc) { qfv[tc] = *(LAS float*)(sb + REC_FAC + (16 * tc + fr) * 4); kapv[tc] = *(LAS f32x4*)(sb + REC_FAC + 256 + (16 * tc + 4 * fq) * 4); }
            f32x4 acco[4];
#pragma unroll
            for (int tc = 0; tc < 4; ++tc) acco[tc] = (f32x4){0.f, 0.f, 0.f, 0.f};
            LD256(fA, REC_WNEG, 0);
#pragma unroll
            for (int ks = 0; ks < 4; ++ks) Sa[ks] = *(LAS bf16x8_t*)(scr + fr * SC_ROWA + (ks * 4 + fq) * 16);
            LD256(fB, REC_WNEG, 16); CB();
            MM4(accu[0], fA, Sa); LD256(fC, REC_WNEG, 32); CB();
            MM4(accu[1], fB, Sa); LD256(fA, REC_WNEG, 48); CB();
            MM4(accu[2], fC, Sa); LD256(fB, REC_QG, 0); CB();
            MM4(accu[3], fA, Sa); LD256(fC, REC_QG, 16); CB();
#pragma unroll
            for (int tc = 0; tc < 4; ++tc) { const f32x4 sk = accu[tc] * kapv[tc]; v2u w, wk;
                w.x = pk2(accu[tc][0], accu[tc][1]); w.y = pk2(accu[tc][2], accu[tc][3]); wk.x = pk2(sk[0], sk[1]); wk.y = pk2(sk[2], sk[3]);
                *(LAS v2u*)(scr + fr * SC_ROWB + (16 * tc + 4 * fq) * 2) = w; *(LAS v2u*)(scr + 16 * SC_ROWB + fr * SC_ROWB + (16 * tc + 4 * fq) * 2) = wk; }
            MM4(acco[0], Sa, fB); LD256(fA, REC_QG, 32); CB();
#pragma unroll
            for (int k2 = 0; k2 < 2; ++k2) { Ua[k2] = *(LAS bf16x8_t*)(scr + fr * SC_ROWB + (k2 * 4 + fq) * 16); Uk[k2] = *(LAS bf16x8_t*)(scr + 16 * SC_ROWB + fr * SC_ROWB + (k2 * 4 + fq) * 16); }
            MM4(acco[1], Sa, fC); LD256(fB, REC_QG, 48); CB();
            MM4(acco[2], Sa, fA); LD128x2(fC, REC_AQK, 0); CB();
            MM4(acco[3], Sa, fB); LD128x2(fA, REC_AQK, 32); CB();
#pragma unroll
            for (int tc = 0; tc < 4; ++tc) acco[tc] = acco[tc] * qfv[tc];
            MM2x2(acco[0], acco[1], Ua, fC); LD128x2(fB, REC_KGT, 0); CB();
            MM2x2(acco[2], acco[3], Ua, fA); LD128x2(fC, REC_KGT, 32); CB();
#pragma unroll
            for (int dt = 0; dt < 8; ++dt) Sacc[dt] = Sacc[dt] * egl;
            MM2x2S(Sacc[0], Sacc[1], Uk, fB); LD128x2(fA, REC_KGT, 64); CB();
            MM2x2S(Sacc[2], Sacc[3], Uk, fC); LD128x2(fB, REC_KGT, 96); CB();
            MM2x2S(Sacc[4], Sacc[5], Uk, fA);
            MM2x2S(Sacc[6], Sacc[7], Uk, fB);
#undef CB
#undef LD256
#undef LD128x2
#undef MM4
#undef MM2x2
#undef MM2x2S
#pragma unroll
            for (int tc = 0; tc < 4; ++tc) { v2u w; w.x = pk2(acco[tc][0], acco[tc][1]); w.y = pk2(acco[tc][2], acco[tc][3]);
                *(LAS v2u*)(ob + (16 * tc + fr) * SC_OROW + (16 * wave + 4 * fq) * 2) = w; }
        }
        asm volatile("s_waitcnt vmcnt(0) lgkmcnt(0)" ::: "memory");
        __syncthreads();
        float* sout = ap->out + O_DELTAP + ((size_t)(j * NB_P + b) * 16 + h) * 16384;
#pragma unroll
        for (int dt = 0; dt < 8; ++dt)
#pragma unroll
            for (int r = 0; r < 4; ++r) sout[(size_t)(16 * dt + 4 * fq + r) * 128 + e0 + fr] = Sacc[dt][r];
    }
    __syncthreads();
}
__device__ __forceinline__ void phase_dn_scan(CArgs ap, int j, LAS unsigned char* lds) {
    const int G = gridDim.x; int bid_ = blockIdx.x; asm volatile("" : "+s"(bid_));
    for (int t = bid_; t < 256; t += G) { const int x = t & 7, idx = t >> 3; scan_unit(ap, j, (idx >> 1) * 8 + x, idx & 1, lds); }
    phase_delta_rec(ap, j, lds, (unsigned*)(ap->ws + WS_CTL) + CW_TICKET + 64 * j);
}

constexpr int P2_KIMG = 0, P2_QIMG = 16384, P2_KT = 32768, P2_VT = 49152, P2_LROW = 81920, P2_TB = 98304, P2_TR = 114688, P2_SM = 131072, P2_LDIAG = 135168, P2_PS = 143360;

#ifdef TQ_FROM
#define TQ(k) do { if ((k) == TQ_FROM && tq_on) { asm volatile("" ::: "memory"); tq_t0 = __builtin_amdgcn_s_memtime(); asm volatile("" ::: "memory"); } \
                   if ((k) == TQ_TO && tq_on) { asm volatile("" ::: "memory"); tq_acc += __builtin_amdgcn_s_memtime() - tq_t0; asm volatile("" ::: "memory"); } } while (0)
#else
#define TQ(k) do { } while (0)
#endif
__device__ __forceinline__ void phase_dn_prep2(CArgs ap, int j, LAS unsigned char* lds) {
    int tid_ = threadIdx.x; asm volatile("" : "+v"(tid_)); const int tid0 = tid_, wave = __builtin_amdgcn_readfirstlane(tid0 >> 6);
    const int role = wave >> 1;
    unsigned char* ws0 = ap->ws;
    int bid_ = blockIdx.x; asm volatile("" : "+s"(bid_));
#ifdef TQ_FROM
    unsigned long long tq_t0 = 0, tq_acc = 0; const bool tq_on = (bid_ == 0 && j == 0 && wave == TQ_WAVE);
#endif
    unsigned raw[35];
    for (int zi = bid_; zi < 256; zi += gridDim.x) { GAS v4u* xz = (GAS v4u*)(ws0 + WS_XCH) + ((size_t)zi * 512 + tid0) * 2; xz[0] = (v4u){0u, 0u, 0u, 0u}; xz[1] = (v4u){0u, 0u, 0u, 0u}; }
#define PREP_RAWLOAD(u) do { const int b_ = (u) >> 8, hq_ = ((u) >> 5) & 7, n_ = (u) & 31; int t_ = tid0; asm volatile("" : "+v"(t_)); const int w_ = t_ >> 6, rl_ = w_ >> 1, rh_ = w_ & 1, cp_ = t_ & 63; \
        const int col_ = ((rl_ == 0) ? hq_ * 128 : (rl_ == 1) ? 1024 + hq_ * 128 : 2048 + (2 * hq_ + rl_ - 2) * 128) + 2 * cp_; \
        const GAS bf16* pn_ = (const GAS bf16*)(ws0 + WS_PROJ) + (size_t)(b_ * SEQ + n_ * 64 + 32 * rh_) * PROJ_LD + col_; const bool nh_ = (n_ == 0 && rh_ == 0); \
        _Pragma("unroll") for (int i_ = 0; i_ < 35; ++i_) raw[i_] = (nh_ && i_ < 3) ? 0u : *(const GAS unsigned*)(pn_ + (ptrdiff_t)(i_ - 3) * PROJ_LD); } while (0)
    if (bid_ < 2048) PREP_RAWLOAD(bid_);
    for (int unit = bid_; unit < 2048; unit += gridDim.x) {
        const int b = unit >> 8, hq = (unit >> 5) & 7, n = unit & 31, trow0 = b * SEQ + n * 64;
        int tid = tid0; asm volatile("" : "+v"(tid));
        const int lane = tid & 63, fr = lane & 15, fq = lane >> 4, cidx = tid & 127;
        unsigned char* ws = ws0; asm volatile("" : "+s"(ws));
        const GAS bf16* PROJ = (const GAS bf16*)(ws + WS_PROJ); const GAS float* BA = (const GAS float*)(ws + WS_BA);
        GAS unsigned char* DREC = (GAS unsigned char*)(ws + WS_DREC); GAS float* EGL = (GAS float*)(ws + WS_EGL);
        const GAS float* cw = (const GAS float*)(ap->in[10] + (size_t)j * 4 * CONV_DIM);
        GAS float* oconvp = (GAS float*)(ap->out + O_CONVP + (size_t)j * NB_P * 3 * CONV_DIM);
        GAS unsigned char* rec0 = DREC + (size_t)((b * 16 + 2 * hq) * 32 + n) * HREC_BYTES;
        GAS unsigned char* prec = (GAS unsigned char*)(ws + WS_PREC) + (size_t)((b * 8 + hq) * 32 + n) * PREC_BYTES;
        unsigned lb0 = 0u, lb1 = 32768u, lb2 = 81920u, lb3 = 131072u; asm volatile("" : "+v"(lb0), "+v"(lb1), "+v"(lb2), "+v"(lb3));
        LAS unsigned char* L0 = lds + lb0;
        LAS unsigned char* L1 = lds + lb1;
        LAS unsigned char* L2 = lds + lb2;
        LAS unsigned char* L3 = lds + lb3;
        LAS float* SM = (LAS float*)L3;
        __syncthreads();
        TQ(0);
        if (wave < 2) {
            const int h = 2 * hq + wave; const size_t t = (size_t)(trow0 + lane);
            const float bv = BA[t * 32 + h], av = BA[t * 32 + 16 + h];
            const float x = av + ap->in[12][j * 16 + h]; const float sp = (x > 20.f) ? x : log1pf(__expf(x));
            float g = -__expf(ap->in[11][j * 16 + h]) * sp;
#pragma unroll
            for (int off = 1; off < 64; off <<= 1) { const float o = __shfl_up(g, off); if (lane >= off) g += o; }
            SM[wave * 64 + lane] = g; SM[128 + wave * 64 + lane] = 1.f / (1.f + __expf(-bv));
        }
        *(LAS v4u*)(L3 + (P2_PS - P2_SM) + wave * 2048 + lane * 32) = (v4u){0u, 0u, 0u, 0u};
        *(LAS v4u*)(L3 + (P2_PS - P2_SM) + wave * 2048 + lane * 32 + 16) = (v4u){0u, 0u, 0u, 0u};
#ifndef REPS_S3
#define REPS_S3 1
#endif
#ifndef REPS_S5
#define REPS_S5 1
#endif
#ifndef REPS_S2B
#define REPS_S2B 1
#endif
        {
            const int rh = wave & 1, cp = lane, r0 = 32 * rh;
            const int col = ((role == 0) ? hq * 128 : (role == 1) ? 1024 + hq * 128 : 2048 + (2 * hq + role - 2) * 128) + 2 * cp;
            const f32x2v w0 = *(const GAS f32x2v*)(cw + col), w1 = *(const GAS f32x2v*)(cw + CONV_DIM + col), w2 = *(const GAS f32x2v*)(cw + 2 * CONV_DIM + col), w3 = *(const GAS f32x2v*)(cw + 3 * CONV_DIM + col);
            float va[32], vb[32];
            const bool nohalo = (n == 0 && rh == 0);
            float a3 = nohalo ? 0.f : bflo(raw[0]), a2 = nohalo ? 0.f : bflo(raw[1]), a1 = nohalo ? 0.f : bflo(raw[2]);
            float b3 = nohalo ? 0.f : bfhi(raw[0]), b2 = nohalo ? 0.f : bfhi(raw[1]), b1 = nohalo ? 0.f : bfhi(raw[2]);
#pragma unroll
            for (int c = 0; c < 32; ++c) {
                const float ua = bflo(raw[3 + c]), ub = bfhi(raw[3 + c]);
                va[c] = silu_fast(w3[0] * ua + w2[0] * a1 + w1[0] * a2 + w0[0] * a3);
                vb[c] = silu_fast(w3[1] * ub + w2[1] * b1 + w1[1] * b2 + w0[1] * b3);
                a3 = a2; a2 = a1; a1 = ua; b3 = b2; b2 = b1; b1 = ub;
                if (c >= 29 && n == 31 && rh == 1) *(GAS f32x2v*)(oconvp + (size_t)(b * 3 + c - 29) * CONV_DIM + col) = (f32x2v){ua, ub};
            }
            if (role < 2) {
                LAS unsigned char* img = L0 + (role == 0 ? 16384 : 0);
#pragma unroll
                for (int c = 0; c < 32; ++c) *(LAS unsigned*)(img + swz256(r0 + c, cp >> 2) + (cp & 3) * 4) = pk2(va[c], vb[c]);
            }
            if (role >= 1) {
                LAS unsigned char* img = L1 + (role - 1) * 16384;
#pragma unroll
                for (int ch = 0; ch < 4; ++ch) { v4u wa, wb;
                    wa.x = pk2(va[8 * ch], va[8 * ch + 1]); wa.y = pk2(va[8 * ch + 2], va[8 * ch + 3]); wa.z = pk2(va[8 * ch + 4], va[8 * ch + 5]); wa.w = pk2(va[8 * ch + 6], va[8 * ch + 7]);
                    wb.x = pk2(vb[8 * ch], vb[8 * ch + 1]); wb.y = pk2(vb[8 * ch + 2], vb[8 * ch + 3]); wb.z = pk2(vb[8 * ch + 4], vb[8 * ch + 5]); wb.w = pk2(vb[8 * ch + 6], vb[8 * ch + 7]);
                    *(LAS v4u*)(img + swz128(2 * cp, 4 * rh + ch)) = wa; *(LAS v4u*)(img + swz128(2 * cp + 1, 4 * rh + ch)) = wb; }
            }
        }
        __syncthreads();
        TQ(1);
        f32x4 acc[4];
        {
            const int tr = wave & 3; const bool kq = wave >= 4;
            f32x4 accq = (f32x4){0.f, 0.f, 0.f, 0.f};
#pragma unroll
            for (int tc = 0; tc < 4; ++tc) acc[tc] = (f32x4){0.f, 0.f, 0.f, 0.f};
#pragma unroll
            for (int ks = 0; ks < 4; ++ks) {
                const bf16x8_t af = *(LAS bf16x8_t*)(L0 + swz256(16 * tr + fr, ks * 4 + fq));
                if (kq) { const bf16x8_t qf = *(LAS bf16x8_t*)(L0 + 16384 + swz256(16 * tr + fr, ks * 4 + fq)); accq = __builtin_amdgcn_mfma_f32_16x16x32_bf16(qf, qf, accq, 0, 0, 0); }
#pragma unroll
                for (int tc = 0; tc < 4; ++tc) { const bf16x8_t bfr = *(LAS bf16x8_t*)(L0 + (kq ? 16384 : 0) + swz256(16 * tc + fr, ks * 4 + fq));
                    acc[tc] = __builtin_amdgcn_mfma_f32_16x16x32_bf16(af, bfr, acc[tc], 0, 0, 0); }
            }
            const f32x4 dsrc = kq ? accq : (tr == 0 ? acc[0] : tr == 1 ? acc[1] : tr == 2 ? acc[2] : acc[3]);
            const int rsel = fr & 3; const float dv = rsel == 0 ? dsrc[0] : rsel == 1 ? dsrc[1] : rsel == 2 ? dsrc[2] : dsrc[3];
            if (fq == (fr >> 2)) SM[(kq ? 320 : 256) + 16 * tr + fr] = dv;
#pragma unroll
            for (int it = 0; it < 2; ++it) { const int q = tid + 512 * it;
                { const int c = q >> 4, ch = q & 15; *(GAS v4u*)(prec + P_QT + c * 256 + ch * 16) = *(LAS v4u*)(L0 + 16384 + swz256(c, ch)); }
                { const int d = q >> 3, ch = q & 7; *(GAS v4u*)(prec + P_KTT + d * 128 + ch * 16) = *(LAS v4u*)(L1 + swz128(d, ch)); } }
        }
        __syncthreads();
        TQ(2);
        if (tid < 128) { const int hh = tid >> 6, c = tid & 63;
            const float rk = rsqrtf(SM[256 + c] + L2_EPS), rq = rsqrtf(SM[320 + c] + L2_EPS) * 0.08838834764831845f;
            const float G = SM[hh * 64 + c], Gl = SM[hh * 64 + 63], be = SM[128 + hh * 64 + c];
            SM[384 + hh * 64 + c] = rk * be * __expf(G); SM[512 + hh * 64 + c] = rk * __expf(Gl - G); SM[640 + hh * 64 + c] = rq * __expf(G);
            { GAS float* fac = (GAS float*)(rec0 + (size_t)hh * 32 * HREC_BYTES + H_FAC); fac[c] = rq * __expf(G); fac[64 + c] = rk * __expf(Gl - G); }
            if (c == 63) EGL[(b * 16 + 2 * hq + hh) * 32 + n] = __expf(Gl);
        }
        TQ(3);
        for (int rs_ = 0; rs_ < REPS_S2B; ++rs_) {
            const int tr = wave & 3; const bool kq = wave >= 4; const int i0 = 16 * tr + 4 * fq;
#pragma unroll
            for (int hh = 0; hh < 2; ++hh) {
                float gi[4], fi[4];
#pragma unroll
                for (int r = 0; r < 4; ++r) { gi[r] = SM[hh * 64 + i0 + r]; const float rki = rsqrtf(SM[256 + i0 + r] + L2_EPS); fi[r] = kq ? rki : rki * SM[128 + hh * 64 + i0 + r]; }
                v2u aq[4];
#pragma unroll
                for (int tc = 0; tc < 4; ++tc) { const int jc = 16 * tc + fr; const float gj = SM[hh * 64 + jc]; const float fj = kq ? rsqrtf(SM[320 + jc] + L2_EPS) * 0.08838834764831845f : rsqrtf(SM[256 + jc] + L2_EPS);
                    float o[4];
                    if (!kq) {
#pragma unroll
                        for (int r = 0; r < 4; ++r) { const int i = i0 + r; o[r] = (i > jc) ? fi[r] * fj * acc[tc][r] * __expf(gi[r] - gj) : 0.f;
                            *(LAS bf16*)(L2 + hh * 8192 + swz128(i, jc >> 3) + (jc & 7) * 2) = (bf16)f2bf(o[r]); }
                        if (tc == tr) *(LAS f32x4*)(L3 + (P2_LDIAG - P2_SM) + ((hh * 4 + tr) * 256 + fr * 16 + 4 * fq) * 4) = (f32x4){o[0], o[1], o[2], o[3]};
                    } else {
#pragma unroll
                        for (int r = 0; r < 4; ++r) { const int i = i0 + r; o[r] = (jc >= i) ? fj * fi[r] * acc[tc][r] * __expf(gj - gi[r]) : 0.f; }
                        aq[tc].x = pk2(o[0], o[1]); aq[tc].y = pk2(o[2], o[3]); }
                }
                if (kq) {
#pragma unroll
                    for (int tp = 0; tp < 2; ++tp)
                        *(GAS v4u*)(rec0 + (size_t)hh * 32 * HREC_BYTES + H_AQK + (16 * (2 * tp + (fq & 1)) + fr) * 128 + (16 * tr + 8 * (fq >> 1)) * 2) = widen16(aq[2 * tp], aq[2 * tp + 1]);
                }
            }
        }
        __syncthreads();
        TQ(4);
        for (int rs_ = 0; rs_ < REPS_S3; ++rs_) {
            const int hh = wave >> 2, i = wave & 3;
            LAS unsigned char* Trow = L0 + hh * 8192; LAS unsigned char* TT = L0 + 16384 + hh * 8192;
            LAS unsigned char* Tb = L2 + 16384 + hh * 8192; LAS unsigned char* Tr = L2 + 32768 + hh * 8192;
            const v4u z4 = (v4u){0u, 0u, 0u, 0u};
            { const int row = 16 * i + (lane >> 2), c0 = (lane & 3) * 2;
              *(LAS v4u*)(Trow + swz128(row, c0)) = z4; *(LAS v4u*)(Trow + swz128(row, c0 + 1)) = z4;
              *(LAS v4u*)(Tb + swz128(row, c0)) = z4; *(LAS v4u*)(Tb + swz128(row, c0 + 1)) = z4;
              *(LAS v4u*)(Tr + swz128(row, c0)) = z4; *(LAS v4u*)(Tr + swz128(row, c0 + 1)) = z4;
              *(LAS v4u*)(TT + swz128(lane, 2 * i)) = z4; *(LAS v4u*)(TT + swz128(lane, 2 * i + 1)) = z4; }
            if (lane < 16) {
                const int jcol = lane; const LAS float* Ld = (const LAS float*)(L3 + (P2_LDIAG - P2_SM)) + (hh * 4 + i) * 256;
                float x[16];
#pragma unroll
                for (int r = 0; r < 16; ++r) x[r] = (r == jcol) ? 1.f : 0.f;
#pragma unroll
                for (int s = 0; s < 15; ++s) {
                    const float xs = x[s];
#pragma unroll
                    for (int cg = (s + 1) / 4; cg < 4; ++cg) { const f32x4 m = *(const LAS f32x4*)(Ld + s * 16 + cg * 4);
#pragma unroll
                        for (int e = 0; e < 4; ++e) { const int c = cg * 4 + e; if (c > s) x[c] -= m[e] * xs; } }
                }
                const int gc = 16 * i + jcol; const float be = SM[128 + hh * 64 + gc], rho = SM[384 + hh * 64 + gc];
#pragma unroll
                for (int r = 0; r < 16; ++r) { const int grow = 16 * i + r; const int off = swz128(grow, gc >> 3) + (gc & 7) * 2;
                    *(LAS bf16*)(Trow + off) = (bf16)f2bf(x[r]); *(LAS bf16*)(Tb + off) = (bf16)f2bf(x[r] * be); *(LAS bf16*)(Tr + off) = (bf16)f2bf(x[r] * rho); }
                v4u t0, t1; t0.x = pk2(x[0], x[1]); t0.y = pk2(x[2], x[3]); t0.z = pk2(x[4], x[5]); t0.w = pk2(x[6], x[7]); t1.x = pk2(x[8], x[9]); t1.y = pk2(x[10], x[11]); t1.z = pk2(x[12], x[13]); t1.w = pk2(x[14], x[15]);
                *(LAS v4u*)(TT + swz128(gc, 2 * i)) = t0; *(LAS v4u*)(TT + swz128(gc, 2 * i + 1)) = t1;
            }
        }
        __syncthreads();
        TQ(5);
        if (wave < 4) {
            const int hh = wave >> 1, i = 1 + 2 * (wave & 1), jb = i - 1;
            LAS unsigned char* Trow = L0 + hh * 8192; LAS unsigned char* TT = L0 + 16384 + hh * 8192;
            LAS unsigned char* Lrow = L2 + hh * 8192; LAS unsigned char* Tb = L2 + 16384 + hh * 8192; LAS unsigned char* Tr = L2 + 32768 + hh * 8192;
            LAS unsigned char* PS = L3 + (P2_PS - P2_SM) + wave * 2048 + 1024;
            f32x4 p = (f32x4){0.f, 0.f, 0.f, 0.f};
#pragma unroll
            for (int ks = 0; ks < 2; ++ks) { const bf16x8_t la = *(LAS bf16x8_t*)(Lrow + swz128(16 * i + fr, ks * 4 + fq)), tb = *(LAS bf16x8_t*)(TT + swz128(16 * jb + fr, ks * 4 + fq));
                p = __builtin_amdgcn_mfma_f32_16x16x32_bf16(la, tb, p, 0, 0, 0); }
            { v2u w; w.x = pk2(p[0], p[1]); w.y = pk2(p[2], p[3]); *(LAS v2u*)(PS + fr * 64 + (16 + 4 * fq) * 2) = w; }
            const bf16x8_t ta = *(LAS bf16x8_t*)(Trow + swz128(16 * i + fr, (i >> 1) * 4 + fq)), pb = *(LAS bf16x8_t*)(PS + fr * 64 + fq * 16);
            const f32x4 t = __builtin_amdgcn_mfma_f32_16x16x32_bf16(ta, pb, (f32x4){0.f, 0.f, 0.f, 0.f}, 0, 0, 0);
            const int gc = 16 * jb + fr; const float be = SM[128 + hh * 64 + gc], rho = SM[384 + hh * 64 + gc];
#pragma unroll
            for (int r = 0; r < 4; ++r) { const int grow = 16 * i + 4 * fq + r; const int off = swz128(grow, gc >> 3) + (gc & 7) * 2; const float v = -t[r];
                *(LAS bf16*)(Trow + off) = (bf16)f2bf(v); *(LAS bf16*)(Tb + off) = (bf16)f2bf(v * be); *(LAS bf16*)(Tr + off) = (bf16)f2bf(v * rho); }
            { v2u w; w.x = pk2(-t[0], -t[1]); w.y = pk2(-t[2], -t[3]); const int s0 = 16 * i + 4 * fq; *(LAS v2u*)(TT + swz128(gc, s0 >> 3) + (s0 & 7) * 2) = w; }
        }
        __syncthreads();
        TQ(6);
        {
            const int hh = wave >> 2, i2 = (wave >> 1) & 1, j2 = wave & 1, i = 2 + i2, jb = j2;
            LAS unsigned char* Trow = L0 + hh * 8192; LAS unsigned char* TT = L0 + 16384 + hh * 8192;
            LAS unsigned char* Lrow = L2 + hh * 8192; LAS unsigned char* Tb = L2 + 16384 + hh * 8192; LAS unsigned char* Tr = L2 + 32768 + hh * 8192;
            LAS unsigned char* PS = L3 + (P2_PS - P2_SM) + wave * 2048;
            const bf16x8_t tb = *(LAS bf16x8_t*)(TT + swz128(16 * jb + fr, fq));
#pragma unroll
            for (int k = 0; k < 2; ++k) { const bf16x8_t la = *(LAS bf16x8_t*)(Lrow + swz128(32 + 16 * k + fr, fq));
                const f32x4 p = __builtin_amdgcn_mfma_f32_16x16x32_bf16(la, tb, (f32x4){0.f, 0.f, 0.f, 0.f}, 0, 0, 0);
                v2u w; w.x = pk2(p[0], p[1]); w.y = pk2(p[2], p[3]); *(LAS v2u*)(PS + fr * 64 + (16 * k + 4 * fq) * 2) = w; }
            const bf16x8_t ta = *(LAS bf16x8_t*)(Trow + swz128(16 * i + fr, 4 + fq)), pb = *(LAS bf16x8_t*)(PS + fr * 64 + fq * 16);
            const f32x4 t = __builtin_amdgcn_mfma_f32_16x16x32_bf16(ta, pb, (f32x4){0.f, 0.f, 0.f, 0.f}, 0, 0, 0);
            const int gc = 16 * jb + fr; const float be = SM[128 + hh * 64 + gc], rho = SM[384 + hh * 64 + gc];
#pragma unroll
            for (int r = 0; r < 4; ++r) { const int grow = 16 * i + 4 * fq + r; const int off = swz128(grow, gc >> 3) + (gc & 7) * 2; const float v = -t[r];
                *(LAS bf16*)(Trow + off) = (bf16)f2bf(v); *(LAS bf16*)(Tb + off) = (bf16)f2bf(v * be); *(LAS bf16*)(Tr + off) = (bf16)f2bf(v * rho); }
            { v2u w; w.x = pk2(-t[0], -t[1]); w.y = pk2(-t[2], -t[3]); const int s0 = 16 * i + 4 * fq; *(LAS v2u*)(TT + swz128(gc, s0 >> 3) + (s0 & 7) * 2) = w; }
        }
        __syncthreads();
        { const int un_ = unit + (int)gridDim.x; if (un_ < 2048) PREP_RAWLOAD(un_); }
        for (int rs_ = 0; rs_ < REPS_S5; ++rs_) {
            const int hh = wave >> 2, X = (wave >> 1) & 1;
            LAS unsigned char* RT = X ? L1 : L1 + 16384 + hh * 16384;
            LAS unsigned char* TX = L2 + (X ? 32768 : 16384) + hh * 8192;
            GAS unsigned char* outp = rec0 + (size_t)hh * 32 * HREC_BYTES + (X ? H_WNEG : H_U);
            const float sgn = X ? -1.f : 1.f;
            bf16x8_t tb[4][2];
#pragma unroll
            for (int tc = 0; tc < 4; ++tc)
#pragma unroll
                for (int ks = 0; ks < 2; ++ks) tb[tc][ks] = *(LAS bf16x8_t*)(TX + swz128(16 * tc + fr, ks * 4 + fq));
            if (X) {
#pragma unroll
                for (int c8p = 0; c8p < 2; ++c8p) { const int ctA = 4 * (wave & 1) + 2 * c8p;
                    const bf16x8_t a0 = *(LAS bf16x8_t*)(RT + swz128(16 * ctA + fr, fq)), a1 = *(LAS bf16x8_t*)(RT + swz128(16 * ctA + fr, 4 + fq));
                    const bf16x8_t b0 = *(LAS bf16x8_t*)(RT + swz128(16 * ctA + 16 + fr, fq)), b1 = *(LAS bf16x8_t*)(RT + swz128(16 * ctA + 16 + fr, 4 + fq));
#pragma unroll
                    for (int tc = 0; tc < 4; ++tc) {
                        f32x4 dA = __builtin_amdgcn_mfma_f32_16x16x32_bf16(a0, tb[tc][0], (f32x4){0.f, 0.f, 0.f, 0.f}, 0, 0, 0); dA = __builtin_amdgcn_mfma_f32_16x16x32_bf16(a1, tb[tc][1], dA, 0, 0, 0);
                        f32x4 dB = __builtin_amdgcn_mfma_f32_16x16x32_bf16(b0, tb[tc][0], (f32x4){0.f, 0.f, 0.f, 0.f}, 0, 0, 0); dB = __builtin_amdgcn_mfma_f32_16x16x32_bf16(b1, tb[tc][1], dB, 0, 0, 0);
                        const v4u w = widen16((v2u){pk2(-dA[0], -dA[1]), pk2(-dA[2], -dA[3])}, (v2u){pk2(-dB[0], -dB[1]), pk2(-dB[2], -dB[3])});
                        *(GAS v4u*)(outp + (16 * tc + fr) * 256 + (16 * (ctA + (fq & 1)) + 8 * (fq >> 1)) * 2) = w; } }
            } else {
#pragma unroll
                for (int c8 = 0; c8 < 4; ++c8) { const int ct8 = 4 * (wave & 1) + c8;
                    const bf16x8_t a0 = *(LAS bf16x8_t*)(RT + swz128(16 * ct8 + fr, fq)), a1 = *(LAS bf16x8_t*)(RT + swz128(16 * ct8 + fr, 4 + fq));
#pragma unroll
                    for (int tcp = 0; tcp < 2; ++tcp) {
                        f32x4 dA = __builtin_amdgcn_mfma_f32_16x16x32_bf16(tb[2 * tcp][0], a0, (f32x4){0.f, 0.f, 0.f, 0.f}, 0, 0, 0); dA = __builtin_amdgcn_mfma_f32_16x16x32_bf16(tb[2 * tcp][1], a1, dA, 0, 0, 0);
                        f32x4 dB = __builtin_amdgcn_mfma_f32_16x16x32_bf16(tb[2 * tcp + 1][0], a0, (f32x4){0.f, 0.f, 0.f, 0.f}, 0, 0, 0); dB = __builtin_amdgcn_mfma_f32_16x16x32_bf16(tb[2 * tcp + 1][1], a1, dB, 0, 0, 0);
                        const v4u w = widen16((v2u){pk2(dA[0], dA[1]), pk2(dA[2], dA[3])}, (v2u){pk2(dB[0], dB[1]), pk2(dB[2], dB[3])});
                        *(GAS v4u*)(outp + (16 * ct8 + fr) * 128 + (16 * (2 * tcp + (fq & 1)) + 8 * (fq >> 1)) * 2) = w; } }
            }
        }
        TQ(99);
    }
#ifdef TQ_FROM
    if (tq_on && (threadIdx.x & 63) == 0) *(unsigned long long*)(ap->ws + WS_CTL + 8192) = tq_acc;
#endif
#undef PREP_RAWLOAD
    phase_dn_post_sample(ap, j);
}

constexpr int AT_K = 0, AT_V = 32768, AT_VROW = 528;
__device__ __forceinline__ void attn_qtile(LAS unsigned char* Kl, LAS unsigned char* Vl, int kt0, bf16x8_t qb0, bf16x8_t qb1, bf16* optr, int lo, int hi, float slope, float sink, int fr, int fq) {
    f32x4 acc[9];
#pragma unroll
    for (int i = 0; i < 9; ++i) {
        const bf16x8_t k0 = *(LAS bf16x8_t*)(Kl + swz128(16 * (kt0 + i) + fr, fq)), k1 = *(LAS bf16x8_t*)(Kl + swz128(16 * (kt0 + i) + fr, 4 + fq));
        acc[i] = __builtin_amdgcn_mfma_f32_16x16x32_bf16(k0, qb0, (f32x4){0.f, 0.f, 0.f, 0.f}, 0, 0, 0);
        acc[i] = __builtin_amdgcn_mfma_f32_16x16x32_bf16(k1, qb1, acc[i], 0, 0, 0);
    }
    float m = sink;
#pragma unroll
    for (int i = 0; i < 9; ++i)
#pragma unroll
        for (int r = 0; r < 4; ++r) { const int kc = 16 * (kt0 + i) + 4 * fq + r; const bool valid = (kc >= lo) && (kc <= hi);
            const float s = valid ? acc[i][r] - slope * (float)(hi - kc) : -INFINITY; acc[i][r] = s; m = fmaxf(m, s); }
    m = fmaxf(m, __shfl_xor(m, 16)); m = fmaxf(m, __shfl_xor(m, 32));
    float sum = 0.f;
#pragma unroll
    for (int i = 0; i < 9; ++i)
#pragma unroll
        for (int r = 0; r < 4; ++r) { const float p = __expf(acc[i][r] - m); acc[i][r] = p; sum += p; }
    sum += __shfl_xor(sum, 16); sum += __shfl_xor(sum, 32);
    const float inv = 1.f / (sum + __expf(sink - m));
    f32x4 o[4];
#pragma unroll
    for (int dt = 0; dt < 4; ++dt) o[dt] = (f32x4){0.f, 0.f, 0.f, 0.f};
#pragma unroll
    for (int i2 = 0; i2 < 5; ++i2) {
        const int ia = 2 * i2, ib = 2 * i2 + 1;
        v4u pw; pw.x = pk2(acc[ia][0], acc[ia][1]); pw.y = pk2(acc[ia][2], acc[ia][3]);
        if (ib < 9) { pw.z = pk2(acc[ib < 9 ? ib : 8][0], acc[ib < 9 ? ib : 8][1]); pw.w = pk2(acc[ib < 9 ? ib : 8][2], acc[ib < 9 ? ib : 8][3]); } else { pw.z = 0u; pw.w = 0u; }
        const bf16x8_t pf = __builtin_bit_cast(bf16x8_t, pw);
        const int kta = kt0 + ia; int ktb = kt0 + ib; ktb = ktb > 15 ? 15 : ktb;
#pragma unroll
        for (int dt = 0; dt < 4; ++dt) {
            const v2u va = *(LAS v2u*)(Vl + (16 * dt + fr) * AT_VROW + (16 * kta + 4 * fq) * 2), vb = *(LAS v2u*)(Vl + (16 * dt + fr) * AT_VROW + (16 * ktb + 4 * fq) * 2);
            const v4u vw = (v4u){va.x, va.y, vb.x, vb.y};
            o[dt] = __builtin_amdgcn_mfma_f32_16x16x32_bf16(__builtin_bit_cast(bf16x8_t, vw), pf, o[dt], 0, 0, 0);
        }
    }
#pragma unroll
    for (int dp = 0; dp < 2; ++dp) { v2u wa, wb; wa.x = pk2(o[2 * dp][0] * inv, o[2 * dp][1] * inv); wa.y = pk2(o[2 * dp][2] * inv, o[2 * dp][3] * inv);
        wb.x = pk2(o[2 * dp + 1][0] * inv, o[2 * dp + 1][1] * inv); wb.y = pk2(o[2 * dp + 1][2] * inv, o[2 * dp + 1][3] * inv);
        *(v4u*)(optr + 16 * (2 * dp + (fq & 1)) + 8 * (fq >> 1)) = widen16(wa, wb); }
}

#define VT_WRITE4(Vl_, dc_, kg_, w_) do { LAS unsigned char* vp_ = (Vl_) + (8 * (dc_)) * AT_VROW + 8 * (kg_); \
        *(LAS v2u*)(vp_ + 0 * AT_VROW) = (v2u){__builtin_amdgcn_perm(w_[1].x, w_[0].x, 0x05040100u), __builtin_amdgcn_perm(w_[3].x, w_[2].x, 0x05040100u)}; \
        *(LAS v2u*)(vp_ + 1 * AT_VROW) = (v2u){__builtin_amdgcn_perm(w_[1].x, w_[0].x, 0x07060302u), __builtin_amdgcn_perm(w_[3].x, w_[2].x, 0x07060302u)}; \
        *(LAS v2u*)(vp_ + 2 * AT_VROW) = (v2u){__builtin_amdgcn_perm(w_[1].y, w_[0].y, 0x05040100u), __builtin_amdgcn_perm(w_[3].y, w_[2].y, 0x05040100u)}; \
        *(LAS v2u*)(vp_ + 3 * AT_VROW) = (v2u){__builtin_amdgcn_perm(w_[1].y, w_[0].y, 0x07060302u), __builtin_amdgcn_perm(w_[3].y, w_[2].y, 0x07060302u)}; \
        *(LAS v2u*)(vp_ + 4 * AT_VROW) = (v2u){__builtin_amdgcn_perm(w_[1].z, w_[0].z, 0x05040100u), __builtin_amdgcn_perm(w_[3].z, w_[2].z, 0x05040100u)}; \
        *(LAS v2u*)(vp_ + 5 * AT_VROW) = (v2u){__builtin_amdgcn_perm(w_[1].z, w_[0].z, 0x07060302u), __builtin_amdgcn_perm(w_[3].z, w_[2].z, 0x07060302u)}; \
        *(LAS v2u*)(vp_ + 6 * AT_VROW) = (v2u){__builtin_amdgcn_perm(w_[1].w, w_[0].w, 0x05040100u), __builtin_amdgcn_perm(w_[3].w, w_[2].w, 0x05040100u)}; \
        *(LAS v2u*)(vp_ + 7 * AT_VROW) = (v2u){__builtin_amdgcn_perm(w_[1].w, w_[0].w, 0x07060302u), __builtin_amdgcn_perm(w_[3].w, w_[2].w, 0x07060302u)}; } while (0)
__device__ __forceinline__ void phase_swa_attn_mfma(CArgs ap, int j, LAS unsigned char* lds) {
    int tid_ = threadIdx.x; asm volatile("" : "+v"(tid_)); const int tid = tid_, lane = tid & 63, wave = __builtin_amdgcn_readfirstlane(tid >> 6);
    const int fr = lane & 15, fq = lane >> 4;
    unsigned char* ws = ap->ws;
    const bf16* Q = (const bf16*)(ws + WS_Q); const bf16* KB = (const bf16*)(ws + WS_KB); const bf16* VB = (const bf16*)(ws + WS_VB);
    bf16* ATT = (bf16*)(ws + WS_ATT);
    const float* ck = ap->in[4] + (size_t)j * NB_S * 128 * 256; const float* cv = ap->in[5] + (size_t)j * NB_S * 128 * 256;
    const float* sinks = ap->in[17] + j * 16;
    LAS unsigned char* Kl = lds + AT_K; LAS unsigned char* Vl = lds + AT_V;
    int bid_ = blockIdx.x; asm volatile("" : "+s"(bid_));
    for (int unit = bid_; unit < 1024; unit += gridDim.x) {
        __syncthreads();
        if (unit < 512) {
            const int b = unit >> 6, nb = (unit >> 2) & 15, kh = unit & 3;
            const int trow0 = b * SEQ + nb * 128 - 128;
            const int g = wave >> 1, qh = wave & 1, head = kh * 4 + g;
            const bf16* qp0 = Q + (size_t)(b * SEQ + nb * 128 + 64 * qh + fr) * DM + head * 64 + 8 * fq;
            bf16x8_t qn0 = *(const bf16x8_t*)qp0, qn1 = *(const bf16x8_t*)(qp0 + 32);
#pragma unroll
            for (int it = 0; it < 4; ++it) { const int q = tid + 512 * it;
                { const int key = q >> 3, ch = q & 7; v4u w = (v4u){0u, 0u, 0u, 0u};
                  if (nb > 0 || key >= 128) w = *(const v4u*)(KB + (size_t)(trow0 + key) * 256 + kh * 64 + ch * 8);
                  *(LAS v4u*)(Kl + swz128(key, ch)) = w; }
            }
            { const int kg = tid & 63, dc = tid >> 6; v4u w[4];
#pragma unroll
              for (int i = 0; i < 4; ++i) { const int key = 4 * kg + i; w[i] = (v4u){0u, 0u, 0u, 0u}; if (nb > 0 || key >= 128) w[i] = *(const v4u*)(VB + (size_t)(trow0 + key) * 256 + kh * 64 + dc * 8); }
              VT_WRITE4(Vl, dc, kg, w); }
            __syncthreads();
            const float slope = exp2f(-0.5f * (float)(head + 1)), sink = sinks[head];
#pragma unroll 1
            for (int qt = 0; qt < 4; ++qt) {
                const int o = 64 * qh + 16 * qt, qi = o + fr;
                const size_t tq = (size_t)(b * SEQ + nb * 128 + qi);
                const bf16x8_t qc0 = qn0, qc1 = qn1;
                { const bf16* qp = qp0 + (size_t)(16 * (qt < 3 ? qt + 1 : 3)) * DM; qn0 = *(const bf16x8_t*)qp; qn1 = *(const bf16x8_t*)(qp + 32); }
                attn_qtile(Kl, Vl, 4 * qh + qt, qc0, qc1, ATT + tq * DM + head * 64, (nb == 0 && qi < 128) ? 128 : qi, 128 + qi, slope, sink, fr, fq);
            }
        } else {
            const int su = unit - 512, b = su >> 2, kh = su & 3;
            for (int q = tid; q < 1280; q += 512) {
                { const int key = q >> 3, ch = q & 7; v4u w = (v4u){0u, 0u, 0u, 0u};
                  if (key < 128) { const float* p = ck + (size_t)(b * 128 + key) * 256 + kh * 64 + ch * 8; const f32x4 x0 = *(const f32x4*)p, x1 = *(const f32x4*)(p + 4);
                      w.x = pk2(x0[0], x0[1]); w.y = pk2(x0[2], x0[3]); w.z = pk2(x1[0], x1[1]); w.w = pk2(x1[2], x1[3]); }
                  else if (key < 132) w = *(const v4u*)(KB + (size_t)(TP + b * 4 + key - 128) * 256 + kh * 64 + ch * 8);
                  *(LAS v4u*)(Kl + swz128(key, ch)) = w; }
            }
            if (tid < 320) { const int kg = tid % 40, dc = tid / 40; v4u w[4];
#pragma unroll
              for (int i = 0; i < 4; ++i) { const int key = 4 * kg + i; w[i] = (v4u){0u, 0u, 0u, 0u};
                  if (key < 128) { const float* p = cv + (size_t)(b * 128 + key) * 256 + kh * 64 + dc * 8; const f32x4 x0 = *(const f32x4*)p, x1 = *(const f32x4*)(p + 4);
                      w[i].x = pk2(x0[0], x0[1]); w[i].y = pk2(x0[2], x0[3]); w[i].z = pk2(x1[0], x1[1]); w[i].w = pk2(x1[2], x1[3]); }
                  else if (key < 132) w[i] = *(const v4u*)(VB + (size_t)(TP + b * 4 + key - 128) * 256 + kh * 64 + dc * 8); }
              VT_WRITE4(Vl, dc, kg, w); }
            __syncthreads();
            if (wave == 0) {
                const int tok = fr & 3, g = fr >> 2, head = kh * 4 + g;
                const float slope = exp2f(-0.5f * (float)(head + 1)), sink = sinks[head];
                const size_t tq = (size_t)(TP + b * 4 + tok);
                const bf16* qp = Q + tq * DM + head * 64 + 8 * fq;
                attn_qtile(Kl, Vl, 0, *(const bf16x8_t*)qp, *(const bf16x8_t*)(qp + 32), ATT + tq * DM + head * 64, tok, 128 + tok, slope, sink, fr, fq);
            }
        }
    }
}

#define XB_TMO      128
#define XB_XCNT(j)  (256  + 64 * (j))
#define XB_XSUB(j)  (1280 + 64 * (j))
#define XB_XGEN(j)  (2304 + 64 * (j))
#define XB_TOP      3328
#define XB_TOPGEN   3392
#define XCD_BAR_WORDS 3456
#define XB_SPIN_CAP (1u << 18)

__device__ __forceinline__ unsigned xb_ld(unsigned* p)              { return __hip_atomic_load(p, __ATOMIC_RELAXED, __HIP_MEMORY_SCOPE_AGENT); }
__device__ __forceinline__ unsigned xb_add(unsigned* p, unsigned v) { return __hip_atomic_fetch_add(p, v, __ATOMIC_RELAXED, __HIP_MEMORY_SCOPE_AGENT); }
__device__ __forceinline__ unsigned xb_xcc_id() { return (unsigned)__builtin_amdgcn_s_getreg((3 << 11) | 20) & 0xFu; }
#define XB_SPIN(cond, bar) do { unsigned _sp = 0; while (cond) { __builtin_amdgcn_s_sleep(1); \
    if ((++_sp & 255u) == 0u) { if (xb_ld(&(bar)[XB_TMO])) break; if (_sp > XB_SPIN_CAP) { atomicAdd(&(bar)[XB_TMO], 1u); break; } } } } while (0)

struct XcdBarrier {
    unsigned* bar; unsigned x;
    volatile LAS unsigned* st;
};

__device__ __forceinline__ XcdBarrier xcd_barrier_post(unsigned* bar, volatile LAS unsigned* st) {
    XcdBarrier b; b.bar = bar; b.x = xb_xcc_id(); b.st = st;
    if (threadIdx.x == 0) (void)xb_add(&bar[XB_XCNT(b.x)], 1u);
    return b;
}
__device__ __forceinline__ void xcd_barrier_complete(unsigned* bar, unsigned x, unsigned& nloc, unsigned& nx) {
    const unsigned G = gridDim.x * gridDim.y * gridDim.z;
    unsigned sum, cnt, mine, sp = 0u;
    for (;;) {
        sum = 0u; cnt = 0u; mine = 0u;
#pragma unroll
        for (unsigned j = 0; j < 16; ++j) { const unsigned c = xb_ld(&bar[XB_XCNT(j)]); sum += c; cnt += (c > 0u) ? 1u : 0u; mine = (j == x) ? c : mine; }
        if (sum == G) break;
        __builtin_amdgcn_s_sleep(1);
        if ((++sp & 255u) == 0u) { if (xb_ld(&bar[XB_TMO])) break; if (sp > XB_SPIN_CAP) { atomicAdd(&bar[XB_TMO], 1u); break; } }
    }
    nloc = mine > 0u ? mine : 1u; nx = cnt > 0u ? cnt : 1u;
}

__device__ __forceinline__ void xcd_barrier(const XcdBarrier& b) {
    asm volatile("s_waitcnt vmcnt(0)" ::: "memory");
    __syncthreads();
    if (threadIdx.x == 0) {
        unsigned* bar = b.bar;
        __builtin_amdgcn_s_waitcnt(0);
        unsigned nloc = b.st[0], nx = b.st[1];
        if (nloc == 0u) { xcd_barrier_complete(bar, b.x, nloc, nx); b.st[0] = nloc; b.st[1] = nx; }
        const unsigned old = xb_add(&bar[XB_XSUB(b.x)], 1u);
        const unsigned gen = old / nloc;
        if (old + 1u == (gen + 1u) * nloc) {
            __builtin_amdgcn_fence(__ATOMIC_RELEASE, "agent");
            asm volatile("s_waitcnt vmcnt(0)" ::: "memory");
            const unsigned og = xb_add(&bar[XB_TOP], 1u);
            const unsigned tg = og / nx;
            if (og + 1u == (tg + 1u) * nx) xb_add(&bar[XB_TOPGEN], 1u);
            else XB_SPIN(xb_ld(&bar[XB_TOPGEN]) == tg, bar);
            __builtin_amdgcn_fence(__ATOMIC_ACQUIRE, "agent");
            xb_add(&bar[XB_XGEN(b.x)], 1u);
            asm volatile("s_waitcnt vmcnt(0)" ::: "memory");
        } else {
            XB_SPIN(xb_ld(&bar[XB_XGEN(b.x)]) == gen, bar);
            __builtin_amdgcn_fence(__ATOMIC_ACQUIRE, "agent");
            asm volatile("s_waitcnt vmcnt(0)" ::: "memory");
        }
    }
    __syncthreads();
}

constexpr int CW_BAR = 4096;
constexpr int MISC_OFF = 163584;

#ifndef REP_PREP
#define REP_PREP 1
#endif
#ifndef REP_SCAN
#define REP_SCAN 1
#endif
#ifndef REP_ATTN
#define REP_ATTN 1
#endif
#ifndef REP_GIN
#define REP_GIN 1
#endif
#ifndef REP_GGU
#define REP_GGU 1
#endif
#ifndef REP_GQKV
#define REP_GQKV 1
#endif

__device__ __forceinline__ void small_res(const bf16* A, const bf16* Wt, int K, const float* bias, bf16* XBp, float* SSQp, LAS unsigned char* lds) {
    int tid_ = threadIdx.x; asm volatile("" : "+v"(tid_)); const int tid = tid_, lane = tid & 63, wave = __builtin_amdgcn_readfirstlane(tid >> 6);
    const int fr = lane & 15, fq = lane >> 4, rt = wave >> 2, ct = wave & 3;
    int bid_ = blockIdx.x; asm volatile("" : "+s"(bid_));
    LAS float* red = (LAS float*)lds;
    for (int piece = bid_; piece < 256; piece += gridDim.x) {
        const int rb = piece >> 4, cc = piece & 15, m0 = TP + rb * 32 + rt * 16, n0 = cc * 64 + ct * 16;
        const bf16* apx = A + (size_t)(m0 + fr) * K + 8 * fq; const bf16* wpx = Wt + (size_t)(n0 + fr) * K + 8 * fq;
        f32x4 acc = (f32x4){0.f, 0.f, 0.f, 0.f};
        bf16x8_t a0[4], w0[4], a1[4], w1[4];
#pragma unroll
        for (int i = 0; i < 4; ++i) { a0[i] = *(const bf16x8_t*)(apx + 32 * i); w0[i] = *(const bf16x8_t*)(wpx + 32 * i); }
#pragma unroll 1
        for (int k = 0; k < K; k += 256) {
#pragma unroll
            for (int i = 0; i < 4; ++i) { a1[i] = *(const bf16x8_t*)(apx + k + 128 + 32 * i); w1[i] = *(const bf16x8_t*)(wpx + k + 128 + 32 * i); }
#pragma unroll
            for (int i = 0; i < 4; ++i) acc = __builtin_amdgcn_mfma_f32_16x16x32_bf16(w0[i], a0[i], acc, 0, 0, 0);
            const int kn = (k + 256 < K) ? k + 256 : k;
#pragma unroll
            for (int i = 0; i < 4; ++i) { a0[i] = *(const bf16x8_t*)(apx + kn + 32 * i); w0[i] = *(const bf16x8_t*)(wpx + kn + 32 * i); }
#pragma unroll
            for (int i = 0; i < 4; ++i) acc = __builtin_amdgcn_mfma_f32_16x16x32_bf16(w1[i], a1[i], acc, 0, 0, 0);
        }
        const int row = m0 + fr, col = n0 + 4 * fq;
        bf16* xp = XBp + (size_t)row * DM + col;
        const v2u xo = *(const v2u*)xp;
        f32x4 x = (f32x4){bflo(xo.x), bfhi(xo.x), bflo(xo.y), bfhi(xo.y)} + acc;
        if (bias) x = x + *(const f32x4*)(bias + col);
        v2u w; w.x = pk2(x[0], x[1]); w.y = pk2(x[2], x[3]);
        *(v2u*)xp = w;
        const float r0 = bflo(w.x), r1 = bfhi(w.x), r2 = bflo(w.y), r3 = bfhi(w.y);
        float s = (r0 * r0 + r1 * r1) + (r2 * r2 + r3 * r3);
        s += __shfl_xor(s, 16); s += __shfl_xor(s, 32);
        __syncthreads();
        if (fq == 0) red[wave * 16 + fr] = s;
        __syncthreads();
        if (ct == 0 && fq == 0) SSQp[(size_t)row * 16 + cc] = (red[(rt * 4) * 16 + fr] + red[(rt * 4 + 1) * 16 + fr]) + (red[(rt * 4 + 2) * 16 + fr] + red[(rt * 4 + 3) * 16 + fr]);
    }
}

__device__ __forceinline__ void small_in(const bf16* XBp, const bf16* Wt, const float* SSQp, bf16* proj, float* ba) {
    int tid_ = threadIdx.x; asm volatile("" : "+v"(tid_)); const int tid = tid_, lane = tid & 63, wave = __builtin_amdgcn_readfirstlane(tid >> 6);
    const int fr = lane & 15, fq = lane >> 4;
    int bid_ = blockIdx.x; asm volatile("" : "+s"(bid_));
    const int gw = bid_ * NWAVES + wave, NGW = gridDim.x * NWAVES;
    for (int task = gw; task < 2048; task += NGW) {
        const int rt = task >> 6, cg = task & 63, m0 = TP + 16 * rt, n0 = 96 * cg;
        const bf16* apx = XBp + (size_t)(m0 + fr) * DM + 8 * fq; const bf16* wpx = Wt + (size_t)(n0 + fr) * DM + 8 * fq;
        f32x4 acc[6];
#pragma unroll
        for (int t = 0; t < 6; ++t) acc[t] = (f32x4){0.f, 0.f, 0.f, 0.f};
#pragma unroll 1
        for (int k = 0; k < DM; k += 128) {
            bf16x8_t av[4], wv[4][6];
#pragma unroll
            for (int i = 0; i < 4; ++i) { av[i] = *(const bf16x8_t*)(apx + k + 32 * i);
#pragma unroll
                for (int t = 0; t < 6; ++t) wv[i][t] = *(const bf16x8_t*)(wpx + (size_t)(16 * t) * DM + k + 32 * i); }
#pragma unroll
            for (int i = 0; i < 4; ++i)
#pragma unroll
                for (int t = 0; t < 6; ++t) acc[t] = __builtin_amdgcn_mfma_f32_16x16x32_bf16(wv[i][t], av[i], acc[t], 0, 0, 0);
        }
        const int row = m0 + fr; const float rs = row_rstd(SSQp, row);
#pragma unroll
        for (int t = 0; t < 6; ++t) { v2u w; w.x = pk2(acc[t][0] * rs, acc[t][1] * rs); w.y = pk2(acc[t][2] * rs, acc[t][3] * rs);
            *(v2u*)(proj + (size_t)row * PROJ_LD + n0 + 16 * t + 4 * fq) = w; }
    }
    for (int task = gw; task < T / 16; task += NGW) {
        const int m0 = 16 * task;
        const bf16* apx = XBp + (size_t)(m0 + fr) * DM + 8 * fq; const bf16* wpx = Wt + (size_t)(6144 + fr) * DM + 8 * fq;
        f32x4 acc0 = (f32x4){0.f, 0.f, 0.f, 0.f}, acc1 = (f32x4){0.f, 0.f, 0.f, 0.f};
#pragma unroll 1
        for (int k = 0; k < DM; k += 256) {
            bf16x8_t av[8], w0[8], w1[8];
#pragma unroll
            for (int i = 0; i < 8; ++i) { av[i] = *(const bf16x8_t*)(apx + k + 32 * i); w0[i] = *(const bf16x8_t*)(wpx + k + 32 * i); w1[i] = *(const bf16x8_t*)(wpx + (size_t)16 * DM + k + 32 * i); }
#pragma unroll
            for (int i = 0; i < 8; ++i) { acc0 = __builtin_amdgcn_mfma_f32_16x16x32_bf16(w0[i], av[i], acc0, 0, 0, 0); acc1 = __builtin_amdgcn_mfma_f32_16x16x32_bf16(w1[i], av[i], acc1, 0, 0, 0); }
        }
        const int row = m0 + fr; const float rs = row_rstd(SSQp, row);
        *(f32x4*)(ba + (size_t)row * 32 + 4 * fq) = acc0 * rs; *(f32x4*)(ba + (size_t)row * 32 + 16 + 4 * fq) = acc1 * rs;
    }
}
template <class Epi>
__device__ __forceinline__ void run_gemm(LAS unsigned char* lds, const bf16* A, const bf16* Bt, int M, int N, int K, const Epi& E) {
    int c_ = blockIdx.x; asm volatile("" : "+s"(c_));
    pg8::Gemm g{A, Bt, M, N, K}; pg8::StaticOrder S; S.init(M, N, (int)gridDim.x, c_);
    pg8::gemm_phase<Epi, pg8::StaticOrder, true, true>(lds, g, S, E);
}

__global__ void __launch_bounds__(NTHREADS, 2) mk_fwd(Args a) {
    extern __shared__ __attribute__((aligned(16))) unsigned char lds_raw[];
    LAS unsigned char* lds = (LAS unsigned char*)lds_raw;
    unsigned char* ws0_ = kargs()->ws;
    for (int u = threadIdx.x; u < (LDS_BYTES - MISC_OFF) / 4; u += NTHREADS) ((LAS unsigned*)(lds + MISC_OFF))[u] = 0u;
    __syncthreads();
    (void)xcd_barrier_post((unsigned*)(ws0_ + WS_CTL) + CW_BAR, (volatile LAS unsigned*)(lds + MISC_OFF));
#ifndef BAR_REP
#define BAR_REP 1
#endif
#define GRID_BAR() do { for (int br_ = 0; br_ < BAR_REP; ++br_) { XcdBarrier b_; b_.bar = (unsigned*)(kargs()->ws + WS_CTL) + CW_BAR; b_.x = xb_xcc_id(); b_.st = (volatile LAS unsigned*)(lds + MISC_OFF); xcd_barrier(b_); } } while (0)

#ifndef REP_PROLOGUE
#define REP_PROLOGUE 1
#endif
    for (int rep = 0; rep < REP_PROLOGUE; ++rep) { if (rep) GRID_BAR(); phase_prologue(kargs(), lds); }
    GRID_BAR();
#pragma unroll 1
    for (int li = 0; li < 4; ++li) {
        const int j = li >> 1;
#define WSP (kargs()->ws)
#define XB ((bf16*)(WSP + WS_XB))
#define SSQ ((float*)(WSP + WS_SSQ))
        if ((li & 1) == 0) {
            for (int rep = 0; rep < REP_GIN; ++rep) { EpiDnIn E{(bf16*)(WSP + WS_PROJ), (float*)(WSP + WS_BA), SSQ, (LAS float*)(lds + 131072)};
              run_gemm(lds, XB, (const bf16*)(WSP + WS_WIN) + (size_t)j * DN_INP * DM, T, DN_INP, DM, E);
            GRID_BAR(); }
            for (int rep = 0; rep < REP_PREP; ++rep) { phase_dn_prep2(kargs(), j, lds);
            GRID_BAR(); }
            for (int rep = 0; rep < REP_SCAN; ++rep) { phase_dn_scan(kargs(), j, lds);
            GRID_BAR(); }
            { EpiRes E{XB, SSQ, nullptr};
              run_gemm(lds, (const bf16*)(WSP + WS_OG), (const bf16*)(WSP + WS_WOUT) + (size_t)j * DM * VAL_DIM, TP, DM, VAL_DIM, E); }
            small_res((const bf16*)(WSP + WS_OG), (const bf16*)(WSP + WS_WOUT) + (size_t)j * DM * VAL_DIM, VAL_DIM, nullptr, XB, SSQ, lds);
            GRID_BAR();
        } else {
            { EpiQkv E{(bf16*)(WSP + WS_Q), (bf16*)(WSP + WS_KB), SSQ, kargs()->in[16] + j * QKV_N,
                       kargs()->out + O_KP + (size_t)j * NB_P * 128 * 256, kargs()->out + O_KS + (size_t)j * NB_S * 4 * 256, (LAS float*)(lds + 131072)};
              run_gemm(lds, XB, (const bf16*)(WSP + WS_WQKV) + (size_t)j * QKV_N * DM, T, QKV_N, DM, E); }
            GRID_BAR();
            for (int rep = 0; rep < REP_ATTN; ++rep) { phase_swa_attn_mfma(kargs(), j, lds);
            GRID_BAR(); }
            { EpiRes E{XB, SSQ, kargs()->in[19] + j * DM};
              run_gemm(lds, (const bf16*)(WSP + WS_ATT), (const bf16*)(WSP + WS_WO) + (size_t)j * DM * DM, TP, DM, DM, E); }
            small_res((const bf16*)(WSP + WS_ATT), (const bf16*)(WSP + WS_WO) + (size_t)j * DM * DM, DM, kargs()->in[19] + j * DM, XB, SSQ, lds);
            GRID_BAR();
        }
        for (int rep = 0; rep < REP_GGU; ++rep) { EpiGu E{(bf16*)(WSP + WS_ACT), SSQ, (LAS float*)(lds + 131072)};
          run_gemm(lds, XB, (const bf16*)(WSP + WS_WGU) + (size_t)li * GU_N * DM, T, GU_N, DM, E);
        GRID_BAR(); }
        { EpiRes E{XB, SSQ, nullptr};
          run_gemm(lds, (const bf16*)(WSP + WS_ACT), (const bf16*)(WSP + WS_WDOWN) + (size_t)li * DM * DFF, TP, DM, DFF, E); }
        small_res((const bf16*)(WSP + WS_ACT), (const bf16*)(WSP + WS_WDOWN) + (size_t)li * DM * DFF, DFF, nullptr, XB, SSQ, lds);
        GRID_BAR();
    }
#undef WSP
#undef XB
#undef SSQ
    phase_final(kargs());
}

extern "C" void kernel_launch(void* const* d_in, const int* in_sizes, int n_in, void* d_out, int out_size, void* d_ws, size_t ws_size, hipStream_t stream) {
    static int grid = 0;
    if (grid == 0) {
        if (n_in != 22 || (size_t)out_size != O_END || ws_size < WS_END) { fprintf(stderr, "kernel_launch: unexpected shapes: n_in %d out %d ws %zu\n", n_in, out_size, ws_size); grid = -1; return; }
        int dev = 0, cus = 0, per_cu = 0;
        if (hipGetDevice(&dev) != hipSuccess || hipDeviceGetAttribute(&cus, hipDeviceAttributeMultiprocessorCount, dev) != hipSuccess) { grid = -1; return; }
        if (hipFuncSetAttribute((const void*)mk_fwd, hipFuncAttributeMaxDynamicSharedMemorySize, LDS_BYTES) != hipSuccess) { fprintf(stderr, "kernel_launch: hipFuncSetAttribute failed\n"); grid = -1; return; }
        if (hipOccupancyMaxActiveBlocksPerMultiprocessor(&per_cu, (const void*)mk_fwd, NTHREADS, LDS_BYTES) != hipSuccess || per_cu < 1) { fprintf(stderr, "kernel_launch: occupancy query reports %d blocks per CU\n", per_cu); (void)hipGetLastError(); }
        grid = cus;
    }
    if (grid < 0) return;
    (void)hipMemsetAsync((char*)d_ws + WS_CTL, 0, CTL_ZERO_BYTES, stream);
    Args a{};
    for (int i = 0; i < 22; ++i) a.in[i] = (const float*)d_in[i];
    a.out = (float*)d_out; a.ws = (unsigned char*)d_ws;
    hipLaunchKernelGGL(mk_fwd, dim3(grid), dim3(NTHREADS), LDS_BYTES, stream, a);
}
```

```cpp
#include <hip/hip_runtime.h>
#include <cstdio>
#include <cstdint>
namespace pg8 {
#define PG8_LAS __attribute__((address_space(3)))
typedef unsigned short bf16_t;
typedef short bf16x8 __attribute__((ext_vector_type(8)));
typedef float f32x4 __attribute__((ext_vector_type(4)));
typedef unsigned u32x4 __attribute__((ext_vector_type(4)));
constexpr int BM = 256, BK = 64, HALF = 128, HTB = HALF * BK * 2  , STAGE_BYTES = 8 * HTB, NXCD = 8, WGM = 8;

__host__ __device__ __forceinline__ int lds_byte(int r, int c) { const int st = (r >> 4) * 2 + (c >> 5), rr = r & 15, cc = c & 31, ob = rr * 64 + cc * 2; return st * 1024 + (ob ^ (((ob >> 9) & 1) << 5)); }
__host__ __device__ __forceinline__ void stage_rc(int b, int& R, int& C) { const int st = b / 1024, sb = b % 1024, swz = sb ^ (((sb >> 9) & 1) << 5); R = (st >> 1) * 16 + swz / 64; C = (st & 1) * 32 + (swz % 64) / 2; }
__host__ __device__ __forceinline__ int perm32(int rho) { const int n = rho >> 4, i = rho & 15; return 8 * (i >> 2) + 4 * n + (i & 3); }

struct Unit { int pm, pn; };
struct Gemm { const bf16_t* A; const bf16_t* Bt; int M, N, K; };

struct StaticOrder {
    int nM, nN, nwg, G, c;
    __host__ __device__ void init(int M, int N, int G_, int c_) { nM = M / BM; nN = N / BM; nwg = nM * nN; G = G_; c = c_; }
    __host__ __device__ bool next(int i, Unit& u) const {
        const long L = (long)i * G + c; if (L >= nwg) return false;
        int wgid = (int)L; { const int q = nwg / NXCD, r = nwg % NXCD, xcd = wgid % NXCD, off = wgid / NXCD; wgid = (xcd < r ? xcd * (q + 1) : r * (q + 1) + (xcd - r) * q) + off; }
        const int nig = WGM * nN, gid = wgid / nig, fm = gid * WGM, gsz = (nM - fm) < WGM ? (nM - fm) : WGM;
        u.pm = fm + ((wgid % nig) % gsz); u.pn = (wgid % nig) / gsz; return true;
    }
    __device__ __forceinline__ void a_ready(const Unit&) const {}
    __device__ __forceinline__ void done(const Unit&) const {}
};
__device__ __forceinline__ unsigned cvt_pk_bf16(float lo, float hi) { unsigned r; asm volatile("v_cvt_pk_bf16_f32 %0, %1, %2" : "=v"(r) : "v"(lo), "v"(hi)); return r; }
typedef float f32x2 __attribute__((ext_vector_type(2)));
template <class Epi, class Sched, bool ALIGN_EPI = false, bool SP2 = false>
__device__ __forceinline__ void gemm_phase(PG8_LAS unsigned char* lds, const Gemm g, const Sched& S, const Epi& E) {
    int tid_ = threadIdx.x; asm volatile("" : "+v"(tid_)); const int tid = tid_, wid = __builtin_amdgcn_readfirstlane(tid >> 6), lane = tid & 63, wr = wid >> 2, wc = wid & 3, fr = lane & 15, fq = lane >> 4;
    const int K = g.K, nt = K / BK;
    unsigned voffA[2], voffB[2];
#pragma unroll
    for (int i = 0; i < 2; ++i) { int R, C; stage_rc(tid * 16 + i * 8192, R, C); const int Rb = Epi::PERM ? ((R & ~31) + perm32(R & 31)) : R;
        voffA[i] = (unsigned)(R * K + C) * 2u; voffB[i] = (unsigned)(Rb * K + C) * 2u; }
    const size_t kstep = (size_t)(BK * 2);
    const size_t hstep = (size_t)HALF * K * 2;
    const size_t tstep = 2 * hstep;
    const unsigned ldsw = (unsigned)wid * 1024u;
    const int aoff = lds_byte(wr * 64 + fr, fq * 8), boff = lds_byte(wc * 32 + fr, fq * 8);
#define PG8_SA(b, h) (((b) * 2 + (h)) * HTB)
#define PG8_SB(b, h) ((4 + (b) * 2 + (h)) * HTB)
#define PG8_STAGE(bufoff, gbase, voff) do { _Pragma("unroll") for (int _i = 0; _i < 2; ++_i) \
        __builtin_amdgcn_global_load_lds((const unsigned*)((const char*)(gbase) + (voff)[_i]), (PG8_LAS unsigned*)(lds + (bufoff) + ldsw + _i * 8192), 16, 0, 0); } while (0)
#define PG8_LDA(dst, b, h) do { _Pragma("unroll") for (int m = 0; m < 4; ++m) _Pragma("unroll") for (int k = 0; k < 2; ++k) dst[m][k] = *(const PG8_LAS bf16x8*)(lds + PG8_SA(b, h) + aoff + m * 2048 + k * 1024); } while (0)
#define PG8_LDB(dst, b, h) do { _Pragma("unroll") for (int n = 0; n < 2; ++n) _Pragma("unroll") for (int k = 0; k < 2; ++k) dst[n][k] = *(const PG8_LAS bf16x8*)(lds + PG8_SB(b, h) + boff + n * 2048 + k * 1024); } while (0)
#define PG8_MMA(ai, bj, At, Bt) do { __builtin_amdgcn_s_setprio(1); _Pragma("unroll") for (int m = 0; m < 4; ++m) _Pragma("unroll") for (int n = 0; n < 2; ++n) _Pragma("unroll") for (int k = 0; k < 2; ++k) \
        acc[ai][bj][m][n] = __builtin_amdgcn_mfma_f32_16x16x32_bf16(Bt[n][k], At[m][k], acc[ai][bj][m][n], 0, 0, 0); __builtin_amdgcn_s_setprio(0); } while (0)
#define PG8_WAIT_V(n) asm volatile("s_waitcnt vmcnt(" #n ")" ::: "memory")
#define PG8_WAIT_L(n) asm volatile("s_waitcnt lgkmcnt(" #n ")" ::: "memory")
#define PG8_BAR __builtin_amdgcn_s_barrier()
#define PG8_SCHED __builtin_amdgcn_sched_barrier(0)
    Unit cur, nxt; int ui = 0;
    if (!S.next(0, cur)) return;
    f32x4 acc[2][2][4][2];
#pragma unroll
    for (int a = 0; a < 2; ++a)
#pragma unroll
        for (int b = 0; b < 2; ++b)
#pragma unroll
            for (int m = 0; m < 4; ++m)
#pragma unroll
                for (int n = 0; n < 2; ++n) acc[a][b][m][n] = (f32x4){0.f, 0.f, 0.f, 0.f};
    bf16x8 At[4][2], B0[2][2], B1[2][2];
    const char* cA = (const char*)g.A + (size_t)cur.pm * tstep; const char* cB = (const char*)g.Bt + (size_t)cur.pn * tstep;
    S.a_ready(cur);
    if constexpr (SP2) {
        PG8_STAGE(PG8_SB(0, 0), cB, voffB); PG8_STAGE(PG8_SB(0, 1), cB + hstep, voffB); PG8_STAGE(PG8_SA(0, 0), cA, voffA); PG8_STAGE(PG8_SA(0, 1), cA + hstep, voffA);
        if (wr == 1) PG8_BAR;
        PG8_WAIT_V(2); PG8_BAR;
        PG8_STAGE(PG8_SB(1, 0), cB + kstep, voffB); PG8_STAGE(PG8_SA(1, 0), cA + kstep, voffA); PG8_STAGE(PG8_SB(1, 1), cB + hstep + kstep, voffB);
        PG8_WAIT_V(6); PG8_BAR;
    } else {
        PG8_STAGE(PG8_SB(0, 0), cB, voffB); PG8_STAGE(PG8_SA(0, 0), cA, voffA); PG8_STAGE(PG8_SB(0, 1), cB + hstep, voffB); PG8_STAGE(PG8_SA(0, 1), cA + hstep, voffA);
        if (wr == 1) PG8_BAR;
        PG8_WAIT_V(4); PG8_BAR;
        PG8_STAGE(PG8_SB(1, 0), cB + kstep, voffB); PG8_STAGE(PG8_SA(1, 0), cA + kstep, voffA); PG8_STAGE(PG8_SB(1, 1), cB + hstep + kstep, voffB);
        PG8_WAIT_V(6); PG8_BAR;
    }
    for (;;) {
        const bool has_next = S.next(ui + 1, nxt);
        const char* nA = has_next ? (const char*)g.A + (size_t)nxt.pm * tstep : cA; const char* nB = has_next ? (const char*)g.Bt + (size_t)nxt.pn * tstep : cB;
        for (int t = 0; t < nt; t += 2) {
            const bool last = (t == nt - 2);
            const char* a1 = cA + (size_t)(t + 1) * kstep;
            const char* a2 = last ? nA : cA + (size_t)(t + 2) * kstep; const char* b2 = last ? nB : cB + (size_t)(t + 2) * kstep;
            const char* a3 = a2 + kstep; const char* b3 = b2 + kstep;
            if (last && has_next) S.a_ready(nxt);
            if constexpr (SP2) {
            PG8_LDB(B0, 0, 0); PG8_LDB(B1, 0, 1); PG8_SCHED; PG8_LDA(At, 0, 0); PG8_STAGE(PG8_SA(1, 1), a1 + hstep, voffA);
            PG8_WAIT_V(8); PG8_WAIT_L(0); PG8_BAR; PG8_MMA(0, 0, At, B0); PG8_MMA(0, 1, At, B1); PG8_BAR; PG8_SCHED;
            PG8_LDA(At, 0, 1); PG8_STAGE(PG8_SB(0, 0), b2, voffB); PG8_STAGE(PG8_SB(0, 1), b2 + hstep, voffB); PG8_STAGE(PG8_SA(0, 0), a2, voffA);
            PG8_WAIT_V(8); PG8_WAIT_L(0); PG8_BAR; PG8_MMA(1, 0, At, B0); PG8_MMA(1, 1, At, B1); PG8_BAR; PG8_SCHED;
            PG8_LDB(B0, 1, 0); PG8_LDB(B1, 1, 1); PG8_SCHED; PG8_LDA(At, 1, 0); PG8_STAGE(PG8_SA(0, 1), a2 + hstep, voffA);
            PG8_WAIT_V(8); PG8_WAIT_L(0); PG8_BAR; PG8_MMA(0, 0, At, B0); PG8_MMA(0, 1, At, B1); PG8_BAR; PG8_SCHED;
            PG8_LDA(At, 1, 1); PG8_STAGE(PG8_SB(1, 0), b3, voffB); PG8_STAGE(PG8_SB(1, 1), b3 + hstep, voffB); PG8_STAGE(PG8_SA(1, 0), a3, voffA);
            PG8_WAIT_V(8); PG8_WAIT_L(0); PG8_BAR; PG8_MMA(1, 0, At, B0); PG8_MMA(1, 1, At, B1); PG8_BAR; PG8_SCHED;
            } else {
            PG8_LDB(B0, 0, 0); PG8_SCHED; PG8_LDA(At, 0, 0); PG8_STAGE(PG8_SA(1, 1), a1 + hstep, voffA);
            PG8_WAIT_L(8); PG8_BAR; PG8_WAIT_L(0); PG8_MMA(0, 0, At, B0); PG8_BAR; PG8_SCHED;
            PG8_LDB(B1, 0, 1); PG8_STAGE(PG8_SB(0, 0), b2, voffB);
            PG8_BAR; PG8_WAIT_L(0); PG8_MMA(0, 1, At, B1); PG8_BAR;
            PG8_LDA(At, 0, 1); PG8_STAGE(PG8_SA(0, 0), a2, voffA);
            PG8_BAR; PG8_WAIT_L(0); PG8_MMA(1, 0, At, B0); PG8_BAR; PG8_SCHED;
            PG8_STAGE(PG8_SB(0, 1), b2 + hstep, voffB);
            PG8_WAIT_V(6); PG8_BAR; PG8_MMA(1, 1, At, B1); PG8_BAR;
            PG8_LDB(B0, 1, 0); PG8_SCHED; PG8_LDA(At, 1, 0); PG8_STAGE(PG8_SA(0, 1), a2 + hstep, voffA);
            PG8_WAIT_L(8); PG8_BAR; PG8_WAIT_L(0); PG8_MMA(0, 0, At, B0); PG8_BAR; PG8_SCHED;
            PG8_LDB(B1, 1, 1); PG8_STAGE(PG8_SB(1, 0), b3, voffB);
            PG8_BAR; PG8_WAIT_L(0); PG8_MMA(0, 1, At, B1); PG8_BAR;
            PG8_LDA(At, 1, 1); PG8_STAGE(PG8_SA(1, 0), a3, voffA);
            PG8_BAR; PG8_WAIT_L(0); PG8_MMA(1, 0, At, B0); PG8_BAR; PG8_SCHED;
            PG8_STAGE(PG8_SB(1, 1), b3 + hstep, voffB);
            PG8_WAIT_V(6); PG8_BAR; PG8_MMA(1, 1, At, B1); PG8_BAR;
            }
        }
        if constexpr (ALIGN_EPI) { if (wr == 0) PG8_BAR; }
        if constexpr (!Epi::AFTER_DRAIN) { E(acc, cur, wr, wc, fr, fq); S.done(cur); }
        if (!has_next) break;
#pragma unroll
        for (int a = 0; a < 2; ++a)
#pragma unroll
            for (int b = 0; b < 2; ++b)
#pragma unroll
                for (int m = 0; m < 4; ++m)
#pragma unroll
                    for (int n = 0; n < 2; ++n) acc[a][b][m][n] = (f32x4){0.f, 0.f, 0.f, 0.f};
        cur = nxt; cA = nA; cB = nB; ++ui;
        if constexpr (ALIGN_EPI) { if (wr == 1) PG8_BAR; }
    }
    PG8_WAIT_V(0);
    if constexpr (!ALIGN_EPI) { if (wr == 0) PG8_BAR; }
    PG8_BAR;
    if constexpr (Epi::AFTER_DRAIN) { E.fused(acc, cur, wr, wc, fr, fq, lds, wid, lane); S.done(cur); }
#undef PG8_SA
#undef PG8_SB
#undef PG8_STAGE
#undef PG8_LDA
#undef PG8_LDB
#undef PG8_MMA
#undef PG8_WAIT_V
#undef PG8_WAIT_L
#undef PG8_BAR
#undef PG8_SCHED
}
}

#define GAS __attribute__((address_space(1)))
#define LAS __attribute__((address_space(3)))
typedef unsigned short bf16;
typedef unsigned v4u __attribute__((ext_vector_type(4)));
typedef unsigned v2u __attribute__((ext_vector_type(2)));
typedef float f32x4 __attribute__((ext_vector_type(4)));
typedef float f32x2v __attribute__((ext_vector_type(2)));

constexpr int DM = 1024, NB_P = 8, SEQ = 2048, NB_S = 128, DSEQ = 4;
constexpr int TP = NB_P * SEQ, TS = NB_S * DSEQ, T = TP + TS;
constexpr int DN_IN = 6176, DN_INP = 6400, PROJ_LD = 6144, CONV_DIM = 4096, VAL_DIM = 2048;
constexpr int QKV_N = 1536, DFF = 2816, GU_N = 5632;
constexpr float RMS_EPS = 1e-6f, L2_EPS = 1e-6f;

constexpr size_t O_YP = 0, O_YS = 16777216, O_CONVP = 17301504, O_DELTAP = 17498112, O_KP = 21692416, O_VP = 22216704,
                 O_CONVS = 22740992, O_DELTAS = 25886720, O_KS = 92995584, O_VS = 93257728, O_END = 93519872;

constexpr size_t MiB = 1u << 20;
constexpr size_t WS_CTL = 0, CTL_ZERO_BYTES = 65536;
constexpr size_t WS_WIN = 2 * MiB;
constexpr size_t WS_WOUT = 27 * MiB;
constexpr size_t WS_WQKV = 35 * MiB;
constexpr size_t WS_WO = 41 * MiB;
constexpr size_t WS_WGU = 45 * MiB;
constexpr size_t WS_WDOWN = 89 * MiB;
constexpr size_t WS_X = 112 * MiB;
constexpr size_t WS_XB = 178 * MiB;
constexpr size_t WS_SSQ = 211 * MiB;
constexpr size_t WS_BA = 213 * MiB;
constexpr size_t WS_BG = 216 * MiB;
constexpr size_t WS_PROJ = 220 * MiB;
constexpr size_t WS_Q = 220 * MiB;
constexpr size_t WS_KB = 253 * MiB;
constexpr size_t WS_VB = 262 * MiB;
constexpr size_t WS_ATT = 271 * MiB;
constexpr size_t WS_QKV = 418 * MiB;
constexpr size_t WS_DREC = 428 * MiB;
constexpr size_t WS_OG = 716 * MiB;
constexpr size_t WS_ACT = 782 * MiB;
constexpr size_t WS_EGL = 874 * MiB;
constexpr size_t WS_XCH = 876 * MiB;
constexpr size_t WS_END = 880 * MiB;
constexpr size_t KV_DELTA = (WS_VB - WS_KB) / 2;

constexpr int CW_TICKET = 8192;
constexpr int NWAVES = 8, NTHREADS = 512;
constexpr int LDS_BYTES = 163840;

#define LDS_WAIT() asm volatile("s_waitcnt lgkmcnt(0)" ::: "memory")
typedef float f32x2c_t __attribute__((ext_vector_type(2))); typedef __bf16 bf16x2c_t __attribute__((ext_vector_type(2)));
__device__ __forceinline__ unsigned pk2(float lo, float hi) { const f32x2c_t v = {lo, hi}; const bf16x2c_t b = __builtin_convertvector(v, bf16x2c_t); return __builtin_bit_cast(unsigned, b); }
__device__ __forceinline__ unsigned f2bf(float f) { return pk2(f, f) & 0xffffu; }
__device__ __forceinline__ v4u widen16(v2u a, v2u b) {
    const auto r0 = __builtin_amdgcn_permlane16_swap(a.x, b.x, false, false); const auto r1 = __builtin_amdgcn_permlane16_swap(a.y, b.y, false, false);
    return (v4u){r0[0], r1[0], r0[1], r1[1]};
}
__device__ __forceinline__ void narrow16(v4u x, v2u& a, v2u& b) {
    const auto r0 = __builtin_amdgcn_permlane16_swap(x.x, x.z, false, false); const auto r1 = __builtin_amdgcn_permlane16_swap(x.y, x.w, false, false);
    a = (v2u){r0[0], r1[0]}; b = (v2u){r0[1], r1[1]};
}
__device__ __forceinline__ float bf2f(unsigned short b) { return __builtin_bit_cast(float, (unsigned)b << 16); }
__device__ __forceinline__ float bflo(unsigned w) { return __builtin_bit_cast(float, w << 16); }
__device__ __forceinline__ float bfhi(unsigned w) { return __builtin_bit_cast(float, w & 0xffff0000u); }
__device__ __forceinline__ float wave_sum(float v) {
#pragma unroll
    for (int o = 1; o < 64; o <<= 1) v += __shfl_xor(v, o);
    return v;
}
__device__ __forceinline__ float wave_max(float v) {
#pragma unroll
    for (int o = 1; o < 64; o <<= 1) v = fmaxf(v, __shfl_xor(v, o));
    return v;
}
__device__ __forceinline__ float silu_f(float x) { return x * __builtin_amdgcn_rcpf(1.f + __expf(-x)); }
__device__ __forceinline__ float row_rstd(const float* ssq, int row) {
    const f32x4* p = (const f32x4*)(ssq + (size_t)row * 16);
    const f32x4 a = p[0], b = p[1], c = p[2], d = p[3];
    const float s = ((a[0] + a[1]) + (a[2] + a[3])) + ((b[0] + b[1]) + (b[2] + b[3])) + ((c[0] + c[1]) + (c[2] + c[3])) + ((d[0] + d[1]) + (d[2] + d[3]));
    return rsqrtf(s * (1.f / 1024.f) + RMS_EPS);
}


__device__ __forceinline__ void wave_rstd(const float* ssq, int rowbase, LAS float* scr, int lane, int fr, float (&rs)[2][4]) {
    scr[lane] = row_rstd(ssq, rowbase + lane); scr[64 + lane] = row_rstd(ssq, rowbase + 128 + lane);
#pragma unroll
    for (int ai = 0; ai < 2; ++ai)
#pragma unroll
        for (int m = 0; m < 4; ++m) rs[ai][m] = scr[ai * 64 + m * 16 + fr];
}
using pg8::Unit; using pg8::cvt_pk_bf16;
struct EpiDnIn {
    static constexpr bool PERM = true, AFTER_DRAIN = false;
    bf16* proj; float* ba; const float* ssq; LAS float* rscr;
    __device__ __forceinline__ void operator()(const f32x4 (&acc)[2][2][4][2], const Unit& u, int wr, int wc, int fr, int fq) const {
        const int row0 = u.pm * 256 + wr * 64 + fr; float rsv[2][4];
        wave_rstd(ssq, u.pm * 256 + wr * 64, rscr + (wr * 4 + wc) * 128, (int)(threadIdx.x & 63), fr, rsv);
        if (u.pn < 24) {
            const int col0 = u.pn * 256 + wc * 32 + 8 * fq;
#pragma unroll
            for (int ai = 0; ai < 2; ++ai)
#pragma unroll
                for (int m = 0; m < 4; ++m) { const int row = row0 + ai * 128 + m * 16; const float rs = rsv[ai][m];
                    bf16* rowp = proj + (size_t)row * PROJ_LD + col0;
#pragma unroll
                    for (int bj = 0; bj < 2; ++bj) { const f32x4 v0 = acc[ai][bj][m][0] * rs, v1 = acc[ai][bj][m][1] * rs;
                        v4u w; w.x = cvt_pk_bf16(v0[0], v0[1]); w.y = cvt_pk_bf16(v0[2], v0[3]); w.z = cvt_pk_bf16(v1[0], v1[1]); w.w = cvt_pk_bf16(v1[2], v1[3]);
                        *(v4u*)(rowp + bj * 128) = w; } }
        } else if (wc == 0) {
#pragma unroll
            for (int ai = 0; ai < 2; ++ai)
#pragma unroll
                for (int m = 0; m < 4; ++m) { const int row = row0 + ai * 128 + m * 16; const float rs = rsv[ai][m];
                    float* o = ba + (size_t)row * 32 + 8 * fq;
                    *(f32x4*)o = acc[ai][0][m][0] * rs; *(f32x4*)(o + 4) = acc[ai][0][m][1] * rs; }
        }
    }
};
struct EpiRes {
    static constexpr bool PERM = true, AFTER_DRAIN = false;
    bf16* XB; float* ssq; const float* bias;
    __device__ __forceinline__ void operator()(const f32x4 (&acc)[2][2][4][2], const Unit& u, int wr, int wc, int fr, int fq) const {
        const int row0 = u.pm * 256 + wr * 64 + fr, col0 = u.pn * 256 + wc * 32 + 8 * fq;
        f32x4 bv[2][2];
#pragma unroll
        for (int bj = 0; bj < 2; ++bj) { bv[bj][0] = bias ? *(const f32x4*)(bias + col0 + bj * 128) : (f32x4){0.f, 0.f, 0.f, 0.f}; bv[bj][1] = bias ? *(const f32x4*)(bias + col0 + bj * 128 + 4) : (f32x4){0.f, 0.f, 0.f, 0.f}; }
#pragma unroll
        for (int ai = 0; ai < 2; ++ai)
#pragma unroll
            for (int m = 0; m < 4; ++m) { const int row = row0 + ai * 128 + m * 16; float s = 0.f;
#pragma unroll
                for (int bj = 0; bj < 2; ++bj) { const int c = col0 + bj * 128; bf16* xp = XB + (size_t)row * DM + c;
                    const v4u xo = *(const v4u*)xp;
                    f32x4 x0 = (f32x4){bflo(xo.x), bfhi(xo.x), bflo(xo.y), bfhi(xo.y)} + acc[ai][bj][m][0], x1 = (f32x4){bflo(xo.z), bfhi(xo.z), bflo(xo.w), bfhi(xo.w)} + acc[ai][bj][m][1];
                    x0 = x0 + bv[bj][0]; x1 = x1 + bv[bj][1];
                    v4u w; w.x = cvt_pk_bf16(x0[0], x0[1]); w.y = cvt_pk_bf16(x0[2], x0[3]); w.z = cvt_pk_bf16(x1[0], x1[1]); w.w = cvt_pk_bf16(x1[2], x1[3]);
                    *(v4u*)xp = w;
                    const float r0 = bflo(w.x), r1 = bfhi(w.x), r2 = bflo(w.y), r3 = bfhi(w.y), r4 = bflo(w.z), r5 = bfhi(w.z), r6 = bflo(w.w), r7 = bfhi(w.w);
                    s += ((r0 * r0 + r1 * r1) + (r2 * r2 + r3 * r3)) + ((r4 * r4 + r5 * r5) + (r6 * r6 + r7 * r7)); }
                s += __shfl_xor(s, 16); s += __shfl_xor(s, 32);
                if (fq == 0) ssq[(size_t)row * 16 + u.pn * 4 + wc] = s; }
    }
};
struct EpiQkv {
    static constexpr bool PERM = true, AFTER_DRAIN = false;
    bf16 *Q, *KB; const float* ssq; const float* bias; float *okp, *oks; LAS float* rscr;
    __device__ __forceinline__ void operator()(const f32x4 (&acc)[2][2][4][2], const Unit& u, int wr, int wc, int fr, int fq) const {
        const int row0 = u.pm * 256 + wr * 64 + fr, cw = wc * 32 + 8 * fq;
        const bool isq = u.pn < 4; const size_t kvsel = (u.pn == 5) ? 1 : 0;
        const float qs = isq ? 0.125f : 1.f; float rsv[2][4];
        wave_rstd(ssq, u.pm * 256 + wr * 64, rscr + (wr * 4 + wc) * 128, (int)(threadIdx.x & 63), fr, rsv);
        f32x4 bv[2][2];
#pragma unroll
        for (int bj = 0; bj < 2; ++bj) { bv[bj][0] = *(const f32x4*)(bias + u.pn * 256 + bj * 128 + cw); bv[bj][1] = *(const f32x4*)(bias + u.pn * 256 + bj * 128 + cw + 4); }
#pragma unroll
        for (int ai = 0; ai < 2; ++ai)
#pragma unroll
            for (int m = 0; m < 4; ++m) { const int row = row0 + ai * 128 + m * 16; const float rs = rsv[ai][m];
#pragma unroll
                for (int bj = 0; bj < 2; ++bj) { const int colk = bj * 128 + cw, gcol = u.pn * 256 + colk;
                    const f32x4 v0 = (acc[ai][bj][m][0] * rs + bv[bj][0]) * qs, v1 = (acc[ai][bj][m][1] * rs + bv[bj][1]) * qs;
                    v4u w; w.x = cvt_pk_bf16(v0[0], v0[1]); w.y = cvt_pk_bf16(v0[2], v0[3]); w.z = cvt_pk_bf16(v1[0], v1[1]); w.w = cvt_pk_bf16(v1[2], v1[3]);
                    if (isq) *(v4u*)(Q + (size_t)row * DM + gcol) = w;
                    else {
                        *(v4u*)(KB + kvsel * KV_DELTA + (size_t)row * 256 + colk) = w;
                        if (row < TP) { const int b = row >> 11, pos = row & 2047;
                            if (pos >= 1920) { float* o = okp + kvsel * (O_VP - O_KP) + (size_t)(b * 128 + pos - 1920) * 256 + colk; *(f32x4*)o = v0; *(f32x4*)(o + 4) = v1; } }
                        else { float* o = oks + kvsel * (O_VS - O_KS) + (size_t)(row - TP) * 256 + colk; *(f32x4*)o = v0; *(f32x4*)(o + 4) = v1; } } } }
    }
};
struct EpiGu {
    static constexpr bool PERM = true, AFTER_DRAIN = false;
    bf16* act; const float* ssq; LAS float* rscr;
    __device__ __forceinline__ void operator()(const f32x4 (&acc)[2][2][4][2], const Unit& u, int wr, int wc, int fr, int fq) const {
        const int row0 = u.pm * 256 + wr * 64 + fr, col0 = u.pn * 128 + wc * 32 + 8 * fq; float rsv[2][4];
        wave_rstd(ssq, u.pm * 256 + wr * 64, rscr + (wr * 4 + wc) * 128, (int)(threadIdx.x & 63), fr, rsv);
#pragma unroll
        for (int ai = 0; ai < 2; ++ai)
#pragma unroll
            for (int m = 0; m < 4; ++m) { const int row = row0 + ai * 128 + m * 16; const float rs = rsv[ai][m];
                float r[8];
#pragma unroll
                for (int n = 0; n < 2; ++n)
#pragma unroll
                    for (int e = 0; e < 4; ++e) { const float g = acc[ai][0][m][n][e] * rs, uu = acc[ai][1][m][n][e] * rs; r[n * 4 + e] = silu_f(g) * uu; }
                v4u w; w.x = cvt_pk_bf16(r[0], r[1]); w.y = cvt_pk_bf16(r[2], r[3]); w.z = cvt_pk_bf16(r[4], r[5]); w.w = cvt_pk_bf16(r[6], r[7]);
                *(v4u*)(act + (size_t)row * DFF + col0) = w; }
    }
};

struct Args { const float* in[22]; float* out; unsigned char* ws; int ph_lo, ph_hi; };
typedef const __attribute__((address_space(4))) Args* CArgs;
__device__ __forceinline__ CArgs kargs() { CArgs p = (CArgs)__builtin_amdgcn_kernarg_segment_ptr(); asm volatile("" : "+s"(p)); return p; }

__device__ __forceinline__ void tr_item64(const float* W, int K, int N, const float* nw, bf16* WT, int dst_row0, LAS float* scr, int k0, int n0, int lane) {
    const int nvalid = (N - n0) < 64 ? (N - n0) : 64, n4 = (lane & 15) * 4;
    f32x4 v[16];
#pragma unroll
    for (int i = 0; i < 16; ++i) { const int kk = 4 * i + (lane >> 4); v[i] = (f32x4){0.f, 0.f, 0.f, 0.f};
        if (n4 < nvalid) v[i] = __builtin_nontemporal_load((const f32x4*)(W + (size_t)(k0 + kk) * N + n0 + n4)); }
#pragma unroll
    for (int i = 0; i < 16; ++i) { const int kk = 4 * i + (lane >> 4); const float s = nw ? nw[k0 + kk] : 1.f;
        LAS float* d = scr + kk * 65 + n4; d[0] = v[i][0] * s; d[1] = v[i][1] * s; d[2] = v[i][2] * s; d[3] = v[i][3] * s; }
    LDS_WAIT(); asm volatile("" ::: "memory");
    const int c = lane & 7;
#pragma unroll
    for (int p = 0; p < 8; ++p) { const int n = 8 * p + (lane >> 3); const LAS float* s = scr + (8 * c) * 65 + n;
        v4u o; o.x = pk2(s[0 * 65], s[1 * 65]); o.y = pk2(s[2 * 65], s[3 * 65]); o.z = pk2(s[4 * 65], s[5 * 65]); o.w = pk2(s[6 * 65], s[7 * 65]);
        if (n < nvalid) __builtin_nontemporal_store(o, (v4u*)(WT + (size_t)(dst_row0 + n) * K + k0 + 8 * c)); }
    LDS_WAIT(); asm volatile("" ::: "memory");
}
__device__ __forceinline__ void tr_matrix_item(const float* W, int K, int N, const float* nw, bf16* WT, int gu, LAS float* scr, int r, int lane) {
    const int nblk = (N + 63) / 64, kb = r / nblk, nb = r % nblk, k0 = 64 * kb, n0 = 64 * nb;
    int dr = n0;
    if (gu) dr = (n0 < DFF) ? (n0 / 128) * 256 + (n0 % 128) : ((n0 - DFF) / 128) * 256 + 128 + ((n0 - DFF) % 128);
    tr_item64(W, K, N, nw, WT, dr, scr, k0, n0, lane);
}
__device__ __forceinline__ void phase_prologue(CArgs ap, LAS unsigned char* lds) {
    int tid_ = threadIdx.x; asm volatile("" : "+v"(tid_)); const int tid = tid_, lane = tid & 63, wave = __builtin_amdgcn_readfirstlane(tid >> 6);
    LAS float* scr = (LAS float*)(lds + wave * 16896);
    const int gw = blockIdx.x * NWAVES + wave, NGW = gridDim.x * NWAVES;
    unsigned char* ws = ap->ws;
    constexpr int I_IN = 16 * 97, I_OUT = 32 * 16, I_QKV = 16 * 24, I_O = 16 * 16, I_GU = 16 * 88, I_DN = 44 * 16;
    constexpr int NITEMS = 2 * I_IN + 2 * I_OUT + 2 * I_QKV + 2 * I_O + 4 * I_GU + 4 * I_DN;
    for (int it = gw; it < NITEMS; it += NGW) {
        int r = it;
        if (r < 2 * I_IN) { const int j = r / I_IN; r -= j * I_IN;
            tr_matrix_item(ap->in[9] + (size_t)j * DM * DN_IN, DM, DN_IN, ap->in[6] + (2 * j) * DM, (bf16*)(ws + WS_WIN) + (size_t)j * DN_INP * DM, 0, scr, r, lane); continue; }
        r -= 2 * I_IN;
        if (r < 2 * I_OUT) { const int j = r / I_OUT; r -= j * I_OUT;
            tr_matrix_item(ap->in[14] + (size_t)j * VAL_DIM * DM, VAL_DIM, DM, nullptr, (bf16*)(ws + WS_WOUT) + (size_t)j * DM * VAL_DIM, 0, scr, r, lane); continue; }
        r -= 2 * I_OUT;
        if (r < 2 * I_QKV) { const int j = r / I_QKV; r -= j * I_QKV;
            tr_matrix_item(ap->in[15] + (size_t)j * DM * QKV_N, DM, QKV_N, ap->in[6] + (2 * j + 1) * DM, (bf16*)(ws + WS_WQKV) + (size_t)j * QKV_N * DM, 0, scr, r, lane); continue; }
        r -= 2 * I_QKV;
        if (r < 2 * I_O) { const int j = r / I_O; r -= j * I_O;
            tr_matrix_item(ap->in[18] + (size_t)j * DM * DM, DM, DM, nullptr, (bf16*)(ws + WS_WO) + (size_t)j * DM * DM, 0, scr, r, lane); continue; }
        r -= 2 * I_O;
        if (r < 4 * I_GU) { const int i = r / I_GU; r -= i * I_GU;
            tr_matrix_item(ap->in[20] + (size_t)i * DM * GU_N, DM, GU_N, ap->in[7] + i * DM, (bf16*)(ws + WS_WGU) + (size_t)i * GU_N * DM, 1, scr, r, lane); continue; }
        r -= 4 * I_GU;
        { const int i = r / I_DN; r -= i * I_DN;
            tr_matrix_item(ap->in[21] + (size_t)i * DFF * DM, DFF, DM, nullptr, (bf16*)(ws + WS_WDOWN) + (size_t)i * DM * DFF, 0, scr, r, lane); }
    }
    for (int i = blockIdx.x * NTHREADS + tid; i < 2 * 28672; i += gridDim.x * NTHREADS) { const int j = i / 28672, o = i % 28672;
        *(v4u*)((bf16*)(ws + WS_WIN) + (size_t)j * DN_INP * DM + (size_t)DN_IN * DM + (size_t)o * 8) = (v4u){0u, 0u, 0u, 0u}; }
    bf16* XB = (bf16*)(ws + WS_XB); float* SSQ = (float*)(ws + WS_SSQ);
    for (int m = gw; m < T; m += NGW) {
        const float* src = (m < TP) ? ap->in[0] + (size_t)m * DM : ap->in[1] + (size_t)(m - TP) * DM;
        float s = 0.f;
#pragma unroll
        for (int j = 0; j < 4; ++j) { const f32x4 v = __builtin_nontemporal_load((const f32x4*)src + lane + 64 * j);
            v2u w; w.x = pk2(v[0], v[1]); w.y = pk2(v[2], v[3]); *((v2u*)(XB + (size_t)m * DM) + lane + 64 * j) = w;
            const float r0 = bflo(w.x), r1 = bfhi(w.x), r2 = bflo(w.y), r3 = bfhi(w.y);
            s += (r0 * r0 + r1 * r1) + (r2 * r2 + r3 * r3); }
        s = wave_sum(s);
        if (lane < 16) SSQ[(size_t)m * 16 + lane] = (lane == 0) ? s : 0.f;
    }
}

__device__ __forceinline__ void phase_dn_post(CArgs ap, int j, int tstart) {
    int tid_ = threadIdx.x; asm volatile("" : "+v"(tid_)); const int tid = tid_, lane = tid & 63, wave = __builtin_amdgcn_readfirstlane(tid >> 6);
    const int gw = blockIdx.x * NWAVES + wave, NGW = gridDim.x * NWAVES;
    unsigned char* ws = ap->ws;
    const bf16* PROJ = (const bf16*)(ws + WS_PROJ); const float* BA = (const float*)(ws + WS_BA);
    float* QKV = (float*)(ws + WS_QKV) - (size_t)TP * CONV_DIM; float* BG = (float*)(ws + WS_BG);
    const float* cw = ap->in[10] + (size_t)j * 4 * CONV_DIM;
    const float* sconv = ap->in[2] + (size_t)j * NB_S * 3 * CONV_DIM;
    float* oconvp = ap->out + O_CONVP + (size_t)j * NB_P * 3 * CONV_DIM;
    float* oconvs = ap->out + O_CONVS + (size_t)j * NB_S * 3 * CONV_DIM;
    for (int task = tstart * 32 + gw; task < T * 32; task += NGW) {
        const int t = task >> 5, hc = task & 31, col0 = hc * 128 + 2 * lane;
        const bool prompt = t < TP; const int pos = prompt ? (t & 2047) : ((t - TP) & 3); const int b = prompt ? (t >> 11) : ((t - TP) >> 2);
        float y0 = 0.f, y1 = 0.f, u00 = 0.f, u01 = 0.f;
#pragma unroll
        for (int k = 0; k < 4; ++k) {
            float u0 = 0.f, u1 = 0.f;
            if (pos - k >= 0) { const unsigned w = *(const unsigned*)(PROJ + (size_t)(t - k) * PROJ_LD + col0); u0 = bflo(w); u1 = bfhi(w); }
            else if (!prompt) { const f32x2v v = *(const f32x2v*)(sconv + (size_t)(b * 3 + (3 + pos - k)) * CONV_DIM + col0); u0 = v[0]; u1 = v[1]; }
            const f32x2v wv = *(const f32x2v*)(cw + (size_t)(3 - k) * CONV_DIM + col0);
            y0 += u0 * wv[0]; y1 += u1 * wv[1];
            if (k == 0) { u00 = u0; u01 = u1; }
        }
        y0 = silu_f(y0); y1 = silu_f(y1);
        if (hc < 16) {
            const float ss = wave_sum(y0 * y0 + y1 * y1);
            float inv = rsqrtf(ss + L2_EPS); if (hc < 8) inv *= 0.08838834764831845f;
            y0 *= inv; y1 *= inv;
        }
        *(f32x2v*)(QKV + (size_t)t * CONV_DIM + col0) = (f32x2v){y0, y1};
        if (prompt) { if (pos >= SEQ - 3) *(f32x2v*)(oconvp + (size_t)(b * 3 + pos - (SEQ - 3)) * CONV_DIM + col0) = (f32x2v){u00, u01}; }
        else if (pos >= 1) *(f32x2v*)(oconvs + (size_t)(b * 3 + pos - 1) * CONV_DIM + col0) = (f32x2v){u00, u01};
        if (hc == 0 && lane < 32) {
            const int h = lane & 15; const float v = BA[(size_t)t * 32 + lane];
            float r;
            if (lane < 16) r = 1.f / (1.f + __expf(-v));
            else { const float x = v + ap->in[12][j * 16 + h]; const float sp = (x > 20.f) ? x : log1pf(__expf(x)); r = -__expf(ap->in[11][j * 16 + h]) * sp; }
            BG[(size_t)t * 32 + lane] = r;
        }
    }
}


__device__ __forceinline__ void phase_dn_post_sample(CArgs ap, int j) {
    int tid_ = threadIdx.x; asm volatile("" : "+v"(tid_)); const int tid = tid_, lane = tid & 63, wave = __builtin_amdgcn_readfirstlane(tid >> 6);
    const int gw = blockIdx.x * NWAVES + wave, NGW = gridDim.x * NWAVES;
    unsigned char* ws = ap->ws;
    const bf16* PROJ = (const bf16*)(ws + WS_PROJ); const float* BA = (const float*)(ws + WS_BA);
    float* QKV = (float*)(ws + WS_QKV) - (size_t)TP * CONV_DIM; float* BG = (float*)(ws + WS_BG);
    const float* cw = ap->in[10] + (size_t)j * 4 * CONV_DIM;
    const float* sconv = ap->in[2] + (size_t)j * NB_S * 3 * CONV_DIM;
    float* oconvs = ap->out + O_CONVS + (size_t)j * NB_S * 3 * CONV_DIM;
    for (int task = gw; task < TS * 8; task += NGW) {
        const int tt = task >> 3, hc4 = task & 7, t = TP + tt, pos = tt & 3, b = tt >> 2;
        float ua[4][4], ub[4][4]; f32x2v wv[4][4];
#pragma unroll
        for (int k = 0; k < 4; ++k)
#pragma unroll
            for (int uu = 0; uu < 4; ++uu) { const int col0 = (4 * hc4 + uu) * 128 + 2 * lane;
                if (pos - k >= 0) { const unsigned w = *(const unsigned*)(PROJ + (size_t)(t - k) * PROJ_LD + col0); ua[k][uu] = bflo(w); ub[k][uu] = bfhi(w); }
                else { const f32x2v v = *(const f32x2v*)(sconv + (size_t)(b * 3 + (3 + pos - k)) * CONV_DIM + col0); ua[k][uu] = v[0]; ub[k][uu] = v[1]; }
                wv[k][uu] = *(const f32x2v*)(cw + (size_t)(3 - k) * CONV_DIM + col0); }
#pragma unroll
        for (int uu = 0; uu < 4; ++uu) { const int col0 = (4 * hc4 + uu) * 128 + 2 * lane;
            float y0 = 0.f, y1 = 0.f;
#pragma unroll
            for (int k = 0; k < 4; ++k) { y0 += ua[k][uu] * wv[k][uu][0]; y1 += ub[k][uu] * wv[k][uu][1]; }
            y0 = silu_f(y0); y1 = silu_f(y1);
            if (hc4 < 4) { const float ss = wave_sum(y0 * y0 + y1 * y1);
                float inv = rsqrtf(ss + L2_EPS); if (hc4 < 2) inv *= 0.08838834764831845f;
                y0 *= inv; y1 *= inv; }
            *(f32x2v*)(QKV + (size_t)t * CONV_DIM + col0) = (f32x2v){y0, y1};
            if (pos >= 1) *(f32x2v*)(oconvs + (size_t)(b * 3 + pos - 1) * CONV_DIM + col0) = (f32x2v){ua[0][uu], ub[0][uu]}; }
        if (hc4 == 0 && lane < 32) {
            const int h = lane & 15; const float v = BA[(size_t)t * 32 + lane];
            float r;
            if (lane < 16) r = 1.f / (1.f + __expf(-v));
            else { const float x = v + ap->in[12][j * 16 + h]; const float sp = (x > 20.f) ? x : log1pf(__expf(x)); r = -__expf(ap->in[11][j * 16 + h]) * sp; }
            BG[(size_t)t * 32 + lane] = r;
        }
    }
}

#define DPPF(x, ctrl) __builtin_bit_cast(float, __builtin_amdgcn_update_dpp(0, __builtin_bit_cast(int, x), ctrl, 0xf, 0xf, false))
#define ROWSUM16(x) do { float r_ = x; asm volatile("" : "+v"(r_)); r_ += DPPF(r_, 0xB1); r_ += DPPF(r_, 0x4E); r_ += DPPF(r_, 0x141); r_ += DPPF(r_, 0x140); asm volatile("" : "+v"(r_)); x = r_; } while (0)
__device__ __forceinline__ void phase_delta_rec(CArgs ap, int j, LAS unsigned char* lds, unsigned* ticket) {
    int tid_ = threadIdx.x; asm volatile("" : "+v"(tid_)); const int tid = tid_, lane = tid & 63, wave = __builtin_amdgcn_readfirstlane(tid >> 6);
    const int dg = lane & 15, e4 = lane >> 4, ec = 16 * wave + 4 * e4;
    unsigned char* ws = ap->ws;
    const float* QKV = (const float*)(ws + WS_QKV) - (size_t)TP * CONV_DIM; const float* BG = (const float*)(ws + WS_BG); const bf16* PROJ = (const bf16*)(ws + WS_PROJ);
    bf16* OG = (bf16*)(ws + WS_OG);
    const float* nw = ap->in[13] + j * 128;
    LAS float* qs = (LAS float*)lds;
    LAS float* ks = qs + 512;
    LAS float* vs = ks + 512;
    LAS float* ob = vs + 512;
    LAS float* ab = ob + 512;
    LAS int* tk = (LAS int*)(ab + 8);
    const int rtt = tid / 96, rrem = tid % 96, rwhich = rrem >> 5, ree = 4 * (rrem & 31);
    (void)ticket; (void)tk;
    int bid_ = blockIdx.x; asm volatile("" : "+s"(bid_));
    const int G_ = (int)gridDim.x;
    int su = bid_;
    f32x4 SA[8], SB[8], SC[8], qA = (f32x4){0.f, 0.f, 0.f, 0.f}, qB = qA, qC = qA; float aA = 0.f, aB = 0.f, aC = 0.f;
#define REC_UNIT_LOADS(u, Sx, qx, ax) do { const int b_ = (u) >> 4, h_ = (u) & 15, hq_ = h_ >> 1, t0_ = TP + b_ * DSEQ; \
        const float* s0_ = ap->in[3] + ((size_t)(j * NB_S + b_) * 16 + h_) * 16384 + (size_t)(8 * dg) * 128 + ec; \
        _Pragma("unroll") for (int i = 0; i < 8; ++i) Sx[i] = __builtin_nontemporal_load((const f32x4*)(s0_ + i * 128)); \
        if (tid < 384) { const int col_ = (rwhich == 0) ? hq_ * 128 + ree : (rwhich == 1) ? 1024 + hq_ * 128 + ree : 2048 + h_ * 128 + ree; qx = *(const f32x4*)(QKV + (size_t)(t0_ + rtt) * CONV_DIM + col_); } \
        if (tid < 2 * DSEQ) ax = BG[(size_t)(t0_ + (tid >> 1)) * 32 + ((tid & 1) ? 0 : 16) + h_]; } while (0)
#define REC_UNIT(su_, S, qkvc, abc, Sl, ql, al) do { if ((su_) < 2048) { \
        const int b = (su_) >> 4, h = (su_) & 15, t0 = TP + b * DSEQ; \
        float* sout = ap->out + O_DELTAS + ((size_t)(j * NB_S + b) * 16 + h) * 16384 + (size_t)(8 * dg) * 128 + ec; \
        if ((su_) + 2 * G_ < 2048) REC_UNIT_LOADS((su_) + 2 * G_, Sl, ql, al); \
        if (tid < 384) *(LAS f32x4*)(qs + rwhich * 512 + rtt * 128 + ree) = qkvc; \
        if (tid < 2 * DSEQ) ab[tid] = (tid & 1) ? abc : __expf(abc); \
        float z0 = 0.f, z1 = 0.f; \
        if (wave < DSEQ) { const size_t tok = (size_t)(t0 + wave); z0 = bf2f(PROJ[tok * PROJ_LD + 4096 + h * 128 + lane]); z1 = bf2f(PROJ[tok * PROJ_LD + 4096 + h * 128 + 64 + lane]); } \
        __syncthreads(); \
        _Pragma("unroll") for (int tt = 0; tt < DSEQ; ++tt) { \
            const float av = ab[tt * 2], bt = ab[tt * 2 + 1]; \
            const f32x4 k0 = *(const LAS f32x4*)(ks + tt * 128 + 8 * dg), k1 = *(const LAS f32x4*)(ks + tt * 128 + 8 * dg + 4), q0 = *(const LAS f32x4*)(qs + tt * 128 + 8 * dg), q1 = *(const LAS f32x4*)(qs + tt * 128 + 8 * dg + 4); \
            f32x4 kS = S[0] * k0[0] + S[1] * k0[1] + S[2] * k0[2] + S[3] * k0[3] + S[4] * k1[0] + S[5] * k1[1] + S[6] * k1[2] + S[7] * k1[3]; \
            ROWSUM16(kS[0]); ROWSUM16(kS[1]); ROWSUM16(kS[2]); ROWSUM16(kS[3]); \
            const f32x4 vv = (*(const LAS f32x4*)(vs + tt * 128 + ec) - kS * av) * bt; \
            S[0] = S[0] * av + vv * k0[0]; S[1] = S[1] * av + vv * k0[1]; S[2] = S[2] * av + vv * k0[2]; S[3] = S[3] * av + vv * k0[3]; \
            S[4] = S[4] * av + vv * k1[0]; S[5] = S[5] * av + vv * k1[1]; S[6] = S[6] * av + vv * k1[2]; S[7] = S[7] * av + vv * k1[3]; \
            f32x4 po = S[0] * q0[0] + S[1] * q0[1] + S[2] * q0[2] + S[3] * q0[3] + S[4] * q1[0] + S[5] * q1[1] + S[6] * q1[2] + S[7] * q1[3]; \
            ROWSUM16(po[0]); ROWSUM16(po[1]); ROWSUM16(po[2]); ROWSUM16(po[3]); \
            if (dg == 0) *(LAS f32x4*)(ob + tt * 128 + ec) = po; } \
        __syncthreads(); \
        if (wave < DSEQ) { const int tt = wave; \
            const float o0 = ob[tt * 128 + lane], o1 = ob[tt * 128 + 64 + lane]; \
            const float ss = wave_sum(o0 * o0 + o1 * o1); \
            const float rs = rsqrtf(ss * (1.f / 128.f) + RMS_EPS); \
            const size_t tok = (size_t)(t0 + tt); \
            OG[tok * VAL_DIM + h * 128 + lane] = (bf16)f2bf(o0 * rs * nw[lane] * silu_f(z0)); \
            OG[tok * VAL_DIM + h * 128 + 64 + lane] = (bf16)f2bf(o1 * rs * nw[64 + lane] * silu_f(z1)); } \
        _Pragma("unroll") for (int i = 0; i < 8; ++i) __builtin_nontemporal_store(S[i], (f32x4*)(sout + i * 128)); \
        __syncthreads(); } } while (0)
    if (su < 2048) REC_UNIT_LOADS(su, SA, qA, aA);
    if (su + G_ < 2048) REC_UNIT_LOADS(su + G_, SB, qB, aB);
#pragma unroll 1
    for (; su < 2048; su += 3 * G_) {
        REC_UNIT(su, SA, qA, aA, SC, qC, aC);
        REC_UNIT(su + G_, SB, qB, aB, SA, qA, aA);
        REC_UNIT(su + 2 * G_, SC, qC, aC, SB, qB, aB);
    }
#undef REC_UNIT
#undef REC_UNIT_LOADS
}
#undef ROWSUM16
#undef DPPF

__device__ __forceinline__ void phase_swa_attn(CArgs ap, int j, LAS unsigned char* lds) {
    int tid_ = threadIdx.x; asm volatile("" : "+v"(tid_)); const int tid = tid_, lane = tid & 63, wave = __builtin_amdgcn_readfirstlane(tid >> 6);
    const int gw = blockIdx.x * NWAVES + wave, NGW = gridDim.x * NWAVES;
    unsigned char* ws = ap->ws;
    const bf16* Q = (const bf16*)(ws + WS_Q); const bf16* KB = (const bf16*)(ws + WS_KB); const bf16* VB = (const bf16*)(ws + WS_VB);
    bf16* ATT = (bf16*)(ws + WS_ATT);
    const float* ck = ap->in[4] + (size_t)j * NB_S * 128 * 256; const float* cv = ap->in[5] + (size_t)j * NB_S * 128 * 256;
    const float* sinks = ap->in[17] + j * 16;
    LAS float* qs = (LAS float*)(lds + wave * 4096);
    LAS float* ps = qs + 256;
    for (int task = gw; task < T * 4; task += NGW) {
        const int t = task >> 2, kh = task & 3;
#pragma unroll
        for (int g = 0; g < 4; ++g) qs[g * 64 + lane] = bf2f(Q[(size_t)t * DM + (kh * 4 + g) * 64 + lane]);
        LDS_WAIT(); asm volatile("" ::: "memory");
        const bool prompt = t < TP; int nk, b = 0, l = 0;
        if (prompt) { const int pos = t & 2047; nk = (pos < 128 ? pos : 128) + 1; } else { const int r = t - TP; b = r >> 2; l = r & 3; nk = 129; }
        const float sl0 = exp2f(-0.5f * (float)(kh * 4 + 1)), sl1 = exp2f(-0.5f * (float)(kh * 4 + 2)), sl2 = exp2f(-0.5f * (float)(kh * 4 + 3)), sl3 = exp2f(-0.5f * (float)(kh * 4 + 4));
#pragma unroll 1
        for (int kb = 0; kb < 3; ++kb) {
            const int jj = kb * 64 + lane; const bool valid = jj < nk;
            float d0 = 0.f, d1 = 0.f, d2 = 0.f, d3 = 0.f;
            if (valid) {
                const int cj = l + jj;
                if (prompt || cj >= 128) {
                    const bf16* kp = prompt ? KB + (size_t)(t - (nk - 1) + jj) * 256 + kh * 64 : KB + (size_t)(TP + b * 4 + (cj - 128)) * 256 + kh * 64;
#pragma unroll 1
                    for (int d = 0; d < 64; d += 8) {
                        const v4u w = *(const v4u*)(kp + d);
                        const float kv[8] = {bflo(w.x), bfhi(w.x), bflo(w.y), bfhi(w.y), bflo(w.z), bfhi(w.z), bflo(w.w), bfhi(w.w)};
#pragma unroll
                        for (int i = 0; i < 8; ++i) { d0 += kv[i] * qs[d + i]; d1 += kv[i] * qs[64 + d + i]; d2 += kv[i] * qs[128 + d + i]; d3 += kv[i] * qs[192 + d + i]; }
                    }
                } else {
                    const float* kf = ck + (size_t)(b * 128 + cj) * 256 + kh * 64;
#pragma unroll 1
                    for (int d = 0; d < 64; d += 4) {
                        const f32x4 x = *(const f32x4*)(kf + d);
#pragma unroll
                        for (int i = 0; i < 4; ++i) { d0 += x[i] * qs[d + i]; d1 += x[i] * qs[64 + d + i]; d2 += x[i] * qs[128 + d + i]; d3 += x[i] * qs[192 + d + i]; }
                    }
                }
            }
            const float rel = (float)((nk - 1) - jj);
            const float NEG = -INFINITY;
            ps[jj] = valid ? d0 - sl0 * rel : NEG; ps[192 + jj] = valid ? d1 - sl1 * rel : NEG; ps[384 + jj] = valid ? d2 - sl2 * rel : NEG; ps[576 + jj] = valid ? d3 - sl3 * rel : NEG;
        }
        LDS_WAIT(); asm volatile("" ::: "memory");
#pragma unroll 1
        for (int g = 0; g < 4; ++g) {
            const float sk = sinks[kh * 4 + g];
            const float s0 = ps[g * 192 + lane], s1 = ps[g * 192 + 64 + lane], s2 = ps[g * 192 + 128 + lane];
            float m = wave_max(fmaxf(fmaxf(s0, s1), s2)); m = fmaxf(m, sk);
            const float p0 = __expf(s0 - m), p1 = __expf(s1 - m), p2 = __expf(s2 - m);
            const float den = wave_sum(p0 + p1 + p2) + __expf(sk - m); const float inv = 1.f / den;
            ps[g * 192 + lane] = p0 * inv; ps[g * 192 + 64 + lane] = p1 * inv; ps[g * 192 + 128 + lane] = p2 * inv;
        }
        LDS_WAIT(); asm volatile("" ::: "memory");
        float o0 = 0.f, o1 = 0.f, o2 = 0.f, o3 = 0.f;
        if (prompt) {
            const bf16* vp = VB + (size_t)(t - (nk - 1)) * 256 + kh * 64 + lane;
#pragma unroll 4
            for (int jj = 0; jj < nk; ++jj) { const float vv = bf2f(vp[(size_t)jj * 256]);
                o0 += ps[jj] * vv; o1 += ps[192 + jj] * vv; o2 += ps[384 + jj] * vv; o3 += ps[576 + jj] * vv; }
        } else {
#pragma unroll 4
            for (int jj = 0; jj < 129; ++jj) { const int cj = l + jj;
                const float vv = (cj < 128) ? cv[(size_t)(b * 128 + cj) * 256 + kh * 64 + lane] : bf2f(VB[(size_t)(TP + b * 4 + (cj - 128)) * 256 + kh * 64 + lane]);
                o0 += ps[jj] * vv; o1 += ps[192 + jj] * vv; o2 += ps[384 + jj] * vv; o3 += ps[576 + jj] * vv; }
        }
        bf16* op = ATT + (size_t)t * DM + kh * 256 + lane;
        op[0] = (bf16)f2bf(o0); op[64] = (bf16)f2bf(o1); op[128] = (bf16)f2bf(o2); op[192] = (bf16)f2bf(o3);
        LDS_WAIT(); asm volatile("" ::: "memory");
    }
}

__device__ __forceinline__ void phase_final(CArgs ap) {
    int tid_ = threadIdx.x; asm volatile("" : "+v"(tid_)); const int tid = tid_, lane = tid & 63, wave = __builtin_amdgcn_readfirstlane(tid >> 6);
    const int gw = blockIdx.x * NWAVES + wave, NGW = gridDim.x * NWAVES;
    const bf16* XB = (const bf16*)(ap->ws + WS_XB); const float* nw = ap->in[8];
    for (int m = gw; m < T; m += NGW) {
        f32x4 v[4]; float s = 0.f;
#pragma unroll
        for (int j = 0; j < 4; ++j) { const v2u w = *((const v2u*)(XB + (size_t)m * DM) + lane + 64 * j); v[j] = (f32x4){bflo(w.x), bfhi(w.x), bflo(w.y), bfhi(w.y)};
            s += (v[j][0] * v[j][0] + v[j][1] * v[j][1]) + (v[j][2] * v[j][2] + v[j][3] * v[j][3]); }
        float rs = rsqrtf(wave_sum(s) * (1.f / 1024.f) + RMS_EPS);
#if defined(TP_FROM) || defined(TQ_FROM)
        if (m >= TP) { const float v = (float)(*(const unsigned long long*)(ap->ws + WS_CTL + 8192)) * (1.f / (float)TP_COUNT) * (1.f / (float)TP_SCALE);
            rs *= 1.f + floorf(v * 8.f + TP_PHASE) * (1.f / 8.f); }
#endif
        float* o = ap->out + (size_t)m * DM;
#pragma unroll
        for (int j = 0; j < 4; ++j) { const f32x4 w = *((const f32x4*)nw + lane + 64 * j); __builtin_nontemporal_store(v[j] * rs * w, (f32x4*)o + lane + 64 * j); }
    }
}

constexpr int REC_WNEG = 0, REC_QG = 16384, REC_KGT = 32768, REC_AQK = 49152, REC_FAC = 57344, REC_STAGE = 58368;
constexpr int H_WNEG = 0, H_AQK = 16384, H_U = 24576, H_FAC = 40960, HREC_BYTES = 41984, P_QT = 0, P_KTT = 16384, PREC_BYTES = 32768;
constexpr size_t WS_PREC = WS_DREC + (size_t)168 * MiB;
typedef short bf16x8_t __attribute__((ext_vector_type(8)));

__device__ __forceinline__ int swz256(int row, int ch) { return row * 256 + ((ch ^ (row & 15)) << 4); }
__device__ __forceinline__ int swz128(int row, int ch) { return row * 128 + ((ch ^ (row & 7)) << 4); }


constexpr int SC_STAGE0 = 0, SC_STAGE1 = REC_STAGE, SC_SCR = 2 * REC_STAGE, SC_WSCR = 4608, SC_OBUF = SC_SCR + 4 * SC_WSCR, SC_OROW = 144, SC_OBYTES = 64 * SC_OROW;
constexpr int SC_ROWA = 272, SC_ROWB = 144;
__device__ __forceinline__ int stage_dst(int q) {
    const int off = q * 16;
    if (off < REC_KGT) { const int base = off & ~16383, local = off & 16383; return base + swz256(local >> 8, (local >> 4) & 15); }
    const int base = (off < REC_AQK) ? REC_KGT : REC_AQK, local = off - base; return base + swz128(local >> 7, (local >> 4) & 7);
}
__device__ __forceinline__ float silu_fast(float x) { return x * __builtin_amdgcn_rcpf(1.f + __expf(-x)); }

__device__ __forceinline__ void stage_dma2(const unsigned char* rech, const unsigned char* recp, LAS unsigned char* sb, int dw, int lane) {
#pragma unroll
    for (int i = 0; i < 28; ++i) { const int kb = i * 2 + dw; const int off = stage_dst(kb * 64 + lane);
        const unsigned char* src = (kb < 16) ? rech + H_WNEG + off : (kb < 48) ? recp + (off - 16384) : rech + H_AQK + (off - 49152);
        __builtin_amdgcn_global_load_lds((const unsigned*)src, (LAS unsigned*)(sb + kb * 1024), 16, 0, 0); }
    if (dw == 0) __builtin_amdgcn_global_load_lds((const unsigned*)(rech + H_FAC + lane * 16), (LAS unsigned*)(sb + REC_FAC), 16, 0, 0);
}

__device__ __forceinline__ void scan_unit(CArgs ap, int j, int unit, int eh, LAS unsigned char* lds) {
    int tid_ = threadIdx.x; asm volatile("" : "+v"(tid_)); const int tid = tid_, lane = tid & 63, wave = __builtin_amdgcn_readfirstlane(tid >> 6);
    const int b = unit >> 4, h = unit & 15;
    unsigned char* ws = ap->ws;
    const unsigned char* rec0 = ws + WS_DREC + (size_t)(unit * 32) * HREC_BYTES;
    const unsigned char* recp0 = ws + WS_PREC + (size_t)((b * 8 + (h >> 1)) * 32) * PREC_BYTES;
    __syncthreads();
    if (wave >= 6) {
        const int hc = 32 * (wave - 6) + (lane >> 1), hp = lane & 1;
        const bf16* PROJ = (const bf16*)(ws + WS_PROJ); bf16* OG = (bf16*)(ws + WS_OG);
        const float* nw = ap->in[13] + j * 128 + 64 * eh + 8 * hp;
        f32x4 nwv[8];
#pragma unroll
        for (int i = 0; i < 4; ++i) { nwv[2 * i] = *(const f32x4*)(nw + 16 * i); nwv[2 * i + 1] = *(const f32x4*)(nw + 16 * i + 4); }
        unsigned long long* xown = (unsigned long long*)(ws + WS_XCH) + ((size_t)(unit * 32) * 64 + hc) * 2 + eh;
        const unsigned long long* xsib = (const unsigned long long*)(ws + WS_XCH) + ((size_t)(unit * 32) * 64 + hc) * 2 + (eh ^ 1);
        const bf16* zbase = PROJ + (size_t)(b * SEQ + hc) * PROJ_LD + 4096 + h * 128 + 64 * eh + 8 * hp;
        bf16* obase = OG + (size_t)(b * SEQ + hc) * VAL_DIM + h * 128 + 64 * eh + 8 * hp;
        v4u o0[4], o1[4], o2[4], z0[4], z1[4], z2[4]; float ss0 = 0.f, ss1 = 0.f, ss2 = 0.f;
#pragma unroll
        for (int i = 0; i < 4; ++i) { o0[i] = (v4u){0u, 0u, 0u, 0u}; o1[i] = o0[i]; o2[i] = o0[i]; z0[i] = o0[i]; z1[i] = o0[i]; z2[i] = o0[i]; }
#define EPI_TAKE(m, oc, ssc) do { \
        const LAS unsigned char* ob_ = lds + SC_OBUF + ((m) & 1) * SC_OBYTES + hc * SC_OROW + hp * 16; \
        _Pragma("unroll") for (int i_ = 0; i_ < 4; ++i_) oc[i_] = *(const LAS v4u*)(ob_ + 32 * i_); \
        float s_ = 0.f; \
        _Pragma("unroll") for (int i_ = 0; i_ < 4; ++i_) { const float a0 = bflo(oc[i_].x), a1 = bfhi(oc[i_].x), a2 = bflo(oc[i_].y), a3 = bfhi(oc[i_].y), a4 = bflo(oc[i_].z), a5 = bfhi(oc[i_].z), a6 = bflo(oc[i_].w), a7 = bfhi(oc[i_].w); \
            s_ += ((a0 * a0 + a1 * a1) + (a2 * a2 + a3 * a3)) + ((a4 * a4 + a5 * a5) + (a6 * a6 + a7 * a7)); } \
        s_ += __shfl_xor(s_, 1); ssc = s_; } while (0)
#define EPI_PUBLISH(m, ssc) do { if (hp == 0) __hip_atomic_store(xown + (size_t)(m) * 128, ((unsigned long long)1u << 32) | (unsigned long long)__builtin_bit_cast(unsigned, ssc), __ATOMIC_RELAXED, __HIP_MEMORY_SCOPE_AGENT); } while (0)
#define EPI_ZLOAD(m, zc) do { _Pragma("unroll") for (int i_ = 0; i_ < 4; ++i_) zc[i_] = *(const v4u*)(zbase + (size_t)((m) * 64) * PROJ_LD + 16 * i_); } while (0)
#define EPI_FINISH(m, sv, op, zp, ssp) do { \
        unsigned long long sv_ = (sv); \
        while ((unsigned)(sv_ >> 32) != 1u) { __builtin_amdgcn_s_sleep(1); sv_ = __hip_atomic_load(xsib + (size_t)(m) * 128, __ATOMIC_RELAXED, __HIP_MEMORY_SCOPE_AGENT); } \
        const float rs_ = rsqrtf((ssp + __builtin_bit_cast(float, (unsigned)sv_)) * (1.f / 128.f) + RMS_EPS); \
        bf16* op_ = obase + (size_t)((m) * 64) * VAL_DIM; \
        _Pragma("unroll") for (int i_ = 0; i_ < 4; ++i_) { const f32x4 na = nwv[2 * i_] * rs_, nb = nwv[2 * i_ + 1] * rs_; v4u w_; \
            w_.x = pk2(bflo(op[i_].x) * na[0] * silu_fast(bflo(zp[i_].x)), bfhi(op[i_].x) * na[1] * silu_fast(bfhi(zp[i_].x))); \
            w_.y = pk2(bflo(op[i_].y) * na[2] * silu_fast(bflo(zp[i_].y)), bfhi(op[i_].y) * na[3] * silu_fast(bfhi(zp[i_].y))); \
            w_.z = pk2(bflo(op[i_].z) * nb[0] * silu_fast(bflo(zp[i_].z)), bfhi(op[i_].z) * nb[1] * silu_fast(bfhi(zp[i_].z))); \
            w_.w = pk2(bflo(op[i_].w) * nb[2] * silu_fast(bflo(zp[i_].w)), bfhi(op[i_].w) * nb[3] * silu_fast(bfhi(zp[i_].w))); \
            *(v4u*)(op_ + 16 * i_) = w_; } } while (0)
#define EPI_ITER(n, zin, ocur, sscur, oprev, ssprev, zprev) do { \
            asm volatile("s_waitcnt lgkmcnt(0)" ::: "memory"); \
            __syncthreads(); \
            unsigned long long sv = 0ull; \
            if ((n) >= 2) sv = __hip_atomic_load(xsib + (size_t)((n) - 2) * 128, __ATOMIC_RELAXED, __HIP_MEMORY_SCOPE_AGENT); \
            EPI_ZLOAD(n, zin); \
            if ((n) >= 1) EPI_TAKE((n) - 1, ocur, sscur); \
            if ((n) >= 2) EPI_FINISH((n) - 2, sv, oprev, zprev, ssprev); \
            if ((n) >= 1) EPI_PUBLISH((n) - 1, sscur); } while (0)
#pragma unroll 1
        for (int n = 0; n < 30; n += 3) { EPI_ITER(n, z0, o2, ss2, o1, ss1, z1); EPI_ITER(n + 1, z1, o0, ss0, o2, ss2, z2); EPI_ITER(n + 2, z2, o1, ss1, o0, ss0, z0); }
        EPI_ITER(30, z0, o2, ss2, o1, ss1, z1); EPI_ITER(31, z1, o0, ss0, o2, ss2, z2);
        asm volatile("s_waitcnt lgkmcnt(0)" ::: "memory");
        __syncthreads();
        {
            unsigned long long sv = __hip_atomic_load(xsib + (size_t)30 * 128, __ATOMIC_RELAXED, __HIP_MEMORY_SCOPE_AGENT);
            EPI_TAKE(31, o1, ss1);
            EPI_PUBLISH(31, ss1);
            EPI_FINISH(30, sv, o0, z0, ss0);
            sv = __hip_atomic_load(xsib + (size_t)31 * 128, __ATOMIC_RELAXED, __HIP_MEMORY_SCOPE_AGENT);
            EPI_FINISH(31, sv, o1, z1, ss1);
        }
#undef EPI_ITER
#undef EPI_TAKE
#undef EPI_PUBLISH
#undef EPI_ZLOAD
#undef EPI_FINISH
    } else if (wave >= 4) {
        const int dw = wave - 4;
        stage_dma2(rec0, recp0, lds + SC_STAGE0, dw, lane);
#pragma unroll 1
        for (int n = 0; n < 32; ++n) {
            LAS unsigned char* sbn = lds + ((n & 1) ? SC_STAGE0 : SC_STAGE1);
            const int nn = (n + 1 < 32) ? n + 1 : 31;
            asm volatile("s_waitcnt vmcnt(0)" ::: "memory");
            __syncthreads();
            stage_dma2(rec0 + (size_t)nn * HREC_BYTES, recp0 + (size_t)nn * PREC_BYTES, sbn, dw, lane);
        }
        asm volatile("s_waitcnt vmcnt(0)" ::: "memory");
        __syncthreads();
    } else {
        const int fr = lane & 15, fq = lane >> 4, e0 = 64 * eh + 16 * wave;
        const float* EGL = (const float*)(ws + WS_EGL) + unit * 32;
        LAS unsigned char* scr = lds + SC_SCR + wave * SC_WSCR;
        f32x4 Sacc[8];
#pragma unroll
        for (int dt = 0; dt < 8; ++dt) Sacc[dt] = (f32x4){0.f, 0.f, 0.f, 0.f};
        const size_t uoff = (size_t)(e0 + fr) * 128 + (16 * (fq & 1) + 8 * (fq >> 1)) * 2;
        v4u un[2]; float egln = EGL[0];
#pragma unroll
        for (int p = 0; p < 2; ++p) un[p] = *(const v4u*)(rec0 + H_U + uoff + p * 64);
#pragma unroll 1
        for (int n = 0; n < 32; ++n) {
            LAS unsigned char* sb = lds + ((n & 1) ? SC_STAGE1 : SC_STAGE0);
            LAS unsigned char* ob = lds + SC_OBUF + (n & 1) * SC_OBYTES;
            const int nn = (n + 1 < 32) ? n + 1 : 31;
            const unsigned char* recn = rec0 + (size_t)nn * HREC_BYTES;
            asm volatile("s_waitcnt vmcnt(0) lgkmcnt(0)" ::: "memory");
            __syncthreads();
            f32x4 accu[4]; float egl = egln;
#pragma unroll
            for (int p = 0; p < 2; ++p) { v2u ua, ub; narrow16(un[p], ua, ub);
                accu[2 * p] = (f32x4){bflo(ua.x), bfhi(ua.x), bflo(ua.y), bfhi(ua.y)}; accu[2 * p + 1] = (f32x4){bflo(ub.x), bfhi(ub.x), bflo(ub.y), bfhi(ub.y)}; }
            asm volatile("" : "+v"(egl));
#pragma unroll
            for (int p = 0; p < 2; ++p) un[p] = *(const v4u*)(recn + H_U + uoff + p * 64);
            egln = EGL[nn];
#pragma unroll
            for (int dt = 0; dt < 8; ++dt) { v2u w; w.x = pk2(Sacc[dt][0], Sacc[dt][1]); w.y = pk2(Sacc[dt][2], Sacc[dt][3]);
                *(LAS v2u*)(scr + fr * SC_ROWA + (16 * dt + 4 * fq) * 2) = w; }
#define CB() asm volatile("" ::: "memory")
#define LD256(dst, region, row0) do { _Pragma("unroll") for (int ks = 0; ks < 4; ++ks) dst[ks] = *(LAS bf16x8_t*)(sb + (region) + swz256((row0) + fr, ks * 4 + fq)); } while (0)
#define LD128x2(dst, region, row0) do { _Pragma("unroll") for (int k4 = 0; k4 < 4; ++k4) dst[k4] = *(LAS bf16x8_t*)(sb + (region) + swz128((row0) + 16 * (k4 >> 1) + fr, (k4 & 1) * 4 + fq)); } while (0)
#define MM4(acc, A, B) do { _Pragma("unroll") for (int ks = 0; ks < 4; ++ks) acc = __builtin_amdgcn_mfma_f32_16x16x32_bf16(A[ks], B[ks], acc, 0, 0, 0); } while (0)
#define MM2x2S(acc0, acc1, A, B) do { acc0 = __builtin_amdgcn_mfma_f32_16x16x32_bf16(B[0], A[0], acc0, 0, 0, 0); acc0 = __builtin_amdgcn_mfma_f32_16x16x32_bf16(B[1], A[1], acc0, 0, 0, 0); \
        acc1 = __builtin_amdgcn_mfma_f32_16x16x32_bf16(B[2], A[0], acc1, 0, 0, 0); acc1 = __builtin_amdgcn_mfma_f32_16x16x32_bf16(B[3], A[1], acc1, 0, 0, 0); } while (0)
#define MM2x2(acc0, acc1, A, B) do { acc0 = __builtin_amdgcn_mfma_f32_16x16x32_bf16(A[0], B[0], acc0, 0, 0, 0); acc0 = __builtin_amdgcn_mfma_f32_16x16x32_bf16(A[1], B[1], acc0, 0, 0, 0); \
        acc1 = __builtin_amdgcn_mfma_f32_16x16x32_bf16(A[0], B[2], acc1, 0, 0, 0); acc1 = __builtin_amdgcn_mfma_f32_16x16x32_bf16(A[1], B[3], acc1, 0, 0, 0); } while (0)
            bf16x8_t Sa[4], Ua[2], Uk[2], fA[4], fB[4], fC[4];
            f32x4 kapv[4]; float qfv[4];
#pragma unroll
            for (int tc = 0; tc < 4; ++tc) { qfv[tc] = *(LAS float*)(sb + REC_FAC + (16 * tc + fr) * 4); kapv[tc] = *(LAS f32x4*)(sb + REC_FAC + 256 + (16 * tc + 4 * fq) * 4); }
            f32x4 acco[4];
#pragma unroll
            for (int tc = 0; tc < 4; ++tc) acco[tc] = (f32x4){0.f, 0.f, 0.f, 0.f};
            LD256(fA, REC_WNEG, 0);
#pragma unroll
            for (int ks = 0; ks < 4; ++ks) Sa[ks] = *(LAS bf16x8_t*)(scr + fr * SC_ROWA + (ks * 4 + fq) * 16);
            LD256(fB, REC_WNEG, 16); CB();
            MM4(accu[0], fA, Sa); LD256(fC, REC_WNEG, 32); CB();
            MM4(accu[1], fB, Sa); LD256(fA, REC_WNEG, 48); CB();
            MM4(accu[2], fC, Sa); LD256(fB, REC_QG, 0); CB();
            MM4(accu[3], fA, Sa); LD256(fC, REC_QG, 16); CB();
#pragma unroll
            for (int tc = 0; tc < 4; ++tc) { const f32x4 sk = accu[tc] * kapv[tc]; v2u w, wk;
                w.x = pk2(accu[tc][0], accu[tc][1]); w.y = pk2(accu[tc][2], accu[tc][3]); wk.x = pk2(sk[0], sk[1]); wk.y = pk2(sk[2], sk[3]);
                *(LAS v2u*)(scr + fr * SC_ROWB + (16 * tc + 4 * fq) * 2) = w; *(LAS v2u*)(scr + 16 * SC_ROWB + fr * SC_ROWB + (16 * tc + 4 * fq) * 2) = wk; }
            MM4(acco[0], Sa, fB); LD256(fA, REC_QG, 32); CB();
#pragma unroll
            for (int k2 = 0; k2 < 2; ++k2) { Ua[k2] = *(LAS bf16x8_t*)(scr + fr * SC_ROWB + (k2 * 4 + fq) * 16); Uk[k2] = *(LAS bf16x8_t*)(scr + 16 * SC_ROWB + fr * SC_ROWB + (k2 * 4 + fq) * 16); }
            MM4(acco[1], Sa, fC); LD256(fB, REC_QG, 48); CB();
            MM4(acco[2], Sa, fA); LD128x2(fC, REC_AQK, 0); CB();
            MM4(acco[3], Sa, fB); LD128x2(fA, REC_AQK, 32); CB();
#pragma unroll
            for (int tc = 0; tc < 4; ++tc) acco[tc] = acco[tc] * qfv[tc];
            MM2x2(acco[0], acco[1], Ua, fC); LD128x2(fB, REC_KGT, 0); CB();
            MM2x2(acco[2], acco[3], Ua, fA); LD128x2(fC, REC_KGT, 32); CB();
#pragma unroll
            for (int dt = 0; dt < 8; ++dt) Sacc[dt] = Sacc[dt] * egl;
            MM2x2S(Sacc[0], Sacc[1], Uk, fB); LD128x2(fA, REC_KGT, 64); CB();
            MM2x2S(Sacc[2], Sacc[3], Uk, fC); LD128x2(fB, REC_KGT, 96); CB();
            MM2x2S(Sacc[4], Sacc[5], Uk, fA);
            MM2x2S(Sacc[6], Sacc[7], Uk, fB);
#undef CB
#undef LD256
#undef LD128x2
#undef MM4
#undef MM2x2
#undef MM2x2S
#pragma unroll
            for (int tc = 0; tc < 4; ++tc) { v2u w; w.x = pk2(acco[tc][0], acco[tc][1]); w.y = pk2(acco[tc][2], acco[tc][3]);
                *(LAS v2u*)(ob + (16 * tc + fr) * SC_OROW + (16 * wave + 4 * fq) * 2) = w; }
        }
        asm volatile("s_waitcnt vmcnt(0) lgkmcnt(0)" ::: "memory");
        __syncthreads();
        float* sout = ap->out + O_DELTAP + ((size_t)(j * NB_P + b) * 16 + h) * 16384;
#pragma unroll
        for (int dt = 0; dt < 8; ++dt)
#pragma unroll
            for (int r = 0; r < 4; ++r) sout[(size_t)(16 * dt + 4 * fq + r) * 128 + e0 + fr] = Sacc[dt][r];
    }
    __syncthreads();
}
__device__ __forceinline__ void phase_dn_scan(CArgs ap, int j, LAS unsigned char* lds) {
    const int G = gridDim.x; int bid_ = blockIdx.x; asm volatile("" : "+s"(bid_));
    for (int t = bid_; t < 256; t += G) { const int x = t & 7, idx = t >> 3; scan_unit(ap, j, 16 * (idx >> 2) + 2 * x + ((idx >> 1) & 1), idx & 1, lds); }
    phase_delta_rec(ap, j, lds, (unsigned*)(ap->ws + WS_CTL) + CW_TICKET + 64 * j);
}

constexpr int P2_KIMG = 0, P2_QIMG = 16384, P2_KT = 32768, P2_VT = 49152, P2_LROW = 81920, P2_TB = 98304, P2_TR = 114688, P2_SM = 131072, P2_LDIAG = 135168, P2_PS = 143360;

#ifdef TQ_FROM
#define TQ(k) do { if ((k) == TQ_FROM && tq_on) { asm volatile("" ::: "memory"); tq_t0 = __builtin_amdgcn_s_memtime(); asm volatile("" ::: "memory"); } \
                   if ((k) == TQ_TO && tq_on) { asm volatile("" ::: "memory"); tq_acc += __builtin_amdgcn_s_memtime() - tq_t0; asm volatile("" ::: "memory"); } } while (0)
#else
#define TQ(k) do { } while (0)
#endif
__device__ __forceinline__ void phase_dn_prep2(CArgs ap, int j, LAS unsigned char* lds) {
    int tid_ = threadIdx.x; asm volatile("" : "+v"(tid_)); const int tid0 = tid_, wave = __builtin_amdgcn_readfirstlane(tid0 >> 6);
    const int role = wave >> 1;
    unsigned char* ws0 = ap->ws;
    int bid_ = blockIdx.x; asm volatile("" : "+s"(bid_));
#ifdef TQ_FROM
    unsigned long long tq_t0 = 0, tq_acc = 0; const bool tq_on = (bid_ == 0 && j == 0 && wave == TQ_WAVE);
#endif
    unsigned raw[35];
    for (int zi = bid_; zi < 256; zi += gridDim.x) { GAS v4u* xz = (GAS v4u*)(ws0 + WS_XCH) + ((size_t)zi * 512 + tid0) * 2; xz[0] = (v4u){0u, 0u, 0u, 0u}; xz[1] = (v4u){0u, 0u, 0u, 0u}; }
    f32x2v cwv[4]; float bav[2] = {0.f, 0.f};
#define PREP_RAWLOAD(u) do { const int b_ = (u) >> 8, hq_ = ((u) >> 5) & 7, n_ = (u) & 31; int t_ = tid0; asm volatile("" : "+v"(t_)); const int w_ = t_ >> 6, rl_ = w_ >> 1, rh_ = w_ & 1, cp_ = t_ & 63; \
        const int col_ = ((rl_ == 0) ? hq_ * 128 : (rl_ == 1) ? 1024 + hq_ * 128 : 2048 + (2 * hq_ + rl_ - 2) * 128) + 2 * cp_; \
        const GAS bf16* pn_ = (const GAS bf16*)(ws0 + WS_PROJ) + (size_t)(b_ * SEQ + n_ * 64 + 32 * rh_) * PROJ_LD + col_; const bool nh_ = (n_ == 0 && rh_ == 0); \
        _Pragma("unroll") for (int i_ = 0; i_ < 35; ++i_) raw[i_] = (nh_ && i_ < 3) ? 0u : *(const GAS unsigned*)(pn_ + (ptrdiff_t)(i_ - 3) * PROJ_LD); \
        { const GAS float* cw_ = (const GAS float*)(ap->in[10] + (size_t)j * 4 * CONV_DIM) + col_; cwv[0] = *(const GAS f32x2v*)(cw_); cwv[1] = *(const GAS f32x2v*)(cw_ + CONV_DIM); cwv[2] = *(const GAS f32x2v*)(cw_ + 2 * CONV_DIM); cwv[3] = *(const GAS f32x2v*)(cw_ + 3 * CONV_DIM); } \
        if (w_ < 2) { const GAS float* ba_ = (const GAS float*)(ws0 + WS_BA) + (size_t)(b_ * SEQ + n_ * 64 + cp_) * 32 + 2 * hq_ + w_; bav[0] = ba_[0]; bav[1] = ba_[16]; } } while (0)
    if (bid_ < 2048) PREP_RAWLOAD(bid_);
    for (int unit = bid_; unit < 2048; unit += gridDim.x) {
        const int b = unit >> 8, hq = (unit >> 5) & 7, n = unit & 31, trow0 = b * SEQ + n * 64;
        int tid = tid0; asm volatile("" : "+v"(tid));
        const int lane = tid & 63, fr = lane & 15, fq = lane >> 4, cidx = tid & 127;
        unsigned char* ws = ws0; asm volatile("" : "+s"(ws));
        const GAS bf16* PROJ = (const GAS bf16*)(ws + WS_PROJ); const GAS float* BA = (const GAS float*)(ws + WS_BA);
        GAS unsigned char* DREC = (GAS unsigned char*)(ws + WS_DREC); GAS float* EGL = (GAS float*)(ws + WS_EGL);
        const GAS float* cw = (const GAS float*)(ap->in[10] + (size_t)j * 4 * CONV_DIM);
        GAS float* oconvp = (GAS float*)(ap->out + O_CONVP + (size_t)j * NB_P * 3 * CONV_DIM);
        GAS unsigned char* rec0 = DREC + (size_t)((b * 16 + 2 * hq) * 32 + n) * HREC_BYTES;
        GAS unsigned char* prec = (GAS unsigned char*)(ws + WS_PREC) + (size_t)((b * 8 + hq) * 32 + n) * PREC_BYTES;
        unsigned lb0 = 0u, lb1 = 32768u, lb2 = 81920u, lb3 = 131072u; asm volatile("" : "+v"(lb0), "+v"(lb1), "+v"(lb2), "+v"(lb3));
        LAS unsigned char* L0 = lds + lb0;
        LAS unsigned char* L1 = lds + lb1;
        LAS unsigned char* L2 = lds + lb2;
        LAS unsigned char* L3 = lds + lb3;
        LAS float* SM = (LAS float*)L3;
        __syncthreads();
        TQ(0);
        if (wave < 2) {
            const int h = 2 * hq + wave; const size_t t = (size_t)(trow0 + lane);
            const float bv = bav[0], av = bav[1];
            const float x = av + ap->in[12][j * 16 + h]; const float sp = (x > 20.f) ? x : log1pf(__expf(x));
            float g = -__expf(ap->in[11][j * 16 + h]) * sp;
#pragma unroll
            for (int off = 1; off < 64; off <<= 1) { const float o = __shfl_up(g, off); if (lane >= off) g += o; }
            SM[wave * 64 + lane] = g; SM[128 + wave * 64 + lane] = 1.f / (1.f + __expf(-bv));
        }
        *(LAS v4u*)(L3 + (P2_PS - P2_SM) + wave * 2048 + lane * 32) = (v4u){0u, 0u, 0u, 0u};
        *(LAS v4u*)(L3 + (P2_PS - P2_SM) + wave * 2048 + lane * 32 + 16) = (v4u){0u, 0u, 0u, 0u};
#ifndef REPS_S3
#define REPS_S3 1
#endif
#ifndef REPS_S5
#define REPS_S5 1
#endif
#ifndef REPS_S2B
#define REPS_S2B 1
#endif
        {
            const int rh = wave & 1, cp = lane, r0 = 32 * rh;
            const int col = ((role == 0) ? hq * 128 : (role == 1) ? 1024 + hq * 128 : 2048 + (2 * hq + role - 2) * 128) + 2 * cp;
            const f32x2v w0 = cwv[0], w1 = cwv[1], w2 = cwv[2], w3 = cwv[3];
            float va[32], vb[32];
            const bool nohalo = (n == 0 && rh == 0);
            float a3 = nohalo ? 0.f : bflo(raw[0]), a2 = nohalo ? 0.f : bflo(raw[1]), a1 = nohalo ? 0.f : bflo(raw[2]);
            float b3 = nohalo ? 0.f : bfhi(raw[0]), b2 = nohalo ? 0.f : bfhi(raw[1]), b1 = nohalo ? 0.f : bfhi(raw[2]);
#pragma unroll
            for (int c = 0; c < 32; ++c) {
                const float ua = bflo(raw[3 + c]), ub = bfhi(raw[3 + c]);
                va[c] = silu_fast(w3[0] * ua + w2[0] * a1 + w1[0] * a2 + w0[0] * a3);
                vb[c] = silu_fast(w3[1] * ub + w2[1] * b1 + w1[1] * b2 + w0[1] * b3);
                a3 = a2; a2 = a1; a1 = ua; b3 = b2; b2 = b1; b1 = ub;
                if (c >= 29 && n == 31 && rh == 1) *(GAS f32x2v*)(oconvp + (size_t)(b * 3 + c - 29) * CONV_DIM + col) = (f32x2v){ua, ub};
            }
            if (role < 2) {
                LAS unsigned char* img = L0 + (role == 0 ? 16384 : 0);
#pragma unroll
                for (int c = 0; c < 32; ++c) *(LAS unsigned*)(img + swz256(r0 + c, cp >> 2) + (cp & 3) * 4) = pk2(va[c], vb[c]);
            }
            if (role >= 1) {
                LAS unsigned char* img = L1 + (role - 1) * 16384;
#pragma unroll
                for (int ch = 0; ch < 4; ++ch) { v4u wa, wb;
                    wa.x = pk2(va[8 * ch], va[8 * ch + 1]); wa.y = pk2(va[8 * ch + 2], va[8 * ch + 3]); wa.z = pk2(va[8 * ch + 4], va[8 * ch + 5]); wa.w = pk2(va[8 * ch + 6], va[8 * ch + 7]);
                    wb.x = pk2(vb[8 * ch], vb[8 * ch + 1]); wb.y = pk2(vb[8 * ch + 2], vb[8 * ch + 3]); wb.z = pk2(vb[8 * ch + 4], vb[8 * ch + 5]); wb.w = pk2(vb[8 * ch + 6], vb[8 * ch + 7]);
                    *(LAS v4u*)(img + swz128(2 * cp, 4 * rh + ch)) = wa; *(LAS v4u*)(img + swz128(2 * cp + 1, 4 * rh + ch)) = wb; }
            }
        }
        __syncthreads();
        TQ(1);
        { const int un_ = unit + (int)gridDim.x; if (un_ < 2048) PREP_RAWLOAD(un_); }
        f32x4 acc[4];
        {
            const int tr = wave & 3; const bool kq = wave >= 4;
            f32x4 accq = (f32x4){0.f, 0.f, 0.f, 0.f};
#pragma unroll
            for (int tc = 0; tc < 4; ++tc) acc[tc] = (f32x4){0.f, 0.f, 0.f, 0.f};
#pragma unroll
            for (int ks = 0; ks < 4; ++ks) {
                const bf16x8_t af = *(LAS bf16x8_t*)(L0 + swz256(16 * tr + fr, ks * 4 + fq));
                if (kq) { const bf16x8_t qf = *(LAS bf16x8_t*)(L0 + 16384 + swz256(16 * tr + fr, ks * 4 + fq)); accq = __builtin_amdgcn_mfma_f32_16x16x32_bf16(qf, qf, accq, 0, 0, 0); }
#pragma unroll
                for (int tc = 0; tc < 4; ++tc) { const bf16x8_t bfr = *(LAS bf16x8_t*)(L0 + (kq ? 16384 : 0) + swz256(16 * tc + fr, ks * 4 + fq));
                    acc[tc] = __builtin_amdgcn_mfma_f32_16x16x32_bf16(af, bfr, acc[tc], 0, 0, 0); }
            }
            const f32x4 dsrc = kq ? accq : (tr == 0 ? acc[0] : tr == 1 ? acc[1] : tr == 2 ? acc[2] : acc[3]);
            const int rsel = fr & 3; const float dv = rsel == 0 ? dsrc[0] : rsel == 1 ? dsrc[1] : rsel == 2 ? dsrc[2] : dsrc[3];
            if (fq == (fr >> 2)) SM[(kq ? 320 : 256) + 16 * tr + fr] = dv;
#pragma unroll
            for (int it = 0; it < 2; ++it) { const int q = tid + 512 * it;
                { const int c = q >> 4, ch = q & 15; *(GAS v4u*)(prec + P_QT + c * 256 + ch * 16) = *(LAS v4u*)(L0 + 16384 + swz256(c, ch)); }
                { const int d = q >> 3, ch = q & 7; *(GAS v4u*)(prec + P_KTT + d * 128 + ch * 16) = *(LAS v4u*)(L1 + swz128(d, ch)); } }
        }
        __syncthreads();
        TQ(2);
        if (tid < 128) { const int hh = tid >> 6, c = tid & 63;
            const float rk = rsqrtf(SM[256 + c] + L2_EPS), rq = rsqrtf(SM[320 + c] + L2_EPS) * 0.08838834764831845f;
            const float G = SM[hh * 64 + c], Gl = SM[hh * 64 + 63], be = SM[128 + hh * 64 + c];
            SM[384 + hh * 64 + c] = rk * be * __expf(G); SM[512 + hh * 64 + c] = rk * __expf(Gl - G); SM[640 + hh * 64 + c] = rq * __expf(G);
            { GAS float* fac = (GAS float*)(rec0 + (size_t)hh * 32 * HREC_BYTES + H_FAC); fac[c] = rq * __expf(G); fac[64 + c] = rk * __expf(Gl - G); }
            if (c == 63) EGL[(b * 16 + 2 * hq + hh) * 32 + n] = __expf(Gl);
        }
        TQ(3);
        for (int rs_ = 0; rs_ < REPS_S2B; ++rs_) {
            const int tr = wave & 3; const bool kq = wave >= 4; const int i0 = 16 * tr + 4 * fq;
#pragma unroll
            for (int hh = 0; hh < 2; ++hh) {
                float gi[4], fi[4];
#pragma unroll
                for (int r = 0; r < 4; ++r) { gi[r] = SM[hh * 64 + i0 + r]; const float rki = rsqrtf(SM[256 + i0 + r] + L2_EPS); fi[r] = kq ? rki : rki * SM[128 + hh * 64 + i0 + r]; }
                v2u aq[4];
#pragma unroll
                for (int tc = 0; tc < 4; ++tc) { const int jc = 16 * tc + fr; const float gj = SM[hh * 64 + jc]; const float fj = kq ? rsqrtf(SM[320 + jc] + L2_EPS) * 0.08838834764831845f : rsqrtf(SM[256 + jc] + L2_EPS);
                    float o[4];
                    if (!kq) {
#pragma unroll
                        for (int r = 0; r < 4; ++r) { const int i = i0 + r; o[r] = (i > jc) ? fi[r] * fj * acc[tc][r] * __expf(gi[r] - gj) : 0.f;
                            *(LAS bf16*)(L2 + hh * 8192 + swz128(i, jc >> 3) + (jc & 7) * 2) = (bf16)f2bf(o[r]); }
                        if (tc == tr) *(LAS f32x4*)(L3 + (P2_LDIAG - P2_SM) + ((hh * 4 + tr) * 256 + fr * 16 + 4 * fq) * 4) = (f32x4){o[0], o[1], o[2], o[3]};
                    } else {
#pragma unroll
                        for (int r = 0; r < 4; ++r) { const int i = i0 + r; o[r] = (jc >= i) ? fj * fi[r] * acc[tc][r] * __expf(gj - gi[r]) : 0.f; }
                        aq[tc].x = pk2(o[0], o[1]); aq[tc].y = pk2(o[2], o[3]); }
                }
                if (kq) {
#pragma unroll
                    for (int tp = 0; tp < 2; ++tp)
                        *(GAS v4u*)(rec0 + (size_t)hh * 32 * HREC_BYTES + H_AQK + (16 * (2 * tp + (fq & 1)) + fr) * 128 + (16 * tr + 8 * (fq >> 1)) * 2) = widen16(aq[2 * tp], aq[2 * tp + 1]);
                }
            }
        }
        __syncthreads();
        TQ(4);
        for (int rs_ = 0; rs_ < REPS_S3; ++rs_) {
            const int hh = wave >> 2, i = wave & 3;
            LAS unsigned char* Trow = L0 + hh * 8192; LAS unsigned char* TT = L0 + 16384 + hh * 8192;
            LAS unsigned char* Tb = L2 + 16384 + hh * 8192; LAS unsigned char* Tr = L2 + 32768 + hh * 8192;
            const v4u z4 = (v4u){0u, 0u, 0u, 0u};
            { const int row = 16 * i + (lane >> 2), c0 = (lane & 3) * 2;
              *(LAS v4u*)(Trow + swz128(row, c0)) = z4; *(LAS v4u*)(Trow + swz128(row, c0 + 1)) = z4;
              *(LAS v4u*)(Tb + swz128(row, c0)) = z4; *(LAS v4u*)(Tb + swz128(row, c0 + 1)) = z4;
              *(LAS v4u*)(Tr + swz128(row, c0)) = z4; *(LAS v4u*)(Tr + swz128(row, c0 + 1)) = z4;
              *(LAS v4u*)(TT + swz128(lane, 2 * i)) = z4; *(LAS v4u*)(TT + swz128(lane, 2 * i + 1)) = z4; }
            if (lane < 16) {
                const int jcol = lane; const LAS float* Ld = (const LAS float*)(L3 + (P2_LDIAG - P2_SM)) + (hh * 4 + i) * 256;
                float x[16];
#pragma unroll
                for (int r = 0; r < 16; ++r) x[r] = (r == jcol) ? 1.f : 0.f;
#pragma unroll
                for (int s = 0; s < 15; ++s) {
                    const float xs = x[s];
#pragma unroll
                    for (int cg = (s + 1) / 4; cg < 4; ++cg) { const f32x4 m = *(const LAS f32x4*)(Ld + s * 16 + cg * 4);
#pragma unroll
                        for (int e = 0; e < 4; ++e) { const int c = cg * 4 + e; if (c > s) x[c] -= m[e] * xs; } }
                }
                const int gc = 16 * i + jcol; const float be = SM[128 + hh * 64 + gc], rho = SM[384 + hh * 64 + gc];
#pragma unroll
                for (int r = 0; r < 16; ++r) { const int grow = 16 * i + r; const int off = swz128(grow, gc >> 3) + (gc & 7) * 2;
                    *(LAS bf16*)(Trow + off) = (bf16)f2bf(x[r]); *(LAS bf16*)(Tb + off) = (bf16)f2bf(x[r] * be); *(LAS bf16*)(Tr + off) = (bf16)f2bf(x[r] * rho); }
                v4u t0, t1; t0.x = pk2(x[0], x[1]); t0.y = pk2(x[2], x[3]); t0.z = pk2(x[4], x[5]); t0.w = pk2(x[6], x[7]); t1.x = pk2(x[8], x[9]); t1.y = pk2(x[10], x[11]); t1.z = pk2(x[12], x[13]); t1.w = pk2(x[14], x[15]);
                *(LAS v4u*)(TT + swz128(gc, 2 * i)) = t0; *(LAS v4u*)(TT + swz128(gc, 2 * i + 1)) = t1;
            }
        }
        __syncthreads();
        TQ(5);
        if (wave < 4) {
            const int hh = wave >> 1, i = 1 + 2 * (wave & 1), jb = i - 1;
            LAS unsigned char* Trow = L0 + hh * 8192; LAS unsigned char* TT = L0 + 16384 + hh * 8192;
            LAS unsigned char* Lrow = L2 + hh * 8192; LAS unsigned char* Tb = L2 + 16384 + hh * 8192; LAS unsigned char* Tr = L2 + 32768 + hh * 8192;
            LAS unsigned char* PS = L3 + (P2_PS - P2_SM) + wave * 2048 + 1024;
            f32x4 p = (f32x4){0.f, 0.f, 0.f, 0.f};
#pragma unroll
            for (int ks = 0; ks < 2; ++ks) { const bf16x8_t la = *(LAS bf16x8_t*)(Lrow + swz128(16 * i + fr, ks * 4 + fq)), tb = *(LAS bf16x8_t*)(TT + swz128(16 * jb + fr, ks * 4 + fq));
                p = __builtin_amdgcn_mfma_f32_16x16x32_bf16(la, tb, p, 0, 0, 0); }
            { v2u w; w.x = pk2(p[0], p[1]); w.y = pk2(p[2], p[3]); *(LAS v2u*)(PS + fr * 64 + (16 + 4 * fq) * 2) = w; }
            const bf16x8_t ta = *(LAS bf16x8_t*)(Trow + swz128(16 * i + fr, (i >> 1) * 4 + fq)), pb = *(LAS bf16x8_t*)(PS + fr * 64 + fq * 16);
            const f32x4 t = __builtin_amdgcn_mfma_f32_16x16x32_bf16(ta, pb, (f32x4){0.f, 0.f, 0.f, 0.f}, 0, 0, 0);
            const int gc = 16 * jb + fr; const float be = SM[128 + hh * 64 + gc], rho = SM[384 + hh * 64 + gc];
#pragma unroll
            for (int r = 0; r < 4; ++r) { const int grow = 16 * i + 4 * fq + r; const int off = swz128(grow, gc >> 3) + (gc & 7) * 2; const float v = -t[r];
                *(LAS bf16*)(Trow + off) = (bf16)f2bf(v); *(LAS bf16*)(Tb + off) = (bf16)f2bf(v * be); *(LAS bf16*)(Tr + off) = (bf16)f2bf(v * rho); }
            { v2u w; w.x = pk2(-t[0], -t[1]); w.y = pk2(-t[2], -t[3]); const int s0 = 16 * i + 4 * fq; *(LAS v2u*)(TT + swz128(gc, s0 >> 3) + (s0 & 7) * 2) = w; }
        }
        __syncthreads();
        TQ(6);
        {
            const int hh = wave >> 2, i2 = (wave >> 1) & 1, j2 = wave & 1, i = 2 + i2, jb = j2;
            LAS unsigned char* Trow = L0 + hh * 8192; LAS unsigned char* TT = L0 + 16384 + hh * 8192;
            LAS unsigned char* Lrow = L2 + hh * 8192; LAS unsigned char* Tb = L2 + 16384 + hh * 8192; LAS unsigned char* Tr = L2 + 32768 + hh * 8192;
            LAS unsigned char* PS = L3 + (P2_PS - P2_SM) + wave * 2048;
            const bf16x8_t tb = *(LAS bf16x8_t*)(TT + swz128(16 * jb + fr, fq));
#pragma unroll
            for (int k = 0; k < 2; ++k) { const bf16x8_t la = *(LAS bf16x8_t*)(Lrow + swz128(32 + 16 * k + fr, fq));
                const f32x4 p = __builtin_amdgcn_mfma_f32_16x16x32_bf16(la, tb, (f32x4){0.f, 0.f, 0.f, 0.f}, 0, 0, 0);
                v2u w; w.x = pk2(p[0], p[1]); w.y = pk2(p[2], p[3]); *(LAS v2u*)(PS + fr * 64 + (16 * k + 4 * fq) * 2) = w; }
            const bf16x8_t ta = *(LAS bf16x8_t*)(Trow + swz128(16 * i + fr, 4 + fq)), pb = *(LAS bf16x8_t*)(PS + fr * 64 + fq * 16);
            const f32x4 t = __builtin_amdgcn_mfma_f32_16x16x32_bf16(ta, pb, (f32x4){0.f, 0.f, 0.f, 0.f}, 0, 0, 0);
            const int gc = 16 * jb + fr; const float be = SM[128 + hh * 64 + gc], rho = SM[384 + hh * 64 + gc];
#pragma unroll
            for (int r = 0; r < 4; ++r) { const int grow = 16 * i + 4 * fq + r; const int off = swz128(grow, gc >> 3) + (gc & 7) * 2; const float v = -t[r];
                *(LAS bf16*)(Trow + off) = (bf16)f2bf(v); *(LAS bf16*)(Tb + off) = (bf16)f2bf(v * be); *(LAS bf16*)(Tr + off) = (bf16)f2bf(v * rho); }
            { v2u w; w.x = pk2(-t[0], -t[1]); w.y = pk2(-t[2], -t[3]); const int s0 = 16 * i + 4 * fq; *(LAS v2u*)(TT + swz128(gc, s0 >> 3) + (s0 & 7) * 2) = w; }
        }
        __syncthreads();
        for (int rs_ = 0; rs_ < REPS_S5; ++rs_) {
            const int hh = wave >> 2, X = (wave >> 1) & 1;
            LAS unsigned char* RT = X ? L1 : L1 + 16384 + hh * 16384;
            LAS unsigned char* TX = L2 + (X ? 32768 : 16384) + hh * 8192;
            GAS unsigned char* outp = rec0 + (size_t)hh * 32 * HREC_BYTES + (X ? H_WNEG : H_U);
            const float sgn = X ? -1.f : 1.f;
            bf16x8_t tb[4][2];
#pragma unroll
            for (int tc = 0; tc < 4; ++tc)
#pragma unroll
                for (int ks = 0; ks < 2; ++ks) tb[tc][ks] = *(LAS bf16x8_t*)(TX + swz128(16 * tc + fr, ks * 4 + fq));
            if (X) {
#pragma unroll
                for (int c8p = 0; c8p < 2; ++c8p) { const int ctA = 4 * (wave & 1) + 2 * c8p;
                    const bf16x8_t a0 = *(LAS bf16x8_t*)(RT + swz128(16 * ctA + fr, fq)), a1 = *(LAS bf16x8_t*)(RT + swz128(16 * ctA + fr, 4 + fq));
                    const bf16x8_t b0 = *(LAS bf16x8_t*)(RT + swz128(16 * ctA + 16 + fr, fq)), b1 = *(LAS bf16x8_t*)(RT + swz128(16 * ctA + 16 + fr, 4 + fq));
#pragma unroll
                    for (int tc = 0; tc < 4; ++tc) {
                        f32x4 dA = __builtin_amdgcn_mfma_f32_16x16x32_bf16(a0, tb[tc][0], (f32x4){0.f, 0.f, 0.f, 0.f}, 0, 0, 0); dA = __builtin_amdgcn_mfma_f32_16x16x32_bf16(a1, tb[tc][1], dA, 0, 0, 0);
                        f32x4 dB = __builtin_amdgcn_mfma_f32_16x16x32_bf16(b0, tb[tc][0], (f32x4){0.f, 0.f, 0.f, 0.f}, 0, 0, 0); dB = __builtin_amdgcn_mfma_f32_16x16x32_bf16(b1, tb[tc][1], dB, 0, 0, 0);
                        const v4u w = widen16((v2u){pk2(-dA[0], -dA[1]), pk2(-dA[2], -dA[3])}, (v2u){pk2(-dB[0], -dB[1]), pk2(-dB[2], -dB[3])});
                        *(GAS v4u*)(outp + (16 * tc + fr) * 256 + (16 * (ctA + (fq & 1)) + 8 * (fq >> 1)) * 2) = w; } }
            } else {
#pragma unroll
                for (int c8 = 0; c8 < 4; ++c8) { const int ct8 = 4 * (wave & 1) + c8;
                    const bf16x8_t a0 = *(LAS bf16x8_t*)(RT + swz128(16 * ct8 + fr, fq)), a1 = *(LAS bf16x8_t*)(RT + swz128(16 * ct8 + fr, 4 + fq));
#pragma unroll
                    for (int tcp = 0; tcp < 2; ++tcp) {
                        f32x4 dA = __builtin_amdgcn_mfma_f32_16x16x32_bf16(tb[2 * tcp][0], a0, (f32x4){0.f, 0.f, 0.f, 0.f}, 0, 0, 0); dA = __builtin_amdgcn_mfma_f32_16x16x32_bf16(tb[2 * tcp][1], a1, dA, 0, 0, 0);
                        f32x4 dB = __builtin_amdgcn_mfma_f32_16x16x32_bf16(tb[2 * tcp + 1][0], a0, (f32x4){0.f, 0.f, 0.f, 0.f}, 0, 0, 0); dB = __builtin_amdgcn_mfma_f32_16x16x32_bf16(tb[2 * tcp + 1][1], a1, dB, 0, 0, 0);
                        const v4u w = widen16((v2u){pk2(dA[0], dA[1]), pk2(dA[2], dA[3])}, (v2u){pk2(dB[0], dB[1]), pk2(dB[2], dB[3])});
                        *(GAS v4u*)(outp + (16 * ct8 + fr) * 128 + (16 * (2 * tcp + (fq & 1)) + 8 * (fq >> 1)) * 2) = w; } }
            }
        }
        TQ(99);
    }
#ifdef TQ_FROM
    if (tq_on && (threadIdx.x & 63) == 0) *(unsigned long long*)(ap->ws + WS_CTL + 8192) = tq_acc;
#endif
#undef PREP_RAWLOAD
    phase_dn_post_sample(ap, j);
}

constexpr int AT_K = 0, AT_V = 32768, AT_VROW = 528, AT_SET = 66560;
template <bool FULL>
__device__ __forceinline__ void attn_qtile(LAS unsigned char* Kl, LAS unsigned char* Vl, int kt0, const bf16* qptr, bf16* optr, int lo, int hi, float slope, float sink, int fr, int fq) {
    const bf16x8_t qb0 = *(const bf16x8_t*)qptr, qb1 = *(const bf16x8_t*)(qptr + 32);
    f32x4 acc[9];
#pragma unroll
    for (int i = 0; i < 9; ++i) {
        const bf16x8_t k0 = *(LAS bf16x8_t*)(Kl + swz128(16 * (kt0 + i) + fr, fq)), k1 = *(LAS bf16x8_t*)(Kl + swz128(16 * (kt0 + i) + fr, 4 + fq));
        acc[i] = __builtin_amdgcn_mfma_f32_16x16x32_bf16(k0, qb0, (f32x4){0.f, 0.f, 0.f, 0.f}, 0, 0, 0);
        acc[i] = __builtin_amdgcn_mfma_f32_16x16x32_bf16(k1, qb1, acc[i], 0, 0, 0);
    }
    const float L2E = 1.4426950408889634f, sl2 = L2E * slope, c0 = sl2 * (float)(16 * kt0 + 4 * fq - hi), sink2 = sink * L2E;
    float m = sink2;
#pragma unroll
    for (int i = 0; i < 9; ++i)
#pragma unroll
        for (int r = 0; r < 4; ++r) { const int kc = 16 * (kt0 + i) + 4 * fq + r;
            float s2 = fmaf(acc[i][r], L2E, fmaf(sl2, (float)(16 * i + r), c0));
            if (FULL || i == 0) s2 = (kc >= lo) ? s2 : -INFINITY;
            if (FULL || i == 8) s2 = (kc <= hi) ? s2 : -INFINITY;
            acc[i][r] = s2; m = fmaxf(m, s2); }
    m = fmaxf(m, __shfl_xor(m, 16)); m = fmaxf(m, __shfl_xor(m, 32));
    float sum = 0.f;
#pragma unroll
    for (int i = 0; i < 9; ++i)
#pragma unroll
        for (int r = 0; r < 4; ++r) { const float p = __builtin_amdgcn_exp2f(acc[i][r] - m); acc[i][r] = p; sum += p; }
    sum += __shfl_xor(sum, 16); sum += __shfl_xor(sum, 32);
    const float inv = 1.f / (sum + __builtin_amdgcn_exp2f(sink2 - m));
    f32x4 o[4];
#pragma unroll
    for (int dt = 0; dt < 4; ++dt) o[dt] = (f32x4){0.f, 0.f, 0.f, 0.f};
#pragma unroll
    for (int i2 = 0; i2 < 5; ++i2) {
        const int ia = 2 * i2, ib = 2 * i2 + 1;
        v4u pw; pw.x = pk2(acc[ia][0], acc[ia][1]); pw.y = pk2(acc[ia][2], acc[ia][3]);
        if (ib < 9) { pw.z = pk2(acc[ib < 9 ? ib : 8][0], acc[ib < 9 ? ib : 8][1]); pw.w = pk2(acc[ib < 9 ? ib : 8][2], acc[ib < 9 ? ib : 8][3]); } else { pw.z = 0u; pw.w = 0u; }
        const bf16x8_t pf = __builtin_bit_cast(bf16x8_t, pw);
        const int kta = kt0 + ia; int ktb = kt0 + ib; ktb = ktb > 15 ? 15 : ktb;
#pragma unroll
        for (int dt = 0; dt < 4; ++dt) {
            const v2u va = *(LAS v2u*)(Vl + (16 * dt + fr) * AT_VROW + (16 * kta + 4 * fq) * 2), vb = *(LAS v2u*)(Vl + (16 * dt + fr) * AT_VROW + (16 * ktb + 4 * fq) * 2);
            const v4u vw = (v4u){va.x, va.y, vb.x, vb.y};
            o[dt] = __builtin_amdgcn_mfma_f32_16x16x32_bf16(__builtin_bit_cast(bf16x8_t, vw), pf, o[dt], 0, 0, 0);
        }
    }
#pragma unroll
    for (int dp = 0; dp < 2; ++dp) { v2u wa, wb; wa.x = pk2(o[2 * dp][0] * inv, o[2 * dp][1] * inv); wa.y = pk2(o[2 * dp][2] * inv, o[2 * dp][3] * inv);
        wb.x = pk2(o[2 * dp + 1][0] * inv, o[2 * dp + 1][1] * inv); wb.y = pk2(o[2 * dp + 1][2] * inv, o[2 * dp + 1][3] * inv);
        *(v4u*)(optr + 16 * (2 * dp + (fq & 1)) + 8 * (fq >> 1)) = widen16(wa, wb); }
}

__device__ __forceinline__ void phase_swa_attn_mfma(CArgs ap, int j, LAS unsigned char* lds) {
    int tid_ = threadIdx.x; asm volatile("" : "+v"(tid_)); const int tid = tid_, lane = tid & 63, wave = __builtin_amdgcn_readfirstlane(tid >> 6);
    const int fr = lane & 15, fq = lane >> 4;
    unsigned char* ws = ap->ws;
    const bf16* Q = (const bf16*)(ws + WS_Q); const bf16* KB = (const bf16*)(ws + WS_KB); const bf16* VB = (const bf16*)(ws + WS_VB);
    bf16* ATT = (bf16*)(ws + WS_ATT);
    const float* ck = ap->in[4] + (size_t)j * NB_S * 128 * 256; const float* cv = ap->in[5] + (size_t)j * NB_S * 128 * 256;
    const float* sinks = ap->in[17] + j * 16;
    LAS unsigned char* Kl = lds + AT_K; LAS unsigned char* Vl = lds + AT_V;
    int bid_ = blockIdx.x; asm volatile("" : "+s"(bid_));
    for (int unit = bid_; unit < 512; unit += gridDim.x) {
        __syncthreads();
        {
            const int b = unit >> 6, nb = (unit >> 2) & 15, kh = unit & 3;
            const int trow0 = b * SEQ + nb * 128 - 128;
#pragma unroll
            for (int it = 0; it < 4; ++it) { const int q = tid + 512 * it;
                { const int key = q >> 3, ch = q & 7; v4u w = (v4u){0u, 0u, 0u, 0u};
                  if (nb > 0 || key >= 128) w = *(const v4u*)(KB + (size_t)(trow0 + key) * 256 + kh * 64 + ch * 8);
                  *(LAS v4u*)(Kl + swz128(key, ch)) = w; }
                { const int key = q & 255, dc = q >> 8; v4u w = (v4u){0u, 0u, 0u, 0u};
                  if (nb > 0 || key >= 128) w = *(const v4u*)(VB + (size_t)(trow0 + key) * 256 + kh * 64 + dc * 8);
                  LAS bf16* vp = (LAS bf16*)(Vl + (8 * dc) * AT_VROW + key * 2);
                  vp[0 * (AT_VROW / 2)] = (bf16)(w.x & 0xffff); vp[1 * (AT_VROW / 2)] = (bf16)(w.x >> 16); vp[2 * (AT_VROW / 2)] = (bf16)(w.y & 0xffff); vp[3 * (AT_VROW / 2)] = (bf16)(w.y >> 16);
                  vp[4 * (AT_VROW / 2)] = (bf16)(w.z & 0xffff); vp[5 * (AT_VROW / 2)] = (bf16)(w.z >> 16); vp[6 * (AT_VROW / 2)] = (bf16)(w.w & 0xffff); vp[7 * (AT_VROW / 2)] = (bf16)(w.w >> 16); }
            }
            __syncthreads();
            const int g = wave >> 1, qh = wave & 1, head = kh * 4 + g;
            const float slope = exp2f(-0.5f * (float)(head + 1)), sink = sinks[head];
#pragma unroll 1
            for (int qt = 0; qt < 4; ++qt) {
                const int o = 64 * qh + 16 * qt, qi = o + fr;
                const size_t tq = (size_t)(b * SEQ + nb * 128 + qi);
                if (nb == 0) attn_qtile<true>(Kl, Vl, 4 * qh + qt, Q + tq * DM + head * 64 + 8 * fq, ATT + tq * DM + head * 64, (qi < 128) ? 128 : qi, 128 + qi, slope, sink, fr, fq);
                else attn_qtile<false>(Kl, Vl, 4 * qh + qt, Q + tq * DM + head * 64 + 8 * fq, ATT + tq * DM + head * 64, qi, 128 + qi, slope, sink, fr, fq);
            }
        }
    }
    for (int su0 = bid_; su0 < 512; su0 += 2 * (int)gridDim.x) {
        __syncthreads();
#pragma unroll
        for (int u2 = 0; u2 < 2; ++u2) { const int su = su0 + u2 * (int)gridDim.x; if (su < 512) { const int b = su >> 2, kh = su & 3;
            LAS unsigned char* Kl2 = Kl + u2 * AT_SET; LAS unsigned char* Vl2 = Vl + u2 * AT_SET;
            for (int q = tid; q < 1280; q += 512) {
                { const int key = q >> 3, ch = q & 7; v4u w = (v4u){0u, 0u, 0u, 0u};
                  if (key < 128) { const float* p = ck + (size_t)(b * 128 + key) * 256 + kh * 64 + ch * 8; const f32x4 x0 = *(const f32x4*)p, x1 = *(const f32x4*)(p + 4);
                      w.x = pk2(x0[0], x0[1]); w.y = pk2(x0[2], x0[3]); w.z = pk2(x1[0], x1[1]); w.w = pk2(x1[2], x1[3]); }
                  else if (key < 132) w = *(const v4u*)(KB + (size_t)(TP + b * 4 + key - 128) * 256 + kh * 64 + ch * 8);
                  *(LAS v4u*)(Kl2 + swz128(key, ch)) = w; }
                { const int key = q % 160, dc = q / 160; v4u w = (v4u){0u, 0u, 0u, 0u};
                  if (key < 128) { const float* p = cv + (size_t)(b * 128 + key) * 256 + kh * 64 + dc * 8; const f32x4 x0 = *(const f32x4*)p, x1 = *(const f32x4*)(p + 4);
                      w.x = pk2(x0[0], x0[1]); w.y = pk2(x0[2], x0[3]); w.z = pk2(x1[0], x1[1]); w.w = pk2(x1[2], x1[3]); }
                  else if (key < 132) w = *(const v4u*)(VB + (size_t)(TP + b * 4 + key - 128) * 256 + kh * 64 + dc * 8);
                  LAS bf16* vp = (LAS bf16*)(Vl2 + (8 * dc) * AT_VROW + key * 2);
                  vp[0 * (AT_VROW / 2)] = (bf16)(w.x & 0xffff); vp[1 * (AT_VROW / 2)] = (bf16)(w.x >> 16); vp[2 * (AT_VROW / 2)] = (bf16)(w.y & 0xffff); vp[3 * (AT_VROW / 2)] = (bf16)(w.y >> 16);
                  vp[4 * (AT_VROW / 2)] = (bf16)(w.z & 0xffff); vp[5 * (AT_VROW / 2)] = (bf16)(w.z >> 16); vp[6 * (AT_VROW / 2)] = (bf16)(w.w & 0xffff); vp[7 * (AT_VROW / 2)] = (bf16)(w.w >> 16); }
            } } }
        __syncthreads();
        if (wave < 2) { const int su = su0 + wave * (int)gridDim.x;
            if (su < 512) { const int b = su >> 2, kh = su & 3;
                const int tok = fr & 3, g = fr >> 2, head = kh * 4 + g;
                const float slope = exp2f(-0.5f * (float)(head + 1)), sink = sinks[head];
                const size_t tq = (size_t)(TP + b * 4 + tok);
                attn_qtile<false>(Kl + wave * AT_SET, Vl + wave * AT_SET, 0, Q + tq * DM + head * 64 + 8 * fq, ATT + tq * DM + head * 64, tok, 128 + tok, slope, sink, fr, fq); } }
    }
}

#define XB_TMO      128
#define XB_XCNT(j)  (256  + 64 * (j))
#define XB_XSUB(j)  (1280 + 64 * (j))
#define XB_XGEN(j)  (2304 + 64 * (j))
#define XB_TOP      3328
#define XB_TOPGEN   3392
#define XCD_BAR_WORDS 3456
#define XB_SPIN_CAP (1u << 18)

__device__ __forceinline__ unsigned xb_ld(unsigned* p)              { return __hip_atomic_load(p, __ATOMIC_RELAXED, __HIP_MEMORY_SCOPE_AGENT); }
__device__ __forceinline__ unsigned xb_add(unsigned* p, unsigned v) { return __hip_atomic_fetch_add(p, v, __ATOMIC_RELAXED, __HIP_MEMORY_SCOPE_AGENT); }
__device__ __forceinline__ unsigned xb_xcc_id() { return (unsigned)__builtin_amdgcn_s_getreg((3 << 11) | 20) & 0xFu; }
#define XB_SPIN(cond, bar) do { unsigned _sp = 0; while (cond) { __builtin_amdgcn_s_sleep(1); \
    if ((++_sp & 255u) == 0u) { if (xb_ld(&(bar)[XB_TMO])) break; if (_sp > XB_SPIN_CAP) { atomicAdd(&(bar)[XB_TMO], 1u); break; } } } } while (0)

struct XcdBarrier {
    unsigned* bar; unsigned x;
    volatile LAS unsigned* st;
};

__device__ __forceinline__ XcdBarrier xcd_barrier_post(unsigned* bar, volatile LAS unsigned* st) {
    XcdBarrier b; b.bar = bar; b.x = xb_xcc_id(); b.st = st;
    if (threadIdx.x == 0) (void)xb_add(&bar[XB_XCNT(b.x)], 1u);
    return b;
}
__device__ __forceinline__ void xcd_barrier_complete(unsigned* bar, unsigned x, unsigned& nloc, unsigned& nx) {
    const unsigned G = gridDim.x * gridDim.y * gridDim.z;
    unsigned sum, cnt, mine, sp = 0u;
    for (;;) {
        sum = 0u; cnt = 0u; mine = 0u;
#pragma unroll
        for (unsigned j = 0; j < 16; ++j) { const unsigned c = xb_ld(&bar[XB_XCNT(j)]); sum += c; cnt += (c > 0u) ? 1u : 0u; mine = (j == x) ? c : mine; }
        if (sum == G) break;
        __builtin_amdgcn_s_sleep(1);
        if ((++sp & 255u) == 0u) { if (xb_ld(&bar[XB_TMO])) break; if (sp > XB_SPIN_CAP) { atomicAdd(&bar[XB_TMO], 1u); break; } }
    }
    nloc = mine > 0u ? mine : 1u; nx = cnt > 0u ? cnt : 1u;
}

__device__ __forceinline__ void xcd_barrier(const XcdBarrier& b) {
    asm volatile("s_waitcnt vmcnt(0)" ::: "memory");
    __syncthreads();
    if (threadIdx.x == 0) {
        unsigned* bar = b.bar;
        __builtin_amdgcn_s_waitcnt(0);
        unsigned nloc = b.st[0], nx = b.st[1];
        if (nloc == 0u) { xcd_barrier_complete(bar, b.x, nloc, nx); b.st[0] = nloc; b.st[1] = nx; }
        const unsigned old = xb_add(&bar[XB_XSUB(b.x)], 1u);
        const unsigned gen = old / nloc;
        if (old + 1u == (gen + 1u) * nloc) {
            __builtin_amdgcn_fence(__ATOMIC_RELEASE, "agent");
            asm volatile("s_waitcnt vmcnt(0)" ::: "memory");
            const unsigned og = xb_add(&bar[XB_TOP], 1u);
            const unsigned tg = og / nx;
            if (og + 1u == (tg + 1u) * nx) xb_add(&bar[XB_TOPGEN], 1u);
            else XB_SPIN(xb_ld(&bar[XB_TOPGEN]) == tg, bar);
            __builtin_amdgcn_fence(__ATOMIC_ACQUIRE, "agent");
            xb_add(&bar[XB_XGEN(b.x)], 1u);
            asm volatile("s_waitcnt vmcnt(0)" ::: "memory");
        } else {
            XB_SPIN(xb_ld(&bar[XB_XGEN(b.x)]) == gen, bar);
            __builtin_amdgcn_fence(__ATOMIC_ACQUIRE, "agent");
            asm volatile("s_waitcnt vmcnt(0)" ::: "memory");
        }
    }
    __syncthreads();
}

constexpr int CW_BAR = 4096;
constexpr int MISC_OFF = 163584;

#ifndef REP_PREP
#define REP_PREP 1
#endif
#ifndef REP_SCAN
#define REP_SCAN 1
#endif
#ifndef REP_ATTN
#define REP_ATTN 1
#endif
#ifndef REP_GIN
#define REP_GIN 1
#endif
#ifndef REP_GGU
#define REP_GGU 1
#endif
#ifndef REP_GQKV
#define REP_GQKV 1
#endif

__device__ __forceinline__ void small_res(const bf16* A, const bf16* Wt, int K, const float* bias, bf16* XBp, float* SSQp, LAS unsigned char* lds) {
    int tid_ = threadIdx.x; asm volatile("" : "+v"(tid_)); const int tid = tid_, lane = tid & 63, wave = __builtin_amdgcn_readfirstlane(tid >> 6);
    const int fr = lane & 15, fq = lane >> 4, rt = wave >> 2, ct = wave & 3;
    int bid_ = blockIdx.x; asm volatile("" : "+s"(bid_));
    constexpr int SRB = 49152;
    LAS float* red = (LAS float*)(lds + 3 * SRB);
    const int nc = K >> 8;
    for (int piece = bid_; piece < 256; piece += gridDim.x) {
        const int rb = piece >> 4, cc = piece & 15, m0 = TP + rb * 32 + rt * 16, n0 = cc * 64 + ct * 16;
        const unsigned char* src[6];
#pragma unroll
        for (int i = 0; i < 6; ++i) { const int p = 6 * wave + i, pr = (p < 16 ? p : p - 16), r = 2 * pr + (lane >> 5), pc = lane & 31;
            const bf16* rowp = (p < 16) ? A + (size_t)(TP + rb * 32 + r) * K : Wt + (size_t)(cc * 64 + r) * K;
            src[i] = (const unsigned char*)rowp + ((pc ^ (r & 15)) << 4); }
#define SR_DMA(chunk, buf) do { const int ch_ = (chunk) < nc ? (chunk) : nc - 1; _Pragma("unroll") for (int i = 0; i < 6; ++i) \
            __builtin_amdgcn_global_load_lds((const unsigned*)(src[i] + (size_t)ch_ * 512), (LAS unsigned*)(lds + (buf) * SRB + (6 * wave + i) * 1024), 16, 0, 0); } while (0)
        __syncthreads();
        SR_DMA(0, 0); SR_DMA(1, 1);
        f32x4 acc = (f32x4){0.f, 0.f, 0.f, 0.f};
        const int arow = rt * 16 + fr, wrow = ct * 16 + fr;
#pragma unroll 1
        for (int c = 0; c < nc; ++c) {
            const int bufc = c % 3, bufn = (c + 2) % 3;
            asm volatile("s_waitcnt vmcnt(6) lgkmcnt(0)" ::: "memory");
            __builtin_amdgcn_s_barrier();
            asm volatile("" ::: "memory");
            SR_DMA(c + 2, bufn);
            LAS unsigned char* ab_ = lds + bufc * SRB + arow * 512; LAS unsigned char* wb_ = lds + bufc * SRB + 16384 + wrow * 512;
            bf16x8_t af[8], wf[8];
#pragma unroll
            for (int ks = 0; ks < 8; ++ks) { af[ks] = *(LAS bf16x8_t*)(ab_ + (((ks * 4 + fq) ^ (arow & 15)) << 4)); wf[ks] = *(LAS bf16x8_t*)(wb_ + (((ks * 4 + fq) ^ (wrow & 15)) << 4)); }
#pragma unroll
            for (int ks = 0; ks < 8; ++ks) acc = __builtin_amdgcn_mfma_f32_16x16x32_bf16(wf[ks], af[ks], acc, 0, 0, 0);
        }
#undef SR_DMA
        asm volatile("s_waitcnt vmcnt(0)" ::: "memory");
        const int row = m0 + fr, col = n0 + 4 * fq;
        bf16* xp = XBp + (size_t)row * DM + col;
        const v2u xo = *(const v2u*)xp;
        f32x4 x = (f32x4){bflo(xo.x), bfhi(xo.x), bflo(xo.y), bfhi(xo.y)} + acc;
        if (bias) x = x + *(const f32x4*)(bias + col);
        v2u w; w.x = pk2(x[0], x[1]); w.y = pk2(x[2], x[3]);
        *(v2u*)xp = w;
        const float r0 = bflo(w.x), r1 = bfhi(w.x), r2 = bflo(w.y), r3 = bfhi(w.y);
        float s = (r0 * r0 + r1 * r1) + (r2 * r2 + r3 * r3);
        s += __shfl_xor(s, 16); s += __shfl_xor(s, 32);
        __syncthreads();
        if (fq == 0) red[wave * 16 + fr] = s;
        __syncthreads();
        if (ct == 0 && fq == 0) SSQp[(size_t)row * 16 + cc] = (red[(rt * 4) * 16 + fr] + red[(rt * 4 + 1) * 16 + fr]) + (red[(rt * 4 + 2) * 16 + fr] + red[(rt * 4 + 3) * 16 + fr]);
    }
}

__device__ __forceinline__ void small_in(const bf16* XBp, const bf16* Wt, const float* SSQp, bf16* proj, float* ba) {
    int tid_ = threadIdx.x; asm volatile("" : "+v"(tid_)); const int tid = tid_, lane = tid & 63, wave = __builtin_amdgcn_readfirstlane(tid >> 6);
    const int fr = lane & 15, fq = lane >> 4;
    int bid_ = blockIdx.x; asm volatile("" : "+s"(bid_));
    const int gw = bid_ * NWAVES + wave, NGW = gridDim.x * NWAVES;
    for (int task = gw; task < 2048; task += NGW) {
        const int rt = task >> 6, cg = task & 63, m0 = TP + 16 * rt, n0 = 96 * cg;
        const bf16* apx = XBp + (size_t)(m0 + fr) * DM + 8 * fq; const bf16* wpx = Wt + (size_t)(n0 + fr) * DM + 8 * fq;
        f32x4 acc[6];
#pragma unroll
        for (int t = 0; t < 6; ++t) acc[t] = (f32x4){0.f, 0.f, 0.f, 0.f};
#pragma unroll 1
        for (int k = 0; k < DM; k += 128) {
            bf16x8_t av[4], wv[4][6];
#pragma unroll
            for (int i = 0; i < 4; ++i) { av[i] = *(const bf16x8_t*)(apx + k + 32 * i);
#pragma unroll
                for (int t = 0; t < 6; ++t) wv[i][t] = *(const bf16x8_t*)(wpx + (size_t)(16 * t) * DM + k + 32 * i); }
#pragma unroll
            for (int i = 0; i < 4; ++i)
#pragma unroll
                for (int t = 0; t < 6; ++t) acc[t] = __builtin_amdgcn_mfma_f32_16x16x32_bf16(wv[i][t], av[i], acc[t], 0, 0, 0);
        }
        const int row = m0 + fr; const float rs = row_rstd(SSQp, row);
#pragma unroll
        for (int t = 0; t < 6; ++t) { v2u w; w.x = pk2(acc[t][0] * rs, acc[t][1] * rs); w.y = pk2(acc[t][2] * rs, acc[t][3] * rs);
            *(v2u*)(proj + (size_t)row * PROJ_LD + n0 + 16 * t + 4 * fq) = w; }
    }
    for (int task = gw; task < T / 16; task += NGW) {
        const int m0 = 16 * task;
        const bf16* apx = XBp + (size_t)(m0 + fr) * DM + 8 * fq; const bf16* wpx = Wt + (size_t)(6144 + fr) * DM + 8 * fq;
        f32x4 acc0 = (f32x4){0.f, 0.f, 0.f, 0.f}, acc1 = (f32x4){0.f, 0.f, 0.f, 0.f};
#pragma unroll 1
        for (int k = 0; k < DM; k += 256) {
            bf16x8_t av[8], w0[8], w1[8];
#pragma unroll
            for (int i = 0; i < 8; ++i) { av[i] = *(const bf16x8_t*)(apx + k + 32 * i); w0[i] = *(const bf16x8_t*)(wpx + k + 32 * i); w1[i] = *(const bf16x8_t*)(wpx + (size_t)16 * DM + k + 32 * i); }
#pragma unroll
            for (int i = 0; i < 8; ++i) { acc0 = __builtin_amdgcn_mfma_f32_16x16x32_bf16(w0[i], av[i], acc0, 0, 0, 0); acc1 = __builtin_amdgcn_mfma_f32_16x16x32_bf16(w1[i], av[i], acc1, 0, 0, 0); }
        }
        const int row = m0 + fr; const float rs = row_rstd(SSQp, row);
        *(f32x4*)(ba + (size_t)row * 32 + 4 * fq) = acc0 * rs; *(f32x4*)(ba + (size_t)row * 32 + 16 + 4 * fq) = acc1 * rs;
    }
}
template <class Epi>
__device__ __forceinline__ void run_gemm(LAS unsigned char* lds, const bf16* A, const bf16* Bt, int M, int N, int K, const Epi& E) {
    int c_ = blockIdx.x; asm volatile("" : "+s"(c_));
    pg8::Gemm g{A, Bt, M, N, K}; pg8::StaticOrder S; S.init(M, N, (int)gridDim.x, c_);
    pg8::gemm_phase<Epi, pg8::StaticOrder, true, true>(lds, g, S, E);
}

__global__ void __launch_bounds__(NTHREADS, 2) mk_fwd(Args a) {
    extern __shared__ __attribute__((aligned(16))) unsigned char lds_raw[];
    LAS unsigned char* lds = (LAS unsigned char*)lds_raw;
    unsigned char* ws0_ = kargs()->ws;
    for (int u = threadIdx.x; u < (LDS_BYTES - MISC_OFF) / 4; u += NTHREADS) ((LAS unsigned*)(lds + MISC_OFF))[u] = 0u;
    __syncthreads();
    (void)xcd_barrier_post((unsigned*)(ws0_ + WS_CTL) + CW_BAR, (volatile LAS unsigned*)(lds + MISC_OFF));
#ifndef BAR_REP
#define BAR_REP 1
#endif
#define GRID_BAR() do { for (int br_ = 0; br_ < BAR_REP; ++br_) { XcdBarrier b_; b_.bar = (unsigned*)(kargs()->ws + WS_CTL) + CW_BAR; b_.x = xb_xcc_id(); b_.st = (volatile LAS unsigned*)(lds + MISC_OFF); xcd_barrier(b_); } } while (0)

#ifndef REP_PROLOGUE
#define REP_PROLOGUE 1
#endif
    for (int rep = 0; rep < REP_PROLOGUE; ++rep) { if (rep) GRID_BAR(); phase_prologue(kargs(), lds); }
    GRID_BAR();
#pragma unroll 1
    for (int li = 0; li < 4; ++li) {
        const int j = li >> 1;
#define WSP (kargs()->ws)
#define XB ((bf16*)(WSP + WS_XB))
#define SSQ ((float*)(WSP + WS_SSQ))
        if ((li & 1) == 0) {
            for (int rep = 0; rep < REP_GIN; ++rep) { EpiDnIn E{(bf16*)(WSP + WS_PROJ), (float*)(WSP + WS_BA), SSQ, (LAS float*)(lds + 131072)};
              run_gemm(lds, XB, (const bf16*)(WSP + WS_WIN) + (size_t)j * DN_INP * DM, T, DN_INP, DM, E);
            GRID_BAR(); }
            for (int rep = 0; rep < REP_PREP; ++rep) { phase_dn_prep2(kargs(), j, lds);
            GRID_BAR(); }
            for (int rep = 0; rep < REP_SCAN; ++rep) { phase_dn_scan(kargs(), j, lds);
            GRID_BAR(); }
            { EpiRes E{XB, SSQ, nullptr};
              run_gemm(lds, (const bf16*)(WSP + WS_OG), (const bf16*)(WSP + WS_WOUT) + (size_t)j * DM * VAL_DIM, TP, DM, VAL_DIM, E); }
            small_res((const bf16*)(WSP + WS_OG), (const bf16*)(WSP + WS_WOUT) + (size_t)j * DM * VAL_DIM, VAL_DIM, nullptr, XB, SSQ, lds);
            GRID_BAR();
        } else {
            { EpiQkv E{(bf16*)(WSP + WS_Q), (bf16*)(WSP + WS_KB), SSQ, kargs()->in[16] + j * QKV_N,
                       kargs()->out + O_KP + (size_t)j * NB_P * 128 * 256, kargs()->out + O_KS + (size_t)j * NB_S * 4 * 256, (LAS float*)(lds + 131072)};
              run_gemm(lds, XB, (const bf16*)(WSP + WS_WQKV) + (size_t)j * QKV_N * DM, T, QKV_N, DM, E); }
            GRID_BAR();
            for (int rep = 0; rep < REP_ATTN; ++rep) { phase_swa_attn_mfma(kargs(), j, lds);
            GRID_BAR(); }
            { EpiRes E{XB, SSQ, kargs()->in[19] + j * DM};
              run_gemm(lds, (const bf16*)(WSP + WS_ATT), (const bf16*)(WSP + WS_WO) + (size_t)j * DM * DM, TP, DM, DM, E); }
            small_res((const bf16*)(WSP + WS_ATT), (const bf16*)(WSP + WS_WO) + (size_t)j * DM * DM, DM, kargs()->in[19] + j * DM, XB, SSQ, lds);
            GRID_BAR();
        }
        for (int rep = 0; rep < REP_GGU; ++rep) { EpiGu E{(bf16*)(WSP + WS_ACT), SSQ, (LAS float*)(lds + 131072)};
          run_gemm(lds, XB, (const bf16*)(WSP + WS_WGU) + (size_t)li * GU_N * DM, T, GU_N, DM, E);
        GRID_BAR(); }
        { EpiRes E{XB, SSQ, nullptr};
          run_gemm(lds, (const bf16*)(WSP + WS_ACT), (const bf16*)(WSP + WS_WDOWN) + (size_t)li * DM * DFF, TP, DM, DFF, E); }
        small_res((const bf16*)(WSP + WS_ACT), (const bf16*)(WSP + WS_WDOWN) + (size_t)li * DM * DFF, DFF, nullptr, XB, SSQ, lds);
        GRID_BAR();
    }
#undef WSP
#undef XB
#undef SSQ
    phase_final(kargs());
}

extern "C" void kernel_launch(void* const* d_in, const int* in_sizes, int n_in, void* d_out, int out_size, void* d_ws, size_t ws_size, hipStream_t stream) {
    static int grid = 0;
    if (grid == 0) {
        if (n_in != 22 || (size_t)out_size != O_END || ws_size < WS_END) { fprintf(stderr, "kernel_launch: unexpected shapes: n_in %d out %d ws %zu\n", n_in, out_size, ws_size); grid = -1; return; }
        int dev = 0, cus = 0, per_cu = 0;
        if (hipGetDevice(&dev) != hipSuccess || hipDeviceGetAttribute(&cus, hipDeviceAttributeMultiprocessorCount, dev) != hipSuccess) { grid = -1; return; }
        if (hipFuncSetAttribute((const void*)mk_fwd, hipFuncAttributeMaxDynamicSharedMemorySize, LDS_BYTES) != hipSuccess) { fprintf(stderr, "kernel_launch: hipFuncSetAttribute failed\n"); grid = -1; return; }
        if (hipOccupancyMaxActiveBlocksPerMultiprocessor(&per_cu, (const void*)mk_fwd, NTHREADS, LDS_BYTES) != hipSuccess || per_cu < 1) { fprintf(stderr, "kernel_launch: occupancy query reports %d blocks per CU\n", per_cu); (void)hipGetLastError(); }
        grid = cus;
    }
    if (grid < 0) return;
    (void)hipMemsetAsync((char*)d_ws + WS_CTL, 0, CTL_ZERO_BYTES, stream);
    Args a{};
    for (int i = 0; i < 22; ++i) a.in[i] = (const float*)d_in[i];
    a.out = (float*)d_out; a.ws = (unsigned char*)d_ws;
    hipLaunchKernelGGL(mk_fwd, dim3(grid), dim3(NTHREADS), LDS_BYTES, stream, a);
}
```
